# Optimizing an MI355X kernel written in HIP

```python
import jax, jax.numpy as jnp
from jax import lax
import numpy as np

D_MODEL = 2048
BATCH = 2
SEQ = 4096
DEPTH = 1

CHUNK = 64
MIX_WIDTH = D_MODEL
RWKV_WIDTH = MIX_WIDTH // 2
ATTN_WIDTH = MIX_WIDTH - RWKV_WIDTH
HEAD_DIM = 64
RWKV_HEADS = RWKV_WIDTH // HEAD_DIM
ATTN_HEADS = ATTN_WIDTH // HEAD_DIM
DECAY_LORA = 64
AAA_LORA = 64
GATE_LORA = 160
LEFT_CHUNKS = 8
BAND = (LEFT_CHUNKS + 1) * CHUNK
REL_CLIP = 128
N_REL = 2 * REL_CLIP + 1
N_GROUPS = 4
EXPERTS_PER_GROUP = 8
TOP_K = 2
EXPERT_HIDDEN = 512
RMS_EPS = 1e-6
GN_EPS = 64e-5
L2_EPS = 1e-12
NEG_INF = -1e30
SHIFT_WIDTH = 3 * RWKV_WIDTH + DECAY_LORA + AAA_LORA + GATE_LORA
PROJ_WIDTH = SHIFT_WIDTH + 3 * ATTN_WIDTH

kernel_name = "hymba_rwkv7_chunkattn_hiermoe_adaln"


def rms_norm(x, gain):
    xf = x.astype(jnp.float32)
    y = xf * lax.rsqrt(jnp.mean(xf * xf, axis=-1, keepdims=True) + RMS_EPS)
    return (y * gain.astype(jnp.float32)).astype(x.dtype)


def modulate(h, shift, scale):
    return h * (1 + scale[:, None, :]) + shift[:, None, :]


def token_shift(p, mu):
    p_prev = jnp.pad(p, ((0, 0), (1, 0), (0, 0)))[:, :-1]
    return p + (p_prev - p) * mu


def rwkv7_mix(p, mu_shift, w0, w_decay_up, a0, w_aaa_up, w_gate_up, k_k, k_a, r_k, ln_x_w, ln_x_b):
    B, T, _ = p.shape
    C, H, N = RWKV_WIDTH, RWKV_HEADS, HEAD_DIM
    p = token_shift(p, mu_shift)
    r = p[..., :C]
    k = p[..., C:2 * C]
    v = p[..., 2 * C:3 * C]
    o = 3 * C
    xw = p[..., o:o + DECAY_LORA]
    o += DECAY_LORA
    xa = p[..., o:o + AAA_LORA]
    o += AAA_LORA
    xg = p[..., o:o + GATE_LORA]
    w_log = -jax.nn.softplus(-(w0 + jnp.tanh(xw) @ w_decay_up)) - 0.5
    decay = jnp.exp(-jnp.exp(w_log.astype(jnp.float32)))
    a = jax.nn.sigmoid(a0 + xa @ w_aaa_up)
    g = jax.nn.sigmoid(xg) @ w_gate_up
    kk = (k * k_k).reshape(B, T, H, N).astype(jnp.float32)
    kk = kk / jnp.maximum(jnp.sqrt(jnp.sum(kk * kk, axis=-1, keepdims=True)), L2_EPS)
    k = k * (1 + (a - 1) * k_a)
    heads = lambda z: z.reshape(B, T, H, N).astype(jnp.float32)
    r_h, k_h, v_h, w_h, a_h = heads(r), heads(k), heads(v), heads(decay), heads(a)
    xs = tuple(jnp.moveaxis(z, 1, 0) for z in (r_h, w_h, k_h, v_h, kk, a_h))

    def step(S, inp):
        r_t, w_t, k_t, v_t, kk_t, a_t = inp
        sa = jnp.einsum('bhvk,bhk->bhv', S, -kk_t)
        S = (S * w_t[:, :, None, :] + sa[..., None] * (kk_t * a_t)[:, :, None, :]
             + v_t[..., None] * k_t[:, :, None, :])
        y = jnp.einsum('bhvk,bhk->bhv', S, r_t)
        return S, y

    S0 = jnp.zeros((B, H, N, N), jnp.float32)
    _, ys = lax.scan(step, S0, xs)
    y = jnp.moveaxis(ys, 0, 1)
    mean = jnp.mean(y, axis=-1, keepdims=True)
    var = jnp.mean(jnp.square(y - mean), axis=-1, keepdims=True)
    y = ((y - mean) * lax.rsqrt(var + GN_EPS)).reshape(B, T, C)
    y = y * ln_x_w.astype(jnp.float32) + ln_x_b.astype(jnp.float32)
    bonus = jnp.sum(r_h * k_h * r_k.astype(jnp.float32), axis=-1, keepdims=True) * v_h
    y = (y + bonus.reshape(B, T, C)) * g.astype(jnp.float32)
    return y.astype(p.dtype)


def chunk_band_attention(p, rel_bias):
    B, T, _ = p.shape
    H, Dh, W = ATTN_HEADS, HEAD_DIM, ATTN_WIDTH
    q = p[..., :W].reshape(B, T, H, Dh)
    k = p[..., W:2 * W].reshape(B, T, H, Dh)
    v = p[..., 2 * W:3 * W].reshape(B, T, H, Dh)
    pad = LEFT_CHUNKS * CHUNK
    kp = jnp.pad(k, ((0, 0), (pad, 0), (0, 0), (0, 0)))
    vp = jnp.pad(v, ((0, 0), (pad, 0), (0, 0), (0, 0)))
    n_chunks = T // CHUNK
    rel = jnp.arange(CHUNK)[:, None] - jnp.arange(BAND)[None, :] + pad
    rel_idx = jnp.clip(rel, -REL_CLIP, REL_CLIP) + REL_CLIP
    bias = rel_bias[:, rel_idx].astype(jnp.float32)
    scale = HEAD_DIM ** -0.5

    def one_chunk(i):
        start = i * CHUNK
        q_c = lax.dynamic_slice_in_dim(q, start, CHUNK, axis=1)
        k_c = lax.dynamic_slice_in_dim(kp, start, BAND, axis=1)
        v_c = lax.dynamic_slice_in_dim(vp, start, BAND, axis=1)
        s = jnp.einsum('bqhd,bkhd->bhqk', q_c, k_c).astype(jnp.float32) * scale + bias
        key_pos = start - pad + jnp.arange(BAND)
        s = jnp.where((key_pos >= 0)[None, None, None, :], s, NEG_INF)
        prob = jax.nn.softmax(s, axis=-1).astype(v_c.dtype)
        return jnp.einsum('bhqk,bkhd->bqhd', prob, v_c)

    out = lax.map(one_chunk, jnp.arange(n_chunks))
    return jnp.moveaxis(out, 0, 1).reshape(B, T, W)


def hier_moe(h, w_group, b_group, w_expert, b_expert, w_gate, w_up, w_down):
    B, T, D = h.shape
    t = h.reshape(B * T, D)
    gl = (t @ w_group).astype(jnp.float32) + b_group.astype(jnp.float32)
    gp = jax.nn.softmax(gl, axis=-1)
    g_idx = jnp.argmax(gl, axis=-1)
    g_w = jnp.take_along_axis(gp, g_idx[:, None], axis=1)
    el = jnp.einsum('nd,gde->nge', t, w_expert).astype(jnp.float32) + b_expert.astype(jnp.float32)
    el_sel = jnp.take_along_axis(el, g_idx[:, None, None], axis=1)[:, 0]
    ep = jax.nn.softmax(el_sel, axis=-1)
    top_p, top_i = lax.top_k(ep, TOP_K)
    top_p = top_p / jnp.sum(top_p, axis=-1, keepdims=True)
    e_w = jnp.sum(jax.nn.one_hot(top_i, EXPERTS_PER_GROUP, dtype=jnp.float32) * top_p[..., None], axis=1)
    comb = jax.nn.one_hot(g_idx, N_GROUPS, dtype=jnp.float32)[:, :, None] * (g_w * e_w)[:, None, :]
    y = jnp.zeros((B * T, D), jnp.float32)
    for gi in range(N_GROUPS):
        hg = jax.nn.silu(jnp.einsum('nd,edf->nef', t, w_gate[gi])) * jnp.einsum('nd,edf->nef', t, w_up[gi])
        hg = hg * comb[:, gi, :, None].astype(hg.dtype)
        y = y + jnp.einsum('nef,efd->nd', hg, w_down[gi]).astype(jnp.float32)
    return y.astype(h.dtype).reshape(B, T, D)


def setup_inputs(seed: int = 0) -> dict:
    key = jax.random.key(seed)
    ks = iter(jax.random.split(key, 40))
    nrm = lambda shape, s: jax.random.normal(next(ks), shape, jnp.float32) * s
    L, D, C = DEPTH, D_MODEL, RWKV_WIDTH
    G, E, F = N_GROUPS, EXPERTS_PER_GROUP, EXPERT_HIDDEN
    return {
        "x": nrm((BATCH, SEQ, D), 1.0),
        "c": nrm((BATCH, D), 1.0),
        "w_ada": nrm((L, D, 6 * D), 0.3 * D ** -0.5),
        "b_ada": nrm((L, 6 * D), 0.02),
        "norm1_g": 1.0 + nrm((L, D), 0.02),
        "w_in": nrm((L, D, PROJ_WIDTH), D ** -0.5),
        "mu_shift": jax.random.uniform(next(ks), (L, SHIFT_WIDTH), jnp.float32),
        "w0": jax.random.uniform(next(ks), (L, C), jnp.float32, -6.0, 1.0),
        "w_decay_up": nrm((L, DECAY_LORA, C), 0.5 * DECAY_LORA ** -0.5),
        "a0": nrm((L, C), 0.5),
        "w_aaa_up": nrm((L, AAA_LORA, C), 0.5 * AAA_LORA ** -0.5),
        "w_gate_up": nrm((L, GATE_LORA, C), GATE_LORA ** -0.5),
        "k_k": 0.85 + nrm((L, C), 0.1),
        "k_a": 1.0 + nrm((L, C), 0.1),
        "r_k": nrm((L, RWKV_HEADS, HEAD_DIM), 0.1),
        "ln_x_w": 1.0 + nrm((L, C), 0.02),
        "ln_x_b": nrm((L, C), 0.02),
        "rel_bias": nrm((L, ATTN_HEADS, N_REL), 0.5),
        "beta_rwkv": 1.0 + nrm((L, RWKV_WIDTH), 0.02),
        "beta_attn": 1.0 + nrm((L, ATTN_WIDTH), 0.02),
        "w_out": nrm((L, MIX_WIDTH, D), MIX_WIDTH ** -0.5),
        "norm2_g": 1.0 + nrm((L, D), 0.02),
        "w_group": nrm((L, D, G), D ** -0.5),
        "b_group": nrm((L, G), 0.01),
        "w_expert": nrm((L, G, D, E), D ** -0.5),
        "b_expert": nrm((L, G, E), 0.01),
        "w_gate": nrm((L, G, E, D, F), D ** -0.5),
        "w_up": nrm((L, G, E, D, F), D ** -0.5),
        "w_down": nrm((L, G, E, F, D), F ** -0.5),
        "norm_f_g": 1.0 + nrm((D,), 0.02),
    }


def reference(x, c, w_ada, b_ada, norm1_g, w_in, mu_shift, w0, w_decay_up, a0, w_aaa_up,
              w_gate_up, k_k, k_a, r_k, ln_x_w, ln_x_b, rel_bias, beta_rwkv, beta_attn,
              w_out, norm2_g, w_group, b_group, w_expert, b_expert, w_gate, w_up, w_down,
              norm_f_g):
    c_act = jax.nn.silu(c)
    for l in range(DEPTH):
        mod = c_act @ w_ada[l] + b_ada[l]
        shift1, scale1, gate1, shift2, scale2, gate2 = jnp.split(mod, 6, axis=-1)
        h = modulate(rms_norm(x, norm1_g[l]), shift1, scale1)
        p = h @ w_in[l]
        y_r = rwkv7_mix(p[..., :SHIFT_WIDTH], mu_shift[l], w0[l], w_decay_up[l], a0[l],
                        w_aaa_up[l], w_gate_up[l], k_k[l], k_a[l], r_k[l], ln_x_w[l], ln_x_b[l])
        y_a = chunk_band_attention(p[..., SHIFT_WIDTH:], rel_bias[l])
        y = jnp.concatenate([y_r * beta_rwkv[l], y_a * beta_attn[l]], axis=-1) @ w_out[l]
        x = x + gate1[:, None, :] * y
        h2 = modulate(rms_norm(x, norm2_g[l]), shift2, scale2)
        f = hier_moe(h2, w_group[l], b_group[l], w_expert[l], b_expert[l],
                     w_gate[l], w_up[l], w_down[l])
        x = x + gate2[:, None, :] * f
    return rms_norm(x, norm_f_g)
```

```cpp
#include <hip/hip_runtime.h>
#include <hip/hip_bf16.h>
#include <cstdio>
#include <cstdint>

constexpr int NWAVES = 8, NTHR = 512;
constexpr int BATCH = 2, SEQ = 4096, DM = 2048, MTOK = BATCH * SEQ;
constexpr int CW = 1024, NHEAD = 16, HD = 64;
constexpr int SHIFTW = 3360, PROJW = 6432, PROJP = 6656;
constexpr int LORA_K = 384, LORA_N = 3072;
constexpr int NEXP = 32, FF = 512;
constexpr int MAXSLOT = 24576;
constexpr float RMS_EPS = 1e-6f, GN_EPS = 64e-5f;
constexpr float LOG2E = 1.4426950408889634f;

constexpr size_t MiB = 1u << 20;
constexpr size_t WS_CTL = 0, CTL_ZERO_BYTES = 1 * MiB;
constexpr size_t WS_MOD = 1 * MiB;
constexpr size_t WS_ROUTE = 1 * MiB + 128 * 1024;
constexpr size_t WS_SW = 1 * MiB + 512 * 1024;
constexpr size_t WS_WIN = 2 * MiB;
constexpr size_t WS_WOUT = 28 * MiB;
constexpr size_t WS_WL = 36 * MiB;
constexpr size_t WS_WGU = 39 * MiB;
constexpr size_t WS_WD = 167 * MiB;
constexpr size_t B0 = 231 * MiB;
constexpr size_t WS_P = B0;
constexpr size_t WS_HB = B0 + 104 * MiB;
constexpr size_t WS_AL = B0 + 136 * MiB;
constexpr size_t WS_LW = B0 + 142 * MiB;
constexpr size_t WS_AA = B0 + 174 * MiB;
constexpr size_t WS_GG = B0 + 190 * MiB;
constexpr size_t WS_R = B0 + 206 * MiB, WS_K2 = B0 + 222 * MiB, WS_V = B0 + 238 * MiB, WS_KK = B0 + 254 * MiB, WS_BB = B0 + 270 * MiB;
constexpr size_t WS_YMIX = B0 + 286 * MiB;
constexpr size_t WS_X1 = B0;
constexpr size_t WS_H2P = B0 + 136 * MiB;
constexpr size_t WS_HG = B0 + 232 * MiB;
constexpr size_t WS_FP = B0 + 136 * MiB;
constexpr size_t WS_END = B0 + 318 * MiB;
constexpr int CW_CNT = 1024, CW_POS = 1088, CW_NRT = 1152, CW_TE = 1280, CW_BAR = 4096;

constexpr int RING_BYTES = 131072;
constexpr int LDSCTL_OFF = RING_BYTES, MISC_OFF = LDSCTL_OFF + 320;
constexpr int LDS_BYTES = 147456;

#define GAS __attribute__((address_space(1)))
#define LAS __attribute__((address_space(3)))
typedef unsigned short bf16;
typedef unsigned v4u __attribute__((ext_vector_type(4)));
typedef unsigned v2u __attribute__((ext_vector_type(2)));
typedef float f32x4 __attribute__((ext_vector_type(4)));
typedef short bf16x8 __attribute__((ext_vector_type(8)));
typedef short s16x4 __attribute__((ext_vector_type(4)));
typedef GAS unsigned gu32;
typedef GAS unsigned long long gu64;
#define RLX_AGENT __ATOMIC_RELAXED, __HIP_MEMORY_SCOPE_AGENT
#define LDS_WAIT() asm volatile("s_waitcnt lgkmcnt(0)" ::: "memory")
#define VM_WAIT() asm volatile("s_waitcnt vmcnt(0)" ::: "memory")
__device__ __forceinline__ unsigned f2bf(float f) { unsigned u = __builtin_bit_cast(unsigned, f); return (u + 0x7fffu + ((u >> 16) & 1u)) >> 16; }
__device__ __forceinline__ unsigned pk2(float lo, float hi) { return f2bf(lo) | (f2bf(hi) << 16); }
__device__ __forceinline__ float bflo(unsigned u) { return __builtin_bit_cast(float, u << 16); }
__device__ __forceinline__ float bfhi(unsigned u) { return __builtin_bit_cast(float, u & 0xffff0000u); }
__device__ __forceinline__ float wave_sum(float v) {
#pragma unroll
    for (int o = 1; o < 64; o <<= 1) v += __shfl_xor(v, o);
    return v;
}
__device__ __forceinline__ float sigmoid_f(float x) { return 1.f / (1.f + __expf(-x)); }
namespace pg8 {
#define PG8_LAS __attribute__((address_space(3)))
typedef unsigned short bf16_t;
typedef short bf16x8 __attribute__((ext_vector_type(8)));
typedef float f32x4 __attribute__((ext_vector_type(4)));
typedef unsigned u32x4 __attribute__((ext_vector_type(4)));
constexpr int BM = 256, BK = 64, HALF = 128, HTB = HALF * BK * 2  , STAGE_BYTES = 8 * HTB, NXCD = 8, WGM = 8;

__host__ __device__ __forceinline__ int lds_byte(int r, int c) { const int st = (r >> 4) * 2 + (c >> 5), rr = r & 15, cc = c & 31, ob = rr * 64 + cc * 2; return st * 1024 + (ob ^ (((ob >> 9) & 1) << 5)); }
__host__ __device__ __forceinline__ void stage_rc(int b, int& R, int& C) { const int st = b / 1024, sb = b % 1024, swz = sb ^ (((sb >> 9) & 1) << 5); R = (st >> 1) * 16 + swz / 64; C = (st & 1) * 32 + (swz % 64) / 2; }
__host__ __device__ __forceinline__ int perm32(int rho) { const int n = rho >> 4, i = rho & 15; return 8 * (i >> 2) + 4 * n + (i & 3); }

struct Unit { int pm, pn; };
struct Gemm { const bf16_t* A; const bf16_t* Bt; int M, N, K; };

struct StaticOrder {
    int nM, nN, nwg, G, c;
    __host__ __device__ void init(int M, int N, int G_, int c_) { nM = M / BM; nN = N / BM; nwg = nM * nN; G = G_; c = c_; }
    __host__ __device__ bool next(int i, Unit& u) const {
        const long L = (long)i * G + c; if (L >= nwg) return false;
        int wgid = (int)L; { const int q = nwg / NXCD, r = nwg % NXCD, xcd = wgid % NXCD, off = wgid / NXCD; wgid = (xcd < r ? xcd * (q + 1) : r * (q + 1) + (xcd - r) * q) + off; }
        const int nig = WGM * nN, gid = wgid / nig, fm = gid * WGM, gsz = (nM - fm) < WGM ? (nM - fm) : WGM;
        u.pm = fm + ((wgid % nig) % gsz); u.pn = (wgid % nig) / gsz; return true;
    }
    __device__ __forceinline__ void a_ready(const Unit&) const {}
    __device__ __forceinline__ void done(const Unit&) const {}
};

__device__ __forceinline__ unsigned cvt_pk_bf16(float lo, float hi) { unsigned r; asm volatile("v_cvt_pk_bf16_f32 %0, %1, %2" : "=v"(r) : "v"(lo), "v"(hi)); return r; }
template <class Epi, class Sched, bool ALIGN_EPI = false, bool SP2 = false>
__device__ __forceinline__ void gemm_phase(PG8_LAS unsigned char* lds, const Gemm g, const Sched& S, const Epi& E) {
    const int tid = threadIdx.x, wid = __builtin_amdgcn_readfirstlane(tid >> 6), lane = tid & 63, wr = wid >> 2, wc = wid & 3, fr = lane & 15, fq = lane >> 4;
    const int K = g.K, nt = K / BK;
    unsigned voffA[2], voffB[2];
#pragma unroll
    for (int i = 0; i < 2; ++i) { int R, C; stage_rc(tid * 16 + i * 8192, R, C); const int Rb = Epi::PERM ? ((R & ~31) + perm32(R & 31)) : R;
        voffA[i] = (unsigned)(R * K + C) * 2u; voffB[i] = (unsigned)(Rb * K + C) * 2u; }
    const size_t kstep = (size_t)(BK * 2);
    const size_t hstep = (size_t)HALF * K * 2;
    const size_t tstep = 2 * hstep;
    const unsigned ldsw = (unsigned)wid * 1024u;
    const int aoff = lds_byte(wr * 64 + fr, fq * 8), boff = lds_byte(wc * 32 + fr, fq * 8);
#define PG8_SA(b, h) (((b) * 2 + (h)) * HTB)
#define PG8_SB(b, h) ((4 + (b) * 2 + (h)) * HTB)
#define PG8_STAGE(bufoff, gbase, voff) do { _Pragma("unroll") for (int _i = 0; _i < 2; ++_i) \
        __builtin_amdgcn_global_load_lds((const unsigned*)((const char*)(gbase) + (voff)[_i]), (PG8_LAS unsigned*)(lds + (bufoff) + ldsw + _i * 8192), 16, 0, 0); } while (0)
#define PG8_LDA(dst, b, h) do { _Pragma("unroll") for (int m = 0; m < 4; ++m) _Pragma("unroll") for (int k = 0; k < 2; ++k) dst[m][k] = *(const PG8_LAS bf16x8*)(lds + PG8_SA(b, h) + aoff + m * 2048 + k * 1024); } while (0)
#define PG8_LDB(dst, b, h) do { _Pragma("unroll") for (int n = 0; n < 2; ++n) _Pragma("unroll") for (int k = 0; k < 2; ++k) dst[n][k] = *(const PG8_LAS bf16x8*)(lds + PG8_SB(b, h) + boff + n * 2048 + k * 1024); } while (0)
#define PG8_MMA(ai, bj, At, Bt) do { __builtin_amdgcn_s_setprio(1); _Pragma("unroll") for (int m = 0; m < 4; ++m) _Pragma("unroll") for (int n = 0; n < 2; ++n) _Pragma("unroll") for (int k = 0; k < 2; ++k) \
        acc[ai][bj][m][n] = __builtin_amdgcn_mfma_f32_16x16x32_bf16(Bt[n][k], At[m][k], acc[ai][bj][m][n], 0, 0, 0); __builtin_amdgcn_s_setprio(0); } while (0)
#define PG8_WAIT_V(n) asm volatile("s_waitcnt vmcnt(" #n ")" ::: "memory")
#define PG8_WAIT_L(n) asm volatile("s_waitcnt lgkmcnt(" #n ")" ::: "memory")
#define PG8_BAR __builtin_amdgcn_s_barrier()
#define PG8_SCHED __builtin_amdgcn_sched_barrier(0)
    Unit cur, nxt; int ui = 0;
    if (!S.next(0, cur)) return;
    f32x4 acc[2][2][4][2];
#pragma unroll
    for (int a = 0; a < 2; ++a)
#pragma unroll
        for (int b = 0; b < 2; ++b)
#pragma unroll
            for (int m = 0; m < 4; ++m)
#pragma unroll
                for (int n = 0; n < 2; ++n) acc[a][b][m][n] = (f32x4){0.f, 0.f, 0.f, 0.f};
    bf16x8 At[4][2], B0[2][2], B1[2][2];
    const char* cA = (const char*)g.A + (size_t)cur.pm * tstep; const char* cB = (const char*)g.Bt + (size_t)cur.pn * tstep;
    S.a_ready(cur);
    if constexpr (SP2) {
        PG8_STAGE(PG8_SB(0, 0), cB, voffB); PG8_STAGE(PG8_SB(0, 1), cB + hstep, voffB); PG8_STAGE(PG8_SA(0, 0), cA, voffA); PG8_STAGE(PG8_SA(0, 1), cA + hstep, voffA);
        if (wr == 1) PG8_BAR;
        PG8_WAIT_V(2); PG8_BAR;
        PG8_STAGE(PG8_SB(1, 0), cB + kstep, voffB); PG8_STAGE(PG8_SA(1, 0), cA + kstep, voffA); PG8_STAGE(PG8_SB(1, 1), cB + hstep + kstep, voffB);
        PG8_WAIT_V(6); PG8_BAR;
    } else {
        PG8_STAGE(PG8_SB(0, 0), cB, voffB); PG8_STAGE(PG8_SA(0, 0), cA, voffA); PG8_STAGE(PG8_SB(0, 1), cB + hstep, voffB); PG8_STAGE(PG8_SA(0, 1), cA + hstep, voffA);
        if (wr == 1) PG8_BAR;
        PG8_WAIT_V(4); PG8_BAR;
        PG8_STAGE(PG8_SB(1, 0), cB + kstep, voffB); PG8_STAGE(PG8_SA(1, 0), cA + kstep, voffA); PG8_STAGE(PG8_SB(1, 1), cB + hstep + kstep, voffB);
        PG8_WAIT_V(6); PG8_BAR;
    }
    for (;;) {
        const bool has_next = S.next(ui + 1, nxt);
        const char* nA = has_next ? (const char*)g.A + (size_t)nxt.pm * tstep : cA; const char* nB = has_next ? (const char*)g.Bt + (size_t)nxt.pn * tstep : cB;
        for (int t = 0; t < nt; t += 2) {
            const bool last = (t == nt - 2);
            const char* a1 = cA + (size_t)(t + 1) * kstep;
            const char* a2 = last ? nA : cA + (size_t)(t + 2) * kstep; const char* b2 = last ? nB : cB + (size_t)(t + 2) * kstep;
            const char* a3 = a2 + kstep; const char* b3 = b2 + kstep;
            if (last && has_next) S.a_ready(nxt);
            if constexpr (SP2) {
            PG8_LDB(B0, 0, 0); PG8_LDB(B1, 0, 1); PG8_SCHED; PG8_LDA(At, 0, 0); PG8_STAGE(PG8_SA(1, 1), a1 + hstep, voffA);
            PG8_WAIT_V(8); PG8_WAIT_L(0); PG8_BAR; PG8_MMA(0, 0, At, B0); PG8_MMA(0, 1, At, B1); PG8_BAR; PG8_SCHED;
            PG8_LDA(At, 0, 1); PG8_STAGE(PG8_SB(0, 0), b2, voffB); PG8_STAGE(PG8_SB(0, 1), b2 + hstep, voffB); PG8_STAGE(PG8_SA(0, 0), a2, voffA);
            PG8_WAIT_V(8); PG8_WAIT_L(0); PG8_BAR; PG8_MMA(1, 0, At, B0); PG8_MMA(1, 1, At, B1); PG8_BAR; PG8_SCHED;
            PG8_LDB(B0, 1, 0); PG8_LDB(B1, 1, 1); PG8_SCHED; PG8_LDA(At, 1, 0); PG8_STAGE(PG8_SA(0, 1), a2 + hstep, voffA);
            PG8_WAIT_V(8); PG8_WAIT_L(0); PG8_BAR; PG8_MMA(0, 0, At, B0); PG8_MMA(0, 1, At, B1); PG8_BAR; PG8_SCHED;
            PG8_LDA(At, 1, 1); PG8_STAGE(PG8_SB(1, 0), b3, voffB); PG8_STAGE(PG8_SB(1, 1), b3 + hstep, voffB); PG8_STAGE(PG8_SA(1, 0), a3, voffA);
            PG8_WAIT_V(8); PG8_WAIT_L(0); PG8_BAR; PG8_MMA(1, 0, At, B0); PG8_MMA(1, 1, At, B1); PG8_BAR; PG8_SCHED;
            } else {
            PG8_LDB(B0, 0, 0); PG8_SCHED; PG8_LDA(At, 0, 0); PG8_STAGE(PG8_SA(1, 1), a1 + hstep, voffA);
            PG8_WAIT_L(8); PG8_BAR; PG8_WAIT_L(0); PG8_MMA(0, 0, At, B0); PG8_BAR; PG8_SCHED;
            PG8_LDB(B1, 0, 1); PG8_STAGE(PG8_SB(0, 0), b2, voffB);
            PG8_BAR; PG8_WAIT_L(0); PG8_MMA(0, 1, At, B1); PG8_BAR;
            PG8_LDA(At, 0, 1); PG8_STAGE(PG8_SA(0, 0), a2, voffA);
            PG8_BAR; PG8_WAIT_L(0); PG8_MMA(1, 0, At, B0); PG8_BAR; PG8_SCHED;
            PG8_STAGE(PG8_SB(0, 1), b2 + hstep, voffB);
            PG8_WAIT_V(6); PG8_BAR; PG8_MMA(1, 1, At, B1); PG8_BAR;
            PG8_LDB(B0, 1, 0); PG8_SCHED; PG8_LDA(At, 1, 0); PG8_STAGE(PG8_SA(0, 1), a2 + hstep, voffA);
            PG8_WAIT_L(8); PG8_BAR; PG8_WAIT_L(0); PG8_MMA(0, 0, At, B0); PG8_BAR; PG8_SCHED;
            PG8_LDB(B1, 1, 1); PG8_STAGE(PG8_SB(1, 0), b3, voffB);
            PG8_BAR; PG8_WAIT_L(0); PG8_MMA(0, 1, At, B1); PG8_BAR;
            PG8_LDA(At, 1, 1); PG8_STAGE(PG8_SA(1, 0), a3, voffA);
            PG8_BAR; PG8_WAIT_L(0); PG8_MMA(1, 0, At, B0); PG8_BAR; PG8_SCHED;
            PG8_STAGE(PG8_SB(1, 1), b3 + hstep, voffB);
            PG8_WAIT_V(6); PG8_BAR; PG8_MMA(1, 1, At, B1); PG8_BAR;
            }
        }
        if constexpr (ALIGN_EPI) { if (wr == 0) PG8_BAR; }
        if constexpr (!Epi::AFTER_DRAIN) { E(acc, cur, wr, wc, fr, fq); S.done(cur); }
        if (!has_next) break;
#pragma unroll
        for (int a = 0; a < 2; ++a)
#pragma unroll
            for (int b = 0; b < 2; ++b)
#pragma unroll
                for (int m = 0; m < 4; ++m)
#pragma unroll
                    for (int n = 0; n < 2; ++n) acc[a][b][m][n] = (f32x4){0.f, 0.f, 0.f, 0.f};
        cur = nxt; cA = nA; cB = nB; ++ui;
        if constexpr (ALIGN_EPI) { if (wr == 1) PG8_BAR; }
    }
    PG8_WAIT_V(0);
    if constexpr (!ALIGN_EPI) { if (wr == 0) PG8_BAR; }
    PG8_BAR;
    if constexpr (Epi::AFTER_DRAIN) { E.fused(acc, cur, wr, wc, fr, fq, lds, wid, lane); S.done(cur); }
#undef PG8_SA
#undef PG8_SB
#undef PG8_STAGE
#undef PG8_LDA
#undef PG8_LDB
#undef PG8_MMA
#undef PG8_WAIT_V
#undef PG8_WAIT_L
#undef PG8_BAR
#undef PG8_SCHED
}
}
#define XB_TMO      128
#define XB_XCNT(j)  (256  + 64 * (j))
#define XB_XSUB(j)  (1280 + 64 * (j))
#define XB_XGEN(j)  (2304 + 64 * (j))
#define XB_TOP      3328
#define XB_TOPGEN   3392
#define XCD_BAR_WORDS 3456
#define XB_SPIN_CAP (1u << 18)

__device__ __forceinline__ unsigned xb_ld(unsigned* p)              { return __hip_atomic_load(p, __ATOMIC_RELAXED, __HIP_MEMORY_SCOPE_AGENT); }
__device__ __forceinline__ unsigned xb_add(unsigned* p, unsigned v) { return __hip_atomic_fetch_add(p, v, __ATOMIC_RELAXED, __HIP_MEMORY_SCOPE_AGENT); }
__device__ __forceinline__ unsigned xb_xcc_id() { return (unsigned)__builtin_amdgcn_s_getreg((3 << 11) | 20) & 0xFu; }
#define XB_SPIN(cond, bar) do { unsigned _sp = 0; while (cond) { __builtin_amdgcn_s_sleep(1); \
    if ((++_sp & 255u) == 0u) { if (xb_ld(&(bar)[XB_TMO])) break; if (_sp > XB_SPIN_CAP) { atomicAdd(&(bar)[XB_TMO], 1u); break; } } } } while (0)

struct XcdBarrier {
    unsigned* bar; unsigned x;
    volatile LAS unsigned* st;
};

__device__ __forceinline__ XcdBarrier xcd_barrier_post(unsigned* bar, volatile LAS unsigned* st) {
    XcdBarrier b; b.bar = bar; b.x = xb_xcc_id(); b.st = st;
    if (threadIdx.x == 0) (void)xb_add(&bar[XB_XCNT(b.x)], 1u);
    return b;
}
__device__ __forceinline__ void xcd_barrier_complete(unsigned* bar, unsigned x, unsigned& nloc, unsigned& nx) {
    const unsigned G = gridDim.x * gridDim.y * gridDim.z;
    unsigned sum, cnt, mine, sp = 0u;
    for (;;) {
        sum = 0u; cnt = 0u; mine = 0u;
#pragma unroll
        for (unsigned j = 0; j < 16; ++j) { const unsigned c = xb_ld(&bar[XB_XCNT(j)]); sum += c; cnt += (c > 0u) ? 1u : 0u; mine = (j == x) ? c : mine; }
        if (sum == G) break;
        __builtin_amdgcn_s_sleep(1);
        if ((++sp & 255u) == 0u) { if (xb_ld(&bar[XB_TMO])) break; if (sp > XB_SPIN_CAP) { atomicAdd(&bar[XB_TMO], 1u); break; } }
    }
    nloc = mine > 0u ? mine : 1u; nx = cnt > 0u ? cnt : 1u;
}

__device__ __forceinline__ void xcd_barrier(const XcdBarrier& b) {
    asm volatile("s_waitcnt vmcnt(0)" ::: "memory");
    __syncthreads();
    if (threadIdx.x == 0) {
        unsigned* bar = b.bar;
        __builtin_amdgcn_s_waitcnt(0);
        unsigned nloc = b.st[0], nx = b.st[1];
        if (nloc == 0u) { xcd_barrier_complete(bar, b.x, nloc, nx); b.st[0] = nloc; b.st[1] = nx; }
        const unsigned old = xb_add(&bar[XB_XSUB(b.x)], 1u);
        const unsigned gen = old / nloc;
        if (old + 1u == (gen + 1u) * nloc) {
            __builtin_amdgcn_fence(__ATOMIC_RELEASE, "agent");
            asm volatile("s_waitcnt vmcnt(0)" ::: "memory");
            const unsigned og = xb_add(&bar[XB_TOP], 1u);
            const unsigned tg = og / nx;
            if (og + 1u == (tg + 1u) * nx) xb_add(&bar[XB_TOPGEN], 1u);
            else XB_SPIN(xb_ld(&bar[XB_TOPGEN]) == tg, bar);
            __builtin_amdgcn_fence(__ATOMIC_ACQUIRE, "agent");
            xb_add(&bar[XB_XGEN(b.x)], 1u);
            asm volatile("s_waitcnt vmcnt(0)" ::: "memory");
        } else {
            XB_SPIN(xb_ld(&bar[XB_XGEN(b.x)]) == gen, bar);
            __builtin_amdgcn_fence(__ATOMIC_ACQUIRE, "agent");
            asm volatile("s_waitcnt vmcnt(0)" ::: "memory");
        }
    }
    __syncthreads();
}

struct EpiStoreBf16 {
    static constexpr bool PERM = true, AFTER_DRAIN = false;
    bf16* O; int ldc; int pn_mask;
    __device__ __forceinline__ void operator()(const pg8::f32x4 (&acc)[2][2][4][2], const pg8::Unit& u, int wr, int wc, int fr_, int fq_) const {
        int t_ = threadIdx.x; asm volatile("" : "+v"(t_)); const int fr = t_ & 15, fq = (t_ >> 4) & 3; (void)fr_; (void)fq_;
        const int row0 = u.pm * 256 + wr * 64 + fr, col0 = (u.pn & pn_mask) * 256 + wc * 32 + 8 * fq;
#pragma unroll
        for (int ai = 0; ai < 2; ++ai)
#pragma unroll
            for (int m = 0; m < 4; ++m) { bf16* rowp = O + (size_t)(row0 + ai * 128 + m * 16) * ldc + col0;
#pragma unroll
                for (int bj = 0; bj < 2; ++bj) { const pg8::f32x4 v0 = acc[ai][bj][m][0], v1 = acc[ai][bj][m][1];
                    v4u w; w.x = pg8::cvt_pk_bf16(v0[0], v0[1]); w.y = pg8::cvt_pk_bf16(v0[2], v0[3]); w.z = pg8::cvt_pk_bf16(v1[0], v1[1]); w.w = pg8::cvt_pk_bf16(v1[2], v1[3]);
                    *(v4u*)(rowp + bj * 128) = w; } }
    }
};
struct EpiGateUp {
    static constexpr bool PERM = true, AFTER_DRAIN = false;
    const float* sw; bf16* HG;
    __device__ __forceinline__ void operator()(const pg8::f32x4 (&acc)[2][2][4][2], const pg8::Unit& u, int wr, int wc, int fr_, int fq_) const {
        int t_ = threadIdx.x; asm volatile("" : "+v"(t_)); const int fr = t_ & 15, fq = (t_ >> 4) & 3; (void)fr_; (void)fq_;
        const int pl = u.pn & 3, row0 = u.pm * 256 + wr * 64 + fr, col0 = pl * 128 + wc * 32 + 8 * fq;
#pragma unroll
        for (int ai = 0; ai < 2; ++ai)
#pragma unroll
            for (int m = 0; m < 4; ++m) { const int row = row0 + ai * 128 + m * 16; const float w = sw[row]; float h[8];
#pragma unroll
                for (int n = 0; n < 2; ++n)
#pragma unroll
                    for (int j = 0; j < 4; ++j) { const float g = acc[ai][0][m][n][j], up = acc[ai][1][m][n][j]; h[4 * n + j] = g * sigmoid_f(g) * up * w; }
                v4u o; o.x = pg8::cvt_pk_bf16(h[0], h[1]); o.y = pg8::cvt_pk_bf16(h[2], h[3]); o.z = pg8::cvt_pk_bf16(h[4], h[5]); o.w = pg8::cvt_pk_bf16(h[6], h[7]);
                *(v4u*)(HG + (size_t)row * FF + col0) = o; }
    }
};
struct EpiResGate {
    static constexpr bool PERM = false, AFTER_DRAIN = false;
    const float* x; const float* gate; float* X1;
    __device__ __forceinline__ void operator()(const pg8::f32x4 (&acc)[2][2][4][2], const pg8::Unit& u, int wr, int wc, int fr_, int fq_) const {
        int t_ = threadIdx.x; asm volatile("" : "+v"(t_)); const int fr = t_ & 15, fq = (t_ >> 4) & 3; (void)fr_; (void)fq_;
        const int row0 = u.pm * 256 + wr * 64 + fr, col0 = u.pn * 256 + wc * 32 + 4 * fq;
        const float* gp = gate + (size_t)((u.pm * 256) >> 12) * 12288;
#pragma unroll
        for (int bj = 0; bj < 2; ++bj)
#pragma unroll
            for (int n = 0; n < 2; ++n) { const int c = col0 + bj * 128 + n * 16; const pg8::f32x4 gv = *(const pg8::f32x4*)(gp + c);
#pragma unroll
                for (int ai = 0; ai < 2; ++ai)
#pragma unroll
                    for (int m = 0; m < 4; ++m) { const size_t off = (size_t)(row0 + ai * 128 + m * 16) * DM + c;
                        const pg8::f32x4 xv = *(const pg8::f32x4*)(x + off); *(pg8::f32x4*)(X1 + off) = xv + gv * acc[ai][bj][m][n]; } }
    }
};
struct EpiLora {
    static constexpr bool PERM = false, AFTER_DRAIN = false;
    const float* w0; const float* a0; float* LW; bf16* AA; bf16* GG;
    __device__ __forceinline__ void operator()(const pg8::f32x4 (&acc)[2][2][4][2], const pg8::Unit& u, int wr, int wc, int fr_, int fq_) const {
        int t_ = threadIdx.x; asm volatile("" : "+v"(t_)); const int fr = t_ & 15, fq = (t_ >> 4) & 3; (void)fr_; (void)fq_;
        const int type = u.pn >> 2, row0 = u.pm * 256 + wr * 64 + fr, col0 = (u.pn & 3) * 256 + wc * 32 + 4 * fq;
#pragma unroll
        for (int bj = 0; bj < 2; ++bj)
#pragma unroll
            for (int n = 0; n < 2; ++n) { const int c = col0 + bj * 128 + n * 16;
                pg8::f32x4 bias = (pg8::f32x4){0.f, 0.f, 0.f, 0.f};
                if (type == 0) bias = *(const pg8::f32x4*)(w0 + c); else if (type == 1) bias = *(const pg8::f32x4*)(a0 + c);
#pragma unroll
                for (int ai = 0; ai < 2; ++ai)
#pragma unroll
                    for (int m = 0; m < 4; ++m) { const size_t off = (size_t)(row0 + ai * 128 + m * 16) * CW + c; const pg8::f32x4 v = acc[ai][bj][m][n] + bias;
                        if (type == 0) { pg8::f32x4 o;
#pragma unroll
                            for (int j = 0; j < 4; ++j) { const float z = -v[j]; const float sp = fmaxf(z, 0.f) + __logf(1.f + __expf(-fabsf(z))); o[j] = -__expf(-sp - 0.5f); }
                            *(pg8::f32x4*)(LW + off) = o; }
                        else if (type == 1) { v2u o; o.x = pk2(sigmoid_f(v[0]), sigmoid_f(v[1])); o.y = pk2(sigmoid_f(v[2]), sigmoid_f(v[3])); *(v2u*)(AA + off) = o; }
                        else { v2u o; o.x = pk2(v[0], v[1]); o.y = pk2(v[2], v[3]); *(v2u*)(GG + off) = o; } } }
    }
};
struct GroupOrder {
    const unsigned* te; int nrt, ncol, G, c;
    __device__ __forceinline__ bool next(int i, pg8::Unit& u) const {
        const long L = (long)i * G + c; if (L >= (long)nrt * ncol) return false;
        const int rt = (int)(L / ncol), pl = (int)(L - (long)rt * ncol);
        u.pm = rt; u.pn = (int)te[rt] * ncol + pl; return true;
    }
    __device__ __forceinline__ void a_ready(const pg8::Unit&) const {}
    __device__ __forceinline__ void done(const pg8::Unit&) const {}
};

struct Args { const float* in[30]; float* out; unsigned char* ws; int ph_lo, ph_hi; };
enum { I_X = 0, I_C, I_WADA, I_BADA, I_N1G, I_WIN, I_MU, I_W0, I_WDEC, I_A0, I_WAAA, I_WGATEUP, I_KK, I_KA, I_RK, I_LNW, I_LNB, I_RELB, I_BETAR, I_BETAA,
       I_WOUT, I_N2G, I_WGRP, I_BGRP, I_WEXP, I_BEXP, I_WG, I_WU, I_WDN, I_NFG };
constexpr int NPH = 13;

__device__ __forceinline__ void conv_item(const float* __restrict__ W, int N, bf16* WT, size_t drow0, int ldd, int k0, int n0, LAS float* scr, int lane) {
    float v[32];
#pragma unroll
    for (int i = 0; i < 32; ++i) { const int kk = 2 * i + (lane >> 5); v[i] = W[(size_t)(k0 + kk) * N + n0 + (lane & 31)]; }
#pragma unroll
    for (int i = 0; i < 32; ++i) { const int kk = 2 * i + (lane >> 5); scr[kk * 33 + (lane & 31)] = v[i]; }
    LDS_WAIT(); asm volatile("" ::: "memory");
    const int c = lane & 7;
#pragma unroll
    for (int j = 0; j < 4; ++j) { const int n = (lane >> 3) + 8 * j; const LAS float* s = scr + (8 * c) * 33 + n;
        v4u o; o.x = pk2(s[0 * 33], s[1 * 33]); o.y = pk2(s[2 * 33], s[3 * 33]); o.z = pk2(s[4 * 33], s[5 * 33]); o.w = pk2(s[6 * 33], s[7 * 33]);
        *(v4u*)(WT + (drow0 + n) * (size_t)ldd + k0 + 8 * c) = o; }
    LDS_WAIT(); asm volatile("" ::: "memory");
}
__device__ __forceinline__ void phase0(const Args& a, LAS unsigned char* lds) {
    const int tid = threadIdx.x, lane = tid & 63, wave = __builtin_amdgcn_readfirstlane(tid >> 6), G = gridDim.x, bid = blockIdx.x;
    unsigned char* ws = a.ws;
    LAS float* cact = (LAS float*)lds;
    LAS float* red = (LAS float*)(lds + 16384);
    LAS float* scr = (LAS float*)(lds + 32768 + wave * 8448);
    if (bid < 192 || G < 192) {
        const float* c = a.in[I_C];
        for (int i = tid; i < 2 * DM; i += NTHR) { const float x = c[i]; cact[i] = x / (1.f + __expf(-x)); }
        __syncthreads();
        for (int item = bid; item < 192; item += G) {
            const int ro = lane >> 4, cq = lane & 15;
            const float* wp = a.in[I_WADA] + (size_t)(256 * wave + ro) * 12288 + 64 * item + 4 * cq;
            f32x4 acc0 = (f32x4){0.f, 0.f, 0.f, 0.f}, acc1 = acc0;
#pragma unroll 8
            for (int i = 0; i < 64; ++i) { const f32x4 wv = *(const f32x4*)(wp + (size_t)(4 * i) * 12288);
                const float c0 = cact[256 * wave + 4 * i + ro], c1 = cact[DM + 256 * wave + 4 * i + ro]; acc0 += c0 * wv; acc1 += c1 * wv; }
#pragma unroll
            for (int j = 0; j < 4; ++j) { float v0 = acc0[j], v1 = acc1[j]; v0 += __shfl_xor(v0, 16); v0 += __shfl_xor(v0, 32); v1 += __shfl_xor(v1, 16); v1 += __shfl_xor(v1, 32);
                if (ro == 0) { red[(wave * 2 + 0) * 64 + 4 * cq + j] = v0; red[(wave * 2 + 1) * 64 + 4 * cq + j] = v1; } }
            __syncthreads();
            if (tid < 128) { const int b = tid >> 6, cc = tid & 63; float s = a.in[I_BADA][64 * item + cc];
#pragma unroll
                for (int w2 = 0; w2 < 8; ++w2) s += red[(w2 * 2 + b) * 64 + cc];
                ((float*)(ws + WS_MOD))[b * 12288 + 64 * item + cc] = s; }
            __syncthreads();
        }
    }
    constexpr int NI_IN = 32 * 201, NI_OUT = 32 * 64, NI_E = 32 * 512;
    constexpr int NCONV = NI_IN + NI_OUT + 3 * NI_E;
    const int gw = bid * NWAVES + wave, NGW = G * NWAVES;
    for (int it = gw; it < NCONV; it += NGW) {
        int r = it;
        if (r < NI_IN) { const int kb = r / 201, nb = r - kb * 201; conv_item(a.in[I_WIN], PROJW, (bf16*)(ws + WS_WIN), (size_t)(32 * nb), DM, 64 * kb, 32 * nb, scr, lane); continue; } r -= NI_IN;
        if (r < NI_OUT) { const int kb = r >> 6, nb = r & 63; conv_item(a.in[I_WOUT], DM, (bf16*)(ws + WS_WOUT), (size_t)(32 * nb), DM, 64 * kb, 32 * nb, scr, lane); continue; } r -= NI_OUT;
        if (r < 2 * NI_E) { const int up = r >= NI_E; if (up) r -= NI_E; const int e = r >> 9, q = r & 511, kb = q >> 4, nb = q & 15, n0 = 32 * nb;
            conv_item(a.in[up ? I_WU : I_WG] + (size_t)e * DM * FF, FF, (bf16*)(ws + WS_WGU), (size_t)e * 1024 + 256 * (n0 >> 7) + (n0 & 127) + (up ? 128 : 0), DM, 64 * kb, n0, scr, lane); continue; } r -= 2 * NI_E;
        { const int e = r >> 9, q = r & 511, kb = q >> 6, nb = q & 63;
            conv_item(a.in[I_WDN] + (size_t)e * FF * DM, DM, (bf16*)(ws + WS_WD), (size_t)e * DM + 32 * nb, FF, 64 * kb, 32 * nb, scr, lane); }
    }
    const int gt = bid * NTHR + tid, NGT = G * NTHR;
    bf16* wl = (bf16*)(ws + WS_WL);
    for (int idx = gt; idx < LORA_N * LORA_K; idx += NGT) { const int n = idx / LORA_K, k = idx - n * LORA_K; float v = 0.f;
        if (n < 1024) { if (k < 64) v = a.in[I_WDEC][k * 1024 + n]; }
        else if (n < 2048) { if (k >= 64 && k < 128) v = a.in[I_WAAA][(k - 64) * 1024 + (n - 1024)]; }
        else { if (k >= 128 && k < 288) v = a.in[I_WGATEUP][(k - 128) * 1024 + (n - 2048)]; }
        wl[idx] = (bf16)f2bf(v); }
    v4u* wz = (v4u*)(ws + WS_WIN + (size_t)PROJW * DM * 2);
    for (int idx = gt; idx < (PROJP - PROJW) * DM / 8; idx += NGT) wz[idx] = (v4u){0u, 0u, 0u, 0u};
}

__device__ __forceinline__ void phase1(const Args& a) {
    const int tid = threadIdx.x, lane = tid & 63, wave = tid >> 6;
    const int gw = blockIdx.x * NWAVES + wave, NGW = gridDim.x * NWAVES;
    const float* mod = (const float*)(a.ws + WS_MOD);
    for (int m = gw; m < MTOK; m += NGW) {
        const int b = m >> 12;
        const f32x4* xr = (const f32x4*)(a.in[I_X] + (size_t)m * DM) + lane;
        f32x4 v[8]; float s = 0.f;
#pragma unroll
        for (int j = 0; j < 8; ++j) { v[j] = xr[64 * j]; s += (v[j].x * v[j].x + v[j].y * v[j].y) + (v[j].z * v[j].z + v[j].w * v[j].w); }
        const float rstd = 1.f / sqrtf(wave_sum(s) * (1.f / DM) + RMS_EPS);
        v2u* o8 = (v2u*)((bf16*)(a.ws + WS_HB) + (size_t)m * DM) + lane;
#pragma unroll
        for (int j = 0; j < 8; ++j) { const int c = 4 * (lane + 64 * j);
            const f32x4 g = *(const f32x4*)(a.in[I_N1G] + c), sh = *(const f32x4*)(mod + b * 12288 + c), sc = *(const f32x4*)(mod + b * 12288 + DM + c);
            const f32x4 h = v[j] * rstd * g * (1.f + sc) + sh; v2u o; o.x = pk2(h.x, h.y); o.y = pk2(h.z, h.w); o8[64 * j] = o; }
    }
}

__device__ __forceinline__ void phase3(const Args& a) {
    const int gt = blockIdx.x * NTHR + threadIdx.x, NGT = gridDim.x * NTHR;
    const bf16* P = (const bf16*)(a.ws + WS_P); bf16* AL = (bf16*)(a.ws + WS_AL);
    for (int idx = gt; idx < MTOK * 48; idx += NGT) { const int m = idx / 48, cj = idx - m * 48;
        v4u o = (v4u){0u, 0u, 0u, 0u};
        if (cj < 36) { const int col = 3072 + 8 * cj; const v4u pc = *(const v4u*)(P + (size_t)m * PROJP + col);
            v4u pp = (v4u){0u, 0u, 0u, 0u}; if ((m & (SEQ - 1)) != 0) pp = *(const v4u*)(P + (size_t)(m - 1) * PROJP + col);
            const float* mu = a.in[I_MU] + col; float r[8];
#pragma unroll
            for (int i = 0; i < 4; ++i) { const float c0 = bflo(pc[i]), c1 = bfhi(pc[i]), p0 = bflo(pp[i]), p1 = bfhi(pp[i]);
                r[2 * i] = c0 + (p0 - c0) * mu[2 * i]; r[2 * i + 1] = c1 + (p1 - c1) * mu[2 * i + 1]; }
            if (cj < 8) {
#pragma unroll
                for (int i = 0; i < 8; ++i) r[i] = tanhf(r[i]); }
            else if (cj >= 16) {
#pragma unroll
                for (int i = 0; i < 8; ++i) r[i] = sigmoid_f(r[i]); }
            o.x = pk2(r[0], r[1]); o.y = pk2(r[2], r[3]); o.z = pk2(r[4], r[5]); o.w = pk2(r[6], r[7]); }
        *(v4u*)(AL + (size_t)m * LORA_K + 8 * cj) = o; }
}

__device__ __forceinline__ void load16(const bf16* p, float* o) { const v4u a0 = *(const v4u*)p, a1 = *(const v4u*)(p + 8);
#pragma unroll
    for (int i = 0; i < 4; ++i) { o[2 * i] = bflo(a0[i]); o[2 * i + 1] = bfhi(a0[i]); o[8 + 2 * i] = bflo(a1[i]); o[8 + 2 * i + 1] = bfhi(a1[i]); } }
__device__ __forceinline__ void store16(bf16* p, const float* v) { v4u a0, a1;
#pragma unroll
    for (int i = 0; i < 4; ++i) { a0[i] = pk2(v[2 * i], v[2 * i + 1]); a1[i] = pk2(v[8 + 2 * i], v[8 + 2 * i + 1]); }
    *(v4u*)p = a0; *(v4u*)(p + 8) = a1; }
__device__ __forceinline__ void shift16(const bf16* P, int m, int col, const float* mu, float* o) {
    float c[16], p[16]; load16(P + (size_t)m * PROJP + col, c);
    if ((m & (SEQ - 1)) != 0) load16(P + (size_t)(m - 1) * PROJP + col, p); else {
#pragma unroll
        for (int i = 0; i < 16; ++i) p[i] = 0.f; }
#pragma unroll
    for (int i = 0; i < 16; ++i) o[i] = c[i] + (p[i] - c[i]) * mu[col + i];
}
__device__ __forceinline__ void phase5a(const Args& a) {
    const int tid = threadIdx.x, lane = tid & 63, wave = tid >> 6;
    const int gw = blockIdx.x * NWAVES + wave, NGW = gridDim.x * NWAVES;
    const bf16* P = (const bf16*)(a.ws + WS_P);
    const int c0 = 16 * lane;
    for (int m = gw; m < MTOK; m += NGW) {
        float r[16], k[16], v[16], av[16], kk[16], bb[16];
        shift16(P, m, c0, a.in[I_MU], r); shift16(P, m, 1024 + c0, a.in[I_MU], k); shift16(P, m, 2048 + c0, a.in[I_MU], v);
        load16((const bf16*)(a.ws + WS_AA) + (size_t)m * CW + c0, av);
        float ss = 0.f;
#pragma unroll
        for (int i = 0; i < 16; ++i) { kk[i] = k[i] * a.in[I_KK][c0 + i]; ss += kk[i] * kk[i]; }
        ss += __shfl_xor(ss, 1); ss += __shfl_xor(ss, 2);
        const float inv = 1.f / fmaxf(sqrtf(ss), 1e-12f);
#pragma unroll
        for (int i = 0; i < 16; ++i) { kk[i] *= inv; bb[i] = kk[i] * av[i]; k[i] = k[i] * (1.f + (av[i] - 1.f) * a.in[I_KA][c0 + i]); }
        const size_t off = (size_t)m * CW + c0;
        store16((bf16*)(a.ws + WS_R) + off, r); store16((bf16*)(a.ws + WS_K2) + off, k); store16((bf16*)(a.ws + WS_V) + off, v);
        store16((bf16*)(a.ws + WS_KK) + off, kk); store16((bf16*)(a.ws + WS_BB) + off, bb);
    }
}

__device__ __forceinline__ int swz_off(int key, int chunk) { return key * 128 + ((chunk ^ ((key >> 1) & 7)) << 4); }
__device__ __forceinline__ void phase5b(const Args& a, LAS unsigned char* lds) {
    const int tid = threadIdx.x, lane = tid & 63, wave = __builtin_amdgcn_readfirstlane(tid >> 6), n = lane & 15, g = lane >> 4;
    const bf16* P = (const bf16*)(a.ws + WS_P); bf16* Y = (bf16*)(a.ws + WS_YMIX);
    LAS float* biasL = (LAS float*)(lds + 32768);
    const float SC = 0.125f * LOG2E;
    const int skey = tid >> 3, sdc = tid & 7;
    for (int u = blockIdx.x; u < BATCH * NHEAD * 32; u += gridDim.x) {
        const int cp = u & 31, h = (u >> 5) & 15, b = u >> 9;
        const int t0 = 128 * cp, qrow = t0 + 16 * wave + n;
        const size_t rowbase = (size_t)b * SEQ;
        const bf16* qp = P + (rowbase + qrow) * PROJP + SHIFTW + h * 64;
        bf16x8 qf[2]; qf[0] = *(const bf16x8*)(qp + 8 * g); qf[1] = *(const bf16x8*)(qp + 32 + 8 * g);
        if (tid < 257) biasL[tid] = a.in[I_RELB][h * 257 + tid] * LOG2E;
        const int jstart = (8 - 2 * cp) > 0 ? (8 - 2 * cp) : 0;
        const bf16* kcol = P + rowbase * PROJP + SHIFTW + 1024 + h * 64 + 8 * sdc;
        const bf16* vcol = kcol + 1024;
        v4u kreg, vreg;
        { const int key0 = 64 * (2 * cp - 8 + jstart); kreg = *(const v4u*)(kcol + (size_t)(key0 + skey) * PROJP); vreg = *(const v4u*)(vcol + (size_t)(key0 + skey) * PROJP);
          *(LAS v4u*)(lds + swz_off(skey, sdc)) = kreg; *(LAS v4u*)(lds + 16384 + swz_off(skey, sdc)) = vreg; }
        __syncthreads();
        float mrun = -1e30f, lrun = 0.f;
        f32x4 ot[4];
#pragma unroll
        for (int i = 0; i < 4; ++i) ot[i] = (f32x4){0.f, 0.f, 0.f, 0.f};
        const float bfar = biasL[256];
        for (int j = jstart; j < 10; ++j) {
            const int cur = (j - jstart) & 1;
            const int key0 = 64 * (2 * cp - 8 + j);
            if (j + 1 < 10) { kreg = *(const v4u*)(kcol + (size_t)(key0 + 64 + skey) * PROJP); vreg = *(const v4u*)(vcol + (size_t)(key0 + 64 + skey) * PROJP); }
            const bool active = (wave < 4) ? (j <= 8) : (j >= 1);
            if (active) {
                LAS unsigned char* Kb = lds + cur * 8192; LAS unsigned char* Vb = lds + 16384 + cur * 8192;
                f32x4 s[4];
#pragma unroll
                for (int st = 0; st < 4; ++st) { s[st] = (f32x4){0.f, 0.f, 0.f, 0.f};
#pragma unroll
                    for (int ks = 0; ks < 2; ++ks) { const bf16x8 kf = *(const LAS bf16x8*)(Kb + swz_off(16 * st + n, 4 * ks + g));
                        s[st] = __builtin_amdgcn_mfma_f32_16x16x32_bf16(kf, qf[ks], s[st], 0, 0, 0); } }
                const bool far = (t0 + 16 * wave) - (key0 + 63) >= 128;
                float mx = -1e30f;
#pragma unroll
                for (int st = 0; st < 4; ++st)
#pragma unroll
                    for (int jj = 0; jj < 4; ++jj) { float bv = bfar;
                        if (!far) { const int dist = qrow - (key0 + 16 * st + 4 * g + jj); const int idx = (dist < 128 ? dist : 128) + 128; bv = biasL[idx]; }
                        const float sv = s[st][jj] * SC + bv; s[st][jj] = sv; mx = fmaxf(mx, sv); }
                mx = fmaxf(mx, __shfl_xor(mx, 16)); mx = fmaxf(mx, __shfl_xor(mx, 32));
                const float mnew = fmaxf(mrun, mx), alpha = exp2f(mrun - mnew); mrun = mnew;
                float ls = 0.f;
#pragma unroll
                for (int st = 0; st < 4; ++st)
#pragma unroll
                    for (int jj = 0; jj < 4; ++jj) { const float p = exp2f(s[st][jj] - mnew); s[st][jj] = p; ls += p; }
                lrun = lrun * alpha + ls;
#pragma unroll
                for (int i = 0; i < 4; ++i) ot[i] *= alpha;
#pragma unroll
                for (int k2 = 0; k2 < 2; ++k2) {
                    v4u pw; pw.x = pk2(s[2 * k2][0], s[2 * k2][1]); pw.y = pk2(s[2 * k2][2], s[2 * k2][3]); pw.z = pk2(s[2 * k2 + 1][0], s[2 * k2 + 1][1]); pw.w = pk2(s[2 * k2 + 1][2], s[2 * k2 + 1][3]);
                    const bf16x8 pf = __builtin_bit_cast(bf16x8, pw);
                    const int q4 = n >> 2, p4 = n & 3;
                    const int ka = 32 * k2 + 4 * g + q4, kb = ka + 16;
#pragma unroll
                    for (int nd = 0; nd < 4; ++nd) {
                        const int ch = 2 * nd + (p4 >> 1);
                        const s16x4 v0 = __builtin_bit_cast(s16x4, __builtin_amdgcn_ds_read_tr16_b64_v4i16((LAS s16x4*)(Vb + swz_off(ka, ch) + 8 * (p4 & 1))));
                        const s16x4 v1 = __builtin_bit_cast(s16x4, __builtin_amdgcn_ds_read_tr16_b64_v4i16((LAS s16x4*)(Vb + swz_off(kb, ch) + 8 * (p4 & 1))));
                        bf16x8 vf; vf[0] = v0[0]; vf[1] = v0[1]; vf[2] = v0[2]; vf[3] = v0[3]; vf[4] = v1[0]; vf[5] = v1[1]; vf[6] = v1[2]; vf[7] = v1[3];
                        ot[nd] = __builtin_amdgcn_mfma_f32_16x16x32_bf16(vf, pf, ot[nd], 0, 0, 0);
                    }
                }
            }
            if (j + 1 < 10) { *(LAS v4u*)(lds + (cur ^ 1) * 8192 + swz_off(skey, sdc)) = kreg; *(LAS v4u*)(lds + 16384 + (cur ^ 1) * 8192 + swz_off(skey, sdc)) = vreg; }
            __syncthreads();
        }
        float lt = lrun; lt += __shfl_xor(lt, 16); lt += __shfl_xor(lt, 32);
        const float inv = 1.f / lt;
        bf16* yp = Y + (rowbase + qrow) * DM + 1024 + h * 64 + 4 * g;
        const float* beta = a.in[I_BETAA] + h * 64 + 4 * g;
#pragma unroll
        for (int nd = 0; nd < 4; ++nd) { const f32x4 bt = *(const f32x4*)(beta + 16 * nd); const f32x4 o = ot[nd] * inv * bt;
            v2u w; w.x = pk2(o[0], o[1]); w.y = pk2(o[2], o[3]); *(v2u*)(yp + 16 * nd) = w; }
    }
}

__device__ __forceinline__ void phase6(const Args& a, LAS unsigned char* lds) {
    const int tid = threadIdx.x;
    LAS float* Wd = (LAS float*)lds; LAS float* KKl = Wd + 4096; LAS float* BBl = KKl + 4096; LAS float* K2l = BBl + 4096; LAS float* Rl = K2l + 4096; LAS float* Vl = Rl + 4096; LAS float* Yl = Vl + 4096;
    for (int u = blockIdx.x; u < BATCH * NHEAD; u += gridDim.x) {
        const int b = u >> 4, h = u & 15;
        const int row = tid >> 3, part = tid & 7;
        float S[8];
#pragma unroll
        for (int i = 0; i < 8; ++i) S[i] = 0.f;
        for (int st = 0; st < SEQ / 64; ++st) {
            {
                const int tk = tid >> 3, c8 = 8 * (tid & 7); const size_t off = ((size_t)b * SEQ + 64 * st + tk) * CW + h * 64 + c8; const int lo = tk * 64 + c8;
                const v4u r4 = *(const v4u*)((const bf16*)(a.ws + WS_R) + off), k4 = *(const v4u*)((const bf16*)(a.ws + WS_K2) + off), v4 = *(const v4u*)((const bf16*)(a.ws + WS_V) + off),
                          q4 = *(const v4u*)((const bf16*)(a.ws + WS_KK) + off), b4 = *(const v4u*)((const bf16*)(a.ws + WS_BB) + off);
                const f32x4 l0 = *(const f32x4*)((const float*)(a.ws + WS_LW) + off), l1 = *(const f32x4*)((const float*)(a.ws + WS_LW) + off + 4);
#pragma unroll
                for (int i = 0; i < 4; ++i) { Rl[lo + 2 * i] = bflo(r4[i]); Rl[lo + 2 * i + 1] = bfhi(r4[i]); K2l[lo + 2 * i] = bflo(k4[i]); K2l[lo + 2 * i + 1] = bfhi(k4[i]);
                    Vl[lo + 2 * i] = bflo(v4[i]); Vl[lo + 2 * i + 1] = bfhi(v4[i]); KKl[lo + 2 * i] = bflo(q4[i]); KKl[lo + 2 * i + 1] = bfhi(q4[i]);
                    BBl[lo + 2 * i] = bflo(b4[i]); BBl[lo + 2 * i + 1] = bfhi(b4[i]); Wd[lo + i] = __expf(l0[i]); Wd[lo + 4 + i] = __expf(l1[i]); }
            }
            __syncthreads();
            for (int t = 0; t < 64; ++t) {
                const int o = t * 64 + 8 * part;
                const f32x4 w0 = *(const LAS f32x4*)(Wd + o), w1 = *(const LAS f32x4*)(Wd + o + 4), q0 = *(const LAS f32x4*)(KKl + o), q1 = *(const LAS f32x4*)(KKl + o + 4),
                            b0 = *(const LAS f32x4*)(BBl + o), b1 = *(const LAS f32x4*)(BBl + o + 4), k0 = *(const LAS f32x4*)(K2l + o), k1 = *(const LAS f32x4*)(K2l + o + 4),
                            r0 = *(const LAS f32x4*)(Rl + o), r1 = *(const LAS f32x4*)(Rl + o + 4);
                const float vv = Vl[t * 64 + row];
                float sa = 0.f;
#pragma unroll
                for (int i = 0; i < 4; ++i) sa += S[i] * q0[i] + S[4 + i] * q1[i];
                sa += __shfl_xor(sa, 1); sa += __shfl_xor(sa, 2); sa += __shfl_xor(sa, 4);
                float y = 0.f;
#pragma unroll
                for (int i = 0; i < 4; ++i) { S[i] = S[i] * w0[i] - sa * b0[i] + vv * k0[i]; S[4 + i] = S[4 + i] * w1[i] - sa * b1[i] + vv * k1[i]; y += S[i] * r0[i] + S[4 + i] * r1[i]; }
                y += __shfl_xor(y, 1); y += __shfl_xor(y, 2); y += __shfl_xor(y, 4);
                if (part == 0) Yl[t * 64 + row] = y;
            }
            __syncthreads();
            {
                const int tk = tid >> 3, c8 = 8 * (tid & 7), lo = tk * 64 + c8; const size_t m = (size_t)b * SEQ + 64 * st + tk;
                float y[8], s1 = 0.f, bon = 0.f;
#pragma unroll
                for (int i = 0; i < 8; ++i) { y[i] = Yl[lo + i]; s1 += y[i]; bon += Rl[lo + i] * K2l[lo + i] * a.in[I_RK][h * 64 + c8 + i]; }
                s1 += __shfl_xor(s1, 1); s1 += __shfl_xor(s1, 2); s1 += __shfl_xor(s1, 4);
                bon += __shfl_xor(bon, 1); bon += __shfl_xor(bon, 2); bon += __shfl_xor(bon, 4);
                const float mean = s1 * (1.f / 64.f); float s2 = 0.f;
#pragma unroll
                for (int i = 0; i < 8; ++i) { const float d = y[i] - mean; s2 += d * d; }
                s2 += __shfl_xor(s2, 1); s2 += __shfl_xor(s2, 2); s2 += __shfl_xor(s2, 4);
                const float rstd = 1.f / sqrtf(s2 * (1.f / 64.f) + GN_EPS);
                const v4u g4 = *(const v4u*)((const bf16*)(a.ws + WS_GG) + m * CW + h * 64 + c8);
                float o[8];
#pragma unroll
                for (int i = 0; i < 8; ++i) { const int c = h * 64 + c8 + i; const float gg = (i & 1) ? bfhi(g4[i >> 1]) : bflo(g4[i >> 1]);
                    o[i] = ((y[i] - mean) * rstd * a.in[I_LNW][c] + a.in[I_LNB][c] + bon * Vl[lo + i]) * gg * a.in[I_BETAR][c]; }
                v4u w; w.x = pk2(o[0], o[1]); w.y = pk2(o[2], o[3]); w.z = pk2(o[4], o[5]); w.w = pk2(o[6], o[7]);
                *(v4u*)((bf16*)(a.ws + WS_YMIX) + m * DM + h * 64 + c8) = w;
            }
            __syncthreads();
        }
    }
}

__device__ __forceinline__ void phase8(const Args& a) {
    const int tid = threadIdx.x, lane = tid & 63, wave = tid >> 6;
    const int gw = blockIdx.x * NWAVES + wave, NGW = gridDim.x * NWAVES;
    const float* mod = (const float*)(a.ws + WS_MOD);
    unsigned* ctl = (unsigned*)(a.ws + WS_CTL);
    for (int m = gw; m < MTOK; m += NGW) {
        const int b = m >> 12;
        const f32x4* xr = (const f32x4*)((const float*)(a.ws + WS_X1) + (size_t)m * DM) + lane;
        f32x4 v[8]; float s = 0.f;
#pragma unroll
        for (int j = 0; j < 8; ++j) { v[j] = xr[64 * j]; s += (v[j].x * v[j].x + v[j].y * v[j].y) + (v[j].z * v[j].z + v[j].w * v[j].w); }
        const float rstd = 1.f / sqrtf(wave_sum(s) * (1.f / DM) + RMS_EPS);
        v2u* o8 = (v2u*)((bf16*)(a.ws + WS_HB) + (size_t)m * DM) + lane;
        float gl[4] = {0.f, 0.f, 0.f, 0.f};
#pragma unroll
        for (int j = 0; j < 8; ++j) { const int c = 4 * (lane + 64 * j);
            const f32x4 g = *(const f32x4*)(a.in[I_N2G] + c), sh = *(const f32x4*)(mod + b * 12288 + 3 * DM + c), sc = *(const f32x4*)(mod + b * 12288 + 4 * DM + c);
            const f32x4 h = v[j] * rstd * g * (1.f + sc) + sh; v[j] = h; v2u o; o.x = pk2(h.x, h.y); o.y = pk2(h.z, h.w); o8[64 * j] = o;
#pragma unroll
            for (int i = 0; i < 4; ++i) { const f32x4 wg = *(const f32x4*)(a.in[I_WGRP] + (size_t)(c + i) * 4);
                gl[0] += h[i] * wg[0]; gl[1] += h[i] * wg[1]; gl[2] += h[i] * wg[2]; gl[3] += h[i] * wg[3]; } }
#pragma unroll
        for (int i = 0; i < 4; ++i) gl[i] = wave_sum(gl[i]) + a.in[I_BGRP][i];
        int gi = 0; float gm = gl[0];
#pragma unroll
        for (int i = 1; i < 4; ++i) if (gl[i] > gm) { gm = gl[i]; gi = i; }
        float gs = 0.f;
#pragma unroll
        for (int i = 0; i < 4; ++i) gs += expf(gl[i] - gm);
        const float gwt = 1.f / gs;
        float el[8] = {0.f, 0.f, 0.f, 0.f, 0.f, 0.f, 0.f, 0.f};
        const float* we = a.in[I_WEXP] + (size_t)gi * DM * 8;
#pragma unroll
        for (int j = 0; j < 8; ++j) { const int c = 4 * (lane + 64 * j);
#pragma unroll
            for (int i = 0; i < 4; ++i) { const f32x4 w0 = *(const f32x4*)(we + (size_t)(c + i) * 8), w1 = *(const f32x4*)(we + (size_t)(c + i) * 8 + 4);
                el[0] += v[j][i] * w0[0]; el[1] += v[j][i] * w0[1]; el[2] += v[j][i] * w0[2]; el[3] += v[j][i] * w0[3];
                el[4] += v[j][i] * w1[0]; el[5] += v[j][i] * w1[1]; el[6] += v[j][i] * w1[2]; el[7] += v[j][i] * w1[3]; } }
#pragma unroll
        for (int i = 0; i < 8; ++i) el[i] = wave_sum(el[i]) + a.in[I_BEXP][gi * 8 + i];
        int i1 = 0; float m1 = el[0];
#pragma unroll
        for (int i = 1; i < 8; ++i) if (el[i] > m1) { m1 = el[i]; i1 = i; }
        int i2 = -1; float m2 = -3.0e38f;
#pragma unroll
        for (int i = 0; i < 8; ++i) if (i != i1 && el[i] > m2) { m2 = el[i]; i2 = i; }
        const float e2 = expf(m2 - m1); const float w1 = gwt / (1.f + e2), w2 = gwt * e2 / (1.f + e2);
        if (lane == 0) { int* rt = (int*)(a.ws + WS_ROUTE) + (size_t)m * 8; const int ge1 = gi * 8 + i1, ge2 = gi * 8 + i2;
            rt[0] = ge1; rt[1] = ge2; rt[2] = __float_as_int(w1); rt[3] = __float_as_int(w2);
            atomicAdd(ctl + CW_CNT + ge1, 1u); atomicAdd(ctl + CW_CNT + ge2, 1u); }
    }
}

__device__ __forceinline__ void phase9(const Args& a) {
    const int tid = threadIdx.x, lane = tid & 63, wave = tid >> 6;
    const int gw = blockIdx.x * NWAVES + wave, NGW = gridDim.x * NWAVES;
    unsigned* ctl = (unsigned*)(a.ws + WS_CTL);
    unsigned cnt = (lane < NEXP) ? __hip_atomic_load(ctl + CW_CNT + lane, RLX_AGENT) : 0u;
    const unsigned pad = (cnt + 255u) & ~255u;
    unsigned incl = pad;
#pragma unroll
    for (int o = 1; o < 64; o <<= 1) { const unsigned t = __shfl_up(incl, o); if (lane >= o) incl += t; }
    const unsigned off = incl - pad;
    if (gw == 0) {
        if (lane < NEXP) for (unsigned t = off >> 8; t < (off + pad) >> 8; ++t) ctl[CW_TE + t] = (unsigned)lane;
        if (lane == 63) ctl[CW_NRT] = incl >> 8;
    }
    for (int m = gw; m < MTOK; m += NGW) {
        int* rt = (int*)(a.ws + WS_ROUTE) + (size_t)m * 8;
        const int e1 = rt[0], e2 = rt[1]; const float w1 = __int_as_float(rt[2]), w2 = __int_as_float(rt[3]);
        unsigned p1 = 0, p2 = 0;
        if (lane == 0) { p1 = atomicAdd(ctl + CW_POS + e1, 1u); p2 = atomicAdd(ctl + CW_POS + e2, 1u); }
        p1 = __shfl(p1, 0); p2 = __shfl(p2, 0);
        const unsigned s1 = __shfl(off, e1) + p1, s2 = __shfl(off, e2) + p2;
        if (lane == 0) { rt[4] = (int)s1; rt[5] = (int)s2; ((float*)(a.ws + WS_SW))[s1] = w1; ((float*)(a.ws + WS_SW))[s2] = w2; }
        const v4u* src = (const v4u*)((const bf16*)(a.ws + WS_HB) + (size_t)m * DM) + lane;
        v4u* d1 = (v4u*)((bf16*)(a.ws + WS_H2P) + (size_t)s1 * DM) + lane; v4u* d2 = (v4u*)((bf16*)(a.ws + WS_H2P) + (size_t)s2 * DM) + lane;
#pragma unroll
        for (int j = 0; j < 4; ++j) { const v4u x = src[64 * j]; d1[64 * j] = x; d2[64 * j] = x; }
    }
}

__device__ __forceinline__ void phase12(const Args& a) {
    const int tid = threadIdx.x, lane = tid & 63, wave = tid >> 6;
    const int gw = blockIdx.x * NWAVES + wave, NGW = gridDim.x * NWAVES;
    const float* mod = (const float*)(a.ws + WS_MOD);
    for (int m = gw; m < MTOK; m += NGW) {
        const int b = m >> 12;
        const int* rt = (const int*)(a.ws + WS_ROUTE) + (size_t)m * 8; const int s1 = rt[4], s2 = rt[5];
        const f32x4* xr = (const f32x4*)((const float*)(a.ws + WS_X1) + (size_t)m * DM) + lane;
        const v2u* f1 = (const v2u*)((const bf16*)(a.ws + WS_FP) + (size_t)s1 * DM) + lane; const v2u* f2 = (const v2u*)((const bf16*)(a.ws + WS_FP) + (size_t)s2 * DM) + lane;
        f32x4 v[8]; float s = 0.f;
#pragma unroll
        for (int j = 0; j < 8; ++j) { const int c = 4 * (lane + 64 * j); const f32x4 g2 = *(const f32x4*)(mod + b * 12288 + 5 * DM + c);
            const v2u a1 = f1[64 * j], a2 = f2[64 * j]; f32x4 f;
            f.x = bflo(a1.x) + bflo(a2.x); f.y = bfhi(a1.x) + bfhi(a2.x); f.z = bflo(a1.y) + bflo(a2.y); f.w = bfhi(a1.y) + bfhi(a2.y);
            v[j] = xr[64 * j] + g2 * f; s += (v[j].x * v[j].x + v[j].y * v[j].y) + (v[j].z * v[j].z + v[j].w * v[j].w); }
        const float rstd = 1.f / sqrtf(wave_sum(s) * (1.f / DM) + RMS_EPS);
        f32x4* op = (f32x4*)(a.out + (size_t)m * DM) + lane;
#pragma unroll
        for (int j = 0; j < 8; ++j) { const int c = 4 * (lane + 64 * j); const f32x4 g = *(const f32x4*)(a.in[I_NFG] + c); op[64 * j] = v[j] * rstd * g; }
    }
}

#ifndef MK_ONE_LAUNCH
#define MK_ONE_LAUNCH 1
#endif
__global__ void __launch_bounds__(NTHR, 2) mega_fwd(Args args) {
    extern __shared__ __attribute__((aligned(16))) unsigned char lds_raw[];
    LAS unsigned char* lds = (LAS unsigned char*)lds_raw;
    const int tid = threadIdx.x;
    for (int u = tid; u < (LDS_BYTES - LDSCTL_OFF) / 4; u += NTHR) ((LAS unsigned*)(lds + LDSCTL_OFF))[u] = 0u;
    __syncthreads();
    volatile LAS unsigned* MISC = (volatile LAS unsigned*)(lds + MISC_OFF);
    unsigned* ctl = (unsigned*)(args.ws + WS_CTL);
    XcdBarrier bar; bar.bar = ctl + CW_BAR; bar.x = 0; bar.st = nullptr;
    const bool multi = (args.ph_hi - args.ph_lo) > 1;
    if (multi) bar = xcd_barrier_post(ctl + CW_BAR, MISC + 8);
    const int lo = args.ph_lo, hi = args.ph_hi, G = gridDim.x;
#define IN(k) (lo <= (k) && (k) < hi)
#define SEAM(k) do { if (IN(k) && IN((k) + 1)) xcd_barrier(bar); } while (0)
    if (IN(0)) { phase0(args, lds); } SEAM(0);
    if (IN(1)) { phase1(args); } SEAM(1);
    if (IN(2)) { pg8::Gemm g{(const pg8::bf16_t*)(args.ws + WS_HB), (const pg8::bf16_t*)(args.ws + WS_WIN), MTOK, PROJP, DM}; pg8::StaticOrder S; S.init(MTOK, PROJP, G, (int)blockIdx.x);
        EpiStoreBf16 E{(bf16*)(args.ws + WS_P), PROJP, 0xffff};
        pg8::gemm_phase<EpiStoreBf16, pg8::StaticOrder, true, true>(lds, g, S, E); } SEAM(2);
    if (IN(3)) { phase3(args); } SEAM(3);
    if (IN(4)) { pg8::Gemm g{(const pg8::bf16_t*)(args.ws + WS_AL), (const pg8::bf16_t*)(args.ws + WS_WL), MTOK, LORA_N, LORA_K}; pg8::StaticOrder S; S.init(MTOK, LORA_N, G, (int)blockIdx.x);
        EpiLora E{args.in[I_W0], args.in[I_A0], (float*)(args.ws + WS_LW), (bf16*)(args.ws + WS_AA), (bf16*)(args.ws + WS_GG)};
        pg8::gemm_phase<EpiLora, pg8::StaticOrder, true, true>(lds, g, S, E); } SEAM(4);
    if (IN(5)) { phase5a(args); phase5b(args, lds); } SEAM(5);
    if (IN(6)) { phase6(args, lds); } SEAM(6);
    if (IN(7)) { pg8::Gemm g{(const pg8::bf16_t*)(args.ws + WS_YMIX), (const pg8::bf16_t*)(args.ws + WS_WOUT), MTOK, DM, DM}; pg8::StaticOrder S; S.init(MTOK, DM, G, (int)blockIdx.x);
        EpiResGate E{args.in[I_X], (const float*)(args.ws + WS_MOD) + 2 * DM, (float*)(args.ws + WS_X1)};
        pg8::gemm_phase<EpiResGate, pg8::StaticOrder, true, true>(lds, g, S, E); } SEAM(7);
    if (IN(8)) { phase8(args); } SEAM(8);
    if (IN(9)) { phase9(args); } SEAM(9);
    if (IN(10)) { const int nrt = (int)__hip_atomic_load(ctl + CW_NRT, RLX_AGENT);
        pg8::Gemm g{(const pg8::bf16_t*)(args.ws + WS_H2P), (const pg8::bf16_t*)(args.ws + WS_WGU), nrt * 256, NEXP * 1024, DM}; GroupOrder S{ctl + CW_TE, nrt, 4, G, (int)blockIdx.x};
        EpiGateUp E{(const float*)(args.ws + WS_SW), (bf16*)(args.ws + WS_HG)};
        pg8::gemm_phase<EpiGateUp, GroupOrder, true, true>(lds, g, S, E); } SEAM(10);
    if (IN(11)) { const int nrt = (int)__hip_atomic_load(ctl + CW_NRT, RLX_AGENT);
        pg8::Gemm g{(const pg8::bf16_t*)(args.ws + WS_HG), (const pg8::bf16_t*)(args.ws + WS_WD), nrt * 256, NEXP * DM, FF}; GroupOrder S{ctl + CW_TE, nrt, 8, G, (int)blockIdx.x};
        EpiStoreBf16 E{(bf16*)(args.ws + WS_FP), DM, 7};
        pg8::gemm_phase<EpiStoreBf16, GroupOrder, true, true>(lds, g, S, E); } SEAM(11);
    if (IN(12)) { phase12(args); }
#undef IN
#undef SEAM
}

extern "C" void kernel_launch(void* const* d_in, const int* in_sizes, int n_in, void* d_out, int out_size, void* d_ws, size_t ws_size, hipStream_t stream) {
    static int grid = 0;
    if (grid == 0) {
        if (n_in != 30 || out_size != MTOK * DM || ws_size < WS_END) { fprintf(stderr, "kernel_launch: unexpected shapes (n_in %d, out %d, ws %zu)\n", n_in, out_size, ws_size); grid = -1; return; }
        int dev = 0, cus = 0, per_cu = 0;
        if (hipGetDevice(&dev) != hipSuccess || hipDeviceGetAttribute(&cus, hipDeviceAttributeMultiprocessorCount, dev) != hipSuccess) { grid = -1; return; }
        if (hipFuncSetAttribute((const void*)mega_fwd, hipFuncAttributeMaxDynamicSharedMemorySize, LDS_BYTES) != hipSuccess) { grid = -1; return; }
        if (hipOccupancyMaxActiveBlocksPerMultiprocessor(&per_cu, (const void*)mega_fwd, NTHR, LDS_BYTES) != hipSuccess || per_cu < 1) { fprintf(stderr, "kernel_launch: occupancy query says %d\n", per_cu); grid = -1; (void)hipGetLastError(); return; }
        grid = cus;
    }
    if (grid < 0) return;
    (void)hipMemsetAsync((char*)d_ws + WS_CTL, 0, CTL_ZERO_BYTES, stream);
    Args a{};
    for (int i = 0; i < 30; ++i) a.in[i] = (const float*)d_in[i];
    a.out = (float*)d_out; a.ws = (unsigned char*)d_ws;
#if MK_ONE_LAUNCH
    a.ph_lo = 0; a.ph_hi = NPH;
    void* kargs[] = {&a};
    hipError_t e = hipLaunchCooperativeKernel((const void*)mega_fwd, dim3(grid), dim3(NTHR), kargs, LDS_BYTES, stream);
    if (e != hipSuccess) fprintf(stderr, "cooperative launch failed: %s\n", hipGetErrorString(e));
#else
    for (int p = 0; p < NPH; ++p) { a.ph_lo = p; a.ph_hi = p + 1; hipLaunchKernelGGL(mega_fwd, dim3(grid), dim3(NTHR), LDS_BYTES, stream, a); }
#endif
}
```

```cpp
#include <hip/hip_runtime.h>
#include <hip/hip_bf16.h>
#include <cstdio>
#include <cstdint>

constexpr int NWAVES = 8, NTHR = 512;
constexpr int BATCH = 2, SEQ = 4096, DM = 2048, MTOK = BATCH * SEQ;
constexpr int CW = 1024, NHEAD = 16, HD = 64;
constexpr int SHIFTW = 3360, PROJW = 6432, PROJP = 6656;
constexpr int LORA_K = 384, LORA_N = 3072;
constexpr int NEXP = 32, FF = 512;
constexpr int MAXSLOT = 24576;
constexpr float RMS_EPS = 1e-6f, GN_EPS = 64e-5f;
constexpr float LOG2E = 1.4426950408889634f;

constexpr size_t MiB = 1u << 20;
constexpr size_t WS_CTL = 0, CTL_ZERO_BYTES = 1 * MiB;
constexpr size_t WS_MOD = 1 * MiB;
constexpr size_t WS_ROUTE = 1 * MiB + 128 * 1024;
constexpr size_t WS_SW = 1 * MiB + 512 * 1024;
constexpr size_t WS_WIN = 2 * MiB;
constexpr size_t WS_WOUT = 28 * MiB;
constexpr size_t WS_WL = 36 * MiB;
constexpr size_t WS_WGU = 39 * MiB;
constexpr size_t WS_WD = 167 * MiB;
constexpr size_t B0 = 231 * MiB;
constexpr size_t WS_P = B0;
constexpr size_t WS_HB = B0 + 104 * MiB;
constexpr size_t WS_AL = B0 + 136 * MiB;
constexpr size_t WS_LW = B0 + 142 * MiB;
constexpr size_t WS_AA = B0 + 174 * MiB;
constexpr size_t WS_GG = B0 + 190 * MiB;
constexpr size_t WS_R = B0 + 206 * MiB, WS_K2 = B0 + 222 * MiB, WS_V = B0 + 238 * MiB, WS_KK = B0 + 254 * MiB, WS_BB = B0 + 270 * MiB;
constexpr size_t WS_YMIX = B0 + 286 * MiB;
constexpr size_t WS_X1 = B0;
constexpr size_t WS_H2P = B0 + 136 * MiB;
constexpr size_t WS_HG = B0 + 232 * MiB;
constexpr size_t WS_FP = B0 + 136 * MiB;
constexpr size_t WS_GT = B0, WS_RH = B0 + 16 * MiB, WS_Y1 = B0 + 32 * MiB, WS_HM = B0 + 64 * MiB, WS_PLV = B0 + 96 * MiB;
constexpr size_t WS_SF = B0 + 136 * MiB;
constexpr size_t WS_END = B0 + 318 * MiB;
constexpr int CW_CNT = 1024, CW_POS = 1088, CW_NRT = 1152, CW_TE = 1280, CW_BAR = 4096;

constexpr int RING_BYTES = 131072;
constexpr int LDSCTL_OFF = RING_BYTES, MISC_OFF = LDSCTL_OFF + 320;
constexpr int LDS_BYTES = 147456;

#define GAS __attribute__((address_space(1)))
#define LAS __attribute__((address_space(3)))
typedef unsigned short bf16;
typedef unsigned v4u __attribute__((ext_vector_type(4)));
typedef unsigned v2u __attribute__((ext_vector_type(2)));
typedef float f32x4 __attribute__((ext_vector_type(4)));
typedef short bf16x8 __attribute__((ext_vector_type(8)));
typedef short s16x4 __attribute__((ext_vector_type(4)));
typedef GAS unsigned gu32;
typedef GAS unsigned long long gu64;
#define RLX_AGENT __ATOMIC_RELAXED, __HIP_MEMORY_SCOPE_AGENT
#define LDS_WAIT() asm volatile("s_waitcnt lgkmcnt(0)" ::: "memory")
#define VM_WAIT() asm volatile("s_waitcnt vmcnt(0)" ::: "memory")
__device__ __forceinline__ unsigned f2bf(float f) { unsigned u = __builtin_bit_cast(unsigned, f); return (u + 0x7fffu + ((u >> 16) & 1u)) >> 16; }
__device__ __forceinline__ unsigned pk2(float lo, float hi) { return f2bf(lo) | (f2bf(hi) << 16); }
__device__ __forceinline__ float bflo(unsigned u) { return __builtin_bit_cast(float, u << 16); }
__device__ __forceinline__ float bfhi(unsigned u) { return __builtin_bit_cast(float, u & 0xffff0000u); }
__device__ __forceinline__ float wave_sum(float v) {
#pragma unroll
    for (int o = 1; o < 64; o <<= 1) v += __shfl_xor(v, o);
    return v;
}
__device__ __forceinline__ float sigmoid_f(float x) { return 1.f / (1.f + __expf(-x)); }

struct Args { const float* in[30]; float* out; unsigned char* ws; int ph_lo, ph_hi; };
enum { I_X = 0, I_C, I_WADA, I_BADA, I_N1G, I_WIN, I_MU, I_W0, I_WDEC, I_A0, I_WAAA, I_WGATEUP, I_KK, I_KA, I_RK, I_LNW, I_LNB, I_RELB, I_BETAR, I_BETAA,
       I_WOUT, I_N2G, I_WGRP, I_BGRP, I_WEXP, I_BEXP, I_WG, I_WU, I_WDN, I_NFG };
constexpr int NPH = 15;

namespace pg8 {
#define PG8_LAS __attribute__((address_space(3)))
typedef unsigned short bf16_t;
typedef short bf16x8 __attribute__((ext_vector_type(8)));
typedef float f32x4 __attribute__((ext_vector_type(4)));
typedef unsigned u32x4 __attribute__((ext_vector_type(4)));
constexpr int BM = 256, BK = 64, HALF = 128, HTB = HALF * BK * 2  , STAGE_BYTES = 8 * HTB, NXCD = 8, WGM = 8;

__host__ __device__ __forceinline__ int lds_byte(int r, int c) { const int st = (r >> 4) * 2 + (c >> 5), rr = r & 15, cc = c & 31, ob = rr * 64 + cc * 2; return st * 1024 + (ob ^ (((ob >> 9) & 1) << 5)); }
__host__ __device__ __forceinline__ void stage_rc(int b, int& R, int& C) { const int st = b / 1024, sb = b % 1024, swz = sb ^ (((sb >> 9) & 1) << 5); R = (st >> 1) * 16 + swz / 64; C = (st & 1) * 32 + (swz % 64) / 2; }
__host__ __device__ __forceinline__ int perm32(int rho) { const int n = rho >> 4, i = rho & 15; return 8 * (i >> 2) + 4 * n + (i & 3); }

struct Unit { int pm, pn; };
struct Gemm { const bf16_t* A; const bf16_t* Bt; int M, N, K; };

struct StaticOrder {
    int nM, nN, nwg, G, c;
    __host__ __device__ void init(int M, int N, int G_, int c_) { nM = M / BM; nN = N / BM; nwg = nM * nN; G = G_; c = c_; }
    __host__ __device__ bool next(int i, Unit& u) const {
        const long L = (long)i * G + c; if (L >= nwg) return false;
        int wgid = (int)L; { const int q = nwg / NXCD, r = nwg % NXCD, xcd = wgid % NXCD, off = wgid / NXCD; wgid = (xcd < r ? xcd * (q + 1) : r * (q + 1) + (xcd - r) * q) + off; }
        const int nig = WGM * nN, gid = wgid / nig, fm = gid * WGM, gsz = (nM - fm) < WGM ? (nM - fm) : WGM;
        u.pm = fm + ((wgid % nig) % gsz); u.pn = (wgid % nig) / gsz; return true;
    }
    __device__ __forceinline__ void a_ready(const Unit&) const {}
    __device__ __forceinline__ void done(const Unit&) const {}
};

__device__ __forceinline__ unsigned cvt_pk_bf16(float lo, float hi) { unsigned r; asm volatile("v_cvt_pk_bf16_f32 %0, %1, %2" : "=v"(r) : "v"(lo), "v"(hi)); return r; }
template <class Epi, class Sched, bool ALIGN_EPI = false, bool SP2 = false>
__device__ __forceinline__ void gemm_phase(PG8_LAS unsigned char* lds, const Gemm g, const Sched& S, const Epi& E) {
    const int tid = threadIdx.x, wid = __builtin_amdgcn_readfirstlane(tid >> 6), lane = tid & 63, wr = wid >> 2, wc = wid & 3, fr = lane & 15, fq = lane >> 4;
    const int K = g.K, nt = K / BK;
    unsigned voffA[2], voffB[2];
#pragma unroll
    for (int i = 0; i < 2; ++i) { int R, C; stage_rc(tid * 16 + i * 8192, R, C); const int Rb = Epi::PERM ? ((R & ~31) + perm32(R & 31)) : R;
        voffA[i] = (unsigned)(R * K + C) * 2u; voffB[i] = (unsigned)(Rb * K + C) * 2u; }
    const size_t kstep = (size_t)(BK * 2);
    const size_t hstep = (size_t)HALF * K * 2;
    const size_t tstep = 2 * hstep;
    const unsigned ldsw = (unsigned)wid * 1024u;
    const int aoff = lds_byte(wr * 64 + fr, fq * 8), boff = lds_byte(wc * 32 + fr, fq * 8);
#define PG8_SA(b, h) (((b) * 2 + (h)) * HTB)
#define PG8_SB(b, h) ((4 + (b) * 2 + (h)) * HTB)
#define PG8_STAGE(bufoff, gbase, voff) do { _Pragma("unroll") for (int _i = 0; _i < 2; ++_i) \
        __builtin_amdgcn_global_load_lds((const unsigned*)((const char*)(gbase) + (voff)[_i]), (PG8_LAS unsigned*)(lds + (bufoff) + ldsw + _i * 8192), 16, 0, 0); } while (0)
#define PG8_LDA(dst, b, h) do { _Pragma("unroll") for (int m = 0; m < 4; ++m) _Pragma("unroll") for (int k = 0; k < 2; ++k) dst[m][k] = *(const PG8_LAS bf16x8*)(lds + PG8_SA(b, h) + aoff + m * 2048 + k * 1024); } while (0)
#define PG8_LDB(dst, b, h) do { _Pragma("unroll") for (int n = 0; n < 2; ++n) _Pragma("unroll") for (int k = 0; k < 2; ++k) dst[n][k] = *(const PG8_LAS bf16x8*)(lds + PG8_SB(b, h) + boff + n * 2048 + k * 1024); } while (0)
#define PG8_MMA(ai, bj, At, Bt) do { __builtin_amdgcn_s_setprio(1); _Pragma("unroll") for (int m = 0; m < 4; ++m) _Pragma("unroll") for (int n = 0; n < 2; ++n) _Pragma("unroll") for (int k = 0; k < 2; ++k) \
        acc[ai][bj][m][n] = __builtin_amdgcn_mfma_f32_16x16x32_bf16(Bt[n][k], At[m][k], acc[ai][bj][m][n], 0, 0, 0); __builtin_amdgcn_s_setprio(0); } while (0)
#define PG8_WAIT_V(n) asm volatile("s_waitcnt vmcnt(" #n ")" ::: "memory")
#define PG8_WAIT_L(n) asm volatile("s_waitcnt lgkmcnt(" #n ")" ::: "memory")
#define PG8_BAR __builtin_amdgcn_s_barrier()
#define PG8_SCHED __builtin_amdgcn_sched_barrier(0)
    Unit cur, nxt; int ui = 0;
    if (!S.next(0, cur)) return;
    f32x4 acc[2][2][4][2];
#pragma unroll
    for (int a = 0; a < 2; ++a)
#pragma unroll
        for (int b = 0; b < 2; ++b)
#pragma unroll
            for (int m = 0; m < 4; ++m)
#pragma unroll
                for (int n = 0; n < 2; ++n) acc[a][b][m][n] = (f32x4){0.f, 0.f, 0.f, 0.f};
    bf16x8 At[4][2], B0[2][2], B1[2][2];
    const char* cA = (const char*)g.A + (size_t)cur.pm * tstep; const char* cB = (const char*)g.Bt + (size_t)cur.pn * tstep;
    S.a_ready(cur);
    if constexpr (SP2) {
        PG8_STAGE(PG8_SB(0, 0), cB, voffB); PG8_STAGE(PG8_SB(0, 1), cB + hstep, voffB); PG8_STAGE(PG8_SA(0, 0), cA, voffA); PG8_STAGE(PG8_SA(0, 1), cA + hstep, voffA);
        if (wr == 1) PG8_BAR;
        PG8_WAIT_V(2); PG8_BAR;
        PG8_STAGE(PG8_SB(1, 0), cB + kstep, voffB); PG8_STAGE(PG8_SA(1, 0), cA + kstep, voffA); PG8_STAGE(PG8_SB(1, 1), cB + hstep + kstep, voffB);
        PG8_WAIT_V(6); PG8_BAR;
    } else {
        PG8_STAGE(PG8_SB(0, 0), cB, voffB); PG8_STAGE(PG8_SA(0, 0), cA, voffA); PG8_STAGE(PG8_SB(0, 1), cB + hstep, voffB); PG8_STAGE(PG8_SA(0, 1), cA + hstep, voffA);
        if (wr == 1) PG8_BAR;
        PG8_WAIT_V(4); PG8_BAR;
        PG8_STAGE(PG8_SB(1, 0), cB + kstep, voffB); PG8_STAGE(PG8_SA(1, 0), cA + kstep, voffA); PG8_STAGE(PG8_SB(1, 1), cB + hstep + kstep, voffB);
        PG8_WAIT_V(6); PG8_BAR;
    }
    for (;;) {
        const bool has_next = S.next(ui + 1, nxt);
        const char* nA = has_next ? (const char*)g.A + (size_t)nxt.pm * tstep : cA; const char* nB = has_next ? (const char*)g.Bt + (size_t)nxt.pn * tstep : cB;
        for (int t = 0; t < nt; t += 2) {
            const bool last = (t == nt - 2);
            const char* a1 = cA + (size_t)(t + 1) * kstep;
            const char* a2 = last ? nA : cA + (size_t)(t + 2) * kstep; const char* b2 = last ? nB : cB + (size_t)(t + 2) * kstep;
            const char* a3 = a2 + kstep; const char* b3 = b2 + kstep;
            if (last && has_next) S.a_ready(nxt);
            if constexpr (SP2) {
            PG8_LDB(B0, 0, 0); PG8_LDB(B1, 0, 1); PG8_SCHED; PG8_LDA(At, 0, 0); PG8_STAGE(PG8_SA(1, 1), a1 + hstep, voffA);
            PG8_WAIT_V(8); PG8_WAIT_L(0); PG8_BAR; PG8_MMA(0, 0, At, B0); PG8_MMA(0, 1, At, B1); PG8_BAR; PG8_SCHED;
            PG8_LDA(At, 0, 1); PG8_STAGE(PG8_SB(0, 0), b2, voffB); PG8_STAGE(PG8_SB(0, 1), b2 + hstep, voffB); PG8_STAGE(PG8_SA(0, 0), a2, voffA);
            PG8_WAIT_V(8); PG8_WAIT_L(0); PG8_BAR; PG8_MMA(1, 0, At, B0); PG8_MMA(1, 1, At, B1); PG8_BAR; PG8_SCHED;
            PG8_LDB(B0, 1, 0); PG8_LDB(B1, 1, 1); PG8_SCHED; PG8_LDA(At, 1, 0); PG8_STAGE(PG8_SA(0, 1), a2 + hstep, voffA);
            PG8_WAIT_V(8); PG8_WAIT_L(0); PG8_BAR; PG8_MMA(0, 0, At, B0); PG8_MMA(0, 1, At, B1); PG8_BAR; PG8_SCHED;
            PG8_LDA(At, 1, 1); PG8_STAGE(PG8_SB(1, 0), b3, voffB); PG8_STAGE(PG8_SB(1, 1), b3 + hstep, voffB); PG8_STAGE(PG8_SA(1, 0), a3, voffA);
            PG8_WAIT_V(8); PG8_WAIT_L(0); PG8_BAR; PG8_MMA(1, 0, At, B0); PG8_MMA(1, 1, At, B1); PG8_BAR; PG8_SCHED;
            } else {
            PG8_LDB(B0, 0, 0); PG8_SCHED; PG8_LDA(At, 0, 0); PG8_STAGE(PG8_SA(1, 1), a1 + hstep, voffA);
            PG8_WAIT_L(8); PG8_BAR; PG8_WAIT_L(0); PG8_MMA(0, 0, At, B0); PG8_BAR; PG8_SCHED;
            PG8_LDB(B1, 0, 1); PG8_STAGE(PG8_SB(0, 0), b2, voffB);
            PG8_BAR; PG8_WAIT_L(0); PG8_MMA(0, 1, At, B1); PG8_BAR;
            PG8_LDA(At, 0, 1); PG8_STAGE(PG8_SA(0, 0), a2, voffA);
            PG8_BAR; PG8_WAIT_L(0); PG8_MMA(1, 0, At, B0); PG8_BAR; PG8_SCHED;
            PG8_STAGE(PG8_SB(0, 1), b2 + hstep, voffB);
            PG8_WAIT_V(6); PG8_BAR; PG8_MMA(1, 1, At, B1); PG8_BAR;
            PG8_LDB(B0, 1, 0); PG8_SCHED; PG8_LDA(At, 1, 0); PG8_STAGE(PG8_SA(0, 1), a2 + hstep, voffA);
            PG8_WAIT_L(8); PG8_BAR; PG8_WAIT_L(0); PG8_MMA(0, 0, At, B0); PG8_BAR; PG8_SCHED;
            PG8_LDB(B1, 1, 1); PG8_STAGE(PG8_SB(1, 0), b3, voffB);
            PG8_BAR; PG8_WAIT_L(0); PG8_MMA(0, 1, At, B1); PG8_BAR;
            PG8_LDA(At, 1, 1); PG8_STAGE(PG8_SA(1, 0), a3, voffA);
            PG8_BAR; PG8_WAIT_L(0); PG8_MMA(1, 0, At, B0); PG8_BAR; PG8_SCHED;
            PG8_STAGE(PG8_SB(1, 1), b3 + hstep, voffB);
            PG8_WAIT_V(6); PG8_BAR; PG8_MMA(1, 1, At, B1); PG8_BAR;
            }
        }
        if constexpr (ALIGN_EPI) { if (wr == 0) PG8_BAR; }
        if constexpr (!Epi::AFTER_DRAIN) { E(acc, cur, wr, wc, fr, fq); S.done(cur); }
        if (!has_next) break;
#pragma unroll
        for (int a = 0; a < 2; ++a)
#pragma unroll
            for (int b = 0; b < 2; ++b)
#pragma unroll
                for (int m = 0; m < 4; ++m)
#pragma unroll
                    for (int n = 0; n < 2; ++n) acc[a][b][m][n] = (f32x4){0.f, 0.f, 0.f, 0.f};
        cur = nxt; cA = nA; cB = nB; ++ui;
        if constexpr (ALIGN_EPI) { if (wr == 1) PG8_BAR; }
    }
    PG8_WAIT_V(0);
    if constexpr (!ALIGN_EPI) { if (wr == 0) PG8_BAR; }
    PG8_BAR;
    if constexpr (Epi::AFTER_DRAIN) { E.fused(acc, cur, wr, wc, fr, fq, lds, wid, lane); S.done(cur); }
#undef PG8_SA
#undef PG8_SB
#undef PG8_STAGE
#undef PG8_LDA
#undef PG8_LDB
#undef PG8_MMA
#undef PG8_WAIT_V
#undef PG8_WAIT_L
#undef PG8_BAR
#undef PG8_SCHED
}
}
#define XB_TMO      128
#define XB_XCNT(j)  (256  + 64 * (j))
#define XB_XSUB(j)  (1280 + 64 * (j))
#define XB_XGEN(j)  (2304 + 64 * (j))
#define XB_TOP      3328
#define XB_TOPGEN   3392
#define XCD_BAR_WORDS 3456
#define XB_SPIN_CAP (1u << 18)

__device__ __forceinline__ unsigned xb_ld(unsigned* p)              { return __hip_atomic_load(p, __ATOMIC_RELAXED, __HIP_MEMORY_SCOPE_AGENT); }
__device__ __forceinline__ unsigned xb_add(unsigned* p, unsigned v) { return __hip_atomic_fetch_add(p, v, __ATOMIC_RELAXED, __HIP_MEMORY_SCOPE_AGENT); }
__device__ __forceinline__ unsigned xb_xcc_id() { return (unsigned)__builtin_amdgcn_s_getreg((3 << 11) | 20) & 0xFu; }
#define XB_SPIN(cond, bar) do { unsigned _sp = 0; while (cond) { __builtin_amdgcn_s_sleep(1); \
    if ((++_sp & 255u) == 0u) { if (xb_ld(&(bar)[XB_TMO])) break; if (_sp > XB_SPIN_CAP) { atomicAdd(&(bar)[XB_TMO], 1u); break; } } } } while (0)

struct XcdBarrier {
    unsigned* bar; unsigned x;
    volatile LAS unsigned* st;
};

__device__ __forceinline__ XcdBarrier xcd_barrier_post(unsigned* bar, volatile LAS unsigned* st) {
    XcdBarrier b; b.bar = bar; b.x = xb_xcc_id(); b.st = st;
    if (threadIdx.x == 0) (void)xb_add(&bar[XB_XCNT(b.x)], 1u);
    return b;
}
__device__ __forceinline__ void xcd_barrier_complete(unsigned* bar, unsigned x, unsigned& nloc, unsigned& nx) {
    const unsigned G = gridDim.x * gridDim.y * gridDim.z;
    unsigned sum, cnt, mine, sp = 0u;
    for (;;) {
        sum = 0u; cnt = 0u; mine = 0u;
#pragma unroll
        for (unsigned j = 0; j < 16; ++j) { const unsigned c = xb_ld(&bar[XB_XCNT(j)]); sum += c; cnt += (c > 0u) ? 1u : 0u; mine = (j == x) ? c : mine; }
        if (sum == G) break;
        __builtin_amdgcn_s_sleep(1);
        if ((++sp & 255u) == 0u) { if (xb_ld(&bar[XB_TMO])) break; if (sp > XB_SPIN_CAP) { atomicAdd(&bar[XB_TMO], 1u); break; } }
    }
    nloc = mine > 0u ? mine : 1u; nx = cnt > 0u ? cnt : 1u;
}

__device__ __forceinline__ void xcd_barrier(const XcdBarrier& b) {
    asm volatile("s_waitcnt vmcnt(0)" ::: "memory");
    __syncthreads();
    if (threadIdx.x == 0) {
        unsigned* bar = b.bar;
        __builtin_amdgcn_s_waitcnt(0);
        unsigned nloc = b.st[0], nx = b.st[1];
        if (nloc == 0u) { xcd_barrier_complete(bar, b.x, nloc, nx); b.st[0] = nloc; b.st[1] = nx; }
        const unsigned old = xb_add(&bar[XB_XSUB(b.x)], 1u);
        const unsigned gen = old / nloc;
        if (old + 1u == (gen + 1u) * nloc) {
            __builtin_amdgcn_fence(__ATOMIC_RELEASE, "agent");
            asm volatile("s_waitcnt vmcnt(0)" ::: "memory");
            const unsigned og = xb_add(&bar[XB_TOP], 1u);
            const unsigned tg = og / nx;
            if (og + 1u == (tg + 1u) * nx) xb_add(&bar[XB_TOPGEN], 1u);
            else XB_SPIN(xb_ld(&bar[XB_TOPGEN]) == tg, bar);
            __builtin_amdgcn_fence(__ATOMIC_ACQUIRE, "agent");
            xb_add(&bar[XB_XGEN(b.x)], 1u);
            asm volatile("s_waitcnt vmcnt(0)" ::: "memory");
        } else {
            XB_SPIN(xb_ld(&bar[XB_XGEN(b.x)]) == gen, bar);
            __builtin_amdgcn_fence(__ATOMIC_ACQUIRE, "agent");
            asm volatile("s_waitcnt vmcnt(0)" ::: "memory");
        }
    }
    __syncthreads();
}

struct EpiStoreBf16 {
    static constexpr bool PERM = true, AFTER_DRAIN = false;
    bf16* O; int ldc; int pn_mask;
    __device__ __forceinline__ void operator()(const pg8::f32x4 (&acc)[2][2][4][2], const pg8::Unit& u, int wr, int wc, int fr_, int fq_) const {
        int t_ = threadIdx.x; asm volatile("" : "+v"(t_)); const int fr = t_ & 15, fq = (t_ >> 4) & 3; (void)fr_; (void)fq_;
        const int row0 = u.pm * 256 + wr * 64 + fr, col0 = (u.pn & pn_mask) * 256 + wc * 32 + 8 * fq;
#pragma unroll
        for (int ai = 0; ai < 2; ++ai)
#pragma unroll
            for (int m = 0; m < 4; ++m) { bf16* rowp = O + (size_t)(row0 + ai * 128 + m * 16) * ldc + col0;
#pragma unroll
                for (int bj = 0; bj < 2; ++bj) { const pg8::f32x4 v0 = acc[ai][bj][m][0], v1 = acc[ai][bj][m][1];
                    v4u w; w.x = pg8::cvt_pk_bf16(v0[0], v0[1]); w.y = pg8::cvt_pk_bf16(v0[2], v0[3]); w.z = pg8::cvt_pk_bf16(v1[0], v1[1]); w.w = pg8::cvt_pk_bf16(v1[2], v1[3]);
                    *(v4u*)(rowp + bj * 128) = w; } }
    }
};
struct EpiGateUp {
    static constexpr bool PERM = true, AFTER_DRAIN = false;
    const float* sw; bf16* HG;
    __device__ __forceinline__ void operator()(const pg8::f32x4 (&acc)[2][2][4][2], const pg8::Unit& u, int wr, int wc, int fr_, int fq_) const {
        int t_ = threadIdx.x; asm volatile("" : "+v"(t_)); const int fr = t_ & 15, fq = (t_ >> 4) & 3; (void)fr_; (void)fq_;
        const int pl = u.pn & 3, row0 = u.pm * 256 + wr * 64 + fr, col0 = pl * 128 + wc * 32 + 8 * fq;
#pragma unroll
        for (int ai = 0; ai < 2; ++ai)
#pragma unroll
            for (int m = 0; m < 4; ++m) { const int row = row0 + ai * 128 + m * 16; const float w = sw[row]; float h[8];
#pragma unroll
                for (int n = 0; n < 2; ++n)
#pragma unroll
                    for (int j = 0; j < 4; ++j) { const float g = acc[ai][0][m][n][j], up = acc[ai][1][m][n][j]; h[4 * n + j] = g * sigmoid_f(g) * up * w; }
                v4u o; o.x = pg8::cvt_pk_bf16(h[0], h[1]); o.y = pg8::cvt_pk_bf16(h[2], h[3]); o.z = pg8::cvt_pk_bf16(h[4], h[5]); o.w = pg8::cvt_pk_bf16(h[6], h[7]);
                *(v4u*)(HG + (size_t)row * FF + col0) = o; }
    }
};
struct EpiResGate {
    static constexpr bool PERM = false, AFTER_DRAIN = false;
    const float* x; const float* gate; float* X1;
    __device__ __forceinline__ void operator()(const pg8::f32x4 (&acc)[2][2][4][2], const pg8::Unit& u, int wr, int wc, int fr_, int fq_) const {
        int t_ = threadIdx.x; asm volatile("" : "+v"(t_)); const int fr = t_ & 15, fq = (t_ >> 4) & 3; (void)fr_; (void)fq_;
        const int row0 = u.pm * 256 + wr * 64 + fr, col0 = u.pn * 256 + wc * 32 + 4 * fq;
        const float* gp = gate + (size_t)((u.pm * 256) >> 12) * 12288;
#pragma unroll
        for (int bj = 0; bj < 2; ++bj)
#pragma unroll
            for (int n = 0; n < 2; ++n) { const int c = col0 + bj * 128 + n * 16; const pg8::f32x4 gv = *(const pg8::f32x4*)(gp + c);
#pragma unroll
                for (int ai = 0; ai < 2; ++ai)
#pragma unroll
                    for (int m = 0; m < 4; ++m) { const size_t off = (size_t)(row0 + ai * 128 + m * 16) * DM + c;
                        const pg8::f32x4 xv = *(const pg8::f32x4*)(x + off); *(pg8::f32x4*)(X1 + off) = xv + gv * acc[ai][bj][m][n]; } }
    }
};
struct EpiLora {
    static constexpr bool PERM = false, AFTER_DRAIN = false;
    const float* w0; const float* a0; float* LW; bf16* AA; bf16* GG;
    __device__ __forceinline__ void operator()(const pg8::f32x4 (&acc)[2][2][4][2], const pg8::Unit& u, int wr, int wc, int fr_, int fq_) const {
        int t_ = threadIdx.x; asm volatile("" : "+v"(t_)); const int fr = t_ & 15, fq = (t_ >> 4) & 3; (void)fr_; (void)fq_;
        const int type = u.pn >> 2, row0 = u.pm * 256 + wr * 64 + fr, col0 = (u.pn & 3) * 256 + wc * 32 + 4 * fq;
#pragma unroll
        for (int bj = 0; bj < 2; ++bj)
#pragma unroll
            for (int n = 0; n < 2; ++n) { const int c = col0 + bj * 128 + n * 16;
                pg8::f32x4 bias = (pg8::f32x4){0.f, 0.f, 0.f, 0.f};
                if (type == 0) bias = *(const pg8::f32x4*)(w0 + c); else if (type == 1) bias = *(const pg8::f32x4*)(a0 + c);
#pragma unroll
                for (int ai = 0; ai < 2; ++ai)
#pragma unroll
                    for (int m = 0; m < 4; ++m) { const size_t off = (size_t)(row0 + ai * 128 + m * 16) * CW + c; const pg8::f32x4 v = acc[ai][bj][m][n] + bias;
                        if (type == 0) { pg8::f32x4 o;
#pragma unroll
                            for (int j = 0; j < 4; ++j) { const float z = -v[j]; const float sp = fmaxf(z, 0.f) + __logf(1.f + __expf(-fabsf(z))); o[j] = -__expf(-sp - 0.5f); }
                            *(pg8::f32x4*)(LW + off) = o; }
                        else if (type == 1) { v2u o; o.x = pk2(sigmoid_f(v[0]), sigmoid_f(v[1])); o.y = pk2(sigmoid_f(v[2]), sigmoid_f(v[3])); *(v2u*)(AA + off) = o; }
                        else { v2u o; o.x = pk2(v[0], v[1]); o.y = pk2(v[2], v[3]); *(v2u*)(GG + off) = o; } } }
    }
};
struct GroupOrder {
    const unsigned* te; int nrt, ncol, G, c;
    __device__ __forceinline__ bool next(int i, pg8::Unit& u) const {
        const long L = (long)i * G + c; if (L >= (long)nrt * ncol) return false;
        const int rt = (int)(L / ncol), pl = (int)(L - (long)rt * ncol);
        u.pm = rt; u.pn = (int)te[rt] * ncol + pl; return true;
    }
    __device__ __forceinline__ void a_ready(const pg8::Unit&) const {}
    __device__ __forceinline__ void done(const pg8::Unit&) const {}
};

#define MFMA16(a, b, c) __builtin_amdgcn_mfma_f32_16x16x16bf16_1k(a, b, c, 0, 0, 0)
constexpr int NUNIT = BATCH * NHEAD * (SEQ / 64);
constexpr int LA_GF = 0, LA_SEG = 16384, LA_PL = 18432, LA_RT = 20480, LA_QT = 28672, LA_KT = 36864, LA_BT = 45056, LA_VT = 53248,
              LA_AQB = 61440, LA_AQK = 69632, LA_ARB = 77824, LA_ARK = 86016, LA_DG = 94208, LA_DL = 98304;
__device__ __forceinline__ int swz(int row, int chunk) { return row * 128 + ((chunk ^ ((row >> 1) & 7)) << 4); }
__device__ __forceinline__ s16x4 tr_read(LAS unsigned char* base, int r0, int cb, int n) {
    return __builtin_bit_cast(s16x4, __builtin_amdgcn_ds_read_tr16_b64_v4i16((LAS s16x4*)(base + swz(r0 + (n >> 2), 2 * cb + ((n & 3) >> 1)) + 8 * (n & 1)))); }
__device__ __forceinline__ s16x4 row_read4(LAS unsigned char* base, int row, int col0) {
    return *(const LAS s16x4*)(base + swz(row, col0 >> 3) + 2 * (col0 & 7)); }
__device__ __forceinline__ s16x4 pack4(const f32x4 v) { v2u w; w.x = pk2(v[0], v[1]); w.y = pk2(v[2], v[3]); return __builtin_bit_cast(s16x4, w); }
__device__ __forceinline__ s16x4 pack4n(const f32x4 v) { v2u w; w.x = pk2(-v[0], -v[1]); w.y = pk2(-v[2], -v[3]); return __builtin_bit_cast(s16x4, w); }
__device__ __forceinline__ f32x4 unpack4(const s16x4 s) { const v2u w = __builtin_bit_cast(v2u, s); return (f32x4){bflo(w.x), bfhi(w.x), bflo(w.y), bfhi(w.y)}; }

__device__ __forceinline__ void scanA(const Args& a, LAS unsigned char* lds) {
    const int tid = threadIdx.x, lane = tid & 63, wave = __builtin_amdgcn_readfirstlane(tid >> 6), n = lane & 15, g = lane >> 4;
    LAS float* GF = (LAS float*)(lds + LA_GF); LAS float* SEG = (LAS float*)(lds + LA_SEG); LAS float* PLs = (LAS float*)(lds + LA_PL); LAS float* DG = (LAS float*)(lds + LA_DG);
    const int tk = tid >> 3, c8 = 8 * (tid & 7);
    v4u nr4, nk4, nv4, nq4, nb4; f32x4 nl0, nl1;
#define SCANA_LOAD(U) do { const int bh_ = (U) >> 6, ck_ = (U) & 63; const size_t off_ = ((size_t)(bh_ >> 4) * SEQ + 64 * ck_ + tk) * CW + (bh_ & 15) * 64 + c8; \
        nr4 = *(const v4u*)((const bf16*)(a.ws + WS_R) + off_); nk4 = *(const v4u*)((const bf16*)(a.ws + WS_K2) + off_); nv4 = *(const v4u*)((const bf16*)(a.ws + WS_V) + off_); \
        nq4 = *(const v4u*)((const bf16*)(a.ws + WS_KK) + off_); nb4 = *(const v4u*)((const bf16*)(a.ws + WS_BB) + off_); \
        nl0 = *(const f32x4*)((const float*)(a.ws + WS_LW) + off_); nl1 = *(const f32x4*)((const float*)(a.ws + WS_LW) + off_ + 4); } while (0)
    if ((int)blockIdx.x < NUNIT) SCANA_LOAD((int)blockIdx.x);
    for (int unit = blockIdx.x; unit < NUNIT; unit += gridDim.x) {
        const v4u r4 = nr4, k4 = nk4, v4 = nv4, q4 = nq4, b4 = nb4; const f32x4 l0 = nl0, l1 = nl1;
        *(LAS f32x4*)(GF + tk * 64 + c8) = l0; *(LAS f32x4*)(GF + tk * 64 + c8 + 4) = l1;
        __syncthreads();
        { const int c = tid & 63, sg = tid >> 6; float run = 0.f;
#pragma unroll
          for (int i = 0; i < 8; ++i) { run += GF[(8 * sg + i) * 64 + c]; GF[(8 * sg + i) * 64 + c] = run; }
          SEG[sg * 64 + c] = run; }
        __syncthreads();
        { const int sg = tk >> 3; float gg[8], lw[8];
#pragma unroll
          for (int i = 0; i < 8; ++i) { float x = GF[tk * 64 + c8 + i];
#pragma unroll
              for (int s2 = 0; s2 < 7; ++s2) if (s2 < sg) x += SEG[s2 * 64 + c8 + i];
              gg[i] = x; lw[i] = (i < 4) ? l0[i] : l1[i - 4]; }
          float rr[8], qq[8], kk[8], bb[8];
#pragma unroll
          for (int i = 0; i < 4; ++i) { const int e0 = 2 * i, e1 = 2 * i + 1;
              const float eg0 = __expf(gg[e0]), eg1 = __expf(gg[e1]), en0 = __expf(-gg[e0]), en1 = __expf(-gg[e1]), em0 = __expf(gg[e0] - lw[e0]), em1 = __expf(gg[e1] - lw[e1]);
              rr[e0] = bflo(r4[i]) * eg0; rr[e1] = bfhi(r4[i]) * eg1; qq[e0] = bflo(q4[i]) * em0; qq[e1] = bfhi(q4[i]) * em1;
              kk[e0] = bflo(k4[i]) * en0; kk[e1] = bfhi(k4[i]) * en1; bb[e0] = bflo(b4[i]) * en0; bb[e1] = bfhi(b4[i]) * en1;
              if (tk == 63) { PLs[c8 + e0] = eg0; PLs[c8 + e1] = eg1; } }
          const int so = swz(tk, tid & 7); v4u w;
          w.x = pk2(rr[0], rr[1]); w.y = pk2(rr[2], rr[3]); w.z = pk2(rr[4], rr[5]); w.w = pk2(rr[6], rr[7]); *(LAS v4u*)(lds + LA_RT + so) = w;
          w.x = pk2(qq[0], qq[1]); w.y = pk2(qq[2], qq[3]); w.z = pk2(qq[4], qq[5]); w.w = pk2(qq[6], qq[7]); *(LAS v4u*)(lds + LA_QT + so) = w;
          w.x = pk2(kk[0], kk[1]); w.y = pk2(kk[2], kk[3]); w.z = pk2(kk[4], kk[5]); w.w = pk2(kk[6], kk[7]); *(LAS v4u*)(lds + LA_KT + so) = w;
          w.x = pk2(bb[0], bb[1]); w.y = pk2(bb[2], bb[3]); w.z = pk2(bb[4], bb[5]); w.w = pk2(bb[6], bb[7]); *(LAS v4u*)(lds + LA_BT + so) = w;
          *(LAS v4u*)(lds + LA_VT + so) = v4; }
        __syncthreads();
        if (unit + (int)gridDim.x < NUNIT) SCANA_LOAD(unit + (int)gridDim.x);
        for (int id = wave; id < 40; id += NWAVES) {
            const int mat = id / 10, p = id - mat * 10, tb = p < 1 ? 0 : (p < 3 ? 1 : (p < 6 ? 2 : 3)), sb = p - tb * (tb + 1) / 2;
            LAS unsigned char* Lft = lds + ((mat & 1) ? LA_KT : LA_BT); LAS unsigned char* Rgt = lds + ((mat & 2) ? LA_RT : LA_QT);
            f32x4 acc = (f32x4){0.f, 0.f, 0.f, 0.f};
#pragma unroll
            for (int ks = 0; ks < 2; ++ks) { const bf16x8 af = *(const LAS bf16x8*)(Lft + swz(16 * sb + n, 4 * ks + g)), bfr = *(const LAS bf16x8*)(Rgt + swz(16 * tb + n, 4 * ks + g));
                acc = __builtin_amdgcn_mfma_f32_16x16x32_bf16(af, bfr, acc, 0, 0, 0); }
            const int t = 16 * tb + n, s0 = 16 * sb + 4 * g;
#pragma unroll
            for (int j = 0; j < 4; ++j) { const bool keep = (mat & 2) ? (s0 + j <= t) : (s0 + j < t); if (!keep) acc[j] = 0.f; }
            LAS unsigned char* dst = lds + (mat == 0 ? LA_AQB : (mat == 1 ? LA_AQK : (mat == 2 ? LA_ARB : LA_ARK)));
            v2u w; w.x = pk2(acc[0], acc[1]); w.y = pk2(acc[2], acc[3]);
            *(LAS v2u*)(dst + swz(t, s0 >> 3) + 2 * (s0 & 7)) = w;
            if (mat == 0 && sb == tb) *(LAS f32x4*)(DG + tb * 256 + n * 16 + 4 * g) = acc;
        }
        __syncthreads();
        if (wave < 4 && lane < 16) {
            const LAS float* A = DG + wave * 256; float x[16];
#pragma unroll
            for (int t = 0; t < 16; ++t) { float acc = (t == lane) ? 1.f : 0.f;
#pragma unroll
                for (int s = 0; s < t; ++s) acc -= A[t * 16 + s] * x[s];
                x[t] = acc; }
            LAS bf16* D = (LAS bf16*)(lds + LA_DL) + wave * 256;
#pragma unroll
            for (int t = 0; t < 16; ++t) D[t * 16 + lane] = (bf16)f2bf(x[t]);
        }
        __syncthreads();
        {
            const bool isU = wave >= 4; const int cb = wave & 3;
            LAS unsigned char* AQB = lds + LA_AQB; LAS unsigned char* AQK = lds + LA_AQK; LAS unsigned char* ARB = lds + LA_ARB; LAS unsigned char* ARK = lds + LA_ARK;
            s16x4 vf[4], xn[4];
            f32x4 rhs[4];
            if (isU) {
#pragma unroll
                for (int k = 0; k < 4; ++k) vf[k] = tr_read(lds + LA_VT, 16 * k + 4 * g, cb, n);
#pragma unroll
                for (int i = 0; i < 4; ++i) { f32x4 acc = (f32x4){0.f, 0.f, 0.f, 0.f};
#pragma unroll
                    for (int k = 0; k < 4; ++k) if (k <= i) acc = MFMA16(row_read4(AQK, 16 * i + n, 16 * k + 4 * g), vf[k], acc);
                    rhs[i] = acc; }
            } else {
#pragma unroll
                for (int i = 0; i < 4; ++i) { rhs[i] = unpack4(tr_read(lds + LA_QT, 16 * i + 4 * g, cb, n)); vf[i] = (s16x4){0, 0, 0, 0}; }
            }
#pragma unroll
            for (int i = 0; i < 4; ++i) { f32x4 acc = rhs[i];
#pragma unroll
                for (int k = 0; k < 4; ++k) if (k < i) acc = MFMA16(row_read4(AQB, 16 * i + n, 16 * k + 4 * g), xn[k], acc);
                const s16x4 df = *(const LAS s16x4*)(lds + LA_DL + i * 512 + n * 32 + 8 * g);
                const f32x4 xi = MFMA16(df, pack4(acc), ((f32x4){0.f, 0.f, 0.f, 0.f}));
                xn[i] = pack4n(xi); }
            const float plv[4] = {PLs[n], PLs[16 + n], PLs[32 + n], PLs[48 + n]};
            if (!isU) {
                bf16* RH = (bf16*)(a.ws + WS_RH) + (size_t)unit * 4096;
#pragma unroll
                for (int i = 0; i < 4; ++i) { f32x4 acc = unpack4(tr_read(lds + LA_RT, 16 * i + 4 * g, cb, n));
#pragma unroll
                    for (int k = 0; k < 4; ++k) if (k <= i) acc = MFMA16(row_read4(ARB, 16 * i + n, 16 * k + 4 * g), xn[k], acc);
#pragma unroll
                    for (int j = 0; j < 4; ++j) RH[(16 * i + 4 * g + j) * 64 + 16 * cb + n] = (bf16)f2bf(acc[j]); }
                bf16* GT = (bf16*)(a.ws + WS_GT) + (size_t)unit * 4096;
#pragma unroll
                for (int c2b = 0; c2b < 4; ++c2b) { f32x4 acc = (f32x4){0.f, 0.f, 0.f, 0.f};
#pragma unroll
                    for (int k = 0; k < 4; ++k) acc = MFMA16(xn[k], tr_read(lds + LA_BT, 16 * k + 4 * g, c2b, n), acc);
                    acc *= plv[c2b]; *(v2u*)(GT + (16 * c2b + n) * 64 + 16 * cb + 4 * g) = __builtin_bit_cast(v2u, pack4(acc)); }
            } else {
                float* Y1 = (float*)(a.ws + WS_Y1) + (size_t)unit * 4096;
#pragma unroll
                for (int i = 0; i < 4; ++i) { f32x4 acc = (f32x4){0.f, 0.f, 0.f, 0.f};
#pragma unroll
                    for (int k = 0; k < 4; ++k) if (k <= i) { acc = MFMA16(row_read4(ARK, 16 * i + n, 16 * k + 4 * g), vf[k], acc); acc = MFMA16(row_read4(ARB, 16 * i + n, 16 * k + 4 * g), xn[k], acc); }
#pragma unroll
                    for (int j = 0; j < 4; ++j) Y1[(16 * i + 4 * g + j) * 64 + 16 * cb + n] = acc[j]; }
                float* HM = (float*)(a.ws + WS_HM) + (size_t)unit * 4096;
#pragma unroll
                for (int c2b = 0; c2b < 4; ++c2b) { f32x4 acc = (f32x4){0.f, 0.f, 0.f, 0.f};
#pragma unroll
                    for (int k = 0; k < 4; ++k) { acc = MFMA16(vf[k], tr_read(lds + LA_KT, 16 * k + 4 * g, c2b, n), acc); acc = MFMA16(xn[k], tr_read(lds + LA_BT, 16 * k + 4 * g, c2b, n), acc); }
#pragma unroll
                    for (int j = 0; j < 4; ++j) HM[(16 * cb + 4 * g + j) * 64 + 16 * c2b + n] = acc[j] * plv[c2b]; }
            }
            if (wave == 0) ((float*)(a.ws + WS_PLV))[(size_t)unit * 64 + lane] = PLs[lane];
        }
        __syncthreads();
    }
}

struct ChainFrag { s16x4 gf[4][4]; f32x4 hm[4], pl[4]; };
__device__ __forceinline__ void chain_load(ChainFrag& f, const Args& a, size_t unit, int wave, int n, int g) {
    const bf16* GT = (const bf16*)(a.ws + WS_GT) + unit * 4096; const float* HM = (const float*)(a.ws + WS_HM) + unit * 4096; const float* PLV = (const float*)(a.ws + WS_PLV) + unit * 64;
#pragma unroll
    for (int i = 0; i < 4; ++i) { f.hm[i] = *(const f32x4*)(HM + (16 * wave + n) * 64 + 16 * i + 4 * g); f.pl[i] = *(const f32x4*)(PLV + 16 * i + 4 * g);
#pragma unroll
        for (int k = 0; k < 4; ++k) f.gf[i][k] = *(const s16x4*)(GT + (16 * i + n) * 64 + 16 * k + 4 * g); }
}
__device__ __forceinline__ void chain_step(const ChainFrag& f, f32x4 (&acc)[4], const Args& a, size_t unit, int wave, int lane) {
    s16x4 sb[4];
    v2u* SF = (v2u*)(a.ws + WS_SF) + (unit * 16 + wave * 4) * 64 + lane;
#pragma unroll
    for (int k = 0; k < 4; ++k) { sb[k] = pack4(acc[k]); SF[k * 64] = __builtin_bit_cast(v2u, sb[k]); }
    f32x4 nx[4];
#pragma unroll
    for (int i = 0; i < 4; ++i) { nx[i] = f.pl[i] * acc[i] + f.hm[i];
#pragma unroll
        for (int k = 0; k < 4; ++k) nx[i] = MFMA16(f.gf[i][k], sb[k], nx[i]); }
#pragma unroll
    for (int i = 0; i < 4; ++i) acc[i] = nx[i];
}
__device__ __forceinline__ void scanB(const Args& a) {
    const int tid = threadIdx.x, lane = tid & 63, wave = __builtin_amdgcn_readfirstlane(tid >> 6), n = lane & 15, g = lane >> 4;
    if (wave >= 4) return;
    for (int bh = blockIdx.x; bh < BATCH * NHEAD; bh += gridDim.x) {
        f32x4 acc[4];
#pragma unroll
        for (int i = 0; i < 4; ++i) acc[i] = (f32x4){0.f, 0.f, 0.f, 0.f};
        const size_t u0 = (size_t)bh * 64;
        ChainFrag fa, fb;
        chain_load(fa, a, u0, wave, n, g);
        for (int ck = 0; ck < SEQ / 64; ck += 2) {
            chain_load(fb, a, u0 + ck + 1, wave, n, g);
            chain_step(fa, acc, a, u0 + ck, wave, lane);
            if (ck + 2 < SEQ / 64) chain_load(fa, a, u0 + ck + 2, wave, n, g);
            chain_step(fb, acc, a, u0 + ck + 1, wave, lane);
        }
    }
}

__device__ __forceinline__ void scanC(const Args& a) {
    const int tid = threadIdx.x, lane = tid & 63, wave = tid >> 6, n = lane & 15, g = lane >> 4;
    const int gw = blockIdx.x * NWAVES + wave, NGW = gridDim.x * NWAVES;
    for (int task = gw; task < NUNIT * 4; task += NGW) {
        const int unit = task >> 2, i = task & 3, bh = unit >> 6, ck = unit & 63, b = bh >> 4, h = bh & 15;
        const v2u* SF = (const v2u*)(a.ws + WS_SF) + (size_t)unit * 16 * 64 + lane;
        const bf16* RH = (const bf16*)(a.ws + WS_RH) + (size_t)unit * 4096; const float* Y1 = (const float*)(a.ws + WS_Y1) + (size_t)unit * 4096;
        s16x4 rf[4]; f32x4 acc[4];
#pragma unroll
        for (int k = 0; k < 4; ++k) rf[k] = *(const s16x4*)(RH + (16 * i + n) * 64 + 16 * k + 4 * g);
#pragma unroll
        for (int vb = 0; vb < 4; ++vb) { acc[vb] = *(const f32x4*)(Y1 + (16 * i + n) * 64 + 16 * vb + 4 * g);
#pragma unroll
            for (int k = 0; k < 4; ++k) acc[vb] = MFMA16(__builtin_bit_cast(s16x4, SF[(vb * 4 + k) * 64]), rf[k], acc[vb]); }
        const size_t m = (size_t)b * SEQ + 64 * ck + 16 * i + n;
        float s1 = 0.f;
#pragma unroll
        for (int vb = 0; vb < 4; ++vb) s1 += (acc[vb][0] + acc[vb][1]) + (acc[vb][2] + acc[vb][3]);
        s1 += __shfl_xor(s1, 16); s1 += __shfl_xor(s1, 32);
        const float mean = s1 * (1.f / 64.f); float s2 = 0.f;
#pragma unroll
        for (int vb = 0; vb < 4; ++vb)
#pragma unroll
            for (int j = 0; j < 4; ++j) { const float d = acc[vb][j] - mean; s2 += d * d; }
        s2 += __shfl_xor(s2, 16); s2 += __shfl_xor(s2, 32);
        const float rstd = 1.f / sqrtf(s2 * (1.f / 64.f) + GN_EPS);
        f32x4 rv[4], kv[4], vv[4], gv[4]; float dot = 0.f;
#pragma unroll
        for (int vb = 0; vb < 4; ++vb) { const size_t o = m * CW + h * 64 + 16 * vb + 4 * g;
            rv[vb] = unpack4(*(const s16x4*)((const bf16*)(a.ws + WS_R) + o)); kv[vb] = unpack4(*(const s16x4*)((const bf16*)(a.ws + WS_K2) + o));
            vv[vb] = unpack4(*(const s16x4*)((const bf16*)(a.ws + WS_V) + o)); gv[vb] = unpack4(*(const s16x4*)((const bf16*)(a.ws + WS_GG) + o));
            const f32x4 rk = *(const f32x4*)(a.in[I_RK] + h * 64 + 16 * vb + 4 * g);
#pragma unroll
            for (int j = 0; j < 4; ++j) dot += rv[vb][j] * kv[vb][j] * rk[j]; }
        dot += __shfl_xor(dot, 16); dot += __shfl_xor(dot, 32);
#pragma unroll
        for (int vb = 0; vb < 4; ++vb) { const int c = h * 64 + 16 * vb + 4 * g;
            const f32x4 lw = *(const f32x4*)(a.in[I_LNW] + c), lb = *(const f32x4*)(a.in[I_LNB] + c), be = *(const f32x4*)(a.in[I_BETAR] + c);
            const f32x4 o = ((acc[vb] - mean) * rstd * lw + lb + dot * vv[vb]) * gv[vb] * be;
            *(v2u*)((bf16*)(a.ws + WS_YMIX) + m * DM + c) = __builtin_bit_cast(v2u, pack4(o)); }
    }
}

__device__ __forceinline__ void conv_item(const float* __restrict__ W, int N, bf16* WT, size_t drow0, int ldd, int k0, int n0, LAS float* scr, int lane) {
    float v[32];
#pragma unroll
    for (int i = 0; i < 32; ++i) { const int kk = 2 * i + (lane >> 5); v[i] = W[(size_t)(k0 + kk) * N + n0 + (lane & 31)]; }
#pragma unroll
    for (int i = 0; i < 32; ++i) { const int kk = 2 * i + (lane >> 5); scr[kk * 33 + (lane & 31)] = v[i]; }
    LDS_WAIT(); asm volatile("" ::: "memory");
    const int c = lane & 7;
#pragma unroll
    for (int j = 0; j < 4; ++j) { const int n = (lane >> 3) + 8 * j; const LAS float* s = scr + (8 * c) * 33 + n;
        v4u o; o.x = pk2(s[0 * 33], s[1 * 33]); o.y = pk2(s[2 * 33], s[3 * 33]); o.z = pk2(s[4 * 33], s[5 * 33]); o.w = pk2(s[6 * 33], s[7 * 33]);
        *(v4u*)(WT + (drow0 + n) * (size_t)ldd + k0 + 8 * c) = o; }
    LDS_WAIT(); asm volatile("" ::: "memory");
}
__device__ __forceinline__ void phase0(const Args& a, LAS unsigned char* lds) {
    const int tid = threadIdx.x, lane = tid & 63, wave = __builtin_amdgcn_readfirstlane(tid >> 6), G = gridDim.x, bid = blockIdx.x;
    unsigned char* ws = a.ws;
    LAS float* cact = (LAS float*)lds;
    LAS float* red = (LAS float*)(lds + 16384);
    LAS float* scr = (LAS float*)(lds + 32768 + wave * 8448);
    if (bid < 192 || G < 192) {
        const float* c = a.in[I_C];
        for (int i = tid; i < 2 * DM; i += NTHR) { const float x = c[i]; cact[i] = x / (1.f + __expf(-x)); }
        __syncthreads();
        for (int item = bid; item < 192; item += G) {
            const int ro = lane >> 4, cq = lane & 15;
            const float* wp = a.in[I_WADA] + (size_t)(256 * wave + ro) * 12288 + 64 * item + 4 * cq;
            f32x4 acc0 = (f32x4){0.f, 0.f, 0.f, 0.f}, acc1 = acc0;
#pragma unroll 8
            for (int i = 0; i < 64; ++i) { const f32x4 wv = *(const f32x4*)(wp + (size_t)(4 * i) * 12288);
                const float c0 = cact[256 * wave + 4 * i + ro], c1 = cact[DM + 256 * wave + 4 * i + ro]; acc0 += c0 * wv; acc1 += c1 * wv; }
#pragma unroll
            for (int j = 0; j < 4; ++j) { float v0 = acc0[j], v1 = acc1[j]; v0 += __shfl_xor(v0, 16); v0 += __shfl_xor(v0, 32); v1 += __shfl_xor(v1, 16); v1 += __shfl_xor(v1, 32);
                if (ro == 0) { red[(wave * 2 + 0) * 64 + 4 * cq + j] = v0; red[(wave * 2 + 1) * 64 + 4 * cq + j] = v1; } }
            __syncthreads();
            if (tid < 128) { const int b = tid >> 6, cc = tid & 63; float s = a.in[I_BADA][64 * item + cc];
#pragma unroll
                for (int w2 = 0; w2 < 8; ++w2) s += red[(w2 * 2 + b) * 64 + cc];
                ((float*)(ws + WS_MOD))[b * 12288 + 64 * item + cc] = s; }
            __syncthreads();
        }
    }
    constexpr int NI_IN = 32 * 201, NI_OUT = 32 * 64, NI_E = 32 * 512;
    constexpr int NCONV = NI_IN + NI_OUT + 3 * NI_E;
    const int gw = bid * NWAVES + wave, NGW = G * NWAVES;
    for (int it = gw; it < NCONV; it += NGW) {
        int r = it;
        if (r < NI_IN) { const int kb = r / 201, nb = r - kb * 201; conv_item(a.in[I_WIN], PROJW, (bf16*)(ws + WS_WIN), (size_t)(32 * nb), DM, 64 * kb, 32 * nb, scr, lane); continue; } r -= NI_IN;
        if (r < NI_OUT) { const int kb = r >> 6, nb = r & 63; conv_item(a.in[I_WOUT], DM, (bf16*)(ws + WS_WOUT), (size_t)(32 * nb), DM, 64 * kb, 32 * nb, scr, lane); continue; } r -= NI_OUT;
        if (r < 2 * NI_E) { const int up = r >= NI_E; if (up) r -= NI_E; const int e = r >> 9, q = r & 511, kb = q >> 4, nb = q & 15, n0 = 32 * nb;
            conv_item(a.in[up ? I_WU : I_WG] + (size_t)e * DM * FF, FF, (bf16*)(ws + WS_WGU), (size_t)e * 1024 + 256 * (n0 >> 7) + (n0 & 127) + (up ? 128 : 0), DM, 64 * kb, n0, scr, lane); continue; } r -= 2 * NI_E;
        { const int e = r >> 9, q = r & 511, kb = q >> 6, nb = q & 63;
            conv_item(a.in[I_WDN] + (size_t)e * FF * DM, DM, (bf16*)(ws + WS_WD), (size_t)e * DM + 32 * nb, FF, 64 * kb, 32 * nb, scr, lane); }
    }
    const int gt = bid * NTHR + tid, NGT = G * NTHR;
    bf16* wl = (bf16*)(ws + WS_WL);
    for (int idx = gt; idx < LORA_N * LORA_K; idx += NGT) { const int n = idx / LORA_K, k = idx - n * LORA_K; float v = 0.f;
        if (n < 1024) { if (k < 64) v = a.in[I_WDEC][k * 1024 + n]; }
        else if (n < 2048) { if (k >= 64 && k < 128) v = a.in[I_WAAA][(k - 64) * 1024 + (n - 1024)]; }
        else { if (k >= 128 && k < 288) v = a.in[I_WGATEUP][(k - 128) * 1024 + (n - 2048)]; }
        wl[idx] = (bf16)f2bf(v); }
    v4u* wz = (v4u*)(ws + WS_WIN + (size_t)PROJW * DM * 2);
    for (int idx = gt; idx < (PROJP - PROJW) * DM / 8; idx += NGT) wz[idx] = (v4u){0u, 0u, 0u, 0u};
}

__device__ __forceinline__ void phase1(const Args& a) {
    const int tid = threadIdx.x, lane = tid & 63, wave = tid >> 6;
    const int gw = blockIdx.x * NWAVES + wave, NGW = gridDim.x * NWAVES;
    const float* mod = (const float*)(a.ws + WS_MOD);
    for (int m = gw; m < MTOK; m += NGW) {
        const int b = m >> 12;
        const f32x4* xr = (const f32x4*)(a.in[I_X] + (size_t)m * DM) + lane;
        f32x4 v[8]; float s = 0.f;
#pragma unroll
        for (int j = 0; j < 8; ++j) { v[j] = xr[64 * j]; s += (v[j].x * v[j].x + v[j].y * v[j].y) + (v[j].z * v[j].z + v[j].w * v[j].w); }
        const float rstd = 1.f / sqrtf(wave_sum(s) * (1.f / DM) + RMS_EPS);
        v2u* o8 = (v2u*)((bf16*)(a.ws + WS_HB) + (size_t)m * DM) + lane;
#pragma unroll
        for (int j = 0; j < 8; ++j) { const int c = 4 * (lane + 64 * j);
            const f32x4 g = *(const f32x4*)(a.in[I_N1G] + c), sh = *(const f32x4*)(mod + b * 12288 + c), sc = *(const f32x4*)(mod + b * 12288 + DM + c);
            const f32x4 h = v[j] * rstd * g * (1.f + sc) + sh; v2u o; o.x = pk2(h.x, h.y); o.y = pk2(h.z, h.w); o8[64 * j] = o; }
    }
}

__device__ __forceinline__ void phase3(const Args& a) {
    const int gt = blockIdx.x * NTHR + threadIdx.x, NGT = gridDim.x * NTHR;
    const bf16* P = (const bf16*)(a.ws + WS_P); bf16* AL = (bf16*)(a.ws + WS_AL);
    for (int idx = gt; idx < MTOK * 48; idx += NGT) { const int m = idx / 48, cj = idx - m * 48;
        v4u o = (v4u){0u, 0u, 0u, 0u};
        if (cj < 36) { const int col = 3072 + 8 * cj; const v4u pc = *(const v4u*)(P + (size_t)m * PROJP + col);
            v4u pp = (v4u){0u, 0u, 0u, 0u}; if ((m & (SEQ - 1)) != 0) pp = *(const v4u*)(P + (size_t)(m - 1) * PROJP + col);
            const float* mu = a.in[I_MU] + col; float r[8];
#pragma unroll
            for (int i = 0; i < 4; ++i) { const float c0 = bflo(pc[i]), c1 = bfhi(pc[i]), p0 = bflo(pp[i]), p1 = bfhi(pp[i]);
                r[2 * i] = c0 + (p0 - c0) * mu[2 * i]; r[2 * i + 1] = c1 + (p1 - c1) * mu[2 * i + 1]; }
            if (cj < 8) {
#pragma unroll
                for (int i = 0; i < 8; ++i) r[i] = tanhf(r[i]); }
            else if (cj >= 16) {
#pragma unroll
                for (int i = 0; i < 8; ++i) r[i] = sigmoid_f(r[i]); }
            o.x = pk2(r[0], r[1]); o.y = pk2(r[2], r[3]); o.z = pk2(r[4], r[5]); o.w = pk2(r[6], r[7]); }
        *(v4u*)(AL + (size_t)m * LORA_K + 8 * cj) = o; }
}

__device__ __forceinline__ void load16(const bf16* p, float* o) { const v4u a0 = *(const v4u*)p, a1 = *(const v4u*)(p + 8);
#pragma unroll
    for (int i = 0; i < 4; ++i) { o[2 * i] = bflo(a0[i]); o[2 * i + 1] = bfhi(a0[i]); o[8 + 2 * i] = bflo(a1[i]); o[8 + 2 * i + 1] = bfhi(a1[i]); } }
__device__ __forceinline__ void store16(bf16* p, const float* v) { v4u a0, a1;
#pragma unroll
    for (int i = 0; i < 4; ++i) { a0[i] = pk2(v[2 * i], v[2 * i + 1]); a1[i] = pk2(v[8 + 2 * i], v[8 + 2 * i + 1]); }
    *(v4u*)p = a0; *(v4u*)(p + 8) = a1; }
__device__ __forceinline__ void shift16(const bf16* P, int m, int col, const float* mu, float* o) {
    float c[16], p[16]; load16(P + (size_t)m * PROJP + col, c);
    if ((m & (SEQ - 1)) != 0) load16(P + (size_t)(m - 1) * PROJP + col, p); else {
#pragma unroll
        for (int i = 0; i < 16; ++i) p[i] = 0.f; }
#pragma unroll
    for (int i = 0; i < 16; ++i) o[i] = c[i] + (p[i] - c[i]) * mu[col + i];
}
__device__ __forceinline__ void phase5a(const Args& a) {
    const int tid = threadIdx.x, lane = tid & 63, wave = tid >> 6;
    const int gw = blockIdx.x * NWAVES + wave, NGW = gridDim.x * NWAVES;
    const bf16* P = (const bf16*)(a.ws + WS_P);
    const int c0 = 16 * lane;
    for (int m = gw; m < MTOK; m += NGW) {
        float r[16], k[16], v[16], av[16], kk[16], bb[16];
        shift16(P, m, c0, a.in[I_MU], r); shift16(P, m, 1024 + c0, a.in[I_MU], k); shift16(P, m, 2048 + c0, a.in[I_MU], v);
        load16((const bf16*)(a.ws + WS_AA) + (size_t)m * CW + c0, av);
        float ss = 0.f;
#pragma unroll
        for (int i = 0; i < 16; ++i) { kk[i] = k[i] * a.in[I_KK][c0 + i]; ss += kk[i] * kk[i]; }
        ss += __shfl_xor(ss, 1); ss += __shfl_xor(ss, 2);
        const float inv = 1.f / fmaxf(sqrtf(ss), 1e-12f);
#pragma unroll
        for (int i = 0; i < 16; ++i) { kk[i] *= inv; bb[i] = kk[i] * av[i]; k[i] = k[i] * (1.f + (av[i] - 1.f) * a.in[I_KA][c0 + i]); }
        const size_t off = (size_t)m * CW + c0;
        store16((bf16*)(a.ws + WS_R) + off, r); store16((bf16*)(a.ws + WS_K2) + off, k); store16((bf16*)(a.ws + WS_V) + off, v);
        store16((bf16*)(a.ws + WS_KK) + off, kk); store16((bf16*)(a.ws + WS_BB) + off, bb);
    }
}

__device__ __forceinline__ int swz_off(int key, int chunk) { return key * 128 + ((chunk ^ ((key >> 1) & 7)) << 4); }
__device__ __forceinline__ void phase5b(const Args& a, LAS unsigned char* lds) {
    const int tid = threadIdx.x, lane = tid & 63, wave = __builtin_amdgcn_readfirstlane(tid >> 6), n = lane & 15, g = lane >> 4;
    const bf16* P = (const bf16*)(a.ws + WS_P); bf16* Y = (bf16*)(a.ws + WS_YMIX);
    LAS float* biasL = (LAS float*)(lds + 32768);
    const float SC = 0.125f * LOG2E;
    const int skey = tid >> 3, sdc = tid & 7;
    for (int u = blockIdx.x; u < BATCH * NHEAD * 32; u += gridDim.x) {
        const int cp = u & 31, h = (u >> 5) & 15, b = u >> 9;
        const int t0 = 128 * cp, qrow = t0 + 16 * wave + n;
        const size_t rowbase = (size_t)b * SEQ;
        const bf16* qp = P + (rowbase + qrow) * PROJP + SHIFTW + h * 64;
        bf16x8 qf[2]; qf[0] = *(const bf16x8*)(qp + 8 * g); qf[1] = *(const bf16x8*)(qp + 32 + 8 * g);
        if (tid < 257) biasL[tid] = a.in[I_RELB][h * 257 + tid] * LOG2E;
        const int jstart = (8 - 2 * cp) > 0 ? (8 - 2 * cp) : 0;
        const bf16* kcol = P + rowbase * PROJP + SHIFTW + 1024 + h * 64 + 8 * sdc;
        const bf16* vcol = kcol + 1024;
        v4u kreg, vreg;
        { const int key0 = 64 * (2 * cp - 8 + jstart); kreg = *(const v4u*)(kcol + (size_t)(key0 + skey) * PROJP); vreg = *(const v4u*)(vcol + (size_t)(key0 + skey) * PROJP);
          *(LAS v4u*)(lds + swz_off(skey, sdc)) = kreg; *(LAS v4u*)(lds + 16384 + swz_off(skey, sdc)) = vreg; }
        __syncthreads();
        float mrun = -1e30f, lrun = 0.f;
        f32x4 ot[4];
#pragma unroll
        for (int i = 0; i < 4; ++i) ot[i] = (f32x4){0.f, 0.f, 0.f, 0.f};
        const float bfar = biasL[256];
        for (int j = jstart; j < 10; ++j) {
            const int cur = (j - jstart) & 1;
            const int key0 = 64 * (2 * cp - 8 + j);
            if (j + 1 < 10) { kreg = *(const v4u*)(kcol + (size_t)(key0 + 64 + skey) * PROJP); vreg = *(const v4u*)(vcol + (size_t)(key0 + 64 + skey) * PROJP); }
            const bool active = (wave < 4) ? (j <= 8) : (j >= 1);
            if (active) {
                LAS unsigned char* Kb = lds + cur * 8192; LAS unsigned char* Vb = lds + 16384 + cur * 8192;
                f32x4 s[4];
#pragma unroll
                for (int st = 0; st < 4; ++st) { s[st] = (f32x4){0.f, 0.f, 0.f, 0.f};
#pragma unroll
                    for (int ks = 0; ks < 2; ++ks) { const bf16x8 kf = *(const LAS bf16x8*)(Kb + swz_off(16 * st + n, 4 * ks + g));
                        s[st] = __builtin_amdgcn_mfma_f32_16x16x32_bf16(kf, qf[ks], s[st], 0, 0, 0); } }
                const bool far = (t0 + 16 * wave) - (key0 + 63) >= 128;
                float mx = -1e30f;
#pragma unroll
                for (int st = 0; st < 4; ++st)
#pragma unroll
                    for (int jj = 0; jj < 4; ++jj) { float bv = bfar;
                        if (!far) { const int dist = qrow - (key0 + 16 * st + 4 * g + jj); const int idx = (dist < 128 ? dist : 128) + 128; bv = biasL[idx]; }
                        const float sv = s[st][jj] * SC + bv; s[st][jj] = sv; mx = fmaxf(mx, sv); }
                mx = fmaxf(mx, __shfl_xor(mx, 16)); mx = fmaxf(mx, __shfl_xor(mx, 32));
                const float mnew = fmaxf(mrun, mx), alpha = exp2f(mrun - mnew); mrun = mnew;
                float ls = 0.f;
#pragma unroll
                for (int st = 0; st < 4; ++st)
#pragma unroll
                    for (int jj = 0; jj < 4; ++jj) { const float p = exp2f(s[st][jj] - mnew); s[st][jj] = p; ls += p; }
                lrun = lrun * alpha + ls;
#pragma unroll
                for (int i = 0; i < 4; ++i) ot[i] *= alpha;
#pragma unroll
                for (int k2 = 0; k2 < 2; ++k2) {
                    v4u pw; pw.x = pk2(s[2 * k2][0], s[2 * k2][1]); pw.y = pk2(s[2 * k2][2], s[2 * k2][3]); pw.z = pk2(s[2 * k2 + 1][0], s[2 * k2 + 1][1]); pw.w = pk2(s[2 * k2 + 1][2], s[2 * k2 + 1][3]);
                    const bf16x8 pf = __builtin_bit_cast(bf16x8, pw);
                    const int q4 = n >> 2, p4 = n & 3;
                    const int ka = 32 * k2 + 4 * g + q4, kb = ka + 16;
#pragma unroll
                    for (int nd = 0; nd < 4; ++nd) {
                        const int ch = 2 * nd + (p4 >> 1);
                        const s16x4 v0 = __builtin_bit_cast(s16x4, __builtin_amdgcn_ds_read_tr16_b64_v4i16((LAS s16x4*)(Vb + swz_off(ka, ch) + 8 * (p4 & 1))));
                        const s16x4 v1 = __builtin_bit_cast(s16x4, __builtin_amdgcn_ds_read_tr16_b64_v4i16((LAS s16x4*)(Vb + swz_off(kb, ch) + 8 * (p4 & 1))));
                        bf16x8 vf; vf[0] = v0[0]; vf[1] = v0[1]; vf[2] = v0[2]; vf[3] = v0[3]; vf[4] = v1[0]; vf[5] = v1[1]; vf[6] = v1[2]; vf[7] = v1[3];
                        ot[nd] = __builtin_amdgcn_mfma_f32_16x16x32_bf16(vf, pf, ot[nd], 0, 0, 0);
                    }
                }
            }
            if (j + 1 < 10) { *(LAS v4u*)(lds + (cur ^ 1) * 8192 + swz_off(skey, sdc)) = kreg; *(LAS v4u*)(lds + 16384 + (cur ^ 1) * 8192 + swz_off(skey, sdc)) = vreg; }
            __syncthreads();
        }
        float lt = lrun; lt += __shfl_xor(lt, 16); lt += __shfl_xor(lt, 32);
        const float inv = 1.f / lt;
        bf16* yp = Y + (rowbase + qrow) * DM + 1024 + h * 64 + 4 * g;
        const float* beta = a.in[I_BETAA] + h * 64 + 4 * g;
#pragma unroll
        for (int nd = 0; nd < 4; ++nd) { const f32x4 bt = *(const f32x4*)(beta + 16 * nd); const f32x4 o = ot[nd] * inv * bt;
            v2u w; w.x = pk2(o[0], o[1]); w.y = pk2(o[2], o[3]); *(v2u*)(yp + 16 * nd) = w; }
    }
}

__device__ __forceinline__ void phase8(const Args& a) {
    const int tid = threadIdx.x, lane = tid & 63, wave = tid >> 6;
    const int gw = blockIdx.x * NWAVES + wave, NGW = gridDim.x * NWAVES;
    const float* mod = (const float*)(a.ws + WS_MOD);
    unsigned* ctl = (unsigned*)(a.ws + WS_CTL);
    for (int m = gw; m < MTOK; m += NGW) {
        const int b = m >> 12;
        const f32x4* xr = (const f32x4*)((const float*)(a.ws + WS_X1) + (size_t)m * DM) + lane;
        f32x4 v[8]; float s = 0.f;
#pragma unroll
        for (int j = 0; j < 8; ++j) { v[j] = xr[64 * j]; s += (v[j].x * v[j].x + v[j].y * v[j].y) + (v[j].z * v[j].z + v[j].w * v[j].w); }
        const float rstd = 1.f / sqrtf(wave_sum(s) * (1.f / DM) + RMS_EPS);
        v2u* o8 = (v2u*)((bf16*)(a.ws + WS_HB) + (size_t)m * DM) + lane;
        float gl[4] = {0.f, 0.f, 0.f, 0.f};
#pragma unroll
        for (int j = 0; j < 8; ++j) { const int c = 4 * (lane + 64 * j);
            const f32x4 g = *(const f32x4*)(a.in[I_N2G] + c), sh = *(const f32x4*)(mod + b * 12288 + 3 * DM + c), sc = *(const f32x4*)(mod + b * 12288 + 4 * DM + c);
            const f32x4 h = v[j] * rstd * g * (1.f + sc) + sh; v[j] = h; v2u o; o.x = pk2(h.x, h.y); o.y = pk2(h.z, h.w); o8[64 * j] = o;
#pragma unroll
            for (int i = 0; i < 4; ++i) { const f32x4 wg = *(const f32x4*)(a.in[I_WGRP] + (size_t)(c + i) * 4);
                gl[0] += h[i] * wg[0]; gl[1] += h[i] * wg[1]; gl[2] += h[i] * wg[2]; gl[3] += h[i] * wg[3]; } }
#pragma unroll
        for (int i = 0; i < 4; ++i) gl[i] = wave_sum(gl[i]) + a.in[I_BGRP][i];
        int gi = 0; float gm = gl[0];
#pragma unroll
        for (int i = 1; i < 4; ++i) if (gl[i] > gm) { gm = gl[i]; gi = i; }
        float gs = 0.f;
#pragma unroll
        for (int i = 0; i < 4; ++i) gs += expf(gl[i] - gm);
        const float gwt = 1.f / gs;
        float el[8] = {0.f, 0.f, 0.f, 0.f, 0.f, 0.f, 0.f, 0.f};
        const float* we = a.in[I_WEXP] + (size_t)gi * DM * 8;
#pragma unroll
        for (int j = 0; j < 8; ++j) { const int c = 4 * (lane + 64 * j);
#pragma unroll
            for (int i = 0; i < 4; ++i) { const f32x4 w0 = *(const f32x4*)(we + (size_t)(c + i) * 8), w1 = *(const f32x4*)(we + (size_t)(c + i) * 8 + 4);
                el[0] += v[j][i] * w0[0]; el[1] += v[j][i] * w0[1]; el[2] += v[j][i] * w0[2]; el[3] += v[j][i] * w0[3];
                el[4] += v[j][i] * w1[0]; el[5] += v[j][i] * w1[1]; el[6] += v[j][i] * w1[2]; el[7] += v[j][i] * w1[3]; } }
#pragma unroll
        for (int i = 0; i < 8; ++i) el[i] = wave_sum(el[i]) + a.in[I_BEXP][gi * 8 + i];
        int i1 = 0; float m1 = el[0];
#pragma unroll
        for (int i = 1; i < 8; ++i) if (el[i] > m1) { m1 = el[i]; i1 = i; }
        int i2 = -1; float m2 = -3.0e38f;
#pragma unroll
        for (int i = 0; i < 8; ++i) if (i != i1 && el[i] > m2) { m2 = el[i]; i2 = i; }
        const float e2 = expf(m2 - m1); const float w1 = gwt / (1.f + e2), w2 = gwt * e2 / (1.f + e2);
        if (lane == 0) { int* rt = (int*)(a.ws + WS_ROUTE) + (size_t)m * 8; const int ge1 = gi * 8 + i1, ge2 = gi * 8 + i2;
            rt[0] = ge1; rt[1] = ge2; rt[2] = __float_as_int(w1); rt[3] = __float_as_int(w2);
            atomicAdd(ctl + CW_CNT + ge1, 1u); atomicAdd(ctl + CW_CNT + ge2, 1u); }
    }
}

__device__ __forceinline__ void phase9(const Args& a) {
    const int tid = threadIdx.x, lane = tid & 63, wave = tid >> 6;
    const int gw = blockIdx.x * NWAVES + wave, NGW = gridDim.x * NWAVES;
    unsigned* ctl = (unsigned*)(a.ws + WS_CTL);
    unsigned cnt = (lane < NEXP) ? __hip_atomic_load(ctl + CW_CNT + lane, RLX_AGENT) : 0u;
    const unsigned pad = (cnt + 255u) & ~255u;
    unsigned incl = pad;
#pragma unroll
    for (int o = 1; o < 64; o <<= 1) { const unsigned t = __shfl_up(incl, o); if (lane >= o) incl += t; }
    const unsigned off = incl - pad;
    if (gw == 0) {
        if (lane < NEXP) for (unsigned t = off >> 8; t < (off + pad) >> 8; ++t) ctl[CW_TE + t] = (unsigned)lane;
        if (lane == 63) ctl[CW_NRT] = incl >> 8;
    }
    for (int m = gw; m < MTOK; m += NGW) {
        int* rt = (int*)(a.ws + WS_ROUTE) + (size_t)m * 8;
        const int e1 = rt[0], e2 = rt[1]; const float w1 = __int_as_float(rt[2]), w2 = __int_as_float(rt[3]);
        unsigned p1 = 0, p2 = 0;
        if (lane == 0) { p1 = atomicAdd(ctl + CW_POS + e1, 1u); p2 = atomicAdd(ctl + CW_POS + e2, 1u); }
        p1 = __shfl(p1, 0); p2 = __shfl(p2, 0);
        const unsigned s1 = __shfl(off, e1) + p1, s2 = __shfl(off, e2) + p2;
        if (lane == 0) { rt[4] = (int)s1; rt[5] = (int)s2; ((float*)(a.ws + WS_SW))[s1] = w1; ((float*)(a.ws + WS_SW))[s2] = w2; }
        const v4u* src = (const v4u*)((const bf16*)(a.ws + WS_HB) + (size_t)m * DM) + lane;
        v4u* d1 = (v4u*)((bf16*)(a.ws + WS_H2P) + (size_t)s1 * DM) + lane; v4u* d2 = (v4u*)((bf16*)(a.ws + WS_H2P) + (size_t)s2 * DM) + lane;
#pragma unroll
        for (int j = 0; j < 4; ++j) { const v4u x = src[64 * j]; d1[64 * j] = x; d2[64 * j] = x; }
    }
}

__device__ __forceinline__ void phase12(const Args& a) {
    const int tid = threadIdx.x, lane = tid & 63, wave = tid >> 6;
    const int gw = blockIdx.x * NWAVES + wave, NGW = gridDim.x * NWAVES;
    const float* mod = (const float*)(a.ws + WS_MOD);
    for (int m = gw; m < MTOK; m += NGW) {
        const int b = m >> 12;
        const int* rt = (const int*)(a.ws + WS_ROUTE) + (size_t)m * 8; const int s1 = rt[4], s2 = rt[5];
        const f32x4* xr = (const f32x4*)((const float*)(a.ws + WS_X1) + (size_t)m * DM) + lane;
        const v2u* f1 = (const v2u*)((const bf16*)(a.ws + WS_FP) + (size_t)s1 * DM) + lane; const v2u* f2 = (const v2u*)((const bf16*)(a.ws + WS_FP) + (size_t)s2 * DM) + lane;
        f32x4 v[8]; float s = 0.f;
#pragma unroll
        for (int j = 0; j < 8; ++j) { const int c = 4 * (lane + 64 * j); const f32x4 g2 = *(const f32x4*)(mod + b * 12288 + 5 * DM + c);
            const v2u a1 = f1[64 * j], a2 = f2[64 * j]; f32x4 f;
            f.x = bflo(a1.x) + bflo(a2.x); f.y = bfhi(a1.x) + bfhi(a2.x); f.z = bflo(a1.y) + bflo(a2.y); f.w = bfhi(a1.y) + bfhi(a2.y);
            v[j] = xr[64 * j] + g2 * f; s += (v[j].x * v[j].x + v[j].y * v[j].y) + (v[j].z * v[j].z + v[j].w * v[j].w); }
        const float rstd = 1.f / sqrtf(wave_sum(s) * (1.f / DM) + RMS_EPS);
        f32x4* op = (f32x4*)(a.out + (size_t)m * DM) + lane;
#pragma unroll
        for (int j = 0; j < 8; ++j) { const int c = 4 * (lane + 64 * j); const f32x4 g = *(const f32x4*)(a.in[I_NFG] + c); op[64 * j] = v[j] * rstd * g; }
    }
}

#ifndef MK_ONE_LAUNCH
#define MK_ONE_LAUNCH 1
#endif
__global__ void __launch_bounds__(NTHR, 2) mega_fwd(Args args) {
    extern __shared__ __attribute__((aligned(16))) unsigned char lds_raw[];
    LAS unsigned char* lds = (LAS unsigned char*)lds_raw;
    const int tid = threadIdx.x;
    for (int u = tid; u < (LDS_BYTES - LDSCTL_OFF) / 4; u += NTHR) ((LAS unsigned*)(lds + LDSCTL_OFF))[u] = 0u;
    __syncthreads();
    volatile LAS unsigned* MISC = (volatile LAS unsigned*)(lds + MISC_OFF);
    unsigned* ctl = (unsigned*)(args.ws + WS_CTL);
    XcdBarrier bar; bar.bar = ctl + CW_BAR; bar.x = 0; bar.st = nullptr;
    const bool multi = (args.ph_hi - args.ph_lo) > 1;
    if (multi) bar = xcd_barrier_post(ctl + CW_BAR, MISC + 8);
    const int lo = args.ph_lo, hi = args.ph_hi, G = gridDim.x;
#define IN(k) (lo <= (k) && (k) < hi)
#define SEAM(k) do { if (IN(k) && IN((k) + 1)) xcd_barrier(bar); } while (0)
    if (IN(0)) { phase0(args, lds); } SEAM(0);
    if (IN(1)) { phase1(args); } SEAM(1);
    if (IN(2)) { pg8::Gemm g{(const pg8::bf16_t*)(args.ws + WS_HB), (const pg8::bf16_t*)(args.ws + WS_WIN), MTOK, PROJP, DM}; pg8::StaticOrder S; S.init(MTOK, PROJP, G, (int)blockIdx.x);
        EpiStoreBf16 E{(bf16*)(args.ws + WS_P), PROJP, 0xffff};
        pg8::gemm_phase<EpiStoreBf16, pg8::StaticOrder, true, true>(lds, g, S, E); } SEAM(2);
    if (IN(3)) { phase3(args); } SEAM(3);
    if (IN(4)) { pg8::Gemm g{(const pg8::bf16_t*)(args.ws + WS_AL), (const pg8::bf16_t*)(args.ws + WS_WL), MTOK, LORA_N, LORA_K}; pg8::StaticOrder S; S.init(MTOK, LORA_N, G, (int)blockIdx.x);
        EpiLora E{args.in[I_W0], args.in[I_A0], (float*)(args.ws + WS_LW), (bf16*)(args.ws + WS_AA), (bf16*)(args.ws + WS_GG)};
        pg8::gemm_phase<EpiLora, pg8::StaticOrder, true, true>(lds, g, S, E); } SEAM(4);
    if (IN(5)) { phase5a(args); phase5b(args, lds); } SEAM(5);
    if (IN(6)) { scanA(args, lds); } SEAM(6);
    if (IN(7)) { scanB(args); } SEAM(7);
    if (IN(8)) { scanC(args); } SEAM(8);
    if (IN(9)) { pg8::Gemm g{(const pg8::bf16_t*)(args.ws + WS_YMIX), (const pg8::bf16_t*)(args.ws + WS_WOUT), MTOK, DM, DM}; pg8::StaticOrder S; S.init(MTOK, DM, G, (int)blockIdx.x);
        EpiResGate E{args.in[I_X], (const float*)(args.ws + WS_MOD) + 2 * DM, (float*)(args.ws + WS_X1)};
        pg8::gemm_phase<EpiResGate, pg8::StaticOrder, true, true>(lds, g, S, E); } SEAM(9);
    if (IN(10)) { phase8(args); } SEAM(10);
    if (IN(11)) { phase9(args); } SEAM(11);
    if (IN(12)) { const int nrt = (int)__hip_atomic_load(ctl + CW_NRT, RLX_AGENT);
        pg8::Gemm g{(const pg8::bf16_t*)(args.ws + WS_H2P), (const pg8::bf16_t*)(args.ws + WS_WGU), nrt * 256, NEXP * 1024, DM}; GroupOrder S{ctl + CW_TE, nrt, 4, G, (int)blockIdx.x};
        EpiGateUp E{(const float*)(args.ws + WS_SW), (bf16*)(args.ws + WS_HG)};
        pg8::gemm_phase<EpiGateUp, GroupOrder, true, true>(lds, g, S, E); } SEAM(12);
    if (IN(13)) { const int nrt = (int)__hip_atomic_load(ctl + CW_NRT, RLX_AGENT);
        pg8::Gemm g{(const pg8::bf16_t*)(args.ws + WS_HG), (const pg8::bf16_t*)(args.ws + WS_WD), nrt * 256, NEXP * DM, FF}; GroupOrder S{ctl + CW_TE, nrt, 8, G, (int)blockIdx.x};
        EpiStoreBf16 E{(bf16*)(args.ws + WS_FP), DM, 7};
        pg8::gemm_phase<EpiStoreBf16, GroupOrder, true, true>(lds, g, S, E); } SEAM(13);
    if (IN(14)) { phase12(args); }
#undef IN
#undef SEAM
}

extern "C" void kernel_launch(void* const* d_in, const int* in_sizes, int n_in, void* d_out, int out_size, void* d_ws, size_t ws_size, hipStream_t stream) {
    static int grid = 0;
    if (grid == 0) {
        if (n_in != 30 || out_size != MTOK * DM || ws_size < WS_END) { fprintf(stderr, "kernel_launch: unexpected shapes (n_in %d, out %d, ws %zu)\n", n_in, out_size, ws_size); grid = -1; return; }
        int dev = 0, cus = 0, per_cu = 0;
        if (hipGetDevice(&dev) != hipSuccess || hipDeviceGetAttribute(&cus, hipDeviceAttributeMultiprocessorCount, dev) != hipSuccess) { grid = -1; return; }
        if (hipFuncSetAttribute((const void*)mega_fwd, hipFuncAttributeMaxDynamicSharedMemorySize, LDS_BYTES) != hipSuccess) { grid = -1; return; }
        if (hipOccupancyMaxActiveBlocksPerMultiprocessor(&per_cu, (const void*)mega_fwd, NTHR, LDS_BYTES) != hipSuccess || per_cu < 1) { fprintf(stderr, "kernel_launch: occupancy query says %d\n", per_cu); grid = -1; (void)hipGetLastError(); return; }
        grid = cus;
    }
    if (grid < 0) return;
    (void)hipMemsetAsync((char*)d_ws + WS_CTL, 0, CTL_ZERO_BYTES, stream);
    Args a{};
    for (int i = 0; i < 30; ++i) a.in[i] = (const float*)d_in[i];
    a.out = (float*)d_out; a.ws = (unsigned char*)d_ws;
#if MK_ONE_LAUNCH
    a.ph_lo = 0; a.ph_hi = NPH;
    void* kargs[] = {&a};
    hipError_t e = hipLaunchCooperativeKernel((const void*)mega_fwd, dim3(grid), dim3(NTHR), kargs, LDS_BYTES, stream);
    if (e != hipSuccess) fprintf(stderr, "cooperative launch failed: %s\n", hipGetErrorString(e));
#else
    for (int p = 0; p < NPH; ++p) { a.ph_lo = p; a.ph_hi = p + 1; hipLaunchKernelGGL(mega_fwd, dim3(grid), dim3(NTHR), LDS_BYTES, stream, a); }
#endif
}
```

```cpp
#include <hip/hip_runtime.h>
#include <hip/hip_bf16.h>
#include <cstdio>
#include <cstdint>

constexpr int NWAVES = 8, NTHR = 512;
constexpr int BATCH = 2, SEQ = 4096, DM = 2048, MTOK = BATCH * SEQ;
constexpr int CW = 1024, NHEAD = 16, HD = 64;
constexpr int SHIFTW = 3360, PROJW = 6432, PROJP = 6656;
constexpr int LORA_K = 384, LORA_N = 3072;
constexpr int NEXP = 32, FF = 512;
constexpr int MAXSLOT = 24576;
constexpr float RMS_EPS = 1e-6f, GN_EPS = 64e-5f;
constexpr float LOG2E = 1.4426950408889634f;

constexpr size_t MiB = 1u << 20;
constexpr size_t WS_CTL = 0, CTL_ZERO_BYTES = 1 * MiB;
constexpr size_t WS_MOD = 1 * MiB;
constexpr size_t WS_ROUTE = 1 * MiB + 128 * 1024;
constexpr size_t WS_SW = 1 * MiB + 512 * 1024;
constexpr size_t WS_B36 = 1 * MiB + 96 * 1024;
constexpr size_t WS_RSTD = 1 * MiB + 640 * 1024;
constexpr size_t WS_W36 = 1 * MiB + 704 * 1024;
constexpr size_t WS_WIN = 2 * MiB;
constexpr size_t WS_WOUT = 28 * MiB;
constexpr size_t WS_WL = 36 * MiB;
constexpr size_t WS_WGU = 39 * MiB;
constexpr size_t WS_WD = 167 * MiB;
constexpr size_t B0 = 231 * MiB;
constexpr size_t WS_P = B0;
constexpr size_t WS_HB = B0 + 104 * MiB;
constexpr size_t WS_AL = B0 + 136 * MiB;
constexpr size_t WS_LW = B0 + 142 * MiB;
constexpr size_t WS_AA = B0 + 174 * MiB;
constexpr size_t WS_GG = B0 + 190 * MiB;
constexpr size_t WS_R = B0 + 206 * MiB, WS_K2 = B0 + 222 * MiB, WS_V = B0 + 238 * MiB, WS_KK = B0 + 254 * MiB, WS_BB = B0 + 270 * MiB;
constexpr size_t WS_YMIX = B0 + 286 * MiB;
constexpr size_t WS_X1 = B0;
constexpr size_t WS_H2P = B0 + 136 * MiB;
constexpr size_t WS_HG = B0 + 232 * MiB;
constexpr size_t WS_FP = B0 + 136 * MiB;
constexpr size_t WS_GT = B0, WS_RH = B0 + 16 * MiB, WS_Y1 = B0 + 32 * MiB, WS_HM = B0 + 64 * MiB, WS_PLV = B0 + 96 * MiB;
constexpr size_t WS_SF = B0 + 136 * MiB;
constexpr size_t WS_END = B0 + 318 * MiB;
constexpr int CW_CNT = 1024, CW_POS = 1088, CW_NRT = 1152, CW_TE = 1280, CW_BAR = 4096;

constexpr int RING_BYTES = 131072;
constexpr int LDSCTL_OFF = RING_BYTES, MISC_OFF = LDSCTL_OFF + 320;
constexpr int LDS_BYTES = 147456;

#define GAS __attribute__((address_space(1)))
#define LAS __attribute__((address_space(3)))
typedef unsigned short bf16;
typedef unsigned v4u __attribute__((ext_vector_type(4)));
typedef unsigned v2u __attribute__((ext_vector_type(2)));
typedef float f32x4 __attribute__((ext_vector_type(4)));
typedef short bf16x8 __attribute__((ext_vector_type(8)));
typedef short s16x4 __attribute__((ext_vector_type(4)));
typedef GAS unsigned gu32;
typedef GAS unsigned long long gu64;
#define RLX_AGENT __ATOMIC_RELAXED, __HIP_MEMORY_SCOPE_AGENT
#define LDS_WAIT() asm volatile("s_waitcnt lgkmcnt(0)" ::: "memory")
#define VM_WAIT() asm volatile("s_waitcnt vmcnt(0)" ::: "memory")
__device__ __forceinline__ unsigned f2bf(float f) { unsigned u = __builtin_bit_cast(unsigned, f); return (u + 0x7fffu + ((u >> 16) & 1u)) >> 16; }
__device__ __forceinline__ unsigned pk2(float lo, float hi) { return f2bf(lo) | (f2bf(hi) << 16); }
__device__ __forceinline__ float bflo(unsigned u) { return __builtin_bit_cast(float, u << 16); }
__device__ __forceinline__ float bfhi(unsigned u) { return __builtin_bit_cast(float, u & 0xffff0000u); }
__device__ __forceinline__ float wave_sum(float v) {
#pragma unroll
    for (int o = 1; o < 64; o <<= 1) v += __shfl_xor(v, o);
    return v;
}
__device__ __forceinline__ float sigmoid_f(float x) { return 1.f / (1.f + __expf(-x)); }

struct Args { const float* in[30]; float* out; unsigned char* ws; int ph_lo, ph_hi, li, pad; };
enum { I_X = 0, I_C, I_WADA, I_BADA, I_N1G, I_WIN, I_MU, I_W0, I_WDEC, I_A0, I_WAAA, I_WGATEUP, I_KK, I_KA, I_RK, I_LNW, I_LNB, I_RELB, I_BETAR, I_BETAA,
       I_WOUT, I_N2G, I_WGRP, I_BGRP, I_WEXP, I_BEXP, I_WG, I_WU, I_WDN, I_NFG };
constexpr int NPH = 15;

namespace pg8 {
#define PG8_LAS __attribute__((address_space(3)))
typedef unsigned short bf16_t;
typedef short bf16x8 __attribute__((ext_vector_type(8)));
typedef float f32x4 __attribute__((ext_vector_type(4)));
typedef unsigned u32x4 __attribute__((ext_vector_type(4)));
constexpr int BM = 256, BK = 64, HALF = 128, HTB = HALF * BK * 2  , STAGE_BYTES = 8 * HTB, NXCD = 8, WGM = 8;

__host__ __device__ __forceinline__ int lds_byte(int r, int c) { const int st = (r >> 4) * 2 + (c >> 5), rr = r & 15, cc = c & 31, ob = rr * 64 + cc * 2; return st * 1024 + (ob ^ (((ob >> 9) & 1) << 5)); }
__host__ __device__ __forceinline__ void stage_rc(int b, int& R, int& C) { const int st = b / 1024, sb = b % 1024, swz = sb ^ (((sb >> 9) & 1) << 5); R = (st >> 1) * 16 + swz / 64; C = (st & 1) * 32 + (swz % 64) / 2; }
__host__ __device__ __forceinline__ int perm32(int rho) { const int n = rho >> 4, i = rho & 15; return 8 * (i >> 2) + 4 * n + (i & 3); }

struct Unit { int pm, pn; };
struct Gemm { const bf16_t* A; const bf16_t* Bt; int M, N, K; };

struct StaticOrder {
    int nM, nN, nwg, G, c;
    __host__ __device__ void init(int M, int N, int G_, int c_) { nM = M / BM; nN = N / BM; nwg = nM * nN; G = G_; c = c_; }
    __host__ __device__ bool next(int i, Unit& u) const {
        const long L = (long)i * G + c; if (L >= nwg) return false;
        int wgid = (int)L; { const int q = nwg / NXCD, r = nwg % NXCD, xcd = wgid % NXCD, off = wgid / NXCD; wgid = (xcd < r ? xcd * (q + 1) : r * (q + 1) + (xcd - r) * q) + off; }
        const int nig = WGM * nN, gid = wgid / nig, fm = gid * WGM, gsz = (nM - fm) < WGM ? (nM - fm) : WGM;
        u.pm = fm + ((wgid % nig) % gsz); u.pn = (wgid % nig) / gsz; return true;
    }
    __device__ __forceinline__ void a_ready(const Unit&) const {}
    __device__ __forceinline__ void done(const Unit&) const {}
};

__device__ __forceinline__ unsigned cvt_pk_bf16(float lo, float hi) { unsigned r; asm volatile("v_cvt_pk_bf16_f32 %0, %1, %2" : "=v"(r) : "v"(lo), "v"(hi)); return r; }
template <class Epi, class Sched, bool ALIGN_EPI = false, bool SP2 = false>
__device__ __forceinline__ void gemm_phase(PG8_LAS unsigned char* lds, const Gemm g, const Sched& S, const Epi& E) {
    const int tid = threadIdx.x, wid = __builtin_amdgcn_readfirstlane(tid >> 6), lane = tid & 63, wr = wid >> 2, wc = wid & 3, fr = lane & 15, fq = lane >> 4;
    const int K = g.K, nt = K / BK;
    unsigned voffA[2], voffB[2];
#pragma unroll
    for (int i = 0; i < 2; ++i) { int R, C; stage_rc(tid * 16 + i * 8192, R, C); const int Rb = Epi::PERM ? ((R & ~31) + perm32(R & 31)) : R;
        voffA[i] = (unsigned)(R * K + C) * 2u; voffB[i] = (unsigned)(Rb * K + C) * 2u; }
    const size_t kstep = (size_t)(BK * 2);
    const size_t hstep = (size_t)HALF * K * 2;
    const size_t tstep = 2 * hstep;
    const unsigned ldsw = (unsigned)wid * 1024u;
    const int aoff = lds_byte(wr * 64 + fr, fq * 8), boff = lds_byte(wc * 32 + fr, fq * 8);
#define PG8_SA(b, h) (((b) * 2 + (h)) * HTB)
#define PG8_SB(b, h) ((4 + (b) * 2 + (h)) * HTB)
#define PG8_STAGE(bufoff, gbase, voff) do { _Pragma("unroll") for (int _i = 0; _i < 2; ++_i) \
        __builtin_amdgcn_global_load_lds((const unsigned*)((const char*)(gbase) + (voff)[_i]), (PG8_LAS unsigned*)(lds + (bufoff) + ldsw + _i * 8192), 16, 0, 0); } while (0)
#define PG8_LDA(dst, b, h) do { _Pragma("unroll") for (int m = 0; m < 4; ++m) _Pragma("unroll") for (int k = 0; k < 2; ++k) dst[m][k] = *(const PG8_LAS bf16x8*)(lds + PG8_SA(b, h) + aoff + m * 2048 + k * 1024); } while (0)
#define PG8_LDB(dst, b, h) do { _Pragma("unroll") for (int n = 0; n < 2; ++n) _Pragma("unroll") for (int k = 0; k < 2; ++k) dst[n][k] = *(const PG8_LAS bf16x8*)(lds + PG8_SB(b, h) + boff + n * 2048 + k * 1024); } while (0)
#define PG8_MMA(ai, bj, At, Bt) do { __builtin_amdgcn_s_setprio(1); _Pragma("unroll") for (int m = 0; m < 4; ++m) _Pragma("unroll") for (int n = 0; n < 2; ++n) _Pragma("unroll") for (int k = 0; k < 2; ++k) \
        acc[ai][bj][m][n] = __builtin_amdgcn_mfma_f32_16x16x32_bf16(Bt[n][k], At[m][k], acc[ai][bj][m][n], 0, 0, 0); __builtin_amdgcn_s_setprio(0); } while (0)
#define PG8_WAIT_V(n) asm volatile("s_waitcnt vmcnt(" #n ")" ::: "memory")
#define PG8_WAIT_L(n) asm volatile("s_waitcnt lgkmcnt(" #n ")" ::: "memory")
#define PG8_BAR __builtin_amdgcn_s_barrier()
#define PG8_SCHED __builtin_amdgcn_sched_barrier(0)
    Unit cur, nxt; int ui = 0;
    if (!S.next(0, cur)) return;
    f32x4 acc[2][2][4][2];
#pragma unroll
    for (int a = 0; a < 2; ++a)
#pragma unroll
        for (int b = 0; b < 2; ++b)
#pragma unroll
            for (int m = 0; m < 4; ++m)
#pragma unroll
                for (int n = 0; n < 2; ++n) acc[a][b][m][n] = (f32x4){0.f, 0.f, 0.f, 0.f};
    bf16x8 At[4][2], B0[2][2], B1[2][2];
    const char* cA = (const char*)g.A + (size_t)cur.pm * tstep; const char* cB = (const char*)g.Bt + (size_t)cur.pn * tstep;
    S.a_ready(cur);
    if constexpr (SP2) {
        PG8_STAGE(PG8_SB(0, 0), cB, voffB); PG8_STAGE(PG8_SB(0, 1), cB + hstep, voffB); PG8_STAGE(PG8_SA(0, 0), cA, voffA); PG8_STAGE(PG8_SA(0, 1), cA + hstep, voffA);
        if (wr == 1) PG8_BAR;
        PG8_WAIT_V(2); PG8_BAR;
        PG8_STAGE(PG8_SB(1, 0), cB + kstep, voffB); PG8_STAGE(PG8_SA(1, 0), cA + kstep, voffA); PG8_STAGE(PG8_SB(1, 1), cB + hstep + kstep, voffB);
        PG8_WAIT_V(6); PG8_BAR;
    } else {
        PG8_STAGE(PG8_SB(0, 0), cB, voffB); PG8_STAGE(PG8_SA(0, 0), cA, voffA); PG8_STAGE(PG8_SB(0, 1), cB + hstep, voffB); PG8_STAGE(PG8_SA(0, 1), cA + hstep, voffA);
        if (wr == 1) PG8_BAR;
        PG8_WAIT_V(4); PG8_BAR;
        PG8_STAGE(PG8_SB(1, 0), cB + kstep, voffB); PG8_STAGE(PG8_SA(1, 0), cA + kstep, voffA); PG8_STAGE(PG8_SB(1, 1), cB + hstep + kstep, voffB);
        PG8_WAIT_V(6); PG8_BAR;
    }
    for (;;) {
        const bool has_next = S.next(ui + 1, nxt);
        const char* nA = has_next ? (const char*)g.A + (size_t)nxt.pm * tstep : cA; const char* nB = has_next ? (const char*)g.Bt + (size_t)nxt.pn * tstep : cB;
        for (int t = 0; t < nt; t += 2) {
            const bool last = (t == nt - 2);
            const char* a1 = cA + (size_t)(t + 1) * kstep;
            const char* a2 = last ? nA : cA + (size_t)(t + 2) * kstep; const char* b2 = last ? nB : cB + (size_t)(t + 2) * kstep;
            const char* a3 = a2 + kstep; const char* b3 = b2 + kstep;
            if (last && has_next) S.a_ready(nxt);
            if constexpr (SP2) {
            PG8_LDB(B0, 0, 0); PG8_LDB(B1, 0, 1); PG8_SCHED; PG8_LDA(At, 0, 0); PG8_STAGE(PG8_SA(1, 1), a1 + hstep, voffA);
            PG8_WAIT_V(8); PG8_WAIT_L(0); PG8_BAR; PG8_MMA(0, 0, At, B0); PG8_MMA(0, 1, At, B1); PG8_BAR; PG8_SCHED;
            PG8_LDA(At, 0, 1); PG8_STAGE(PG8_SB(0, 0), b2, voffB); PG8_STAGE(PG8_SB(0, 1), b2 + hstep, voffB); PG8_STAGE(PG8_SA(0, 0), a2, voffA);
            PG8_WAIT_V(8); PG8_WAIT_L(0); PG8_BAR; PG8_MMA(1, 0, At, B0); PG8_MMA(1, 1, At, B1); PG8_BAR; PG8_SCHED;
            PG8_LDB(B0, 1, 0); PG8_LDB(B1, 1, 1); PG8_SCHED; PG8_LDA(At, 1, 0); PG8_STAGE(PG8_SA(0, 1), a2 + hstep, voffA);
            PG8_WAIT_V(8); PG8_WAIT_L(0); PG8_BAR; PG8_MMA(0, 0, At, B0); PG8_MMA(0, 1, At, B1); PG8_BAR; PG8_SCHED;
            PG8_LDA(At, 1, 1); PG8_STAGE(PG8_SB(1, 0), b3, voffB); PG8_STAGE(PG8_SB(1, 1), b3 + hstep, voffB); PG8_STAGE(PG8_SA(1, 0), a3, voffA);
            PG8_WAIT_V(8); PG8_WAIT_L(0); PG8_BAR; PG8_MMA(1, 0, At, B0); PG8_MMA(1, 1, At, B1); PG8_BAR; PG8_SCHED;
            } else {
            PG8_LDB(B0, 0, 0); PG8_SCHED; PG8_LDA(At, 0, 0); PG8_STAGE(PG8_SA(1, 1), a1 + hstep, voffA);
            PG8_WAIT_L(8); PG8_BAR; PG8_WAIT_L(0); PG8_MMA(0, 0, At, B0); PG8_BAR; PG8_SCHED;
            PG8_LDB(B1, 0, 1); PG8_STAGE(PG8_SB(0, 0), b2, voffB);
            PG8_BAR; PG8_WAIT_L(0); PG8_MMA(0, 1, At, B1); PG8_BAR;
            PG8_LDA(At, 0, 1); PG8_STAGE(PG8_SA(0, 0), a2, voffA);
            PG8_BAR; PG8_WAIT_L(0); PG8_MMA(1, 0, At, B0); PG8_BAR; PG8_SCHED;
            PG8_STAGE(PG8_SB(0, 1), b2 + hstep, voffB);
            PG8_WAIT_V(6); PG8_BAR; PG8_MMA(1, 1, At, B1); PG8_BAR;
            PG8_LDB(B0, 1, 0); PG8_SCHED; PG8_LDA(At, 1, 0); PG8_STAGE(PG8_SA(0, 1), a2 + hstep, voffA);
            PG8_WAIT_L(8); PG8_BAR; PG8_WAIT_L(0); PG8_MMA(0, 0, At, B0); PG8_BAR; PG8_SCHED;
            PG8_LDB(B1, 1, 1); PG8_STAGE(PG8_SB(1, 0), b3, voffB);
            PG8_BAR; PG8_WAIT_L(0); PG8_MMA(0, 1, At, B1); PG8_BAR;
            PG8_LDA(At, 1, 1); PG8_STAGE(PG8_SA(1, 0), a3, voffA);
            PG8_BAR; PG8_WAIT_L(0); PG8_MMA(1, 0, At, B0); PG8_BAR; PG8_SCHED;
            PG8_STAGE(PG8_SB(1, 1), b3 + hstep, voffB);
            PG8_WAIT_V(6); PG8_BAR; PG8_MMA(1, 1, At, B1); PG8_BAR;
            }
        }
        if constexpr (ALIGN_EPI) { if (wr == 0) PG8_BAR; }
        if constexpr (!Epi::AFTER_DRAIN) { E(acc, cur, wr, wc, fr, fq); S.done(cur); }
        if (!has_next) break;
#pragma unroll
        for (int a = 0; a < 2; ++a)
#pragma unroll
            for (int b = 0; b < 2; ++b)
#pragma unroll
                for (int m = 0; m < 4; ++m)
#pragma unroll
                    for (int n = 0; n < 2; ++n) acc[a][b][m][n] = (f32x4){0.f, 0.f, 0.f, 0.f};
        cur = nxt; cA = nA; cB = nB; ++ui;
        if constexpr (ALIGN_EPI) { if (wr == 1) PG8_BAR; }
    }
    PG8_WAIT_V(0);
    if constexpr (!ALIGN_EPI) { if (wr == 0) PG8_BAR; }
    PG8_BAR;
    if constexpr (Epi::AFTER_DRAIN) { E.fused(acc, cur, wr, wc, fr, fq, lds, wid, lane); S.done(cur); }
#undef PG8_SA
#undef PG8_SB
#undef PG8_STAGE
#undef PG8_LDA
#undef PG8_LDB
#undef PG8_MMA
#undef PG8_WAIT_V
#undef PG8_WAIT_L
#undef PG8_BAR
#undef PG8_SCHED
}
}
#define XB_TMO      128
#define XB_XCNT(j)  (256  + 64 * (j))
#define XB_XSUB(j)  (1280 + 64 * (j))
#define XB_XGEN(j)  (2304 + 64 * (j))
#define XB_TOP      3328
#define XB_TOPGEN   3392
#define XCD_BAR_WORDS 3456
#define XB_SPIN_CAP (1u << 18)

__device__ __forceinline__ unsigned xb_ld(unsigned* p)              { return __hip_atomic_load(p, __ATOMIC_RELAXED, __HIP_MEMORY_SCOPE_AGENT); }
__device__ __forceinline__ unsigned xb_add(unsigned* p, unsigned v) { return __hip_atomic_fetch_add(p, v, __ATOMIC_RELAXED, __HIP_MEMORY_SCOPE_AGENT); }
__device__ __forceinline__ unsigned xb_xcc_id() { return (unsigned)__builtin_amdgcn_s_getreg((3 << 11) | 20) & 0xFu; }
#define XB_SPIN(cond, bar) do { unsigned _sp = 0; while (cond) { __builtin_amdgcn_s_sleep(1); \
    if ((++_sp & 255u) == 0u) { if (xb_ld(&(bar)[XB_TMO])) break; if (_sp > XB_SPIN_CAP) { atomicAdd(&(bar)[XB_TMO], 1u); break; } } } } while (0)

struct XcdBarrier {
    unsigned* bar; unsigned x;
    volatile LAS unsigned* st;
};

__device__ __forceinline__ XcdBarrier xcd_barrier_post(unsigned* bar, volatile LAS unsigned* st) {
    XcdBarrier b; b.bar = bar; b.x = xb_xcc_id(); b.st = st;
    if (threadIdx.x == 0) (void)xb_add(&bar[XB_XCNT(b.x)], 1u);
    return b;
}
__device__ __forceinline__ void xcd_barrier_complete(unsigned* bar, unsigned x, unsigned& nloc, unsigned& nx) {
    const unsigned G = gridDim.x * gridDim.y * gridDim.z;
    unsigned sum, cnt, mine, sp = 0u;
    for (;;) {
        sum = 0u; cnt = 0u; mine = 0u;
#pragma unroll
        for (unsigned j = 0; j < 16; ++j) { const unsigned c = xb_ld(&bar[XB_XCNT(j)]); sum += c; cnt += (c > 0u) ? 1u : 0u; mine = (j == x) ? c : mine; }
        if (sum == G) break;
        __builtin_amdgcn_s_sleep(1);
        if ((++sp & 255u) == 0u) { if (xb_ld(&bar[XB_TMO])) break; if (sp > XB_SPIN_CAP) { atomicAdd(&bar[XB_TMO], 1u); break; } }
    }
    nloc = mine > 0u ? mine : 1u; nx = cnt > 0u ? cnt : 1u;
}

__device__ __forceinline__ void xcd_barrier(const XcdBarrier& b) {
    asm volatile("s_waitcnt vmcnt(0)" ::: "memory");
    __syncthreads();
    if (threadIdx.x == 0) {
        unsigned* bar = b.bar;
        __builtin_amdgcn_s_waitcnt(0);
        unsigned nloc = b.st[0], nx = b.st[1];
        if (nloc == 0u) { xcd_barrier_complete(bar, b.x, nloc, nx); b.st[0] = nloc; b.st[1] = nx; }
        const unsigned old = xb_add(&bar[XB_XSUB(b.x)], 1u);
        const unsigned gen = old / nloc;
        if (old + 1u == (gen + 1u) * nloc) {
            __builtin_amdgcn_fence(__ATOMIC_RELEASE, "agent");
            asm volatile("s_waitcnt vmcnt(0)" ::: "memory");
            const unsigned og = xb_add(&bar[XB_TOP], 1u);
            const unsigned tg = og / nx;
            if (og + 1u == (tg + 1u) * nx) xb_add(&bar[XB_TOPGEN], 1u);
            else XB_SPIN(xb_ld(&bar[XB_TOPGEN]) == tg, bar);
            __builtin_amdgcn_fence(__ATOMIC_ACQUIRE, "agent");
            xb_add(&bar[XB_XGEN(b.x)], 1u);
            asm volatile("s_waitcnt vmcnt(0)" ::: "memory");
        } else {
            XB_SPIN(xb_ld(&bar[XB_XGEN(b.x)]) == gen, bar);
            __builtin_amdgcn_fence(__ATOMIC_ACQUIRE, "agent");
            asm volatile("s_waitcnt vmcnt(0)" ::: "memory");
        }
    }
    __syncthreads();
}

struct EpiStoreBf16 {
    static constexpr bool PERM = true, AFTER_DRAIN = false;
    bf16* O; int ldc; int pn_mask;
    __device__ __forceinline__ void operator()(const pg8::f32x4 (&acc)[2][2][4][2], const pg8::Unit& u, int wr, int wc, int fr_, int fq_) const {
        int t_ = threadIdx.x; asm volatile("" : "+v"(t_)); const int fr = t_ & 15, fq = (t_ >> 4) & 3; (void)fr_; (void)fq_;
        const int row0 = u.pm * 256 + wr * 64 + fr, col0 = (u.pn & pn_mask) * 256 + wc * 32 + 8 * fq;
#pragma unroll
        for (int ai = 0; ai < 2; ++ai)
#pragma unroll
            for (int m = 0; m < 4; ++m) { bf16* rowp = O + (size_t)(row0 + ai * 128 + m * 16) * ldc + col0;
#pragma unroll
                for (int bj = 0; bj < 2; ++bj) { const pg8::f32x4 v0 = acc[ai][bj][m][0], v1 = acc[ai][bj][m][1];
                    v4u w; w.x = pg8::cvt_pk_bf16(v0[0], v0[1]); w.y = pg8::cvt_pk_bf16(v0[2], v0[3]); w.z = pg8::cvt_pk_bf16(v1[0], v1[1]); w.w = pg8::cvt_pk_bf16(v1[2], v1[3]);
                    *(v4u*)(rowp + bj * 128) = w; } }
    }
};
struct EpiGateUp {
    static constexpr bool PERM = true, AFTER_DRAIN = false;
    const float* sw; bf16* HG;
    __device__ __forceinline__ void operator()(const pg8::f32x4 (&acc)[2][2][4][2], const pg8::Unit& u, int wr, int wc, int fr_, int fq_) const {
        int t_ = threadIdx.x; asm volatile("" : "+v"(t_)); const int fr = t_ & 15, fq = (t_ >> 4) & 3; (void)fr_; (void)fq_;
        const int pl = u.pn & 3, row0 = u.pm * 256 + wr * 64 + fr, col0 = pl * 128 + wc * 32 + 8 * fq;
#pragma unroll
        for (int ai = 0; ai < 2; ++ai)
#pragma unroll
            for (int m = 0; m < 4; ++m) { const int row = row0 + ai * 128 + m * 16; const float w = sw[row]; float h[8];
#pragma unroll
                for (int n = 0; n < 2; ++n)
#pragma unroll
                    for (int j = 0; j < 4; ++j) { const float g = acc[ai][0][m][n][j], up = acc[ai][1][m][n][j]; h[4 * n + j] = g * sigmoid_f(g) * up * w; }
                v4u o; o.x = pg8::cvt_pk_bf16(h[0], h[1]); o.y = pg8::cvt_pk_bf16(h[2], h[3]); o.z = pg8::cvt_pk_bf16(h[4], h[5]); o.w = pg8::cvt_pk_bf16(h[6], h[7]);
                *(v4u*)(HG + (size_t)row * FF + col0) = o; }
    }
};
struct EpiResGate {
    static constexpr bool PERM = false, AFTER_DRAIN = false;
    const float* x; const float* gate; float* X1;
    __device__ __forceinline__ void operator()(const pg8::f32x4 (&acc)[2][2][4][2], const pg8::Unit& u, int wr, int wc, int fr_, int fq_) const {
        int t_ = threadIdx.x; asm volatile("" : "+v"(t_)); const int fr = t_ & 15, fq = (t_ >> 4) & 3; (void)fr_; (void)fq_;
        const int row0 = u.pm * 256 + wr * 64 + fr, col0 = u.pn * 256 + wc * 32 + 4 * fq;
        const float* gp = gate + (size_t)((u.pm * 256) >> 12) * 12288;
#pragma unroll
        for (int bj = 0; bj < 2; ++bj)
#pragma unroll
            for (int n = 0; n < 2; ++n) { const int c = col0 + bj * 128 + n * 16; const pg8::f32x4 gv = *(const pg8::f32x4*)(gp + c);
#pragma unroll
                for (int ai = 0; ai < 2; ++ai)
#pragma unroll
                    for (int m = 0; m < 4; ++m) { const size_t off = (size_t)(row0 + ai * 128 + m * 16) * DM + c;
                        const pg8::f32x4 xv = *(const pg8::f32x4*)(x + off); *(pg8::f32x4*)(X1 + off) = xv + gv * acc[ai][bj][m][n]; } }
    }
};
struct EpiLora {
    static constexpr bool PERM = false, AFTER_DRAIN = false;
    float* LW; bf16* AA; bf16* GG;
    __device__ __forceinline__ void operator()(const pg8::f32x4 (&acc)[2][2][4][2], const pg8::Unit& u, int wr, int wc, int fr_, int fq_) const {
        int t_ = threadIdx.x; asm volatile("" : "+v"(t_)); const int fr = t_ & 15, fq = (t_ >> 4) & 3; (void)fr_; (void)fq_;
        const int type = u.pn >> 2, row0 = u.pm * 256 + wr * 64 + fr, col0 = (u.pn & 3) * 256 + wc * 32 + 4 * fq;
        bf16* hb = (type == 1) ? AA : GG;
#pragma unroll
        for (int bj = 0; bj < 2; ++bj)
#pragma unroll
            for (int n = 0; n < 2; ++n) { const int c = col0 + bj * 128 + n * 16;
#pragma unroll
                for (int ai = 0; ai < 2; ++ai)
#pragma unroll
                    for (int m = 0; m < 4; ++m) { const size_t off = (size_t)(row0 + ai * 128 + m * 16) * CW + c; const pg8::f32x4 v = acc[ai][bj][m][n];
                        if (type == 0) *(pg8::f32x4*)(LW + off) = v;
                        else { v2u o; o.x = pg8::cvt_pk_bf16(v[0], v[1]); o.y = pg8::cvt_pk_bf16(v[2], v[3]); *(v2u*)(hb + off) = o; } } }
    }
};
struct GroupOrder {
    const unsigned* te; int nrt, ncol, G, c;
    __device__ __forceinline__ bool next(int i, pg8::Unit& u) const {
        const long L = (long)i * G + c; if (L >= (long)nrt * ncol) return false;
        const int rt = (int)(L / ncol), pl = (int)(L - (long)rt * ncol);
        u.pm = rt; u.pn = (int)te[rt] * ncol + pl; return true;
    }
    __device__ __forceinline__ void a_ready(const pg8::Unit&) const {}
    __device__ __forceinline__ void done(const pg8::Unit&) const {}
};

#define MFMA16(a, b, c) __builtin_amdgcn_mfma_f32_16x16x16bf16_1k(a, b, c, 0, 0, 0)
constexpr int NUNIT = BATCH * NHEAD * (SEQ / 64);
constexpr int LA_GF = 0, LA_SEG = 16384, LA_PL = 18432, LA_RT = 20480, LA_QT = 28672, LA_KT = 36864, LA_BT = 45056, LA_VT = 53248,
              LA_AQB = 61440, LA_AQK = 69632, LA_ARB = 77824, LA_ARK = 86016, LA_DG = 94208, LA_DL = 98304;
__device__ __forceinline__ int swz(int row, int chunk) { return row * 128 + ((chunk ^ ((row >> 1) & 7)) << 4); }
__device__ __forceinline__ s16x4 tr_read(LAS unsigned char* base, int r0, int cb, int n) {
    return __builtin_bit_cast(s16x4, __builtin_amdgcn_ds_read_tr16_b64_v4i16((LAS s16x4*)(base + swz(r0 + (n >> 2), 2 * cb + ((n & 3) >> 1)) + 8 * (n & 1)))); }
__device__ __forceinline__ s16x4 row_read4(LAS unsigned char* base, int row, int col0) {
    return *(const LAS s16x4*)(base + swz(row, col0 >> 3) + 2 * (col0 & 7)); }
__device__ __forceinline__ s16x4 pack4(const f32x4 v) { v2u w; w.x = pk2(v[0], v[1]); w.y = pk2(v[2], v[3]); return __builtin_bit_cast(s16x4, w); }
__device__ __forceinline__ s16x4 pack4n(const f32x4 v) { v2u w; w.x = pk2(-v[0], -v[1]); w.y = pk2(-v[2], -v[3]); return __builtin_bit_cast(s16x4, w); }
__device__ __forceinline__ f32x4 unpack4(const s16x4 s) { const v2u w = __builtin_bit_cast(v2u, s); return (f32x4){bflo(w.x), bfhi(w.x), bflo(w.y), bfhi(w.y)}; }

__device__ __forceinline__ void scanA(const Args& a, LAS unsigned char* lds) {
    const int tid = threadIdx.x, lane = tid & 63, wave = __builtin_amdgcn_readfirstlane(tid >> 6), n = lane & 15, g = lane >> 4;
    LAS float* GF = (LAS float*)(lds + LA_GF); LAS float* SEG = (LAS float*)(lds + LA_SEG); LAS float* PLs = (LAS float*)(lds + LA_PL); LAS float* DG = (LAS float*)(lds + LA_DG);
    const int tk = tid >> 3, c8 = 8 * (tid & 7);
    v4u nr4, nk4, nv4, nq4, nb4; f32x4 nl0, nl1;
#define SCANA_LOAD(U) do { const int bh_ = (U) >> 6, ck_ = (U) & 63; const size_t off_ = ((size_t)(bh_ >> 4) * SEQ + 64 * ck_ + tk) * CW + (bh_ & 15) * 64 + c8; \
        nr4 = *(const v4u*)((const bf16*)(a.ws + WS_R) + off_); nk4 = *(const v4u*)((const bf16*)(a.ws + WS_K2) + off_); nv4 = *(const v4u*)((const bf16*)(a.ws + WS_V) + off_); \
        nq4 = *(const v4u*)((const bf16*)(a.ws + WS_KK) + off_); nb4 = *(const v4u*)((const bf16*)(a.ws + WS_BB) + off_); \
        nl0 = *(const f32x4*)((const float*)(a.ws + WS_LW) + off_); nl1 = *(const f32x4*)((const float*)(a.ws + WS_LW) + off_ + 4); } while (0)
    if ((int)blockIdx.x < NUNIT) SCANA_LOAD((int)blockIdx.x);
    for (int unit = blockIdx.x; unit < NUNIT; unit += gridDim.x) {
        const v4u r4 = nr4, k4 = nk4, v4 = nv4, q4 = nq4, b4 = nb4; f32x4 l0, l1;
        { const int h_ = (unit >> 6) & 15; const f32x4 wa = *(const f32x4*)(a.in[I_W0] + h_ * 64 + c8), wb = *(const f32x4*)(a.in[I_W0] + h_ * 64 + c8 + 4);
#pragma unroll
          for (int i = 0; i < 4; ++i) { const float z0 = -(nl0[i] + wa[i]), z1 = -(nl1[i] + wb[i]);
              const float s0 = fmaxf(z0, 0.f) + __logf(1.f + __expf(-fabsf(z0))), s1 = fmaxf(z1, 0.f) + __logf(1.f + __expf(-fabsf(z1)));
              l0[i] = -__expf(-s0 - 0.5f); l1[i] = -__expf(-s1 - 0.5f); } }
        *(LAS f32x4*)(GF + tk * 64 + c8) = l0; *(LAS f32x4*)(GF + tk * 64 + c8 + 4) = l1;
        __syncthreads();
        { const int c = tid & 63, sg = tid >> 6; float run = 0.f;
#pragma unroll
          for (int i = 0; i < 8; ++i) { run += GF[(8 * sg + i) * 64 + c]; GF[(8 * sg + i) * 64 + c] = run; }
          SEG[sg * 64 + c] = run; }
        __syncthreads();
        { const int sg = tk >> 3; float gg[8], lw[8];
#pragma unroll
          for (int i = 0; i < 8; ++i) { float x = GF[tk * 64 + c8 + i];
#pragma unroll
              for (int s2 = 0; s2 < 7; ++s2) if (s2 < sg) x += SEG[s2 * 64 + c8 + i];
              gg[i] = x; lw[i] = (i < 4) ? l0[i] : l1[i - 4]; }
          float rr[8], qq[8], kk[8], bb[8];
#pragma unroll
          for (int i = 0; i < 4; ++i) { const int e0 = 2 * i, e1 = 2 * i + 1;
              const float eg0 = __expf(gg[e0]), eg1 = __expf(gg[e1]), en0 = __expf(-gg[e0]), en1 = __expf(-gg[e1]), em0 = __expf(gg[e0] - lw[e0]), em1 = __expf(gg[e1] - lw[e1]);
              rr[e0] = bflo(r4[i]) * eg0; rr[e1] = bfhi(r4[i]) * eg1; qq[e0] = bflo(q4[i]) * em0; qq[e1] = bfhi(q4[i]) * em1;
              kk[e0] = bflo(k4[i]) * en0; kk[e1] = bfhi(k4[i]) * en1; bb[e0] = bflo(b4[i]) * en0; bb[e1] = bfhi(b4[i]) * en1;
              if (tk == 63) { PLs[c8 + e0] = eg0; PLs[c8 + e1] = eg1; } }
          const int so = swz(tk, tid & 7); v4u w;
          w.x = pk2(rr[0], rr[1]); w.y = pk2(rr[2], rr[3]); w.z = pk2(rr[4], rr[5]); w.w = pk2(rr[6], rr[7]); *(LAS v4u*)(lds + LA_RT + so) = w;
          w.x = pk2(qq[0], qq[1]); w.y = pk2(qq[2], qq[3]); w.z = pk2(qq[4], qq[5]); w.w = pk2(qq[6], qq[7]); *(LAS v4u*)(lds + LA_QT + so) = w;
          w.x = pk2(kk[0], kk[1]); w.y = pk2(kk[2], kk[3]); w.z = pk2(kk[4], kk[5]); w.w = pk2(kk[6], kk[7]); *(LAS v4u*)(lds + LA_KT + so) = w;
          w.x = pk2(bb[0], bb[1]); w.y = pk2(bb[2], bb[3]); w.z = pk2(bb[4], bb[5]); w.w = pk2(bb[6], bb[7]); *(LAS v4u*)(lds + LA_BT + so) = w;
          *(LAS v4u*)(lds + LA_VT + so) = v4; }
        __syncthreads();
        if (unit + (int)gridDim.x < NUNIT) SCANA_LOAD(unit + (int)gridDim.x);
        for (int id = wave; id < 40; id += NWAVES) {
            const int mat = id / 10, p = id - mat * 10, tb = p < 1 ? 0 : (p < 3 ? 1 : (p < 6 ? 2 : 3)), sb = p - tb * (tb + 1) / 2;
            LAS unsigned char* Lft = lds + ((mat & 1) ? LA_KT : LA_BT); LAS unsigned char* Rgt = lds + ((mat & 2) ? LA_RT : LA_QT);
            f32x4 acc = (f32x4){0.f, 0.f, 0.f, 0.f};
#pragma unroll
            for (int ks = 0; ks < 2; ++ks) { const bf16x8 af = *(const LAS bf16x8*)(Lft + swz(16 * sb + n, 4 * ks + g)), bfr = *(const LAS bf16x8*)(Rgt + swz(16 * tb + n, 4 * ks + g));
                acc = __builtin_amdgcn_mfma_f32_16x16x32_bf16(af, bfr, acc, 0, 0, 0); }
            const int t = 16 * tb + n, s0 = 16 * sb + 4 * g;
#pragma unroll
            for (int j = 0; j < 4; ++j) { const bool keep = (mat & 2) ? (s0 + j <= t) : (s0 + j < t); if (!keep) acc[j] = 0.f; }
            LAS unsigned char* dst = lds + (mat == 0 ? LA_AQB : (mat == 1 ? LA_AQK : (mat == 2 ? LA_ARB : LA_ARK)));
            v2u w; w.x = pk2(acc[0], acc[1]); w.y = pk2(acc[2], acc[3]);
            *(LAS v2u*)(dst + swz(t, s0 >> 3) + 2 * (s0 & 7)) = w;
            if (mat == 0 && sb == tb) *(LAS f32x4*)(DG + tb * 256 + n * 16 + 4 * g) = acc;
        }
        __syncthreads();
        if (wave < 4 && lane < 16) {
            const LAS float* A = DG + wave * 256; float x[16];
#pragma unroll
            for (int t = 0; t < 16; ++t) { float acc = (t == lane) ? 1.f : 0.f;
#pragma unroll
                for (int s = 0; s < t; ++s) acc -= A[t * 16 + s] * x[s];
                x[t] = acc; }
            LAS bf16* D = (LAS bf16*)(lds + LA_DL) + wave * 256;
#pragma unroll
            for (int t = 0; t < 16; ++t) D[t * 16 + lane] = (bf16)f2bf(x[t]);
        }
        __syncthreads();
        {
            const bool isU = wave >= 4; const int cb = wave & 3;
            LAS unsigned char* AQB = lds + LA_AQB; LAS unsigned char* AQK = lds + LA_AQK; LAS unsigned char* ARB = lds + LA_ARB; LAS unsigned char* ARK = lds + LA_ARK;
            s16x4 vf[4], xn[4];
            f32x4 rhs[4];
            if (isU) {
#pragma unroll
                for (int k = 0; k < 4; ++k) vf[k] = tr_read(lds + LA_VT, 16 * k + 4 * g, cb, n);
#pragma unroll
                for (int i = 0; i < 4; ++i) { f32x4 acc = (f32x4){0.f, 0.f, 0.f, 0.f};
#pragma unroll
                    for (int k = 0; k < 4; ++k) if (k <= i) acc = MFMA16(row_read4(AQK, 16 * i + n, 16 * k + 4 * g), vf[k], acc);
                    rhs[i] = acc; }
            } else {
#pragma unroll
                for (int i = 0; i < 4; ++i) { rhs[i] = unpack4(tr_read(lds + LA_QT, 16 * i + 4 * g, cb, n)); vf[i] = (s16x4){0, 0, 0, 0}; }
            }
#pragma unroll
            for (int i = 0; i < 4; ++i) { f32x4 acc = rhs[i];
#pragma unroll
                for (int k = 0; k < 4; ++k) if (k < i) acc = MFMA16(row_read4(AQB, 16 * i + n, 16 * k + 4 * g), xn[k], acc);
                const s16x4 df = *(const LAS s16x4*)(lds + LA_DL + i * 512 + n * 32 + 8 * g);
                const f32x4 xi = MFMA16(df, pack4(acc), ((f32x4){0.f, 0.f, 0.f, 0.f}));
                xn[i] = pack4n(xi); }
            const float plv[4] = {PLs[n], PLs[16 + n], PLs[32 + n], PLs[48 + n]};
            if (!isU) {
                bf16* RH = (bf16*)(a.ws + WS_RH) + (size_t)unit * 4096;
#pragma unroll
                for (int i = 0; i < 4; ++i) { f32x4 acc = unpack4(tr_read(lds + LA_RT, 16 * i + 4 * g, cb, n));
#pragma unroll
                    for (int k = 0; k < 4; ++k) if (k <= i) acc = MFMA16(row_read4(ARB, 16 * i + n, 16 * k + 4 * g), xn[k], acc);
#pragma unroll
                    for (int j = 0; j < 4; ++j) RH[(16 * i + 4 * g + j) * 64 + 16 * cb + n] = (bf16)f2bf(acc[j]); }
                bf16* GT = (bf16*)(a.ws + WS_GT) + (size_t)unit * 4096;
#pragma unroll
                for (int c2b = 0; c2b < 4; ++c2b) { f32x4 acc = (f32x4){0.f, 0.f, 0.f, 0.f};
#pragma unroll
                    for (int k = 0; k < 4; ++k) acc = MFMA16(xn[k], tr_read(lds + LA_BT, 16 * k + 4 * g, c2b, n), acc);
                    acc *= plv[c2b]; *(v2u*)(GT + (16 * c2b + n) * 64 + 16 * cb + 4 * g) = __builtin_bit_cast(v2u, pack4(acc)); }
            } else {
                float* Y1 = (float*)(a.ws + WS_Y1) + (size_t)unit * 4096;
#pragma unroll
                for (int i = 0; i < 4; ++i) { f32x4 acc = (f32x4){0.f, 0.f, 0.f, 0.f};
#pragma unroll
                    for (int k = 0; k < 4; ++k) if (k <= i) { acc = MFMA16(row_read4(ARK, 16 * i + n, 16 * k + 4 * g), vf[k], acc); acc = MFMA16(row_read4(ARB, 16 * i + n, 16 * k + 4 * g), xn[k], acc); }
#pragma unroll
                    for (int j = 0; j < 4; ++j) Y1[(16 * i + 4 * g + j) * 64 + 16 * cb + n] = acc[j]; }
                float* HM = (float*)(a.ws + WS_HM) + (size_t)unit * 4096;
#pragma unroll
                for (int c2b = 0; c2b < 4; ++c2b) { f32x4 acc = (f32x4){0.f, 0.f, 0.f, 0.f};
#pragma unroll
                    for (int k = 0; k < 4; ++k) { acc = MFMA16(vf[k], tr_read(lds + LA_KT, 16 * k + 4 * g, c2b, n), acc); acc = MFMA16(xn[k], tr_read(lds + LA_BT, 16 * k + 4 * g, c2b, n), acc); }
#pragma unroll
                    for (int j = 0; j < 4; ++j) HM[(16 * cb + 4 * g + j) * 64 + 16 * c2b + n] = acc[j] * plv[c2b]; }
            }
            if (wave == 0) ((float*)(a.ws + WS_PLV))[(size_t)unit * 64 + lane] = PLs[lane];
        }
        __syncthreads();
    }
}

constexpr int LB_SLOT = 13312, LB_NPIECE = 13, LB_PER_WAVE = 4, LB_NSLOT = 8, LB_DIST = 7;
__device__ __forceinline__ void chainB_issue(const Args& a, LAS unsigned char* lds, size_t unit, int vb, int step, int lw, int lane) {
    const unsigned char* gt = a.ws + WS_GT + unit * 8192; const unsigned char* hm = a.ws + WS_HM + unit * 16384 + vb * 4096; const unsigned char* pv = a.ws + WS_PLV + unit * 256;
#pragma unroll
    for (int i = 0; i < LB_PER_WAVE; ++i) { int p = lw + 4 * i; p = p < LB_NPIECE - 1 ? p : LB_NPIECE - 1;
        const unsigned char* src = (p < 8) ? gt + p * 1024 : ((p < 12) ? hm + (p - 8) * 1024 : pv);
        __builtin_amdgcn_global_load_lds((const unsigned*)(src + lane * 16), (LAS unsigned*)(lds + (step & (LB_NSLOT - 1)) * LB_SLOT + p * 1024), 16, 0, 0); }
}
__device__ __forceinline__ void scanB(const Args& a, LAS unsigned char* lds) {
    const int tid = threadIdx.x, lane = tid & 63, wave = __builtin_amdgcn_readfirstlane(tid >> 6), n = lane & 15, g = lane >> 4;
    constexpr int NCK = SEQ / 64;
    for (int item = blockIdx.x; item < BATCH * NHEAD * 4; item += gridDim.x) {
        const int bh = item >> 2, vb = item & 3;
        const size_t u0 = (size_t)bh * 64;
#ifndef SCANB_EXTRA
#define SCANB_EXTRA 0
#endif
      for (int pass = 0; pass < 1 + (SCANB_EXTRA != 0 ? 1 : 0); ++pass) {
        const bool dma = !(SCANB_EXTRA == 2 && pass == 1);
        f32x4 acc[4];
#pragma unroll
        for (int i = 0; i < 4; ++i) acc[i] = (f32x4){0.f, 0.f, 0.f, 0.f};
        if (wave >= 4 && dma) {
#pragma unroll
            for (int s = 0; s < LB_DIST; ++s) chainB_issue(a, lds, u0 + s, vb, s, wave - 4, lane);
            asm volatile("s_waitcnt vmcnt(24)" ::: "memory"); }
        __builtin_amdgcn_s_barrier(); asm volatile("" ::: "memory");
        for (int ck = 0; ck < NCK; ++ck) {
            if (wave >= 4) { if (dma) {
                if (ck + LB_DIST < NCK) { chainB_issue(a, lds, u0 + ck + LB_DIST, vb, ck + LB_DIST, wave - 4, lane); asm volatile("s_waitcnt vmcnt(24)" ::: "memory"); }
                else asm volatile("s_waitcnt vmcnt(0)" ::: "memory"); }
            } else if (wave == 0) {
                LAS unsigned char* sl = lds + (ck & (LB_NSLOT - 1)) * LB_SLOT;
                s16x4 sb[4];
                v2u* SF = (v2u*)(a.ws + WS_SF + (size_t)pass * 16 * MiB) + ((u0 + ck) * 16 + vb * 4) * 64 + lane;
#pragma unroll
                for (int k = 0; k < 4; ++k) { sb[k] = pack4(acc[k]); SF[k * 64] = __builtin_bit_cast(v2u, sb[k]); }
                s16x4 gf[4][4]; f32x4 nx[4];
#pragma unroll
                for (int i = 0; i < 4; ++i) { const f32x4 hm = *(const LAS f32x4*)(sl + 8192 + (n * 64 + 16 * i + 4 * g) * 4), pl = *(const LAS f32x4*)(sl + 12288 + (16 * i + 4 * g) * 4);
                    nx[i] = pl * acc[i] + hm;
#pragma unroll
                    for (int k = 0; k < 4; ++k) gf[i][k] = *(const LAS s16x4*)(sl + (16 * i + n) * 128 + (16 * k + 4 * g) * 2); }
                asm volatile("s_waitcnt lgkmcnt(0)" ::: "memory"); __builtin_amdgcn_sched_barrier(0);
#pragma unroll
                for (int k = 0; k < 4; ++k)
#pragma unroll
                    for (int i = 0; i < 4; ++i) nx[i] = MFMA16(gf[i][k], sb[k], nx[i]);
#pragma unroll
                for (int i = 0; i < 4; ++i) acc[i] = nx[i];
                asm volatile("s_waitcnt lgkmcnt(0)" ::: "memory");
            }
            __builtin_amdgcn_s_barrier(); asm volatile("" ::: "memory");
        }
      }
    }
}

__device__ __forceinline__ void scanC(const Args& a) {
    const int tid = threadIdx.x, lane = tid & 63, wave = tid >> 6, n = lane & 15, g = lane >> 4;
    const int gw = blockIdx.x * NWAVES + wave, NGW = gridDim.x * NWAVES;
    for (int task = gw; task < NUNIT * 4; task += NGW) {
        const int unit = task >> 2, i = task & 3, bh = unit >> 6, ck = unit & 63, b = bh >> 4, h = bh & 15;
        const v2u* SF = (const v2u*)(a.ws + WS_SF) + (size_t)unit * 16 * 64 + lane;
        const bf16* RH = (const bf16*)(a.ws + WS_RH) + (size_t)unit * 4096; const float* Y1 = (const float*)(a.ws + WS_Y1) + (size_t)unit * 4096;
        s16x4 rf[4]; f32x4 acc[4];
#pragma unroll
        for (int k = 0; k < 4; ++k) rf[k] = *(const s16x4*)(RH + (16 * i + n) * 64 + 16 * k + 4 * g);
#pragma unroll
        for (int vb = 0; vb < 4; ++vb) { acc[vb] = *(const f32x4*)(Y1 + (16 * i + n) * 64 + 16 * vb + 4 * g);
#pragma unroll
            for (int k = 0; k < 4; ++k) acc[vb] = MFMA16(__builtin_bit_cast(s16x4, SF[(vb * 4 + k) * 64]), rf[k], acc[vb]); }
        const size_t m = (size_t)b * SEQ + 64 * ck + 16 * i + n;
        float s1 = 0.f;
#pragma unroll
        for (int vb = 0; vb < 4; ++vb) s1 += (acc[vb][0] + acc[vb][1]) + (acc[vb][2] + acc[vb][3]);
        s1 += __shfl_xor(s1, 16); s1 += __shfl_xor(s1, 32);
        const float mean = s1 * (1.f / 64.f); float s2 = 0.f;
#pragma unroll
        for (int vb = 0; vb < 4; ++vb)
#pragma unroll
            for (int j = 0; j < 4; ++j) { const float d = acc[vb][j] - mean; s2 += d * d; }
        s2 += __shfl_xor(s2, 16); s2 += __shfl_xor(s2, 32);
        const float rstd = 1.f / sqrtf(s2 * (1.f / 64.f) + GN_EPS);
        f32x4 rv[4], kv[4], vv[4], gv[4]; float dot = 0.f;
#pragma unroll
        for (int vb = 0; vb < 4; ++vb) { const size_t o = m * CW + h * 64 + 16 * vb + 4 * g;
            rv[vb] = unpack4(*(const s16x4*)((const bf16*)(a.ws + WS_R) + o)); kv[vb] = unpack4(*(const s16x4*)((const bf16*)(a.ws + WS_K2) + o));
            vv[vb] = unpack4(*(const s16x4*)((const bf16*)(a.ws + WS_V) + o)); gv[vb] = unpack4(*(const s16x4*)((const bf16*)(a.ws + WS_GG) + o));
            const f32x4 rk = *(const f32x4*)(a.in[I_RK] + h * 64 + 16 * vb + 4 * g);
#pragma unroll
            for (int j = 0; j < 4; ++j) dot += rv[vb][j] * kv[vb][j] * rk[j]; }
        dot += __shfl_xor(dot, 16); dot += __shfl_xor(dot, 32);
#pragma unroll
        for (int vb = 0; vb < 4; ++vb) { const int c = h * 64 + 16 * vb + 4 * g;
            const f32x4 lw = *(const f32x4*)(a.in[I_LNW] + c), lb = *(const f32x4*)(a.in[I_LNB] + c), be = *(const f32x4*)(a.in[I_BETAR] + c);
            const f32x4 o = ((acc[vb] - mean) * rstd * lw + lb + dot * vv[vb]) * gv[vb] * be;
            *(v2u*)((bf16*)(a.ws + WS_YMIX) + m * DM + c) = __builtin_bit_cast(v2u, pack4(o)); }
    }
}

__device__ __forceinline__ void conv_item(const float* __restrict__ W, int N, bf16* WT, size_t drow0, int ldd, int k0, int n0, LAS float* scr, int lane) {
    float v[32];
#pragma unroll
    for (int i = 0; i < 32; ++i) { const int kk = 2 * i + (lane >> 5); v[i] = W[(size_t)(k0 + kk) * N + n0 + (lane & 31)]; }
#pragma unroll
    for (int i = 0; i < 32; ++i) { const int kk = 2 * i + (lane >> 5); scr[kk * 33 + (lane & 31)] = v[i]; }
    LDS_WAIT(); asm volatile("" ::: "memory");
    const int c = lane & 7;
#pragma unroll
    for (int j = 0; j < 4; ++j) { const int n = (lane >> 3) + 8 * j; const LAS float* s = scr + (8 * c) * 33 + n;
        v4u o; o.x = pk2(s[0 * 33], s[1 * 33]); o.y = pk2(s[2 * 33], s[3 * 33]); o.z = pk2(s[4 * 33], s[5 * 33]); o.w = pk2(s[6 * 33], s[7 * 33]);
        *(v4u*)(WT + (drow0 + n) * (size_t)ldd + k0 + 8 * c) = o; }
    LDS_WAIT(); asm volatile("" ::: "memory");
}
__device__ __forceinline__ void phase0(const Args& a, LAS unsigned char* lds) {
    const int tid = threadIdx.x, lane = tid & 63, wave = __builtin_amdgcn_readfirstlane(tid >> 6), G = gridDim.x, bid = blockIdx.x;
    unsigned char* ws = a.ws;
    LAS float* cact = (LAS float*)lds;
    LAS float* red = (LAS float*)(lds + 16384);
    LAS float* scr = (LAS float*)(lds + 32768 + wave * 8448);
    if (bid < 192 || G < 192) {
        const float* c = a.in[I_C];
        for (int i = tid; i < 2 * DM; i += NTHR) { const float x = c[i]; cact[i] = x / (1.f + __expf(-x)); }
        __syncthreads();
        for (int item = bid; item < 192; item += G) {
            const int ro = lane >> 4, cq = lane & 15;
            const float* wp = a.in[I_WADA] + (size_t)(256 * wave + ro) * 12288 + 64 * item + 4 * cq;
            f32x4 acc0 = (f32x4){0.f, 0.f, 0.f, 0.f}, acc1 = acc0;
#pragma unroll 8
            for (int i = 0; i < 64; ++i) { const f32x4 wv = *(const f32x4*)(wp + (size_t)(4 * i) * 12288);
                const float c0 = cact[256 * wave + 4 * i + ro], c1 = cact[DM + 256 * wave + 4 * i + ro]; acc0 += c0 * wv; acc1 += c1 * wv; }
#pragma unroll
            for (int j = 0; j < 4; ++j) { float v0 = acc0[j], v1 = acc1[j]; v0 += __shfl_xor(v0, 16); v0 += __shfl_xor(v0, 32); v1 += __shfl_xor(v1, 16); v1 += __shfl_xor(v1, 32);
                if (ro == 0) { red[(wave * 2 + 0) * 64 + 4 * cq + j] = v0; red[(wave * 2 + 1) * 64 + 4 * cq + j] = v1; } }
            __syncthreads();
            if (tid < 128) { const int b = tid >> 6, cc = tid & 63; float s = a.in[I_BADA][64 * item + cc];
#pragma unroll
                for (int w2 = 0; w2 < 8; ++w2) s += red[(w2 * 2 + b) * 64 + cc];
                ((float*)(ws + WS_MOD))[b * 12288 + 64 * item + cc] = s; }
            __syncthreads();
        }
    }
    constexpr int NI_IN = 32 * 201, NI_OUT = 32 * 64, NI_E = 32 * 512;
    constexpr int NCONV = NI_IN + NI_OUT + 3 * NI_E;
    const int gw = bid * NWAVES + wave, NGW = G * NWAVES;
    for (int it = gw; it < NCONV; it += NGW) {
        int r = it;
        if (r < NI_IN) { const int kb = r / 201, nb = r - kb * 201; conv_item(a.in[I_WIN], PROJW, (bf16*)(ws + WS_WIN), (size_t)(32 * nb), DM, 64 * kb, 32 * nb, scr, lane); continue; } r -= NI_IN;
        if (r < NI_OUT) { const int kb = r >> 6, nb = r & 63; conv_item(a.in[I_WOUT], DM, (bf16*)(ws + WS_WOUT), (size_t)(32 * nb), DM, 64 * kb, 32 * nb, scr, lane); continue; } r -= NI_OUT;
        if (r < 2 * NI_E) { const int up = r >= NI_E; if (up) r -= NI_E; const int e = r >> 9, q = r & 511, kb = q >> 4, nb = q & 15, n0 = 32 * nb;
            conv_item(a.in[up ? I_WU : I_WG] + (size_t)e * DM * FF, FF, (bf16*)(ws + WS_WGU), (size_t)e * 1024 + 256 * (n0 >> 7) + (n0 & 127) + (up ? 128 : 0), DM, 64 * kb, n0, scr, lane); continue; } r -= 2 * NI_E;
        { const int e = r >> 9, q = r & 511, kb = q >> 6, nb = q & 63;
            conv_item(a.in[I_WDN] + (size_t)e * FF * DM, DM, (bf16*)(ws + WS_WD), (size_t)e * DM + 32 * nb, FF, 64 * kb, 32 * nb, scr, lane); }
    }
    const int gt = bid * NTHR + tid, NGT = G * NTHR;
    bf16* wl = (bf16*)(ws + WS_WL);
    for (int idx = gt; idx < LORA_N * LORA_K; idx += NGT) { const int n = idx / LORA_K, k = idx - n * LORA_K; float v = 0.f;
        if (n < 1024) { if (k < 64) v = a.in[I_WDEC][k * 1024 + n]; }
        else if (n < 2048) { if (k >= 64 && k < 128) v = a.in[I_WAAA][(k - 64) * 1024 + (n - 1024)]; }
        else { if (k >= 128 && k < 288) v = a.in[I_WGATEUP][(k - 128) * 1024 + (n - 2048)]; }
        wl[idx] = (bf16)f2bf(v); }
    float* w36 = (float*)(ws + WS_W36);
    for (int idx = gt; idx < DM * 36; idx += NGT) { const int e = idx >> 11, dd = idx & (DM - 1);
        w36[idx] = (e < 4) ? a.in[I_WGRP][dd * 4 + e] : a.in[I_WEXP][((size_t)((e - 4) >> 3) * DM + dd) * 8 + ((e - 4) & 7)]; }
    v4u* wz = (v4u*)(ws + WS_WIN + (size_t)PROJW * DM * 2);
    for (int idx = gt; idx < (PROJP - PROJW) * DM / 8; idx += NGT) wz[idx] = (v4u){0u, 0u, 0u, 0u};
}

__device__ __forceinline__ void phase1(const Args& a) {
    const int tid = threadIdx.x, lane = tid & 63, wave = tid >> 6;
    const int gw = blockIdx.x * NWAVES + wave, NGW = gridDim.x * NWAVES;
    const float* mod = (const float*)(a.ws + WS_MOD);
    for (int it = gw; it < 72; it += NGW) {
        const int b = it / 36, e = it - b * 36; const float* w36 = (const float*)(a.ws + WS_W36); float s = 0.f;
        for (int dd = lane; dd < DM; dd += 64) s += mod[b * 12288 + 3 * DM + dd] * w36[e * DM + dd];
        s = wave_sum(s) + ((e < 4) ? a.in[I_BGRP][e] : a.in[I_BEXP][e - 4]);
        if (lane == 0) ((float*)(a.ws + WS_B36))[it] = s; }
    for (int m = gw; m < MTOK; m += NGW) {
        const int b = m >> 12;
        const f32x4* xr = (const f32x4*)(a.in[I_X] + (size_t)m * DM) + lane;
        f32x4 v[8]; float s = 0.f;
#pragma unroll
        for (int j = 0; j < 8; ++j) { v[j] = xr[64 * j]; s += (v[j].x * v[j].x + v[j].y * v[j].y) + (v[j].z * v[j].z + v[j].w * v[j].w); }
        const float rstd = 1.f / sqrtf(wave_sum(s) * (1.f / DM) + RMS_EPS);
        v2u* o8 = (v2u*)((bf16*)(a.ws + WS_HB) + (size_t)m * DM) + lane;
#pragma unroll
        for (int j = 0; j < 8; ++j) { const int c = 4 * (lane + 64 * j);
            const f32x4 g = *(const f32x4*)(a.in[I_N1G] + c), sh = *(const f32x4*)(mod + b * 12288 + c), sc = *(const f32x4*)(mod + b * 12288 + DM + c);
            const f32x4 h = v[j] * rstd * g * (1.f + sc) + sh; v2u o; o.x = pk2(h.x, h.y); o.y = pk2(h.z, h.w); o8[64 * j] = o; }
    }
}

__device__ __forceinline__ void phase3(const Args& a) {
    const int gt = blockIdx.x * NTHR + threadIdx.x, NGT = gridDim.x * NTHR;
    const bf16* P = (const bf16*)(a.ws + WS_P); bf16* AL = (bf16*)(a.ws + WS_AL);
    for (int idx = gt; idx < MTOK * 48; idx += NGT) { const int m = idx / 48, cj = idx - m * 48;
        v4u o = (v4u){0u, 0u, 0u, 0u};
        if (cj < 36) { const int col = 3072 + 8 * cj; const v4u pc = *(const v4u*)(P + (size_t)m * PROJP + col);
            v4u pp = (v4u){0u, 0u, 0u, 0u}; if ((m & (SEQ - 1)) != 0) pp = *(const v4u*)(P + (size_t)(m - 1) * PROJP + col);
            const float* mu = a.in[I_MU] + col; float r[8];
#pragma unroll
            for (int i = 0; i < 4; ++i) { const float c0 = bflo(pc[i]), c1 = bfhi(pc[i]), p0 = bflo(pp[i]), p1 = bfhi(pp[i]);
                r[2 * i] = c0 + (p0 - c0) * mu[2 * i]; r[2 * i + 1] = c1 + (p1 - c1) * mu[2 * i + 1]; }
            if (cj < 8) {
#pragma unroll
                for (int i = 0; i < 8; ++i) r[i] = tanhf(r[i]); }
            else if (cj >= 16) {
#pragma unroll
                for (int i = 0; i < 8; ++i) r[i] = sigmoid_f(r[i]); }
            o.x = pk2(r[0], r[1]); o.y = pk2(r[2], r[3]); o.z = pk2(r[4], r[5]); o.w = pk2(r[6], r[7]); }
        *(v4u*)(AL + (size_t)m * LORA_K + 8 * cj) = o; }
}

__device__ __forceinline__ void load16(const bf16* p, float* o) { const v4u a0 = *(const v4u*)p, a1 = *(const v4u*)(p + 8);
#pragma unroll
    for (int i = 0; i < 4; ++i) { o[2 * i] = bflo(a0[i]); o[2 * i + 1] = bfhi(a0[i]); o[8 + 2 * i] = bflo(a1[i]); o[8 + 2 * i + 1] = bfhi(a1[i]); } }
__device__ __forceinline__ void store16(bf16* p, const float* v) { v4u a0, a1;
#pragma unroll
    for (int i = 0; i < 4; ++i) { a0[i] = pk2(v[2 * i], v[2 * i + 1]); a1[i] = pk2(v[8 + 2 * i], v[8 + 2 * i + 1]); }
    *(v4u*)p = a0; *(v4u*)(p + 8) = a1; }
__device__ __forceinline__ void shift16(const bf16* P, int m, int col, const float* mu, float* o) {
    float c[16], p[16]; load16(P + (size_t)m * PROJP + col, c);
    if ((m & (SEQ - 1)) != 0) load16(P + (size_t)(m - 1) * PROJP + col, p); else {
#pragma unroll
        for (int i = 0; i < 16; ++i) p[i] = 0.f; }
#pragma unroll
    for (int i = 0; i < 16; ++i) o[i] = c[i] + (p[i] - c[i]) * mu[col + i];
}
__device__ __forceinline__ void phase5a(const Args& a) {
    const int tid = threadIdx.x, lane = tid & 63, wave = tid >> 6;
    const int gw = blockIdx.x * NWAVES + wave, NGW = gridDim.x * NWAVES;
    const bf16* P = (const bf16*)(a.ws + WS_P);
    const int c0 = 16 * lane;
    for (int m = gw; m < MTOK; m += NGW) {
        float r[16], k[16], v[16], av[16], kk[16], bb[16];
        shift16(P, m, c0, a.in[I_MU], r); shift16(P, m, 1024 + c0, a.in[I_MU], k); shift16(P, m, 2048 + c0, a.in[I_MU], v);
        load16((const bf16*)(a.ws + WS_AA) + (size_t)m * CW + c0, av);
#pragma unroll
        for (int i = 0; i < 16; ++i) av[i] = sigmoid_f(av[i] + a.in[I_A0][c0 + i]);
        float ss = 0.f;
#pragma unroll
        for (int i = 0; i < 16; ++i) { kk[i] = k[i] * a.in[I_KK][c0 + i]; ss += kk[i] * kk[i]; }
        ss += __shfl_xor(ss, 1); ss += __shfl_xor(ss, 2);
        const float inv = 1.f / fmaxf(sqrtf(ss), 1e-12f);
#pragma unroll
        for (int i = 0; i < 16; ++i) { kk[i] *= inv; bb[i] = kk[i] * av[i]; k[i] = k[i] * (1.f + (av[i] - 1.f) * a.in[I_KA][c0 + i]); }
        const size_t off = (size_t)m * CW + c0;
        store16((bf16*)(a.ws + WS_R) + off, r); store16((bf16*)(a.ws + WS_K2) + off, k); store16((bf16*)(a.ws + WS_V) + off, v);
        store16((bf16*)(a.ws + WS_KK) + off, kk); store16((bf16*)(a.ws + WS_BB) + off, bb);
    }
}

__device__ __forceinline__ int swz_off(int key, int chunk) { return key * 128 + ((chunk ^ ((key >> 1) & 7)) << 4); }
__device__ __forceinline__ void phase5b(const Args& a, LAS unsigned char* lds) {
    const int tid = threadIdx.x, lane = tid & 63, wave = __builtin_amdgcn_readfirstlane(tid >> 6), n = lane & 15, g = lane >> 4;
    const bf16* P = (const bf16*)(a.ws + WS_P); bf16* Y = (bf16*)(a.ws + WS_YMIX);
    LAS float* biasL = (LAS float*)(lds + 32768);
    const float SC = 0.125f * LOG2E;
    const int skey = tid >> 3, sdc = tid & 7;
    for (int u = blockIdx.x; u < BATCH * NHEAD * 32; u += gridDim.x) {
        const int cp = u & 31, h = (u >> 5) & 15, b = u >> 9;
        const int t0 = 128 * cp, qrow = t0 + 16 * wave + n;
        const size_t rowbase = (size_t)b * SEQ;
        const bf16* qp = P + (rowbase + qrow) * PROJP + SHIFTW + h * 64;
        bf16x8 qf[2]; qf[0] = *(const bf16x8*)(qp + 8 * g); qf[1] = *(const bf16x8*)(qp + 32 + 8 * g);
        if (tid < 257) biasL[tid] = a.in[I_RELB][h * 257 + tid] * LOG2E;
        const int jstart = (8 - 2 * cp) > 0 ? (8 - 2 * cp) : 0;
        const bf16* kcol = P + rowbase * PROJP + SHIFTW + 1024 + h * 64 + 8 * sdc;
        const bf16* vcol = kcol + 1024;
        v4u kreg, vreg;
        { const int key0 = 64 * (2 * cp - 8 + jstart); kreg = *(const v4u*)(kcol + (size_t)(key0 + skey) * PROJP); vreg = *(const v4u*)(vcol + (size_t)(key0 + skey) * PROJP);
          *(LAS v4u*)(lds + swz_off(skey, sdc)) = kreg; *(LAS v4u*)(lds + 16384 + swz_off(skey, sdc)) = vreg; }
        __syncthreads();
        float mrun = -1e30f, lrun = 0.f;
        f32x4 ot[4];
#pragma unroll
        for (int i = 0; i < 4; ++i) ot[i] = (f32x4){0.f, 0.f, 0.f, 0.f};
        const float bfar = biasL[256];
        for (int j = jstart; j < 10; ++j) {
            const int cur = (j - jstart) & 1;
            const int key0 = 64 * (2 * cp - 8 + j);
            if (j + 1 < 10) { kreg = *(const v4u*)(kcol + (size_t)(key0 + 64 + skey) * PROJP); vreg = *(const v4u*)(vcol + (size_t)(key0 + 64 + skey) * PROJP); }
            const bool active = (wave < 4) ? (j <= 8) : (j >= 1);
            if (active) {
                LAS unsigned char* Kb = lds + cur * 8192; LAS unsigned char* Vb = lds + 16384 + cur * 8192;
                f32x4 s[4];
#pragma unroll
                for (int st = 0; st < 4; ++st) { s[st] = (f32x4){0.f, 0.f, 0.f, 0.f};
#pragma unroll
                    for (int ks = 0; ks < 2; ++ks) { const bf16x8 kf = *(const LAS bf16x8*)(Kb + swz_off(16 * st + n, 4 * ks + g));
                        s[st] = __builtin_amdgcn_mfma_f32_16x16x32_bf16(kf, qf[ks], s[st], 0, 0, 0); } }
                const bool far = (t0 + 16 * wave) - (key0 + 63) >= 128;
                float mx = -1e30f;
#pragma unroll
                for (int st = 0; st < 4; ++st)
#pragma unroll
                    for (int jj = 0; jj < 4; ++jj) { float bv = bfar;
                        if (!far) { const int dist = qrow - (key0 + 16 * st + 4 * g + jj); const int idx = (dist < 128 ? dist : 128) + 128; bv = biasL[idx]; }
                        const float sv = s[st][jj] * SC + bv; s[st][jj] = sv; mx = fmaxf(mx, sv); }
                mx = fmaxf(mx, __shfl_xor(mx, 16)); mx = fmaxf(mx, __shfl_xor(mx, 32));
                const float mnew = fmaxf(mrun, mx), alpha = exp2f(mrun - mnew); mrun = mnew;
                float ls = 0.f;
#pragma unroll
                for (int st = 0; st < 4; ++st)
#pragma unroll
                    for (int jj = 0; jj < 4; ++jj) { const float p = exp2f(s[st][jj] - mnew); s[st][jj] = p; ls += p; }
                lrun = lrun * alpha + ls;
#pragma unroll
                for (int i = 0; i < 4; ++i) ot[i] *= alpha;
#pragma unroll
                for (int k2 = 0; k2 < 2; ++k2) {
                    v4u pw; pw.x = pk2(s[2 * k2][0], s[2 * k2][1]); pw.y = pk2(s[2 * k2][2], s[2 * k2][3]); pw.z = pk2(s[2 * k2 + 1][0], s[2 * k2 + 1][1]); pw.w = pk2(s[2 * k2 + 1][2], s[2 * k2 + 1][3]);
                    const bf16x8 pf = __builtin_bit_cast(bf16x8, pw);
                    const int q4 = n >> 2, p4 = n & 3;
                    const int ka = 32 * k2 + 4 * g + q4, kb = ka + 16;
#pragma unroll
                    for (int nd = 0; nd < 4; ++nd) {
                        const int ch = 2 * nd + (p4 >> 1);
                        const s16x4 v0 = __builtin_bit_cast(s16x4, __builtin_amdgcn_ds_read_tr16_b64_v4i16((LAS s16x4*)(Vb + swz_off(ka, ch) + 8 * (p4 & 1))));
                        const s16x4 v1 = __builtin_bit_cast(s16x4, __builtin_amdgcn_ds_read_tr16_b64_v4i16((LAS s16x4*)(Vb + swz_off(kb, ch) + 8 * (p4 & 1))));
                        bf16x8 vf; vf[0] = v0[0]; vf[1] = v0[1]; vf[2] = v0[2]; vf[3] = v0[3]; vf[4] = v1[0]; vf[5] = v1[1]; vf[6] = v1[2]; vf[7] = v1[3];
                        ot[nd] = __builtin_amdgcn_mfma_f32_16x16x32_bf16(vf, pf, ot[nd], 0, 0, 0);
                    }
                }
            }
            if (j + 1 < 10) { *(LAS v4u*)(lds + (cur ^ 1) * 8192 + swz_off(skey, sdc)) = kreg; *(LAS v4u*)(lds + 16384 + (cur ^ 1) * 8192 + swz_off(skey, sdc)) = vreg; }
            __syncthreads();
        }
        float lt = lrun; lt += __shfl_xor(lt, 16); lt += __shfl_xor(lt, 32);
        const float inv = 1.f / lt;
        bf16* yp = Y + (rowbase + qrow) * DM + 1024 + h * 64 + 4 * g;
        const float* beta = a.in[I_BETAA] + h * 64 + 4 * g;
#pragma unroll
        for (int nd = 0; nd < 4; ++nd) { const f32x4 bt = *(const f32x4*)(beta + 16 * nd); const f32x4 o = ot[nd] * inv * bt;
            v2u w; w.x = pk2(o[0], o[1]); w.y = pk2(o[2], o[3]); *(v2u*)(yp + 16 * nd) = w; }
    }
}

__device__ __forceinline__ void phase8(const Args& a) {
    const int tid = threadIdx.x, lane = tid & 63, wave = tid >> 6;
    const int gw = blockIdx.x * NWAVES + wave, NGW = gridDim.x * NWAVES;
    const float* mod = (const float*)(a.ws + WS_MOD); const float* W36 = (const float*)(a.ws + WS_W36); const float* X1 = (const float*)(a.ws + WS_X1);
    unsigned* ctl = (unsigned*)(a.ws + WS_CTL);
    for (int task = gw; task < MTOK / 2; task += NGW) {
        const int m0 = 2 * task, b = m0 >> 12;
        float acc[2][36], ss[2];
#pragma unroll
        for (int t = 0; t < 2; ++t) { ss[t] = 0.f;
#pragma unroll
            for (int e = 0; e < 36; ++e) acc[t][e] = 0.f; }
#pragma unroll 1
        for (int q = 0; q < 8; ++q) { const int dd = 256 * q + 4 * lane;
            f32x4 x[2];
#pragma unroll
            for (int t = 0; t < 2; ++t) x[t] = *(const f32x4*)(X1 + (size_t)(m0 + t) * DM + dd);
            const f32x4 ab = *(const f32x4*)(a.in[I_N2G] + dd) * (1.f + *(const f32x4*)(mod + b * 12288 + 4 * DM + dd));
#pragma unroll
            for (int t = 0; t < 2; ++t) { ss[t] += (x[t][0] * x[t][0] + x[t][1] * x[t][1]) + (x[t][2] * x[t][2] + x[t][3] * x[t][3]); x[t] *= ab; }
#pragma unroll
            for (int e = 0; e < 36; ++e) { const f32x4 w = *(const f32x4*)(W36 + (size_t)e * DM + dd);
#pragma unroll
                for (int t = 0; t < 2; ++t) acc[t][e] += (x[t][0] * w[0] + x[t][1] * w[1]) + (x[t][2] * w[2] + x[t][3] * w[3]); } }
        const float* b36 = (const float*)(a.ws + WS_B36) + b * 36;
#pragma unroll
        for (int t = 0; t < 2; ++t) {
            const float rstd = 1.f / sqrtf(wave_sum(ss[t]) * (1.f / DM) + RMS_EPS);
            float l[36];
#pragma unroll
            for (int e = 0; e < 36; ++e) l[e] = wave_sum(acc[t][e]) * rstd + b36[e];
            int gi = 0; float gm = l[0];
#pragma unroll
            for (int i = 1; i < 4; ++i) if (l[i] > gm) { gm = l[i]; gi = i; }
            float gs = 0.f;
#pragma unroll
            for (int i = 0; i < 4; ++i) gs += expf(l[i] - gm);
            const float gwt = 1.f / gs;
            float el[8];
#pragma unroll
            for (int j = 0; j < 8; ++j) el[j] = (gi == 0) ? l[4 + j] : ((gi == 1) ? l[12 + j] : ((gi == 2) ? l[20 + j] : l[28 + j]));
            int i1 = 0; float m1 = el[0];
#pragma unroll
            for (int i = 1; i < 8; ++i) if (el[i] > m1) { m1 = el[i]; i1 = i; }
            int i2 = -1; float m2 = -3.0e38f;
#pragma unroll
            for (int i = 0; i < 8; ++i) if (i != i1 && el[i] > m2) { m2 = el[i]; i2 = i; }
            const float e2 = expf(m2 - m1); const float w1 = gwt / (1.f + e2), w2 = gwt * e2 / (1.f + e2);
            if (lane == 0) { int* rt = (int*)(a.ws + WS_ROUTE) + (size_t)(m0 + t) * 8; const int ge1 = gi * 8 + i1, ge2 = gi * 8 + i2;
                rt[0] = ge1; rt[1] = ge2; rt[2] = __float_as_int(w1); rt[3] = __float_as_int(w2);
                ((float*)(a.ws + WS_RSTD))[m0 + t] = rstd;
                atomicAdd(ctl + CW_CNT + ge1, 1u); atomicAdd(ctl + CW_CNT + ge2, 1u); }
        }
    }
}

__device__ __forceinline__ void phase9(const Args& a) {
    const int tid = threadIdx.x, lane = tid & 63, wave = tid >> 6;
    const int gw = blockIdx.x * NWAVES + wave, NGW = gridDim.x * NWAVES;
    unsigned* ctl = (unsigned*)(a.ws + WS_CTL);
    const float* mod = (const float*)(a.ws + WS_MOD);
    unsigned cnt = (lane < NEXP) ? __hip_atomic_load(ctl + CW_CNT + lane, RLX_AGENT) : 0u;
    const unsigned pad = (cnt + 255u) & ~255u;
    unsigned incl = pad;
#pragma unroll
    for (int o = 1; o < 64; o <<= 1) { const unsigned t = __shfl_up(incl, o); if (lane >= o) incl += t; }
    const unsigned off = incl - pad;
    if (gw == 0) {
        if (lane < NEXP) for (unsigned t = off >> 8; t < (off + pad) >> 8; ++t) ctl[CW_TE + t] = (unsigned)lane;
        if (lane == 63) ctl[CW_NRT] = incl >> 8;
    }
    for (int task = gw; task < MTOK / 4; task += NGW) {
        const int m0 = 4 * task, b = m0 >> 12;
        int* rt = (int*)(a.ws + WS_ROUTE) + (size_t)(m0 + (lane & 3)) * 8;
        const int e1 = rt[0], e2 = rt[1];
        unsigned p1 = 0, p2 = 0;
        if (lane < 4) { p1 = atomicAdd(ctl + CW_POS + e1, 1u); p2 = atomicAdd(ctl + CW_POS + e2, 1u); }
        const unsigned s1v = __shfl(off, e1) + p1, s2v = __shfl(off, e2) + p2;
        if (lane < 4) { rt[4] = (int)s1v; rt[5] = (int)s2v; ((float*)(a.ws + WS_SW))[s1v] = __int_as_float(rt[2]); ((float*)(a.ws + WS_SW))[s2v] = __int_as_float(rt[3]); }
#pragma unroll
        for (int t = 0; t < 4; ++t) {
            const unsigned s1 = __shfl(s1v, t), s2 = __shfl(s2v, t);
            const float rstd = ((const float*)(a.ws + WS_RSTD))[m0 + t];
            const f32x4* xr = (const f32x4*)((const float*)(a.ws + WS_X1) + (size_t)(m0 + t) * DM) + lane;
            v2u* d1 = (v2u*)((bf16*)(a.ws + WS_H2P) + (size_t)s1 * DM) + lane; v2u* d2 = (v2u*)((bf16*)(a.ws + WS_H2P) + (size_t)s2 * DM) + lane;
#pragma unroll
            for (int j = 0; j < 8; ++j) { const int c = 4 * (lane + 64 * j);
                const f32x4 g = *(const f32x4*)(a.in[I_N2G] + c), sh = *(const f32x4*)(mod + b * 12288 + 3 * DM + c), sc = *(const f32x4*)(mod + b * 12288 + 4 * DM + c);
                const f32x4 h = xr[64 * j] * rstd * g * (1.f + sc) + sh; v2u o; o.x = pk2(h.x, h.y); o.y = pk2(h.z, h.w); d1[64 * j] = o; d2[64 * j] = o; }
        }
    }
}

__device__ __forceinline__ void phase12(const Args& a) {
    const int tid = threadIdx.x, lane = tid & 63, wave = tid >> 6;
    const int gw = blockIdx.x * NWAVES + wave, NGW = gridDim.x * NWAVES;
    const float* mod = (const float*)(a.ws + WS_MOD);
    for (int m = gw; m < MTOK; m += NGW) {
        const int b = m >> 12;
        const int* rt = (const int*)(a.ws + WS_ROUTE) + (size_t)m * 8; const int s1 = rt[4], s2 = rt[5];
        const f32x4* xr = (const f32x4*)((const float*)(a.ws + WS_X1) + (size_t)m * DM) + lane;
        const v2u* f1 = (const v2u*)((const bf16*)(a.ws + WS_FP) + (size_t)s1 * DM) + lane; const v2u* f2 = (const v2u*)((const bf16*)(a.ws + WS_FP) + (size_t)s2 * DM) + lane;
        f32x4 v[8]; float s = 0.f;
#pragma unroll
        for (int j = 0; j < 8; ++j) { const int c = 4 * (lane + 64 * j); const f32x4 g2 = *(const f32x4*)(mod + b * 12288 + 5 * DM + c);
            const v2u a1 = f1[64 * j], a2 = f2[64 * j]; f32x4 f;
            f.x = bflo(a1.x) + bflo(a2.x); f.y = bfhi(a1.x) + bfhi(a2.x); f.z = bflo(a1.y) + bflo(a2.y); f.w = bfhi(a1.y) + bfhi(a2.y);
            v[j] = xr[64 * j] + g2 * f; s += (v[j].x * v[j].x + v[j].y * v[j].y) + (v[j].z * v[j].z + v[j].w * v[j].w); }
        const float rstd = 1.f / sqrtf(wave_sum(s) * (1.f / DM) + RMS_EPS);
        f32x4* op = (f32x4*)(a.out + (size_t)m * DM) + lane;
#pragma unroll
        for (int j = 0; j < 8; ++j) { const int c = 4 * (lane + 64 * j); const f32x4 g = *(const f32x4*)(a.in[I_NFG] + c); op[64 * j] = v[j] * rstd * g; }
    }
}

#ifndef MK_ONE_LAUNCH
#define MK_ONE_LAUNCH 1
#endif
__global__ void __launch_bounds__(NTHR, 2) mega_fwd(Args args) {
    extern __shared__ __attribute__((aligned(16))) unsigned char lds_raw[];
    LAS unsigned char* lds = (LAS unsigned char*)lds_raw;
    const int tid = threadIdx.x;
    for (int u = tid; u < (LDS_BYTES - LDSCTL_OFF) / 4; u += NTHR) ((LAS unsigned*)(lds + LDSCTL_OFF))[u] = 0u;
    __syncthreads();
    volatile LAS unsigned* MISC = (volatile LAS unsigned*)(lds + MISC_OFF);
    unsigned* ctl = (unsigned*)(args.ws + WS_CTL);
    unsigned* barw = ctl + CW_BAR + args.li * XCD_BAR_WORDS;
    XcdBarrier bar; bar.bar = barw; bar.x = 0; bar.st = nullptr;
    const bool multi = (args.ph_hi - args.ph_lo) > 1;
    if (multi) bar = xcd_barrier_post(barw, MISC + 8);
    const int lo = args.ph_lo, hi = args.ph_hi, G = gridDim.x;
#define IN(k) (lo <= (k) && (k) < hi)
#define SEAM(k) do { if (IN(k) && IN((k) + 1)) xcd_barrier(bar); } while (0)
    if (IN(0)) { phase0(args, lds); } SEAM(0);
    if (IN(1)) { phase1(args); } SEAM(1);
    if (IN(2)) { pg8::Gemm g{(const pg8::bf16_t*)(args.ws + WS_HB), (const pg8::bf16_t*)(args.ws + WS_WIN), MTOK, PROJP, DM}; pg8::StaticOrder S; S.init(MTOK, PROJP, G, (int)blockIdx.x);
        EpiStoreBf16 E{(bf16*)(args.ws + WS_P), PROJP, 0xffff};
        pg8::gemm_phase<EpiStoreBf16, pg8::StaticOrder, true, true>(lds, g, S, E); } SEAM(2);
    if (IN(3)) { phase3(args); } SEAM(3);
    if (IN(4)) { pg8::Gemm g{(const pg8::bf16_t*)(args.ws + WS_AL), (const pg8::bf16_t*)(args.ws + WS_WL), MTOK, LORA_N, LORA_K}; pg8::StaticOrder S; S.init(MTOK, LORA_N, G, (int)blockIdx.x);
        EpiLora E{(float*)(args.ws + WS_LW), (bf16*)(args.ws + WS_AA), (bf16*)(args.ws + WS_GG)};
        pg8::gemm_phase<EpiLora, pg8::StaticOrder, true, true>(lds, g, S, E); } SEAM(4);
    if (IN(5)) { phase5a(args); phase5b(args, lds); } SEAM(5);
    if (IN(6)) { scanA(args, lds); } SEAM(6);
    if (IN(7)) { scanB(args, lds); } SEAM(7);
    if (IN(8)) { scanC(args); } SEAM(8);
    if (IN(9)) { pg8::Gemm g{(const pg8::bf16_t*)(args.ws + WS_YMIX), (const pg8::bf16_t*)(args.ws + WS_WOUT), MTOK, DM, DM}; pg8::StaticOrder S; S.init(MTOK, DM, G, (int)blockIdx.x);
        EpiResGate E{args.in[I_X], (const float*)(args.ws + WS_MOD) + 2 * DM, (float*)(args.ws + WS_X1)};
        pg8::gemm_phase<EpiResGate, pg8::StaticOrder, true, true>(lds, g, S, E); } SEAM(9);
    if (IN(10)) { phase8(args); } SEAM(10);
    if (IN(11)) { phase9(args); } SEAM(11);
    if (IN(12)) { const int nrt = (int)__hip_atomic_load(ctl + CW_NRT, RLX_AGENT);
        pg8::Gemm g{(const pg8::bf16_t*)(args.ws + WS_H2P), (const pg8::bf16_t*)(args.ws + WS_WGU), nrt * 256, NEXP * 1024, DM}; GroupOrder S{ctl + CW_TE, nrt, 4, G, (int)blockIdx.x};
        EpiGateUp E{(const float*)(args.ws + WS_SW), (bf16*)(args.ws + WS_HG)};
        pg8::gemm_phase<EpiGateUp, GroupOrder, true, true>(lds, g, S, E); } SEAM(12);
    if (IN(13)) { const int nrt = (int)__hip_atomic_load(ctl + CW_NRT, RLX_AGENT);
        pg8::Gemm g{(const pg8::bf16_t*)(args.ws + WS_HG), (const pg8::bf16_t*)(args.ws + WS_WD), nrt * 256, NEXP * DM, FF}; GroupOrder S{ctl + CW_TE, nrt, 8, G, (int)blockIdx.x};
        EpiStoreBf16 E{(bf16*)(args.ws + WS_FP), DM, 7};
        pg8::gemm_phase<EpiStoreBf16, GroupOrder, true, true>(lds, g, S, E); } SEAM(13);
    if (IN(14)) { phase12(args); }
#ifdef EXTRA_BARRIERS
    if (multi) for (int i_ = 0; i_ < EXTRA_BARRIERS; ++i_) xcd_barrier(bar);
#endif
#undef IN
#undef SEAM
}

extern "C" void kernel_launch(void* const* d_in, const int* in_sizes, int n_in, void* d_out, int out_size, void* d_ws, size_t ws_size, hipStream_t stream) {
    static int grid = 0;
    if (grid == 0) {
        if (n_in != 30 || out_size != MTOK * DM || ws_size < WS_END) { fprintf(stderr, "kernel_launch: unexpected shapes (n_in %d, out %d, ws %zu)\n", n_in, out_size, ws_size); grid = -1; return; }
        int dev = 0, cus = 0, per_cu = 0;
        if (hipGetDevice(&dev) != hipSuccess || hipDeviceGetAttribute(&cus, hipDeviceAttributeMultiprocessorCount, dev) != hipSuccess) { grid = -1; return; }
        if (hipFuncSetAttribute((const void*)mega_fwd, hipFuncAttributeMaxDynamicSharedMemorySize, LDS_BYTES) != hipSuccess) { grid = -1; return; }
        if (hipOccupancyMaxActiveBlocksPerMultiprocessor(&per_cu, (const void*)mega_fwd, NTHR, LDS_BYTES) != hipSuccess || per_cu < 1) { fprintf(stderr, "kernel_launch: occupancy query says %d\n", per_cu); grid = -1; (void)hipGetLastError(); return; }
        grid = cus;
    }
    if (grid < 0) return;
    (void)hipMemsetAsync((char*)d_ws + WS_CTL, 0, CTL_ZERO_BYTES, stream);
    Args a{};
    for (int i = 0; i < 30; ++i) a.in[i] = (const float*)d_in[i];
    a.out = (float*)d_out; a.ws = (unsigned char*)d_ws;
#if MK_ONE_LAUNCH
#ifdef PROBE_PHASE
    const int cuts[3] = {0, PROBE_PHASE, NPH};
    for (int li = 0; li < 2; ++li) { a.ph_lo = cuts[li]; a.ph_hi = cuts[li + 1] + ((li == 0) ? PROBE_REPEAT : 0); a.li = li;
        void* kargs[] = {&a};
        hipError_t e = hipLaunchCooperativeKernel((const void*)mega_fwd, dim3(grid), dim3(NTHR), kargs, LDS_BYTES, stream);
        if (e != hipSuccess) fprintf(stderr, "cooperative launch failed: %s\n", hipGetErrorString(e)); }
#else
    a.ph_lo = 0; a.ph_hi = NPH;
    void* kargs[] = {&a};
    hipError_t e = hipLaunchCooperativeKernel((const void*)mega_fwd, dim3(grid), dim3(NTHR), kargs, LDS_BYTES, stream);
    if (e != hipSuccess) fprintf(stderr, "cooperative launch failed: %s\n", hipGetErrorString(e));
#endif
#else
    for (int p = 0; p < NPH; ++p) { a.ph_lo = p; a.ph_hi = p + 1; hipLaunchKernelGGL(mega_fwd, dim3(grid), dim3(NTHR), LDS_BYTES, stream, a); }
#endif
}
```

```cpp
#include <hip/hip_runtime.h>
#include <hip/hip_bf16.h>
#include <cstdio>
#include <cstdint>

constexpr int NWAVES = 8, NTHR = 512;
constexpr int BATCH = 2, SEQ = 4096, DM = 2048, MTOK = BATCH * SEQ;
constexpr int CW = 1024, NHEAD = 16, HD = 64;
constexpr int SHIFTW = 3360, PROJW = 6432, PROJP = 6656;
constexpr int LORA_K = 384, LORA_N = 3072;
constexpr int NEXP = 32, FF = 512;
constexpr int MAXSLOT = 24576;
constexpr float RMS_EPS = 1e-6f, GN_EPS = 64e-5f;
constexpr float LOG2E = 1.4426950408889634f;

constexpr size_t MiB = 1u << 20;
constexpr size_t WS_CTL = 0, CTL_ZERO_BYTES = 1 * MiB;
constexpr size_t WS_MOD = 1 * MiB;
constexpr size_t WS_ROUTE = 1 * MiB + 128 * 1024;
constexpr size_t WS_SW = 1 * MiB + 512 * 1024;
constexpr size_t WS_B36 = 1 * MiB + 96 * 1024;
constexpr size_t WS_RSTD = 1 * MiB + 640 * 1024;
constexpr size_t WS_W36 = 1 * MiB + 704 * 1024;
constexpr size_t WS_WIN = 2 * MiB;
constexpr size_t WS_WOUT = 28 * MiB;
constexpr size_t WS_WL = 36 * MiB;
constexpr size_t WS_WGU = 39 * MiB;
constexpr size_t WS_WD = 167 * MiB;
constexpr size_t B0 = 231 * MiB;
constexpr size_t WS_P = B0;
constexpr size_t WS_PLR = B0 + 96 * MiB;
constexpr size_t HM_PART = (size_t)BATCH * NHEAD * SEQ * HD, HM_BATCH = (size_t)NHEAD * SEQ * HD, HM_HEAD = (size_t)SEQ * HD;
constexpr size_t WS_HB = B0 + 104 * MiB;
constexpr size_t WS_AL = B0 + 136 * MiB;
constexpr size_t WS_LW = B0 + 142 * MiB;
constexpr size_t WS_AA = B0 + 174 * MiB;
constexpr size_t WS_GG = B0 + 190 * MiB;
constexpr size_t WS_R = B0 + 206 * MiB, WS_K2 = B0 + 222 * MiB, WS_V = B0 + 238 * MiB, WS_KK = B0 + 254 * MiB, WS_BB = B0 + 270 * MiB;
constexpr size_t WS_YMIX = B0 + 286 * MiB;
constexpr size_t WS_X1 = B0;
constexpr size_t WS_H2P = B0 + 136 * MiB;
constexpr size_t WS_HG = B0 + 232 * MiB;
constexpr size_t WS_FP = B0 + 136 * MiB;
constexpr size_t WS_HM = B0 + 104 * MiB, WS_Y1 = B0 + 254 * MiB, WS_GT = B0 + 318 * MiB, WS_RH = B0 + 334 * MiB, WS_PLV = B0 + 136 * MiB;
constexpr size_t WS_SF = B0 + 152 * MiB;
constexpr size_t WS_END = B0 + 350 * MiB;
constexpr int CW_CNT = 1024, CW_POS = 1088, CW_NRT = 1152, CW_TE = 1280, CW_BAR = 4096;

constexpr int CW_STAMP = 1200, CW_RDY = 1400;
#ifdef STAMP_ID
#ifndef STAMP_BLOCK
#define STAMP_BLOCK 0
#endif
#define STAMP_BEGIN(id) do { if ((id) == STAMP_ID && blockIdx.x == STAMP_BLOCK && threadIdx.x == 0) st_t0_ = __builtin_amdgcn_s_memrealtime(); } while (0)
#define STAMP_END(id) do { if ((id) == STAMP_ID && blockIdx.x == STAMP_BLOCK && threadIdx.x == 0) atomicAdd((unsigned*)(a.ws + WS_CTL) + CW_STAMP, (unsigned)(__builtin_amdgcn_s_memrealtime() - st_t0_)); } while (0)
#define STAMP_DECL unsigned long long st_t0_ = 0
#else
#define STAMP_BEGIN(id) do { } while (0)
#define STAMP_END(id) do { } while (0)
#define STAMP_DECL do { } while (0)
#endif
constexpr int RING_BYTES = 131072;
constexpr int LDSCTL_OFF = RING_BYTES, MISC_OFF = LDSCTL_OFF + 320;
constexpr int LDS_BYTES = 147456;

#define GAS __attribute__((address_space(1)))
#define LAS __attribute__((address_space(3)))
typedef unsigned short bf16;
typedef unsigned v4u __attribute__((ext_vector_type(4)));
typedef unsigned v2u __attribute__((ext_vector_type(2)));
typedef float f32x4 __attribute__((ext_vector_type(4)));
typedef short bf16x8 __attribute__((ext_vector_type(8)));
typedef short s16x4 __attribute__((ext_vector_type(4)));
typedef GAS unsigned gu32;
typedef GAS unsigned long long gu64;
#define RLX_AGENT __ATOMIC_RELAXED, __HIP_MEMORY_SCOPE_AGENT
#define LDS_WAIT() asm volatile("s_waitcnt lgkmcnt(0)" ::: "memory")
#define VM_WAIT() asm volatile("s_waitcnt vmcnt(0)" ::: "memory")
__device__ __forceinline__ unsigned f2bf(float f) { unsigned u = __builtin_bit_cast(unsigned, f); return (u + 0x7fffu + ((u >> 16) & 1u)) >> 16; }
typedef float f32x2_t __attribute__((ext_vector_type(2)));
typedef __bf16 bf16x2_t __attribute__((ext_vector_type(2)));
__device__ __forceinline__ unsigned pk2(float lo, float hi) { const f32x2_t v = {lo, hi}; return __builtin_bit_cast(unsigned, __builtin_convertvector(v, bf16x2_t)); }
__device__ __forceinline__ float bflo(unsigned u) { return __builtin_bit_cast(float, u << 16); }
__device__ __forceinline__ float bfhi(unsigned u) { return __builtin_bit_cast(float, u & 0xffff0000u); }
__device__ __forceinline__ float wave_sum(float v) {
#pragma unroll
    for (int o = 1; o < 64; o <<= 1) v += __shfl_xor(v, o);
    return v;
}
__device__ __forceinline__ float sigmoid_f(float x) { return 1.f / (1.f + __expf(-x)); }

struct Args { const float* in[30]; float* out; unsigned char* ws; int ph_lo, ph_hi, li, pad; };
enum { I_X = 0, I_C, I_WADA, I_BADA, I_N1G, I_WIN, I_MU, I_W0, I_WDEC, I_A0, I_WAAA, I_WGATEUP, I_KK, I_KA, I_RK, I_LNW, I_LNB, I_RELB, I_BETAR, I_BETAA,
       I_WOUT, I_N2G, I_WGRP, I_BGRP, I_WEXP, I_BEXP, I_WG, I_WU, I_WDN, I_NFG };
constexpr int NPH = 14;

namespace pg8 {
#define PG8_LAS __attribute__((address_space(3)))
typedef unsigned short bf16_t;
typedef short bf16x8 __attribute__((ext_vector_type(8)));
typedef float f32x4 __attribute__((ext_vector_type(4)));
typedef unsigned u32x4 __attribute__((ext_vector_type(4)));
constexpr int BM = 256, BK = 64, HALF = 128, HTB = HALF * BK * 2  , STAGE_BYTES = 8 * HTB, NXCD = 8, WGM = 8;

__host__ __device__ __forceinline__ int lds_byte(int r, int c) { const int st = (r >> 4) * 2 + (c >> 5), rr = r & 15, cc = c & 31, ob = rr * 64 + cc * 2; return st * 1024 + (ob ^ (((ob >> 9) & 1) << 5)); }
__host__ __device__ __forceinline__ void stage_rc(int b, int& R, int& C) { const int st = b / 1024, sb = b % 1024, swz = sb ^ (((sb >> 9) & 1) << 5); R = (st >> 1) * 16 + swz / 64; C = (st & 1) * 32 + (swz % 64) / 2; }
__host__ __device__ __forceinline__ int perm32(int rho) { const int n = rho >> 4, i = rho & 15; return 8 * (i >> 2) + 4 * n + (i & 3); }

struct Unit { int pm, pn; };
struct Gemm { const bf16_t* A; const bf16_t* Bt; int M, N, K; };

struct StaticOrder {
    int nM, nN, nwg, G, c;
    __host__ __device__ void init(int M, int N, int G_, int c_) { nM = M / BM; nN = N / BM; nwg = nM * nN; G = G_; c = c_; }
    __host__ __device__ bool next(int i, Unit& u) const {
        const long L = (long)i * G + c; if (L >= nwg) return false;
        int wgid = (int)L; { const int q = nwg / NXCD, r = nwg % NXCD, xcd = wgid % NXCD, off = wgid / NXCD; wgid = (xcd < r ? xcd * (q + 1) : r * (q + 1) + (xcd - r) * q) + off; }
        const int nig = WGM * nN, gid = wgid / nig, fm = gid * WGM, gsz = (nM - fm) < WGM ? (nM - fm) : WGM;
        u.pm = fm + ((wgid % nig) % gsz); u.pn = (wgid % nig) / gsz; return true;
    }
    __device__ __forceinline__ void a_ready(const Unit&) const {}
    __device__ __forceinline__ void done(const Unit&) const {}
};

__device__ __forceinline__ unsigned cvt_pk_bf16(float lo, float hi) { unsigned r; asm volatile("v_cvt_pk_bf16_f32 %0, %1, %2" : "=v"(r) : "v"(lo), "v"(hi)); return r; }
template <class Epi, class Sched, bool ALIGN_EPI = false, bool SP2 = false>
__device__ __forceinline__ void gemm_phase(PG8_LAS unsigned char* lds, const Gemm g, const Sched& S, const Epi& E) {
    const int tid = threadIdx.x, wid = __builtin_amdgcn_readfirstlane(tid >> 6), lane = tid & 63, wr = wid >> 2, wc = wid & 3, fr = lane & 15, fq = lane >> 4;
    const int K = g.K, nt = K / BK;
    unsigned voffA[2], voffB[2];
#pragma unroll
    for (int i = 0; i < 2; ++i) { int R, C; stage_rc(tid * 16 + i * 8192, R, C); const int Rb = Epi::PERM ? ((R & ~31) + perm32(R & 31)) : R;
        voffA[i] = (unsigned)(R * K + C) * 2u; voffB[i] = (unsigned)(Rb * K + C) * 2u; }
    const size_t kstep = (size_t)(BK * 2);
    const size_t hstep = (size_t)HALF * K * 2;
    const size_t tstep = 2 * hstep;
    const unsigned ldsw = (unsigned)wid * 1024u;
    const int aoff = lds_byte(wr * 64 + fr, fq * 8), boff = lds_byte(wc * 32 + fr, fq * 8);
#define PG8_SA(b, h) (((b) * 2 + (h)) * HTB)
#define PG8_SB(b, h) ((4 + (b) * 2 + (h)) * HTB)
#define PG8_STAGE(bufoff, gbase, voff) do { _Pragma("unroll") for (int _i = 0; _i < 2; ++_i) \
        __builtin_amdgcn_global_load_lds((const unsigned*)((const char*)(gbase) + (voff)[_i]), (PG8_LAS unsigned*)(lds + (bufoff) + ldsw + _i * 8192), 16, 0, 0); } while (0)
#define PG8_LDA(dst, b, h) do { _Pragma("unroll") for (int m = 0; m < 4; ++m) _Pragma("unroll") for (int k = 0; k < 2; ++k) dst[m][k] = *(const PG8_LAS bf16x8*)(lds + PG8_SA(b, h) + aoff + m * 2048 + k * 1024); } while (0)
#define PG8_LDB(dst, b, h) do { _Pragma("unroll") for (int n = 0; n < 2; ++n) _Pragma("unroll") for (int k = 0; k < 2; ++k) dst[n][k] = *(const PG8_LAS bf16x8*)(lds + PG8_SB(b, h) + boff + n * 2048 + k * 1024); } while (0)
#define PG8_MMA(ai, bj, At, Bt) do { __builtin_amdgcn_s_setprio(1); _Pragma("unroll") for (int m = 0; m < 4; ++m) _Pragma("unroll") for (int n = 0; n < 2; ++n) _Pragma("unroll") for (int k = 0; k < 2; ++k) \
        acc[ai][bj][m][n] = __builtin_amdgcn_mfma_f32_16x16x32_bf16(Bt[n][k], At[m][k], acc[ai][bj][m][n], 0, 0, 0); __builtin_amdgcn_s_setprio(0); } while (0)
#define PG8_WAIT_V(n) asm volatile("s_waitcnt vmcnt(" #n ")" ::: "memory")
#define PG8_WAIT_L(n) asm volatile("s_waitcnt lgkmcnt(" #n ")" ::: "memory")
#define PG8_BAR __builtin_amdgcn_s_barrier()
#define PG8_SCHED __builtin_amdgcn_sched_barrier(0)
    Unit cur, nxt; int ui = 0;
    if (!S.next(0, cur)) return;
    f32x4 acc[2][2][4][2];
#pragma unroll
    for (int a = 0; a < 2; ++a)
#pragma unroll
        for (int b = 0; b < 2; ++b)
#pragma unroll
            for (int m = 0; m < 4; ++m)
#pragma unroll
                for (int n = 0; n < 2; ++n) acc[a][b][m][n] = (f32x4){0.f, 0.f, 0.f, 0.f};
    bf16x8 At[4][2], B0[2][2], B1[2][2];
    const char* cA = (const char*)g.A + (size_t)cur.pm * tstep; const char* cB = (const char*)g.Bt + (size_t)cur.pn * tstep;
    S.a_ready(cur);
    if constexpr (SP2) {
        PG8_STAGE(PG8_SB(0, 0), cB, voffB); PG8_STAGE(PG8_SB(0, 1), cB + hstep, voffB); PG8_STAGE(PG8_SA(0, 0), cA, voffA); PG8_STAGE(PG8_SA(0, 1), cA + hstep, voffA);
        if (wr == 1) PG8_BAR;
        PG8_WAIT_V(2); PG8_BAR;
        PG8_STAGE(PG8_SB(1, 0), cB + kstep, voffB); PG8_STAGE(PG8_SA(1, 0), cA + kstep, voffA); PG8_STAGE(PG8_SB(1, 1), cB + hstep + kstep, voffB);
        PG8_WAIT_V(6); PG8_BAR;
    } else {
        PG8_STAGE(PG8_SB(0, 0), cB, voffB); PG8_STAGE(PG8_SA(0, 0), cA, voffA); PG8_STAGE(PG8_SB(0, 1), cB + hstep, voffB); PG8_STAGE(PG8_SA(0, 1), cA + hstep, voffA);
        if (wr == 1) PG8_BAR;
        PG8_WAIT_V(4); PG8_BAR;
        PG8_STAGE(PG8_SB(1, 0), cB + kstep, voffB); PG8_STAGE(PG8_SA(1, 0), cA + kstep, voffA); PG8_STAGE(PG8_SB(1, 1), cB + hstep + kstep, voffB);
        PG8_WAIT_V(6); PG8_BAR;
    }
    for (;;) {
        const bool has_next = S.next(ui + 1, nxt);
        const char* nA = has_next ? (const char*)g.A + (size_t)nxt.pm * tstep : cA; const char* nB = has_next ? (const char*)g.Bt + (size_t)nxt.pn * tstep : cB;
        for (int t = 0; t < nt; t += 2) {
            const bool last = (t == nt - 2);
            const char* a1 = cA + (size_t)(t + 1) * kstep;
            const char* a2 = last ? nA : cA + (size_t)(t + 2) * kstep; const char* b2 = last ? nB : cB + (size_t)(t + 2) * kstep;
            const char* a3 = a2 + kstep; const char* b3 = b2 + kstep;
            if (last && has_next) S.a_ready(nxt);
            if constexpr (SP2) {
            PG8_LDB(B0, 0, 0); PG8_LDB(B1, 0, 1); PG8_SCHED; PG8_LDA(At, 0, 0); PG8_STAGE(PG8_SA(1, 1), a1 + hstep, voffA);
            PG8_WAIT_V(8); PG8_WAIT_L(0); PG8_BAR; PG8_MMA(0, 0, At, B0); PG8_MMA(0, 1, At, B1); PG8_BAR; PG8_SCHED;
            PG8_LDA(At, 0, 1); PG8_STAGE(PG8_SB(0, 0), b2, voffB); PG8_STAGE(PG8_SB(0, 1), b2 + hstep, voffB); PG8_STAGE(PG8_SA(0, 0), a2, voffA);
            PG8_WAIT_V(8); PG8_WAIT_L(0); PG8_BAR; PG8_MMA(1, 0, At, B0); PG8_MMA(1, 1, At, B1); PG8_BAR; PG8_SCHED;
            PG8_LDB(B0, 1, 0); PG8_LDB(B1, 1, 1); PG8_SCHED; PG8_LDA(At, 1, 0); PG8_STAGE(PG8_SA(0, 1), a2 + hstep, voffA);
            PG8_WAIT_V(8); PG8_WAIT_L(0); PG8_BAR; PG8_MMA(0, 0, At, B0); PG8_MMA(0, 1, At, B1); PG8_BAR; PG8_SCHED;
            PG8_LDA(At, 1, 1); PG8_STAGE(PG8_SB(1, 0), b3, voffB); PG8_STAGE(PG8_SB(1, 1), b3 + hstep, voffB); PG8_STAGE(PG8_SA(1, 0), a3, voffA);
            PG8_WAIT_V(8); PG8_WAIT_L(0); PG8_BAR; PG8_MMA(1, 0, At, B0); PG8_MMA(1, 1, At, B1); PG8_BAR; PG8_SCHED;
            } else {
            PG8_LDB(B0, 0, 0); PG8_SCHED; PG8_LDA(At, 0, 0); PG8_STAGE(PG8_SA(1, 1), a1 + hstep, voffA);
            PG8_WAIT_L(8); PG8_BAR; PG8_WAIT_L(0); PG8_MMA(0, 0, At, B0); PG8_BAR; PG8_SCHED;
            PG8_LDB(B1, 0, 1); PG8_STAGE(PG8_SB(0, 0), b2, voffB);
            PG8_BAR; PG8_WAIT_L(0); PG8_MMA(0, 1, At, B1); PG8_BAR;
            PG8_LDA(At, 0, 1); PG8_STAGE(PG8_SA(0, 0), a2, voffA);
            PG8_BAR; PG8_WAIT_L(0); PG8_MMA(1, 0, At, B0); PG8_BAR; PG8_SCHED;
            PG8_STAGE(PG8_SB(0, 1), b2 + hstep, voffB);
            PG8_WAIT_V(6); PG8_BAR; PG8_MMA(1, 1, At, B1); PG8_BAR;
            PG8_LDB(B0, 1, 0); PG8_SCHED; PG8_LDA(At, 1, 0); PG8_STAGE(PG8_SA(0, 1), a2 + hstep, voffA);
            PG8_WAIT_L(8); PG8_BAR; PG8_WAIT_L(0); PG8_MMA(0, 0, At, B0); PG8_BAR; PG8_SCHED;
            PG8_LDB(B1, 1, 1); PG8_STAGE(PG8_SB(1, 0), b3, voffB);
            PG8_BAR; PG8_WAIT_L(0); PG8_MMA(0, 1, At, B1); PG8_BAR;
            PG8_LDA(At, 1, 1); PG8_STAGE(PG8_SA(1, 0), a3, voffA);
            PG8_BAR; PG8_WAIT_L(0); PG8_MMA(1, 0, At, B0); PG8_BAR; PG8_SCHED;
            PG8_STAGE(PG8_SB(1, 1), b3 + hstep, voffB);
            PG8_WAIT_V(6); PG8_BAR; PG8_MMA(1, 1, At, B1); PG8_BAR;
            }
        }
        if constexpr (ALIGN_EPI) { if (wr == 0) PG8_BAR; }
        if constexpr (!Epi::AFTER_DRAIN) { E(acc, cur, wr, wc, fr, fq); S.done(cur); }
        if (!has_next) break;
#pragma unroll
        for (int a = 0; a < 2; ++a)
#pragma unroll
            for (int b = 0; b < 2; ++b)
#pragma unroll
                for (int m = 0; m < 4; ++m)
#pragma unroll
                    for (int n = 0; n < 2; ++n) acc[a][b][m][n] = (f32x4){0.f, 0.f, 0.f, 0.f};
        cur = nxt; cA = nA; cB = nB; ++ui;
        if constexpr (ALIGN_EPI) { if (wr == 1) PG8_BAR; }
    }
    PG8_WAIT_V(0);
    if constexpr (!ALIGN_EPI) { if (wr == 0) PG8_BAR; }
    PG8_BAR;
    if constexpr (Epi::AFTER_DRAIN) { E.fused(acc, cur, wr, wc, fr, fq, lds, wid, lane); S.done(cur); }
#undef PG8_SA
#undef PG8_SB
#undef PG8_STAGE
#undef PG8_LDA
#undef PG8_LDB
#undef PG8_MMA
#undef PG8_WAIT_V
#undef PG8_WAIT_L
#undef PG8_BAR
#undef PG8_SCHED
}
}
#define XB_TMO      128
#define XB_XCNT(j)  (256  + 64 * (j))
#define XB_XSUB(j)  (1280 + 64 * (j))
#define XB_XGEN(j)  (2304 + 64 * (j))
#define XB_TOP      3328
#define XB_TOPGEN   3392
#define XCD_BAR_WORDS 3456
#define XB_SPIN_CAP (1u << 18)

__device__ __forceinline__ unsigned xb_ld(unsigned* p)              { return __hip_atomic_load(p, __ATOMIC_RELAXED, __HIP_MEMORY_SCOPE_AGENT); }
__device__ __forceinline__ unsigned xb_add(unsigned* p, unsigned v) { return __hip_atomic_fetch_add(p, v, __ATOMIC_RELAXED, __HIP_MEMORY_SCOPE_AGENT); }
__device__ __forceinline__ unsigned xb_xcc_id() { return (unsigned)__builtin_amdgcn_s_getreg((3 << 11) | 20) & 0xFu; }
#define XB_SPIN(cond, bar) do { unsigned _sp = 0; while (cond) { __builtin_amdgcn_s_sleep(1); \
    if ((++_sp & 255u) == 0u) { if (xb_ld(&(bar)[XB_TMO])) break; if (_sp > XB_SPIN_CAP) { atomicAdd(&(bar)[XB_TMO], 1u); break; } } } } while (0)

struct XcdBarrier {
    unsigned* bar; unsigned x;
    volatile LAS unsigned* st;
};

__device__ __forceinline__ XcdBarrier xcd_barrier_post(unsigned* bar, volatile LAS unsigned* st) {
    XcdBarrier b; b.bar = bar; b.x = xb_xcc_id(); b.st = st;
    if (threadIdx.x == 0) (void)xb_add(&bar[XB_XCNT(b.x)], 1u);
    return b;
}
__device__ __forceinline__ void xcd_barrier_complete(unsigned* bar, unsigned x, unsigned& nloc, unsigned& nx) {
    const unsigned G = gridDim.x * gridDim.y * gridDim.z;
    unsigned sum, cnt, mine, sp = 0u;
    for (;;) {
        sum = 0u; cnt = 0u; mine = 0u;
#pragma unroll
        for (unsigned j = 0; j < 16; ++j) { const unsigned c = xb_ld(&bar[XB_XCNT(j)]); sum += c; cnt += (c > 0u) ? 1u : 0u; mine = (j == x) ? c : mine; }
        if (sum == G) break;
        __builtin_amdgcn_s_sleep(1);
        if ((++sp & 255u) == 0u) { if (xb_ld(&bar[XB_TMO])) break; if (sp > XB_SPIN_CAP) { atomicAdd(&bar[XB_TMO], 1u); break; } }
    }
    nloc = mine > 0u ? mine : 1u; nx = cnt > 0u ? cnt : 1u;
}

__device__ __forceinline__ void xcd_barrier(const XcdBarrier& b) {
    asm volatile("s_waitcnt vmcnt(0)" ::: "memory");
    __syncthreads();
    if (threadIdx.x == 0) {
        unsigned* bar = b.bar;
        __builtin_amdgcn_s_waitcnt(0);
        unsigned nloc = b.st[0], nx = b.st[1];
        if (nloc == 0u) { xcd_barrier_complete(bar, b.x, nloc, nx); b.st[0] = nloc; b.st[1] = nx; }
        const unsigned old = xb_add(&bar[XB_XSUB(b.x)], 1u);
        const unsigned gen = old / nloc;
        if (old + 1u == (gen + 1u) * nloc) {
            __builtin_amdgcn_fence(__ATOMIC_RELEASE, "agent");
            asm volatile("s_waitcnt vmcnt(0)" ::: "memory");
            const unsigned og = xb_add(&bar[XB_TOP], 1u);
            const unsigned tg = og / nx;
            if (og + 1u == (tg + 1u) * nx) xb_add(&bar[XB_TOPGEN], 1u);
            else XB_SPIN(xb_ld(&bar[XB_TOPGEN]) == tg, bar);
            __builtin_amdgcn_fence(__ATOMIC_ACQUIRE, "agent");
            xb_add(&bar[XB_XGEN(b.x)], 1u);
            asm volatile("s_waitcnt vmcnt(0)" ::: "memory");
        } else {
            XB_SPIN(xb_ld(&bar[XB_XGEN(b.x)]) == gen, bar);
            __builtin_amdgcn_fence(__ATOMIC_ACQUIRE, "agent");
            asm volatile("s_waitcnt vmcnt(0)" ::: "memory");
        }
    }
    __syncthreads();
}

struct EpiStoreBf16 {
    static constexpr bool PERM = true, AFTER_DRAIN = false;
    bf16* O; int ldc; int pn_mask;
    __device__ __forceinline__ void operator()(const pg8::f32x4 (&acc)[2][2][4][2], const pg8::Unit& u, int wr, int wc, int fr_, int fq_) const {
        int t_ = threadIdx.x; asm volatile("" : "+v"(t_)); const int fr = t_ & 15, fq = (t_ >> 4) & 3; (void)fr_; (void)fq_;
        const int row0 = u.pm * 256 + wr * 64 + fr, col0 = (u.pn & pn_mask) * 256 + wc * 32 + 8 * fq;
#pragma unroll
        for (int ai = 0; ai < 2; ++ai)
#pragma unroll
            for (int m = 0; m < 4; ++m) { bf16* rowp = O + (size_t)(row0 + ai * 128 + m * 16) * ldc + col0;
#pragma unroll
                for (int bj = 0; bj < 2; ++bj) { const pg8::f32x4 v0 = acc[ai][bj][m][0], v1 = acc[ai][bj][m][1];
                    v4u w; w.x = pg8::cvt_pk_bf16(v0[0], v0[1]); w.y = pg8::cvt_pk_bf16(v0[2], v0[3]); w.z = pg8::cvt_pk_bf16(v1[0], v1[1]); w.w = pg8::cvt_pk_bf16(v1[2], v1[3]);
                    *(v4u*)(rowp + bj * 128) = w; } }
    }
};
struct EpiProj {
    static constexpr bool PERM = true, AFTER_DRAIN = false;
    bf16* HM; bf16* PLR;
    __device__ __forceinline__ void operator()(const pg8::f32x4 (&acc)[2][2][4][2], const pg8::Unit& u, int wr, int wc, int fr_, int fq_) const {
        int t_ = threadIdx.x; asm volatile("" : "+v"(t_)); const int fr = t_ & 15, fq = (t_ >> 4) & 3; (void)fr_; (void)fq_;
        const int row0 = u.pm * 256 + wr * 64 + fr, colb = u.pn * 256 + wc * 32 + 8 * fq;
#pragma unroll
        for (int bj = 0; bj < 2; ++bj) { const int col0 = colb + bj * 128;
            if (col0 >= PROJW) continue;
            const bool lora = col0 >= 3072 && col0 < SHIFTW;
            const int idx = col0 < 3072 ? col0 : col0 - (SHIFTW - 3072);
            const size_t hbase = (size_t)(idx >> 10) * HM_PART + (size_t)((idx >> 6) & 15) * HM_HEAD + (idx & 63);
#pragma unroll
            for (int ai = 0; ai < 2; ++ai)
#pragma unroll
                for (int m = 0; m < 4; ++m) { const int row = row0 + ai * 128 + m * 16;
                    bf16* dst = lora ? PLR + (size_t)row * 288 + (col0 - 3072) : HM + hbase + (size_t)(row >> 12) * HM_BATCH + (size_t)(row & (SEQ - 1)) * HD;
                    const pg8::f32x4 v0 = acc[ai][bj][m][0], v1 = acc[ai][bj][m][1];
                    v4u w; w.x = pg8::cvt_pk_bf16(v0[0], v0[1]); w.y = pg8::cvt_pk_bf16(v0[2], v0[3]); w.z = pg8::cvt_pk_bf16(v1[0], v1[1]); w.w = pg8::cvt_pk_bf16(v1[2], v1[3]);
                    *(v4u*)dst = w; } }
    }
};
struct EpiGateUp {
    static constexpr bool PERM = true, AFTER_DRAIN = false;
    const float* sw; bf16* HG;
    __device__ __forceinline__ void operator()(const pg8::f32x4 (&acc)[2][2][4][2], const pg8::Unit& u, int wr, int wc, int fr_, int fq_) const {
        int t_ = threadIdx.x; asm volatile("" : "+v"(t_)); const int fr = t_ & 15, fq = (t_ >> 4) & 3; (void)fr_; (void)fq_;
        const int pl = u.pn & 3, row0 = u.pm * 256 + wr * 64 + fr, col0 = pl * 128 + wc * 32 + 8 * fq;
#pragma unroll
        for (int ai = 0; ai < 2; ++ai)
#pragma unroll
            for (int m = 0; m < 4; ++m) { const int row = row0 + ai * 128 + m * 16; const float w = sw[row]; float h[8];
#pragma unroll
                for (int n = 0; n < 2; ++n)
#pragma unroll
                    for (int j = 0; j < 4; ++j) { const float g = acc[ai][0][m][n][j], up = acc[ai][1][m][n][j]; h[4 * n + j] = g * sigmoid_f(g) * up * w; }
                v4u o; o.x = pg8::cvt_pk_bf16(h[0], h[1]); o.y = pg8::cvt_pk_bf16(h[2], h[3]); o.z = pg8::cvt_pk_bf16(h[4], h[5]); o.w = pg8::cvt_pk_bf16(h[6], h[7]);
                *(v4u*)(HG + (size_t)row * FF + col0) = o; }
    }
};
struct EpiResGate {
    static constexpr bool PERM = true, AFTER_DRAIN = false;
    const float* x; const float* gate; float* X1;
    __device__ __forceinline__ void operator()(const pg8::f32x4 (&acc)[2][2][4][2], const pg8::Unit& u, int wr, int wc, int fr_, int fq_) const {
        int t_ = threadIdx.x; asm volatile("" : "+v"(t_)); const int fr = t_ & 15, fq = (t_ >> 4) & 3; (void)fr_; (void)fq_;
        const int row0 = u.pm * 256 + wr * 64 + fr, col0 = u.pn * 256 + wc * 32 + 8 * fq;
        const float* gp = gate + (size_t)((u.pm * 256) >> 12) * 12288;
#pragma unroll
        for (int bj = 0; bj < 2; ++bj) { const int c = col0 + bj * 128; const pg8::f32x4 g0 = *(const pg8::f32x4*)(gp + c), g1 = *(const pg8::f32x4*)(gp + c + 4);
#pragma unroll
            for (int ai = 0; ai < 2; ++ai)
#pragma unroll
                for (int m = 0; m < 4; ++m) { const size_t off = (size_t)(row0 + ai * 128 + m * 16) * DM + c;
                    const pg8::f32x4 x0 = *(const pg8::f32x4*)(x + off), x1 = *(const pg8::f32x4*)(x + off + 4);
                    *(pg8::f32x4*)(X1 + off) = x0 + g0 * acc[ai][bj][m][0]; *(pg8::f32x4*)(X1 + off + 4) = x1 + g1 * acc[ai][bj][m][1]; } }
    }
};
struct EpiLora {
    static constexpr bool PERM = false, AFTER_DRAIN = false;
    float* LW; bf16* AA; bf16* GG;
    __device__ __forceinline__ void operator()(const pg8::f32x4 (&acc)[2][2][4][2], const pg8::Unit& u, int wr, int wc, int fr_, int fq_) const {
        int t_ = threadIdx.x; asm volatile("" : "+v"(t_)); const int fr = t_ & 15, fq = (t_ >> 4) & 3; (void)fr_; (void)fq_;
        const int type = u.pn >> 2, row0 = u.pm * 256 + wr * 64 + fr, col0 = (u.pn & 3) * 256 + wc * 32 + 4 * fq;
        bf16* hb = (type == 1) ? AA : GG;
#pragma unroll
        for (int bj = 0; bj < 2; ++bj)
#pragma unroll
            for (int n = 0; n < 2; ++n) { const int c = col0 + bj * 128 + n * 16;
#pragma unroll
                for (int ai = 0; ai < 2; ++ai)
#pragma unroll
                    for (int m = 0; m < 4; ++m) { const size_t off = (size_t)(row0 + ai * 128 + m * 16) * CW + c; const pg8::f32x4 v = acc[ai][bj][m][n];
                        if (type == 0) *(pg8::f32x4*)(LW + off) = v;
                        else { v2u o; o.x = pg8::cvt_pk_bf16(v[0], v[1]); o.y = pg8::cvt_pk_bf16(v[2], v[3]); *(v2u*)(hb + off) = o; } } }
    }
};
struct GroupOrder {
    const unsigned* te; int nrt, ncol, G, c;
    __device__ __forceinline__ bool next(int i, pg8::Unit& u) const {
        const long L = (long)i * G + c; if (L >= (long)nrt * ncol) return false;
        const int rt = (int)(L / ncol), pl = (int)(L - (long)rt * ncol);
        u.pm = rt; u.pn = (int)te[rt] * ncol + pl; return true;
    }
    __device__ __forceinline__ void a_ready(const pg8::Unit&) const {}
    __device__ __forceinline__ void done(const pg8::Unit&) const {}
};


#define MFMA16(a, b, c) __builtin_amdgcn_mfma_f32_16x16x16bf16_1k(a, b, c, 0, 0, 0)
constexpr int NUNIT = BATCH * NHEAD * (SEQ / 64);
constexpr int LA_GF = 0, LA_SEG = 16384, LA_PL = 18432, LA_RT = 20480, LA_QT = 28672, LA_KT = 36864, LA_BT = 45056, LA_VT = 53248,
              LA_AQB = 61440, LA_AQK = 69632, LA_ARB = 77824, LA_ARK = 86016, LA_DG = 94208, LA_DL = 98304, LA_PRM = 100352;
__device__ __forceinline__ int swz(int row, int chunk) { return row * 128 + ((chunk ^ ((row >> 1) & 7)) << 4); }
__device__ __forceinline__ s16x4 tr_read(LAS unsigned char* base, int r0, int cb, int n) {
    return __builtin_bit_cast(s16x4, __builtin_amdgcn_ds_read_tr16_b64_v4i16((LAS s16x4*)(base + swz(r0 + (n >> 2), 2 * cb + ((n & 3) >> 1)) + 8 * (n & 1)))); }
__device__ __forceinline__ s16x4 row_read4(LAS unsigned char* base, int row, int col0) {
    return *(const LAS s16x4*)(base + swz(row, col0 >> 3) + 2 * (col0 & 7)); }
__device__ __forceinline__ s16x4 pack4(const f32x4 v) { v2u w; w.x = pk2(v[0], v[1]); w.y = pk2(v[2], v[3]); return __builtin_bit_cast(s16x4, w); }
__device__ __forceinline__ s16x4 pack4n(const f32x4 v) { v2u w; w.x = pk2(-v[0], -v[1]); w.y = pk2(-v[2], -v[3]); return __builtin_bit_cast(s16x4, w); }
__device__ __forceinline__ f32x4 unpack4(const s16x4 s) { const v2u w = __builtin_bit_cast(v2u, s); return (f32x4){bflo(w.x), bfhi(w.x), bflo(w.y), bfhi(w.y)}; }

#define LGKM0() do { asm volatile("s_waitcnt lgkmcnt(0)" ::: "memory"); __builtin_amdgcn_sched_barrier(0); } while (0)
#define LDS_BARRIER() do { asm volatile("s_waitcnt lgkmcnt(0)" ::: "memory"); __builtin_amdgcn_s_barrier(); asm volatile("" ::: "memory"); } while (0)
__device__ __forceinline__ void scanA(const Args& a, LAS unsigned char* lds) {
    const int tid = threadIdx.x, lane = tid & 63, wave = __builtin_amdgcn_readfirstlane(tid >> 6), n = lane & 15, g = lane >> 4;
    LAS float* GF = (LAS float*)(lds + LA_GF); LAS float* SEG = (LAS float*)(lds + LA_SEG); LAS float* PLs = (LAS float*)(lds + LA_PL); LAS float* DG = (LAS float*)(lds + LA_DG);
    const int tk = tid >> 3, c8 = 8 * (tid & 7);
    v4u nr4, nk4, nv4, pr4, pk4, pv4, na4; f32x4 nl0, nl1;
#define SCANA_LOAD(U) do { const int bh_ = (U) >> 6, ck_ = (U) & 63, h_ = bh_ & 15; const size_t m_ = (size_t)(bh_ >> 4) * SEQ + 64 * ck_ + tk; \
        const bf16* pc_ = (const bf16*)(a.ws + WS_P) + (size_t)(bh_ >> 4) * HM_BATCH + (size_t)h_ * HM_HEAD + (size_t)(64 * ck_ + tk) * HD + c8; const bf16* pp_ = pc_ - ((64 * ck_ + tk) != 0 ? HD : 0); \
        nr4 = *(const v4u*)pc_; nk4 = *(const v4u*)(pc_ + HM_PART); nv4 = *(const v4u*)(pc_ + 2 * HM_PART); pr4 = *(const v4u*)pp_; pk4 = *(const v4u*)(pp_ + HM_PART); pv4 = *(const v4u*)(pp_ + 2 * HM_PART); \
        const size_t off_ = m_ * CW + h_ * 64 + c8; na4 = *(const v4u*)((const bf16*)(a.ws + WS_AA) + off_); \
        nl0 = *(const f32x4*)((const float*)(a.ws + WS_LW) + off_); nl1 = *(const f32x4*)((const float*)(a.ws + WS_LW) + off_ + 4); } while (0)
#define SCANA_UNIT(IDX) (((((IDX) >> 10) * 16 + ((IDX) & 15)) << 6) + (((IDX) >> 4) & 63))
    if ((int)blockIdx.x < NUNIT) SCANA_LOAD(SCANA_UNIT((int)blockIdx.x));
    STAMP_DECL;
    LAS float* PRM = (LAS float*)(lds + LA_PRM);
    int hcur = -1;
    for (int idx = blockIdx.x; idx < NUNIT; idx += gridDim.x) {
        const int unit = SCANA_UNIT(idx);
        int tid_o = threadIdx.x; asm volatile("" : "+v"(tid_o));
        const int tid = tid_o, lane = tid & 63, n = lane & 15, g = lane >> 4, tk = tid >> 3, c8 = 8 * (tid & 7);
        STAMP_BEGIN(5); STAMP_BEGIN(1);
        const int h = (unit >> 6) & 15, ch0 = h * 64 + c8; const bool first = ((unit & 63) == 0) && (tk == 0);
        if (h != hcur) { hcur = h;
            if (tid < 448) { const int which = tid >> 6, c = tid & 63; const float* src = (which == 0) ? a.in[I_MU] : (which == 1) ? a.in[I_MU] + 1024 : (which == 2) ? a.in[I_MU] + 2048 :
                    (which == 3) ? a.in[I_A0] : (which == 4) ? a.in[I_KK] : (which == 5) ? a.in[I_KA] : a.in[I_W0];
                PRM[tid] = src[h * 64 + c]; }
            LDS_BARRIER(); }
        float pmr[8], pmk[8], pmv[8], pa0[8], pkk[8], pka[8], pw0[8];
        { f32x4 pv[14];
#pragma unroll
          for (int q = 0; q < 7; ++q) { pv[2 * q] = *(const LAS f32x4*)(PRM + 64 * q + c8); pv[2 * q + 1] = *(const LAS f32x4*)(PRM + 64 * q + c8 + 4); }
          LGKM0();
#pragma unroll
          for (int i = 0; i < 8; ++i) { pmr[i] = pv[0 + (i >> 2)][i & 3]; pmk[i] = pv[2 + (i >> 2)][i & 3]; pmv[i] = pv[4 + (i >> 2)][i & 3]; pa0[i] = pv[6 + (i >> 2)][i & 3];
              pkk[i] = pv[8 + (i >> 2)][i & 3]; pka[i] = pv[10 + (i >> 2)][i & 3]; pw0[i] = pv[12 + (i >> 2)][i & 3]; } }
        float rf[8], kf[8], vf8[8], qf8[8], bf8[8]; f32x4 l0, l1;
        { float av[8], kkv[8]; float ssq = 0.f;
#pragma unroll
          for (int i = 0; i < 8; ++i) { const int wd = i >> 1; const bool hi = i & 1;
              const float cr = hi ? bfhi(nr4[wd]) : bflo(nr4[wd]), ckk = hi ? bfhi(nk4[wd]) : bflo(nk4[wd]), cv = hi ? bfhi(nv4[wd]) : bflo(nv4[wd]);
              const float qr = first ? 0.f : (hi ? bfhi(pr4[wd]) : bflo(pr4[wd])), qk = first ? 0.f : (hi ? bfhi(pk4[wd]) : bflo(pk4[wd])), qv = first ? 0.f : (hi ? bfhi(pv4[wd]) : bflo(pv4[wd]));
              rf[i] = cr + (qr - cr) * pmr[i]; kf[i] = ckk + (qk - ckk) * pmk[i]; vf8[i] = cv + (qv - cv) * pmv[i];
              av[i] = sigmoid_f((hi ? bfhi(na4[wd]) : bflo(na4[wd])) + pa0[i]);
              kkv[i] = kf[i] * pkk[i]; ssq += kkv[i] * kkv[i]; }
          ssq += __shfl_xor(ssq, 1); ssq += __shfl_xor(ssq, 2); ssq += __shfl_xor(ssq, 4);
          const float inv = 1.f / fmaxf(sqrtf(ssq), 1e-12f);
#pragma unroll
          for (int i = 0; i < 8; ++i) { qf8[i] = kkv[i] * inv; bf8[i] = qf8[i] * av[i]; kf[i] = kf[i] * (1.f + (av[i] - 1.f) * pka[i]); }
#pragma unroll
          for (int i = 0; i < 4; ++i) { const float z0 = -(nl0[i] + pw0[i]), z1 = -(nl1[i] + pw0[4 + i]);
              const float s0 = fmaxf(z0, 0.f) + __logf(1.f + __expf(-fabsf(z0))), s1 = fmaxf(z1, 0.f) + __logf(1.f + __expf(-fabsf(z1)));
              l0[i] = -__expf(-s0 - 0.5f); l1[i] = -__expf(-s1 - 0.5f); }
          const size_t off = ((size_t)(unit >> 10) * SEQ + 64 * (unit & 63) + tk) * CW + ch0; v4u w;
          w.x = pk2(rf[0], rf[1]); w.y = pk2(rf[2], rf[3]); w.z = pk2(rf[4], rf[5]); w.w = pk2(rf[6], rf[7]); *(v4u*)((bf16*)(a.ws + WS_R) + off) = w;
          w.x = pk2(kf[0], kf[1]); w.y = pk2(kf[2], kf[3]); w.z = pk2(kf[4], kf[5]); w.w = pk2(kf[6], kf[7]); *(v4u*)((bf16*)(a.ws + WS_K2) + off) = w;
          w.x = pk2(vf8[0], vf8[1]); w.y = pk2(vf8[2], vf8[3]); w.z = pk2(vf8[4], vf8[5]); w.w = pk2(vf8[6], vf8[7]); *(v4u*)((bf16*)(a.ws + WS_V) + off) = w; }
        *(LAS f32x4*)(GF + tk * 64 + c8) = l0; *(LAS f32x4*)(GF + tk * 64 + c8 + 4) = l1;
        LDS_BARRIER();
        { const int c = tid & 63, sg = tid >> 6; float gv[8], run = 0.f;
#pragma unroll
          for (int i = 0; i < 8; ++i) gv[i] = GF[(8 * sg + i) * 64 + c];
          LGKM0();
#pragma unroll
          for (int i = 0; i < 8; ++i) { run += gv[i]; GF[(8 * sg + i) * 64 + c] = run; }
          SEG[sg * 64 + c] = run; }
        LDS_BARRIER();
        { const int sg = tk >> 3; float gg[8], lw[8];
          f32x4 gq[2], sq[7][2];
          gq[0] = *(const LAS f32x4*)(GF + tk * 64 + c8); gq[1] = *(const LAS f32x4*)(GF + tk * 64 + c8 + 4);
#pragma unroll
          for (int s2 = 0; s2 < 7; ++s2) { sq[s2][0] = *(const LAS f32x4*)(SEG + s2 * 64 + c8); sq[s2][1] = *(const LAS f32x4*)(SEG + s2 * 64 + c8 + 4); }
          LGKM0();
#pragma unroll
          for (int i = 0; i < 8; ++i) { float x = gq[i >> 2][i & 3];
#pragma unroll
              for (int s2 = 0; s2 < 7; ++s2) x += (s2 < sg) ? sq[s2][i >> 2][i & 3] : 0.f;
              gg[i] = x; lw[i] = (i < 4) ? l0[i] : l1[i - 4]; }
          float rr[8], qq[8], kk[8], bb[8];
#pragma unroll
          for (int i = 0; i < 4; ++i) { const int e0 = 2 * i, e1 = 2 * i + 1;
              const float eg0 = __expf(gg[e0]), eg1 = __expf(gg[e1]), en0 = __expf(-gg[e0]), en1 = __expf(-gg[e1]), em0 = __expf(gg[e0] - lw[e0]), em1 = __expf(gg[e1] - lw[e1]);
              rr[e0] = rf[e0] * eg0; rr[e1] = rf[e1] * eg1; qq[e0] = qf8[e0] * em0; qq[e1] = qf8[e1] * em1;
              kk[e0] = kf[e0] * en0; kk[e1] = kf[e1] * en1; bb[e0] = bf8[e0] * en0; bb[e1] = bf8[e1] * en1;
              if (tk == 63) { PLs[c8 + e0] = eg0; PLs[c8 + e1] = eg1; } }
          const int so = swz(tk, tid & 7); v4u w;
          w.x = pk2(rr[0], rr[1]); w.y = pk2(rr[2], rr[3]); w.z = pk2(rr[4], rr[5]); w.w = pk2(rr[6], rr[7]); *(LAS v4u*)(lds + LA_RT + so) = w;
          w.x = pk2(qq[0], qq[1]); w.y = pk2(qq[2], qq[3]); w.z = pk2(qq[4], qq[5]); w.w = pk2(qq[6], qq[7]); *(LAS v4u*)(lds + LA_QT + so) = w;
          w.x = pk2(kk[0], kk[1]); w.y = pk2(kk[2], kk[3]); w.z = pk2(kk[4], kk[5]); w.w = pk2(kk[6], kk[7]); *(LAS v4u*)(lds + LA_KT + so) = w;
          w.x = pk2(bb[0], bb[1]); w.y = pk2(bb[2], bb[3]); w.z = pk2(bb[4], bb[5]); w.w = pk2(bb[6], bb[7]); *(LAS v4u*)(lds + LA_BT + so) = w;
          w.x = pk2(vf8[0], vf8[1]); w.y = pk2(vf8[2], vf8[3]); w.z = pk2(vf8[4], vf8[5]); w.w = pk2(vf8[6], vf8[7]); *(LAS v4u*)(lds + LA_VT + so) = w; }
        LDS_BARRIER();
        STAMP_END(1); STAMP_BEGIN(2);
        if (idx + (int)gridDim.x < NUNIT) SCANA_LOAD(SCANA_UNIT(idx + (int)gridDim.x));
        for (int id = wave; id < 40; id += NWAVES) {
            const int mat = id / 10, p = id - mat * 10, tb = p < 1 ? 0 : (p < 3 ? 1 : (p < 6 ? 2 : 3)), sb = p - tb * (tb + 1) / 2;
            LAS unsigned char* Lft = lds + ((mat & 1) ? LA_KT : LA_BT); LAS unsigned char* Rgt = lds + ((mat & 2) ? LA_RT : LA_QT);
            f32x4 acc = (f32x4){0.f, 0.f, 0.f, 0.f};
#pragma unroll
            for (int ks = 0; ks < 2; ++ks) { const bf16x8 af = *(const LAS bf16x8*)(Lft + swz(16 * sb + n, 4 * ks + g)), bfr = *(const LAS bf16x8*)(Rgt + swz(16 * tb + n, 4 * ks + g));
                acc = __builtin_amdgcn_mfma_f32_16x16x32_bf16(af, bfr, acc, 0, 0, 0); }
            const int t = 16 * tb + n, s0 = 16 * sb + 4 * g;
#pragma unroll
            for (int j = 0; j < 4; ++j) { const bool keep = (mat & 2) ? (s0 + j <= t) : (s0 + j < t); if (!keep) acc[j] = 0.f; }
            LAS unsigned char* dst = lds + (mat == 0 ? LA_AQB : (mat == 1 ? LA_AQK : (mat == 2 ? LA_ARB : LA_ARK)));
            v2u w; w.x = pk2(acc[0], acc[1]); w.y = pk2(acc[2], acc[3]);
            *(LAS v2u*)(dst + swz(t, s0 >> 3) + 2 * (s0 & 7)) = w;
            if (mat == 0 && sb == tb) *(LAS f32x4*)(DG + tb * 256 + n * 16 + 4 * g) = acc;
        }
        LDS_BARRIER();
        STAMP_END(2); STAMP_BEGIN(3);
        const bool isU = wave >= 4; const int cb = wave & 3;
        LAS unsigned char* AQB = lds + LA_AQB; LAS unsigned char* AQK = lds + LA_AQK; LAS unsigned char* ARB = lds + LA_ARB; LAS unsigned char* ARK = lds + LA_ARK;
        s16x4 vf[4], xn[4], fqb[6], frb[10], fbt[16];
        f32x4 rhs[4], y1a[4], hma[4], rti[4];
        if (isU) {
            s16x4 fqk[10], frk[10], fkt[16];
#pragma unroll
            for (int k = 0; k < 4; ++k) vf[k] = tr_read(lds + LA_VT, 16 * k + 4 * g, cb, n);
#pragma unroll
            for (int i = 0; i < 4; ++i)
#pragma unroll
                for (int k = 0; k < 4; ++k) { if (k <= i) { fqk[i * (i + 1) / 2 + k] = row_read4(AQK, 16 * i + n, 16 * k + 4 * g); frk[i * (i + 1) / 2 + k] = row_read4(ARK, 16 * i + n, 16 * k + 4 * g); }
                    fkt[4 * i + k] = tr_read(lds + LA_KT, 16 * k + 4 * g, i, n); }
            LGKM0();
#pragma unroll
            for (int i = 0; i < 4; ++i) { f32x4 acc = (f32x4){0.f, 0.f, 0.f, 0.f}, ac2 = acc, ac3 = acc;
#pragma unroll
                for (int k = 0; k < 4; ++k) { if (k <= i) { acc = MFMA16(fqk[i * (i + 1) / 2 + k], vf[k], acc); ac2 = MFMA16(frk[i * (i + 1) / 2 + k], vf[k], ac2); }
                    ac3 = MFMA16(vf[k], fkt[4 * i + k], ac3); }
                rhs[i] = acc; y1a[i] = ac2; hma[i] = ac3; rti[i] = acc; }
        } else {
            if (lane < 16) {
                const LAS float* A = DG + wave * 256; float x[16]; f32x4 ar[16][4];
                int lj = lane; asm volatile("" : "+v"(lj));
                x[0] = (lj == 0) ? 1.f : 0.f;
#pragma unroll
                for (int t = 1; t < 9; ++t)
#pragma unroll
                    for (int q = 0; q < 4; ++q) if (4 * q < t) ar[t][q] = *(const LAS f32x4*)(A + t * 16 + 4 * q);
                LGKM0();
#pragma unroll
                for (int t = 1; t < 9; ++t) { float a0 = (t == lj) ? 1.f : 0.f, a1 = 0.f;
#pragma unroll
                    for (int s2 = 0; s2 < t; ++s2) { if (s2 & 1) a1 -= ar[t][s2 >> 2][s2 & 3] * x[s2]; else a0 -= ar[t][s2 >> 2][s2 & 3] * x[s2]; }
                    x[t] = a0 + a1; }
#pragma unroll
                for (int t = 9; t < 13; ++t)
#pragma unroll
                    for (int q = 0; q < 4; ++q) if (4 * q < t) ar[t][q] = *(const LAS f32x4*)(A + t * 16 + 4 * q);
                LGKM0();
#pragma unroll
                for (int t = 9; t < 13; ++t) { float a0 = (t == lj) ? 1.f : 0.f, a1 = 0.f;
#pragma unroll
                    for (int s2 = 0; s2 < t; ++s2) { if (s2 & 1) a1 -= ar[t][s2 >> 2][s2 & 3] * x[s2]; else a0 -= ar[t][s2 >> 2][s2 & 3] * x[s2]; }
                    x[t] = a0 + a1; }
#pragma unroll
                for (int t = 13; t < 16; ++t)
#pragma unroll
                    for (int q = 0; q < 4; ++q) if (4 * q < t) ar[t][q] = *(const LAS f32x4*)(A + t * 16 + 4 * q);
                LGKM0();
#pragma unroll
                for (int t = 13; t < 16; ++t) { float a0 = (t == lj) ? 1.f : 0.f, a1 = 0.f;
#pragma unroll
                    for (int s2 = 0; s2 < t; ++s2) { if (s2 & 1) a1 -= ar[t][s2 >> 2][s2 & 3] * x[s2]; else a0 -= ar[t][s2 >> 2][s2 & 3] * x[s2]; }
                    x[t] = a0 + a1; }
                LAS bf16* D = (LAS bf16*)(lds + LA_DL) + wave * 256;
#pragma unroll
                for (int t = 0; t < 16; ++t) D[t * 16 + lane] = (bf16)f2bf(x[t]);
            }
#pragma unroll
            for (int i = 0; i < 4; ++i) { rhs[i] = unpack4(tr_read(lds + LA_QT, 16 * i + 4 * g, cb, n)); rti[i] = unpack4(tr_read(lds + LA_RT, 16 * i + 4 * g, cb, n)); vf[i] = (s16x4){0, 0, 0, 0}; y1a[i] = (f32x4){0.f, 0.f, 0.f, 0.f}; hma[i] = y1a[i]; }
        }
#pragma unroll
        for (int i = 0; i < 4; ++i)
#pragma unroll
            for (int k = 0; k < 4; ++k) { if (k < i) fqb[i * (i - 1) / 2 + k] = row_read4(AQB, 16 * i + n, 16 * k + 4 * g); if (k <= i) frb[i * (i + 1) / 2 + k] = row_read4(ARB, 16 * i + n, 16 * k + 4 * g);
                fbt[4 * i + k] = tr_read(lds + LA_BT, 16 * k + 4 * g, i, n); }
        LDS_BARRIER();
        STAMP_END(3); STAMP_BEGIN(4);
        {
            s16x4 df[4];
#pragma unroll
            for (int i = 0; i < 4; ++i) df[i] = *(const LAS s16x4*)(lds + LA_DL + i * 512 + n * 32 + 8 * g);
            const float plv[4] = {PLs[n], PLs[16 + n], PLs[32 + n], PLs[48 + n]};
            LGKM0();
#pragma unroll
            for (int i = 0; i < 4; ++i) { f32x4 acc = rhs[i];
#pragma unroll
                for (int k = 0; k < 4; ++k) if (k < i) acc = MFMA16(fqb[i * (i - 1) / 2 + k], xn[k], acc);
                const f32x4 xi = MFMA16(df[i], pack4(acc), ((f32x4){0.f, 0.f, 0.f, 0.f}));
                xn[i] = pack4n(xi); }
            if (!isU) {
                bf16* RH = (bf16*)(a.ws + WS_RH) + (size_t)unit * 4096;
#pragma unroll
                for (int i = 0; i < 4; ++i) { f32x4 acc = rti[i];
#pragma unroll
                    for (int k = 0; k < 4; ++k) if (k <= i) acc = MFMA16(frb[i * (i + 1) / 2 + k], xn[k], acc);
#pragma unroll
                    for (int j = 0; j < 4; ++j) RH[(16 * i + 4 * g + j) * 64 + 16 * cb + n] = (bf16)f2bf(acc[j]); }
                bf16* GT = (bf16*)(a.ws + WS_GT) + (size_t)unit * 4096;
#pragma unroll
                for (int c2b = 0; c2b < 4; ++c2b) { f32x4 acc = (f32x4){0.f, 0.f, 0.f, 0.f};
#pragma unroll
                    for (int k = 0; k < 4; ++k) acc = MFMA16(xn[k], fbt[4 * c2b + k], acc);
                    acc *= plv[c2b]; *(v2u*)(GT + (16 * c2b + n) * 64 + 16 * cb + 4 * g) = __builtin_bit_cast(v2u, pack4(acc)); }
            } else {
                float* Y1 = (float*)(a.ws + WS_Y1) + (size_t)unit * 4096;
#pragma unroll
                for (int i = 0; i < 4; ++i) { f32x4 acc = y1a[i];
#pragma unroll
                    for (int k = 0; k < 4; ++k) if (k <= i) acc = MFMA16(frb[i * (i + 1) / 2 + k], xn[k], acc);
#pragma unroll
                    for (int j = 0; j < 4; ++j) Y1[(16 * i + 4 * g + j) * 64 + 16 * cb + n] = acc[j]; }
                float* HM = (float*)(a.ws + WS_HM) + (size_t)unit * 4096;
#pragma unroll
                for (int c2b = 0; c2b < 4; ++c2b) { f32x4 acc = hma[c2b];
#pragma unroll
                    for (int k = 0; k < 4; ++k) acc = MFMA16(xn[k], fbt[4 * c2b + k], acc);
#pragma unroll
                    for (int j = 0; j < 4; ++j) HM[(16 * cb + 4 * g + j) * 64 + 16 * c2b + n] = acc[j] * plv[c2b]; }
            }
            if (wave == 0) ((float*)(a.ws + WS_PLV))[(size_t)unit * 64 + lane] = PLs[lane];
        }
        LDS_BARRIER();
        STAMP_END(4); STAMP_END(5);
    }
}

constexpr int LB_SLOT = 13312, LB_NPIECE = 13, LB_PER_WAVE = 4, LB_NSLOT = 8, LB_DIST = 7;
__device__ __forceinline__ void chainB_issue(const Args& a, LAS unsigned char* lds, size_t unit, int vb, int step, int lw, int lane) {
    const unsigned char* gt = a.ws + WS_GT + unit * 8192; const unsigned char* hm = a.ws + WS_HM + unit * 16384 + vb * 4096; const unsigned char* pv = a.ws + WS_PLV + unit * 256;
#pragma unroll
    for (int i = 0; i < LB_PER_WAVE; ++i) { int p = lw + 4 * i; p = p < LB_NPIECE - 1 ? p : LB_NPIECE - 1;
        const unsigned char* src = (p < 8) ? gt + p * 1024 : ((p < 12) ? hm + (p - 8) * 1024 : pv);
        __builtin_amdgcn_global_load_lds((const unsigned*)(src + lane * 16), (LAS unsigned*)(lds + (step & (LB_NSLOT - 1)) * LB_SLOT + p * 1024), 16, 0, 0); }
}
struct ChainOps { s16x4 gf[4][4]; f32x4 hm[4], pl[4]; };
__device__ __forceinline__ void chainB_read(ChainOps& o, LAS unsigned char* sl, int n, int g) {
#pragma unroll
    for (int i = 0; i < 4; ++i) { o.hm[i] = *(const LAS f32x4*)(sl + 8192 + (n * 64 + 16 * i + 4 * g) * 4); o.pl[i] = *(const LAS f32x4*)(sl + 12288 + (16 * i + 4 * g) * 4);
#pragma unroll
        for (int k = 0; k < 4; ++k) o.gf[i][k] = *(const LAS s16x4*)(sl + (16 * i + n) * 128 + (16 * k + 4 * g) * 2); }
}
__device__ __forceinline__ void chainB_step(const ChainOps& o, f32x4 (&acc)[4], v2u* SF) {
    s16x4 sb[4]; f32x4 nx[4];
#pragma unroll
    for (int k = 0; k < 4; ++k) { sb[k] = pack4(acc[k]); SF[k * 64] = __builtin_bit_cast(v2u, sb[k]); }
#pragma unroll
    for (int i = 0; i < 4; ++i) nx[i] = o.pl[i] * acc[i] + o.hm[i];
#pragma unroll
    for (int k = 0; k < 4; ++k)
#pragma unroll
        for (int i = 0; i < 4; ++i) nx[i] = MFMA16(o.gf[i][k], sb[k], nx[i]);
#pragma unroll
    for (int i = 0; i < 4; ++i) acc[i] = nx[i];
}
__device__ __forceinline__ void scanB(const Args& a, LAS unsigned char* lds) {
    const int tid = threadIdx.x, lane = tid & 63, wave = __builtin_amdgcn_readfirstlane(tid >> 6), n = lane & 15, g = lane >> 4;
    constexpr int NCK = SEQ / 64;
    for (int item = blockIdx.x; item < BATCH * NHEAD * 4; item += gridDim.x) {
        const int bh = item >> 2, vb = item & 3;
        const size_t u0 = (size_t)bh * 64;
        f32x4 acc[4];
#pragma unroll
        for (int i = 0; i < 4; ++i) acc[i] = (f32x4){0.f, 0.f, 0.f, 0.f};
        if (wave >= 4) {
#pragma unroll
            for (int s = 0; s < LB_DIST; ++s) chainB_issue(a, lds, u0 + s, vb, s, wave - 4, lane);
            asm volatile("s_waitcnt vmcnt(20)" ::: "memory"); }
        __builtin_amdgcn_s_barrier(); asm volatile("" ::: "memory");
        if (wave >= 4) {
            for (int ck = 0; ck < NCK; ++ck) {
                if (ck + LB_DIST < NCK) { chainB_issue(a, lds, u0 + ck + LB_DIST, vb, ck + LB_DIST, wave - 4, lane); asm volatile("s_waitcnt vmcnt(20)" ::: "memory"); }
                else asm volatile("s_waitcnt vmcnt(0)" ::: "memory");
                __builtin_amdgcn_s_barrier(); asm volatile("" ::: "memory");
            }
        } else if (wave == 0) {
            v2u* SF = (v2u*)(a.ws + WS_SF) + (u0 * 16 + vb * 4) * 64 + lane;
            ChainOps A, B;
            chainB_read(A, lds, n, g);
            for (int ck = 0; ck < NCK; ck += 2) {
                chainB_read(B, lds + ((ck + 1) & (LB_NSLOT - 1)) * LB_SLOT, n, g);
                chainB_step(A, acc, SF + (size_t)ck * 16 * 64);
                __builtin_amdgcn_s_barrier(); asm volatile("" ::: "memory");
                if (ck + 2 < NCK) chainB_read(A, lds + ((ck + 2) & (LB_NSLOT - 1)) * LB_SLOT, n, g);
                chainB_step(B, acc, SF + (size_t)(ck + 1) * 16 * 64);
                __builtin_amdgcn_s_barrier(); asm volatile("" ::: "memory");
            }
        } else {
            for (int ck = 0; ck < NCK; ++ck) { __builtin_amdgcn_s_barrier(); asm volatile("" ::: "memory"); }
        }
    }
}

__device__ __forceinline__ void scanC(const Args& a) {
    const int tid = threadIdx.x, lane = tid & 63, wave = tid >> 6, n = lane & 15, g = lane >> 4;
    const int gw = blockIdx.x * NWAVES + wave, NGW = gridDim.x * NWAVES;
    for (int task = gw; task < NUNIT * 4; task += NGW) {
        const int unit = task >> 2, i = task & 3, bh = unit >> 6, ck = unit & 63, b = bh >> 4, h = bh & 15;
        const v2u* SF = (const v2u*)(a.ws + WS_SF) + (size_t)unit * 16 * 64 + lane;
        const bf16* RH = (const bf16*)(a.ws + WS_RH) + (size_t)unit * 4096; const float* Y1 = (const float*)(a.ws + WS_Y1) + (size_t)unit * 4096;
        s16x4 rf[4]; f32x4 acc[4];
        const size_t m = (size_t)b * SEQ + 64 * ck + 16 * i + n;
        s16x4 rq[4], kq[4], vq[4], gq[4];
#pragma unroll
        for (int vb = 0; vb < 4; ++vb) { const size_t o = m * CW + h * 64 + 16 * vb + 4 * g;
            rq[vb] = *(const s16x4*)((const bf16*)(a.ws + WS_R) + o); kq[vb] = *(const s16x4*)((const bf16*)(a.ws + WS_K2) + o);
            vq[vb] = *(const s16x4*)((const bf16*)(a.ws + WS_V) + o); gq[vb] = *(const s16x4*)((const bf16*)(a.ws + WS_GG) + o); }
#pragma unroll
        for (int k = 0; k < 4; ++k) rf[k] = *(const s16x4*)(RH + (16 * i + n) * 64 + 16 * k + 4 * g);
#pragma unroll
        for (int vb = 0; vb < 4; ++vb) { acc[vb] = *(const f32x4*)(Y1 + (16 * i + n) * 64 + 16 * vb + 4 * g);
#pragma unroll
            for (int k = 0; k < 4; ++k) acc[vb] = MFMA16(__builtin_bit_cast(s16x4, SF[(vb * 4 + k) * 64]), rf[k], acc[vb]); }
        float s1 = 0.f;
#pragma unroll
        for (int vb = 0; vb < 4; ++vb) s1 += (acc[vb][0] + acc[vb][1]) + (acc[vb][2] + acc[vb][3]);
        s1 += __shfl_xor(s1, 16); s1 += __shfl_xor(s1, 32);
        const float mean = s1 * (1.f / 64.f); float s2 = 0.f;
#pragma unroll
        for (int vb = 0; vb < 4; ++vb)
#pragma unroll
            for (int j = 0; j < 4; ++j) { const float d = acc[vb][j] - mean; s2 += d * d; }
        s2 += __shfl_xor(s2, 16); s2 += __shfl_xor(s2, 32);
        const float rstd = 1.f / sqrtf(s2 * (1.f / 64.f) + GN_EPS);
        f32x4 rv[4], kv[4], vv[4], gv[4]; float dot = 0.f;
#pragma unroll
        for (int vb = 0; vb < 4; ++vb) { rv[vb] = unpack4(rq[vb]); kv[vb] = unpack4(kq[vb]); vv[vb] = unpack4(vq[vb]); gv[vb] = unpack4(gq[vb]);
            const f32x4 rk = *(const f32x4*)(a.in[I_RK] + h * 64 + 16 * vb + 4 * g);
#pragma unroll
            for (int j = 0; j < 4; ++j) dot += rv[vb][j] * kv[vb][j] * rk[j]; }
        dot += __shfl_xor(dot, 16); dot += __shfl_xor(dot, 32);
#pragma unroll
        for (int vb = 0; vb < 4; ++vb) { const int c = h * 64 + 16 * vb + 4 * g;
            const f32x4 lw = *(const f32x4*)(a.in[I_LNW] + c), lb = *(const f32x4*)(a.in[I_LNB] + c), be = *(const f32x4*)(a.in[I_BETAR] + c);
            const f32x4 o = ((acc[vb] - mean) * rstd * lw + lb + dot * vv[vb]) * gv[vb] * be;
            *(v2u*)((bf16*)(a.ws + WS_YMIX) + m * DM + c) = __builtin_bit_cast(v2u, pack4(o)); }
    }
}

struct ConvItem { const float* W; bf16* WT; int N, ldd, k0, n0; size_t drow0; };
__device__ __forceinline__ ConvItem conv_decode(const Args& a, int r) {
    constexpr int NI_IN = 32 * 201, NI_OUT = 32 * 64, NI_E = 32 * 512;
    ConvItem c; unsigned char* ws = a.ws;
    if (r < NI_IN) { const int kb = r / 201, nb = r - kb * 201; c.W = a.in[I_WIN]; c.N = PROJW; c.WT = (bf16*)(ws + WS_WIN); c.drow0 = (size_t)(32 * nb); c.ldd = DM; c.k0 = 64 * kb; c.n0 = 32 * nb; return c; } r -= NI_IN;
    if (r < NI_OUT) { const int kb = r >> 6, nb = r & 63; c.W = a.in[I_WOUT]; c.N = DM; c.WT = (bf16*)(ws + WS_WOUT); c.drow0 = (size_t)(32 * nb); c.ldd = DM; c.k0 = 64 * kb; c.n0 = 32 * nb; return c; } r -= NI_OUT;
    if (r < 2 * NI_E) { const int up = r >= NI_E; if (up) r -= NI_E; const int e = r >> 9, q = r & 511, kb = q >> 4, nb = q & 15, n0 = 32 * nb;
        c.W = a.in[up ? I_WU : I_WG] + (size_t)e * DM * FF; c.N = FF; c.WT = (bf16*)(ws + WS_WGU); c.drow0 = (size_t)e * 1024 + 256 * (n0 >> 7) + (n0 & 127) + (up ? 128 : 0); c.ldd = DM; c.k0 = 64 * kb; c.n0 = n0; return c; } r -= 2 * NI_E;
    { const int e = r >> 9, q = r & 511, kb = q >> 6, nb = q & 63;
        c.W = a.in[I_WDN] + (size_t)e * FF * DM; c.N = DM; c.WT = (bf16*)(ws + WS_WD); c.drow0 = (size_t)e * DM + 32 * nb; c.ldd = FF; c.k0 = 64 * kb; c.n0 = 32 * nb; return c; }
}
__device__ __forceinline__ void conv_load(const ConvItem& c, int lane, float (&v)[32]) {
    const float* p = c.W + (size_t)(c.k0 + (lane >> 5)) * c.N + c.n0 + (lane & 31);
#pragma unroll
    for (int i = 0; i < 32; ++i) v[i] = p[(size_t)(2 * i) * c.N];
}
__device__ __forceinline__ void conv_finish(const ConvItem& c, const float (&v)[32], LAS float* scr, int lane) {
#pragma unroll
    for (int i = 0; i < 32; ++i) { const int kk = 2 * i + (lane >> 5); scr[kk * 33 + (lane & 31)] = v[i]; }
    LDS_WAIT(); asm volatile("" ::: "memory");
    const int cc = lane & 7;
#pragma unroll
    for (int j = 0; j < 4; ++j) { const int n = (lane >> 3) + 8 * j; const LAS float* s = scr + (8 * cc) * 33 + n;
        v4u o; o.x = pk2(s[0 * 33], s[1 * 33]); o.y = pk2(s[2 * 33], s[3 * 33]); o.z = pk2(s[4 * 33], s[5 * 33]); o.w = pk2(s[6 * 33], s[7 * 33]);
        *(v4u*)(c.WT + (c.drow0 + n) * (size_t)c.ldd + c.k0 + 8 * cc) = o; }
    LDS_WAIT(); asm volatile("" ::: "memory");
}
__device__ __forceinline__ void phase0(const Args& a, LAS unsigned char* lds) {
    const int tid = threadIdx.x, lane = tid & 63, wave = __builtin_amdgcn_readfirstlane(tid >> 6), G = gridDim.x, bid = blockIdx.x;
    unsigned char* ws = a.ws;
    LAS float* cact = (LAS float*)lds;
    LAS float* red = (LAS float*)(lds + 16384);
    LAS float* scr = (LAS float*)(lds + 32768 + wave * 8448);
    if (bid < 192 || G < 192) {
        const float* c = a.in[I_C];
        for (int i = tid; i < 2 * DM; i += NTHR) { const float x = c[i]; cact[i] = x / (1.f + __expf(-x)); }
        __syncthreads();
        for (int item = bid; item < 192; item += G) {
            const int ro = lane >> 4, cq = lane & 15;
            const float* wp = a.in[I_WADA] + (size_t)(256 * wave + ro) * 12288 + 64 * item + 4 * cq;
            f32x4 acc0 = (f32x4){0.f, 0.f, 0.f, 0.f}, acc1 = acc0;
#pragma unroll 8
            for (int i = 0; i < 64; ++i) { const f32x4 wv = *(const f32x4*)(wp + (size_t)(4 * i) * 12288);
                const float c0 = cact[256 * wave + 4 * i + ro], c1 = cact[DM + 256 * wave + 4 * i + ro]; acc0 += c0 * wv; acc1 += c1 * wv; }
#pragma unroll
            for (int j = 0; j < 4; ++j) { float v0 = acc0[j], v1 = acc1[j]; v0 += __shfl_xor(v0, 16); v0 += __shfl_xor(v0, 32); v1 += __shfl_xor(v1, 16); v1 += __shfl_xor(v1, 32);
                if (ro == 0) { red[(wave * 2 + 0) * 64 + 4 * cq + j] = v0; red[(wave * 2 + 1) * 64 + 4 * cq + j] = v1; } }
            __syncthreads();
            if (tid < 128) { const int b = tid >> 6, cc = tid & 63; float s = a.in[I_BADA][64 * item + cc];
#pragma unroll
                for (int w2 = 0; w2 < 8; ++w2) s += red[(w2 * 2 + b) * 64 + cc];
                ((float*)(ws + WS_MOD))[b * 12288 + 64 * item + cc] = s; }
            __syncthreads();
        }
    }
    constexpr int NCONV = 32 * 201 + 32 * 64 + 3 * 32 * 512, NPRE = 4;
    const int gw = bid * NWAVES + wave, NGW = G * NWAVES;
    const bool pre = (G == 256), mine = pre && bid >= 192;
    const int pool0 = pre ? 64 * NWAVES * NPRE : 0;
    auto item_of = [&](int j) -> int { if (mine) { if (j < NPRE) return (bid - 192) * NWAVES + wave + 64 * NWAVES * j; j -= NPRE; } return pool0 + gw + NGW * j; };
    { float va[32], vb[32]; ConvItem ca, cb; int j = 0; int ia = item_of(0);
      if (ia < NCONV) { ca = conv_decode(a, ia); conv_load(ca, lane, va); }
      while (ia < NCONV) {
          const int ib = item_of(j + 1);
          if (ib < NCONV) { cb = conv_decode(a, ib); conv_load(cb, lane, vb); }
          conv_finish(ca, va, scr, lane);
          if (ib >= NCONV) break;
          const int ic = item_of(j + 2);
          if (ic < NCONV) { ca = conv_decode(a, ic); conv_load(ca, lane, va); }
          conv_finish(cb, vb, scr, lane);
          ia = ic; j += 2; } }
    const int gt = bid * NTHR + tid, NGT = G * NTHR;
    bf16* wl = (bf16*)(ws + WS_WL);
    for (int idx = gt; idx < LORA_N * LORA_K; idx += NGT) { const int n = idx / LORA_K, k = idx - n * LORA_K; float v = 0.f;
        if (n < 1024) { if (k < 64) v = a.in[I_WDEC][k * 1024 + n]; }
        else if (n < 2048) { if (k >= 64 && k < 128) v = a.in[I_WAAA][(k - 64) * 1024 + (n - 1024)]; }
        else { if (k >= 128 && k < 288) v = a.in[I_WGATEUP][(k - 128) * 1024 + (n - 2048)]; }
        wl[idx] = (bf16)f2bf(v); }
    float* w36 = (float*)(ws + WS_W36);
    for (int idx = gt; idx < DM * 36; idx += NGT) { const int e = idx >> 11, dd = idx & (DM - 1);
        w36[idx] = (e < 4) ? a.in[I_WGRP][dd * 4 + e] : a.in[I_WEXP][((size_t)((e - 4) >> 3) * DM + dd) * 8 + ((e - 4) & 7)]; }
    v4u* wz = (v4u*)(ws + WS_WIN + (size_t)PROJW * DM * 2);
    for (int idx = gt; idx < (PROJP - PROJW) * DM / 8; idx += NGT) wz[idx] = (v4u){0u, 0u, 0u, 0u};
}

__device__ __forceinline__ void phase1(const Args& a) {
    const int tid = threadIdx.x, lane = tid & 63, wave = tid >> 6;
    const int gw = blockIdx.x * NWAVES + wave, NGW = gridDim.x * NWAVES;
    const float* mod = (const float*)(a.ws + WS_MOD);
    for (int it = gw; it < 72; it += NGW) {
        const int b = it / 36, e = it - b * 36; const float* w36 = (const float*)(a.ws + WS_W36); float s = 0.f;
        for (int dd = lane; dd < DM; dd += 64) s += mod[b * 12288 + 3 * DM + dd] * w36[e * DM + dd];
        s = wave_sum(s) + ((e < 4) ? a.in[I_BGRP][e] : a.in[I_BEXP][e - 4]);
        if (lane == 0) ((float*)(a.ws + WS_B36))[it] = s; }
    auto ldrow = [&](int m, f32x4 (&v)[8]) { const f32x4* xr = (const f32x4*)(a.in[I_X] + (size_t)m * DM) + lane;
#pragma unroll
        for (int j = 0; j < 8; ++j) v[j] = xr[64 * j]; };
    auto dorow = [&](int m, f32x4 (&v)[8]) { const int b = m >> 12; float s = 0.f;
#pragma unroll
        for (int j = 0; j < 8; ++j) s += (v[j].x * v[j].x + v[j].y * v[j].y) + (v[j].z * v[j].z + v[j].w * v[j].w);
        const float rstd = 1.f / sqrtf(wave_sum(s) * (1.f / DM) + RMS_EPS);
        v2u* o8 = (v2u*)((bf16*)(a.ws + WS_HB) + (size_t)m * DM) + lane;
#pragma unroll
        for (int j = 0; j < 8; ++j) { const int c = 4 * (lane + 64 * j);
            const f32x4 g = *(const f32x4*)(a.in[I_N1G] + c), sh = *(const f32x4*)(mod + b * 12288 + c), sc = *(const f32x4*)(mod + b * 12288 + DM + c);
            const f32x4 h = v[j] * rstd * g * (1.f + sc) + sh; v2u o; o.x = pk2(h.x, h.y); o.y = pk2(h.z, h.w); o8[64 * j] = o; } };
    { f32x4 va[8], vb[8]; int m = gw; if (m < MTOK) ldrow(m, va);
      while (m < MTOK) { const int m2 = m + NGW; if (m2 < MTOK) ldrow(m2, vb); dorow(m, va); if (m2 >= MTOK) break;
          const int m3 = m2 + NGW; if (m3 < MTOK) ldrow(m3, va); dorow(m2, vb); m = m3; } }
}

__device__ __forceinline__ void phase3(const Args& a) {
    const int gt = blockIdx.x * NTHR + threadIdx.x, NGT = gridDim.x * NTHR;
    const bf16* P = (const bf16*)(a.ws + WS_PLR); bf16* AL = (bf16*)(a.ws + WS_AL);
    for (int idx = gt; idx < MTOK * 48; idx += NGT) { const int m = idx / 48, cj = idx - m * 48;
        v4u o = (v4u){0u, 0u, 0u, 0u};
        if (cj < 36) { const int col = 3072 + 8 * cj; const v4u pc = *(const v4u*)(P + (size_t)m * 288 + 8 * cj);
            v4u pp = (v4u){0u, 0u, 0u, 0u}; if ((m & (SEQ - 1)) != 0) pp = *(const v4u*)(P + (size_t)(m - 1) * 288 + 8 * cj);
            const float* mu = a.in[I_MU] + col; float r[8];
#pragma unroll
            for (int i = 0; i < 4; ++i) { const float c0 = bflo(pc[i]), c1 = bfhi(pc[i]), p0 = bflo(pp[i]), p1 = bfhi(pp[i]);
                r[2 * i] = c0 + (p0 - c0) * mu[2 * i]; r[2 * i + 1] = c1 + (p1 - c1) * mu[2 * i + 1]; }
            if (cj < 8) {
#pragma unroll
                for (int i = 0; i < 8; ++i) r[i] = tanhf(r[i]); }
            else if (cj >= 16) {
#pragma unroll
                for (int i = 0; i < 8; ++i) r[i] = sigmoid_f(r[i]); }
            o.x = pk2(r[0], r[1]); o.y = pk2(r[2], r[3]); o.z = pk2(r[4], r[5]); o.w = pk2(r[6], r[7]); }
        *(v4u*)(AL + (size_t)m * LORA_K + 8 * cj) = o; }
}

__device__ __forceinline__ int swz_off(int key, int chunk) { return key * 128 + ((chunk ^ ((key >> 1) & 7)) << 4); }
__device__ __forceinline__ void attn_issue_tile(const bf16* kcol, int key0, LAS unsigned char* buf, int wave) {
    __builtin_amdgcn_global_load_lds((const unsigned*)(kcol + (size_t)key0 * HD), (LAS unsigned*)(buf + wave * 1024), 16, 0, 0);
    __builtin_amdgcn_global_load_lds((const unsigned*)(kcol + HM_PART + (size_t)key0 * HD), (LAS unsigned*)(buf + 8192 + wave * 1024), 16, 0, 0);
}
__device__ __forceinline__ void phase5b(const Args& a, LAS unsigned char* lds) {
    STAMP_DECL;
    const int tid = threadIdx.x, lane = tid & 63, wave = __builtin_amdgcn_readfirstlane(tid >> 6), n = lane & 15, g = lane >> 4;
    const bf16* P = (const bf16*)(a.ws + WS_P); bf16* Y = (bf16*)(a.ws + WS_YMIX);
    LAS unsigned char* QL = lds + 65536; LAS float* biasA = (LAS float*)(lds + 81920);
    for (int i = tid; i < NHEAD * 257; i += NTHR) biasA[i] = a.in[I_RELB][i] * LOG2E;
    const float SC = 0.125f * LOG2E;
    const int skey = tid >> 3, sdcx = (tid & 7) ^ ((skey >> 1) & 7);
    LAS float* betaL = (LAS float*)(lds + 81920 + NHEAD * 257 * 4 + 64);
    for (int i = tid; i < CW; i += NTHR) betaL[i] = a.in[I_BETAA][i];
#define ATTN_PROLOGUE(U) do { const int cp_ = (U) & 31, h_ = ((U) >> 5) & 15, b_ = (U) >> 9; const int js_ = (8 - 2 * cp_) > 0 ? (8 - 2 * cp_) : 0, kb_ = 64 * (2 * cp_ - 8 + js_); \
        const bf16* Qh_ = P + 3 * HM_PART + (size_t)b_ * HM_BATCH + (size_t)h_ * HM_HEAD; const bf16* kc_ = Qh_ + HM_PART + (size_t)skey * HD + 8 * sdcx; \
        const bf16* qs_ = Qh_ + (size_t)(128 * cp_ + 16 * wave + (lane >> 3)) * HD + 8 * (lane & 7); \
        __builtin_amdgcn_global_load_lds((const unsigned*)qs_, (LAS unsigned*)(QL + wave * 2048), 16, 0, 0); \
        __builtin_amdgcn_global_load_lds((const unsigned*)(qs_ + (size_t)8 * HD), (LAS unsigned*)(QL + wave * 2048 + 1024), 16, 0, 0); \
        attn_issue_tile(kc_, kb_, lds, wave); attn_issue_tile(kc_, kb_ + 64, lds + 16384, wave); \
        if (js_ < 8) attn_issue_tile(kc_, kb_ + 128, lds + 32768, wave); } while (0)
    asm volatile("s_waitcnt vmcnt(0) lgkmcnt(0)" ::: "memory"); __builtin_amdgcn_s_barrier(); asm volatile("" ::: "memory");
    if ((int)blockIdx.x < BATCH * NHEAD * 32) ATTN_PROLOGUE((int)blockIdx.x);
    for (int u = blockIdx.x; u < BATCH * NHEAD * 32; u += gridDim.x) {
        const int cp = u & 31, h = (u >> 5) & 15, b = u >> 9;
        const int t0 = 128 * cp, qrow = t0 + 16 * wave + n;
        const bf16* Qh = P + 3 * HM_PART + (size_t)b * HM_BATCH + (size_t)h * HM_HEAD;
        const LAS float* biasL = biasA + h * 257;
        const int jstart = (8 - 2 * cp) > 0 ? (8 - 2 * cp) : 0, nt = 10 - jstart;
        const bf16* kcol = Qh + HM_PART + (size_t)skey * HD + 8 * sdcx;
        const int keyb = 64 * (2 * cp - 8 + jstart);
        if (nt > 2) asm volatile("s_waitcnt vmcnt(4)" ::: "memory"); else asm volatile("s_waitcnt vmcnt(2)" ::: "memory");
        __builtin_amdgcn_s_barrier(); asm volatile("" ::: "memory");
        bf16x8 qf[2]; qf[0] = *(const LAS bf16x8*)(QL + wave * 2048 + n * 128 + 16 * g); qf[1] = *(const LAS bf16x8*)(QL + wave * 2048 + n * 128 + 64 + 16 * g);
        float mrun = -1e30f, lrun = 0.f;
        f32x4 ot[4];
#pragma unroll
        for (int i = 0; i < 4; ++i) ot[i] = (f32x4){0.f, 0.f, 0.f, 0.f};
        const float bfar = biasL[256];
        for (int r = 0; r < nt; ++r) {
            const int j = jstart + r, key0 = keyb + 64 * r;
            if (r + 3 < nt) attn_issue_tile(kcol, key0 + 192, lds + ((r + 3) & 3) * 16384, wave);
            const bool active = (wave < 4) ? (j <= 8) : (j >= 1);
            STAMP_BEGIN(13);
            if (active) {
                LAS unsigned char* Kb = lds + (r & 3) * 16384; LAS unsigned char* Vb = Kb + 8192;
                f32x4 s[4];
                { bf16x8 kfr[4][2];
#pragma unroll
                  for (int st = 0; st < 4; ++st)
#pragma unroll
                      for (int ks = 0; ks < 2; ++ks) kfr[st][ks] = *(const LAS bf16x8*)(Kb + swz_off(16 * st + n, 4 * ks + g));
                  asm volatile("s_waitcnt lgkmcnt(0)" ::: "memory"); __builtin_amdgcn_sched_barrier(0);
#pragma unroll
                  for (int st = 0; st < 4; ++st) { s[st] = (f32x4){0.f, 0.f, 0.f, 0.f};
#pragma unroll
                      for (int ks = 0; ks < 2; ++ks) s[st] = __builtin_amdgcn_mfma_f32_16x16x32_bf16(kfr[st][ks], qf[ks], s[st], 0, 0, 0); } }
                s16x4 vtr[2][4][2];
                  const int q4 = n >> 2, p4 = n & 3;
#pragma unroll
                  for (int k2 = 0; k2 < 2; ++k2)
#pragma unroll
                      for (int nd = 0; nd < 4; ++nd) { const int ka = 32 * k2 + 4 * g + q4, ch = 2 * nd + (p4 >> 1);
                          vtr[k2][nd][0] = __builtin_bit_cast(s16x4, __builtin_amdgcn_ds_read_tr16_b64_v4i16((LAS s16x4*)(Vb + swz_off(ka, ch) + 8 * (p4 & 1))));
                          vtr[k2][nd][1] = __builtin_bit_cast(s16x4, __builtin_amdgcn_ds_read_tr16_b64_v4i16((LAS s16x4*)(Vb + swz_off(ka + 16, ch) + 8 * (p4 & 1)))); }
                const bool far = (t0 + 16 * wave) - (key0 + 63) >= 128;
                float mx = -1e30f;
                if (far) {
#pragma unroll
                    for (int st = 0; st < 4; ++st)
#pragma unroll
                        for (int jj = 0; jj < 4; ++jj) { const float sv = s[st][jj] * SC + bfar; s[st][jj] = sv; mx = fmaxf(mx, sv); }
                } else {
                    float bv[4][4];
#pragma unroll
                    for (int st = 0; st < 4; ++st)
#pragma unroll
                        for (int jj = 0; jj < 4; ++jj) { const int dist = qrow - (key0 + 16 * st + 4 * g + jj); bv[st][jj] = biasL[(dist < 128 ? dist : 128) + 128]; }
#pragma unroll
                    for (int st = 0; st < 4; ++st)
#pragma unroll
                        for (int jj = 0; jj < 4; ++jj) { const float sv = s[st][jj] * SC + bv[st][jj]; s[st][jj] = sv; mx = fmaxf(mx, sv); }
                }
                mx = fmaxf(mx, __shfl_xor(mx, 16)); mx = fmaxf(mx, __shfl_xor(mx, 32));
                const float mnew = fmaxf(mrun, mx), alpha = __builtin_amdgcn_exp2f(mrun - mnew); mrun = mnew;
                float ls = 0.f;
#pragma unroll
                for (int st = 0; st < 4; ++st)
#pragma unroll
                    for (int jj = 0; jj < 4; ++jj) { const float p = __builtin_amdgcn_exp2f(s[st][jj] - mnew); s[st][jj] = p; ls += p; }
                lrun = lrun * alpha + ls;
#pragma unroll
                for (int i = 0; i < 4; ++i) ot[i] *= alpha;
                {
                  asm volatile("s_waitcnt lgkmcnt(0)" ::: "memory"); __builtin_amdgcn_sched_barrier(0);
#pragma unroll
                  for (int k2 = 0; k2 < 2; ++k2) {
                      v4u pw; pw.x = pk2(s[2 * k2][0], s[2 * k2][1]); pw.y = pk2(s[2 * k2][2], s[2 * k2][3]); pw.z = pk2(s[2 * k2 + 1][0], s[2 * k2 + 1][1]); pw.w = pk2(s[2 * k2 + 1][2], s[2 * k2 + 1][3]);
                      const bf16x8 pf = __builtin_bit_cast(bf16x8, pw);
#pragma unroll
                      for (int nd = 0; nd < 4; ++nd) { const s16x4 v0 = vtr[k2][nd][0], v1 = vtr[k2][nd][1];
                          bf16x8 vf; vf[0] = v0[0]; vf[1] = v0[1]; vf[2] = v0[2]; vf[3] = v0[3]; vf[4] = v1[0]; vf[5] = v1[1]; vf[6] = v1[2]; vf[7] = v1[3];
                          ot[nd] = __builtin_amdgcn_mfma_f32_16x16x32_bf16(vf, pf, ot[nd], 0, 0, 0); } } }
            }
            STAMP_END(13); STAMP_BEGIN(12);
            if (r + 4 <= nt) asm volatile("s_waitcnt vmcnt(4)" ::: "memory"); else if (r + 3 == nt) asm volatile("s_waitcnt vmcnt(2)" ::: "memory"); else asm volatile("s_waitcnt vmcnt(0)" ::: "memory");
            asm volatile("s_waitcnt lgkmcnt(0)" ::: "memory"); __builtin_amdgcn_s_barrier(); asm volatile("" ::: "memory");
            STAMP_END(12);
        }
        if (u + (int)gridDim.x < BATCH * NHEAD * 32) ATTN_PROLOGUE(u + (int)gridDim.x);
        float lt = lrun; lt += __shfl_xor(lt, 16); lt += __shfl_xor(lt, 32);
        const float inv = __builtin_amdgcn_rcpf(lt);
        bf16* yp = Y + ((size_t)b * SEQ + qrow) * DM + 1024 + h * 64 + 4 * g;
        const LAS float* beta = betaL + h * 64 + 4 * g;
#pragma unroll
        for (int nd = 0; nd < 4; ++nd) { const f32x4 bt = *(const LAS f32x4*)(beta + 16 * nd); const f32x4 o = ot[nd] * inv * bt;
            v2u w; w.x = pk2(o[0], o[1]); w.y = pk2(o[2], o[3]); *(v2u*)(yp + 16 * nd) = w; }
    }
}

__device__ __forceinline__ void phase8(const Args& a, LAS unsigned char* lds) {
    const int tid = threadIdx.x, lane = tid & 63, wave = __builtin_amdgcn_readfirstlane(tid >> 6), n = lane & 15, g = lane >> 4;
    const float* mod = (const float*)(a.ws + WS_MOD); const float* W36 = (const float*)(a.ws + WS_W36); const float* X1 = (const float*)(a.ws + WS_X1);
    unsigned* ctl = (unsigned*)(a.ws + WS_CTL);
    LAS float* part = (LAS float*)lds;
    LAS float* ssp = (LAS float*)(lds + 24576);
    LAS float* lg = (LAS float*)(lds + 25088);
    for (int tile = blockIdx.x; tile < MTOK / 16; tile += gridDim.x) {
        const int m0 = 16 * tile, b = m0 >> 12;
        f32x4 acc[3]; float ss = 0.f;
#pragma unroll
        for (int ct = 0; ct < 3; ++ct) acc[ct] = (f32x4){0.f, 0.f, 0.f, 0.f};
        const float* xrow = X1 + (size_t)(m0 + n) * DM + 256 * wave + 4 * g;
        const float* w0p = W36 + (size_t)n * DM + 256 * wave + 4 * g; const float* w1p = w0p + (size_t)16 * DM; const float* w2p = w0p + (size_t)(n < 4 ? 32 : 0) * DM;
        const float* gp = a.in[I_N2G] + 256 * wave + 4 * g; const float* sp = mod + b * 12288 + 4 * DM + 256 * wave + 4 * g;
#pragma unroll 4
        for (int Q = 0; Q < 16; ++Q) {
            f32x4 xa = *(const f32x4*)(xrow + 16 * Q);
            const f32x4 ab = *(const f32x4*)(gp + 16 * Q) * (1.f + *(const f32x4*)(sp + 16 * Q));
            const f32x4 wa = *(const f32x4*)(w0p + 16 * Q), wb = *(const f32x4*)(w1p + 16 * Q); f32x4 wc = *(const f32x4*)(w2p + 16 * Q);
            if (n >= 4) wc = (f32x4){0.f, 0.f, 0.f, 0.f};
            ss += (xa[0] * xa[0] + xa[1] * xa[1]) + (xa[2] * xa[2] + xa[3] * xa[3]); xa *= ab;
#pragma unroll
            for (int r = 0; r < 4; ++r) { acc[0] = __builtin_amdgcn_mfma_f32_16x16x4f32(xa[r], wa[r], acc[0], 0, 0, 0); acc[1] = __builtin_amdgcn_mfma_f32_16x16x4f32(xa[r], wb[r], acc[1], 0, 0, 0);
                acc[2] = __builtin_amdgcn_mfma_f32_16x16x4f32(xa[r], wc[r], acc[2], 0, 0, 0); }
        }
        ss += __shfl_xor(ss, 16); ss += __shfl_xor(ss, 32);
#pragma unroll
        for (int ct = 0; ct < 3; ++ct) *(LAS f32x4*)(part + (wave * 64 + lane) * 12 + 4 * ct) = acc[ct];
        if (lane < 16) ssp[wave * 16 + lane] = ss;
        __syncthreads();
        { const int tk = tid >> 5, sl = tid & 31;
            float s2 = 0.f;
#pragma unroll
            for (int w = 0; w < 8; ++w) s2 += ssp[w * 16 + tk];
            const float rstd = 1.f / sqrtf(s2 * (1.f / DM) + RMS_EPS);
            const float* b36 = (const float*)(a.ws + WS_B36) + b * 36;
            { const int e = sl; float s = 0.f;
#pragma unroll
              for (int w = 0; w < 8; ++w) s += part[(w * 64 + 16 * (tk >> 2) + (e & 15)) * 12 + 4 * (e >> 4) + (tk & 3)];
              lg[tk * 40 + e] = s * rstd + b36[e]; }
            if (sl < 4) { const int e = 32 + sl; float s = 0.f;
#pragma unroll
              for (int w = 0; w < 8; ++w) s += part[(w * 64 + 16 * (tk >> 2) + (e & 15)) * 12 + 4 * (e >> 4) + (tk & 3)];
              lg[tk * 40 + e] = s * rstd + b36[e]; }
            if (sl == 0) ((float*)(a.ws + WS_RSTD))[m0 + tk] = rstd; }
        __syncthreads();
        if (tid < 16) {
            float l[36];
#pragma unroll
            for (int e = 0; e < 36; ++e) l[e] = lg[tid * 40 + e];
            int gi = 0; float gm = l[0];
#pragma unroll
            for (int i = 1; i < 4; ++i) if (l[i] > gm) { gm = l[i]; gi = i; }
            float gs = 0.f;
#pragma unroll
            for (int i = 0; i < 4; ++i) gs += expf(l[i] - gm);
            const float gwt = 1.f / gs;
            float el[8];
#pragma unroll
            for (int j = 0; j < 8; ++j) el[j] = (gi == 0) ? l[4 + j] : ((gi == 1) ? l[12 + j] : ((gi == 2) ? l[20 + j] : l[28 + j]));
            int i1 = 0; float m1 = el[0];
#pragma unroll
            for (int i = 1; i < 8; ++i) if (el[i] > m1) { m1 = el[i]; i1 = i; }
            int i2 = -1; float m2 = -3.0e38f;
#pragma unroll
            for (int i = 0; i < 8; ++i) if (i != i1 && el[i] > m2) { m2 = el[i]; i2 = i; }
            const float e2 = expf(m2 - m1); const float w1 = gwt / (1.f + e2), w2 = gwt * e2 / (1.f + e2);
            int* rt = (int*)(a.ws + WS_ROUTE) + (size_t)(m0 + tid) * 8; const int ge1 = gi * 8 + i1, ge2 = gi * 8 + i2;
            rt[0] = ge1; rt[1] = ge2; rt[2] = __float_as_int(w1); rt[3] = __float_as_int(w2);
            atomicAdd(ctl + CW_CNT + ge1, 1u); atomicAdd(ctl + CW_CNT + ge2, 1u);
        }
        __syncthreads();
    }
}

__device__ __forceinline__ void phase9(const Args& a) {
    const int tid = threadIdx.x, lane = tid & 63, wave = tid >> 6;
    const int gw = blockIdx.x * NWAVES + wave, NGW = gridDim.x * NWAVES;
    unsigned* ctl = (unsigned*)(a.ws + WS_CTL);
    const float* mod = (const float*)(a.ws + WS_MOD);
    unsigned cnt = (lane < NEXP) ? __hip_atomic_load(ctl + CW_CNT + lane, RLX_AGENT) : 0u;
    const unsigned pad = (cnt + 255u) & ~255u;
    unsigned incl = pad;
#pragma unroll
    for (int o = 1; o < 64; o <<= 1) { const unsigned t = __shfl_up(incl, o); if (lane >= o) incl += t; }
    const unsigned off = incl - pad;
    if (gw == 0) {
        if (lane < NEXP) for (unsigned t = off >> 8; t < (off + pad) >> 8; ++t) ctl[CW_TE + t] = (unsigned)lane;
        if (lane == 63) ctl[CW_NRT] = incl >> 8;
    }
    for (int task = gw; task < MTOK / 4; task += NGW) {
        const int m0 = 4 * task, b = m0 >> 12;
        int* rt = (int*)(a.ws + WS_ROUTE) + (size_t)(m0 + (lane & 3)) * 8;
        const int e1 = rt[0], e2 = rt[1];
        unsigned p1 = 0, p2 = 0;
        if (lane < 4) { p1 = atomicAdd(ctl + CW_POS + e1, 1u); p2 = atomicAdd(ctl + CW_POS + e2, 1u); }
        const unsigned s1v = __shfl(off, e1) + p1, s2v = __shfl(off, e2) + p2;
        if (lane < 4) { rt[4] = (int)s1v; rt[5] = (int)s2v; ((float*)(a.ws + WS_SW))[s1v] = __int_as_float(rt[2]); ((float*)(a.ws + WS_SW))[s2v] = __int_as_float(rt[3]); }
        f32x4 xa[8], xb[8];
        auto ldx = [&](int t, f32x4 (&x)[8]) { const f32x4* xr = (const f32x4*)((const float*)(a.ws + WS_X1) + (size_t)(m0 + t) * DM) + lane;
#pragma unroll
            for (int j = 0; j < 8; ++j) x[j] = xr[64 * j]; };
        auto dox = [&](int t, f32x4 (&x)[8]) { const unsigned s1 = __shfl(s1v, t), s2 = __shfl(s2v, t);
            const float rstd = ((const float*)(a.ws + WS_RSTD))[m0 + t];
            v2u* d1 = (v2u*)((bf16*)(a.ws + WS_H2P) + (size_t)s1 * DM) + lane; v2u* d2 = (v2u*)((bf16*)(a.ws + WS_H2P) + (size_t)s2 * DM) + lane;
#pragma unroll
            for (int j = 0; j < 8; ++j) { const int c = 4 * (lane + 64 * j);
                const f32x4 g = *(const f32x4*)(a.in[I_N2G] + c), sh = *(const f32x4*)(mod + b * 12288 + 3 * DM + c), sc = *(const f32x4*)(mod + b * 12288 + 4 * DM + c);
                const f32x4 h = x[j] * rstd * g * (1.f + sc) + sh; v2u o; o.x = pk2(h.x, h.y); o.y = pk2(h.z, h.w); d1[64 * j] = o; d2[64 * j] = o; } };
        ldx(0, xa); ldx(1, xb); dox(0, xa); ldx(2, xa); dox(1, xb); ldx(3, xb); dox(2, xa); dox(3, xb);
    }
}

__device__ __forceinline__ void phase12(const Args& a) {
    const int tid = threadIdx.x, lane = tid & 63, wave = tid >> 6;
    const int gw = blockIdx.x * NWAVES + wave, NGW = gridDim.x * NWAVES;
    const float* mod = (const float*)(a.ws + WS_MOD);
    struct Tok { f32x4 x[8]; v2u f1[8], f2[8]; };
    auto ldslots = [&](int m, int& s1, int& s2) { const int* rt = (const int*)(a.ws + WS_ROUTE) + (size_t)m * 8; s1 = rt[4]; s2 = rt[5]; };
    auto ldtok = [&](int m, int s1, int s2, Tok& t) { const f32x4* xr = (const f32x4*)((const float*)(a.ws + WS_X1) + (size_t)m * DM) + lane;
        const v2u* f1 = (const v2u*)((const bf16*)(a.ws + WS_FP) + (size_t)s1 * DM) + lane; const v2u* f2 = (const v2u*)((const bf16*)(a.ws + WS_FP) + (size_t)s2 * DM) + lane;
#pragma unroll
        for (int j = 0; j < 8; ++j) { t.x[j] = xr[64 * j]; t.f1[j] = f1[64 * j]; t.f2[j] = f2[64 * j]; } };
    auto dotok = [&](int m, Tok& t) { const int b = m >> 12; float s = 0.f; f32x4 v[8];
#pragma unroll
        for (int j = 0; j < 8; ++j) { const int c = 4 * (lane + 64 * j); const f32x4 g2 = *(const f32x4*)(mod + b * 12288 + 5 * DM + c);
            const v2u a1 = t.f1[j], a2 = t.f2[j]; f32x4 f;
            f.x = bflo(a1.x) + bflo(a2.x); f.y = bfhi(a1.x) + bfhi(a2.x); f.z = bflo(a1.y) + bflo(a2.y); f.w = bfhi(a1.y) + bfhi(a2.y);
            v[j] = t.x[j] + g2 * f; s += (v[j].x * v[j].x + v[j].y * v[j].y) + (v[j].z * v[j].z + v[j].w * v[j].w); }
        const float rstd = 1.f / sqrtf(wave_sum(s) * (1.f / DM) + RMS_EPS);
        f32x4* op = (f32x4*)(a.out + (size_t)m * DM) + lane;
#pragma unroll
        for (int j = 0; j < 8; ++j) { const int c = 4 * (lane + 64 * j); const f32x4 g = *(const f32x4*)(a.in[I_NFG] + c); op[64 * j] = v[j] * rstd * g; } };
    { Tok ta, tb; int m = gw, sa1 = 0, sa2 = 0, sb1 = 0, sb2 = 0;
      if (m < MTOK) { ldslots(m, sa1, sa2); if (m + NGW < MTOK) ldslots(m + NGW, sb1, sb2); ldtok(m, sa1, sa2, ta); }
      while (m < MTOK) { const int m2 = m + NGW, m3 = m2 + NGW, m4 = m3 + NGW;
          if (m3 < MTOK) ldslots(m3, sa1, sa2);
          if (m2 < MTOK) ldtok(m2, sb1, sb2, tb);
          dotok(m, ta); if (m2 >= MTOK) break;
          if (m4 < MTOK) ldslots(m4, sb1, sb2);
          if (m3 < MTOK) ldtok(m3, sa1, sa2, ta);
          dotok(m2, tb); m = m3; } }
}

#ifndef MK_ONE_LAUNCH
#define MK_ONE_LAUNCH 1
#endif
__global__ void __launch_bounds__(NTHR, 2) mega_fwd(Args args) {
    extern __shared__ __attribute__((aligned(16))) unsigned char lds_raw[];
    LAS unsigned char* lds = (LAS unsigned char*)lds_raw;
    const int tid = threadIdx.x;
    for (int u = tid; u < (LDS_BYTES - LDSCTL_OFF) / 4; u += NTHR) ((LAS unsigned*)(lds + LDSCTL_OFF))[u] = 0u;
    __syncthreads();
    volatile LAS unsigned* MISC = (volatile LAS unsigned*)(lds + MISC_OFF);
    unsigned* ctl = (unsigned*)(args.ws + WS_CTL);
    unsigned* barw = ctl + CW_BAR + args.li * XCD_BAR_WORDS;
    XcdBarrier bar; bar.bar = barw; bar.x = 0; bar.st = nullptr;
    const bool multi = (args.ph_hi - args.ph_lo) > 1;
    if (multi) bar = xcd_barrier_post(barw, MISC + 8);
    const int lo = args.ph_lo, hi = args.ph_hi, G = gridDim.x;
#define IN(k) (lo <= (k) && (k) < hi)
#define SEAM(k) do { if (IN(k) && IN((k) + 1)) xcd_barrier(bar); } while (0)
    if (IN(0)) { phase0(args, lds); } SEAM(0);
    if (IN(1)) { phase1(args); } SEAM(1);
    if (IN(2)) { pg8::Gemm g{(const pg8::bf16_t*)(args.ws + WS_HB), (const pg8::bf16_t*)(args.ws + WS_WIN), MTOK, PROJP, DM}; pg8::StaticOrder S; S.init(MTOK, PROJP, G, (int)blockIdx.x);
        EpiProj E{(bf16*)(args.ws + WS_P), (bf16*)(args.ws + WS_PLR)};
        pg8::gemm_phase<EpiProj, pg8::StaticOrder, true, true>(lds, g, S, E); } SEAM(2);
    if (IN(3)) { const Args& a = args; STAMP_DECL; STAMP_BEGIN(10); phase3(args); STAMP_END(10); STAMP_BEGIN(11); phase5b(args, lds); STAMP_END(11); } SEAM(3);
    if (IN(4)) { pg8::Gemm g{(const pg8::bf16_t*)(args.ws + WS_AL), (const pg8::bf16_t*)(args.ws + WS_WL), MTOK, LORA_N, LORA_K}; pg8::StaticOrder S; S.init(MTOK, LORA_N, G, (int)blockIdx.x);
        EpiLora E{(float*)(args.ws + WS_LW), (bf16*)(args.ws + WS_AA), (bf16*)(args.ws + WS_GG)};
        pg8::gemm_phase<EpiLora, pg8::StaticOrder, true, true>(lds, g, S, E); } SEAM(4);
    if (IN(5)) { scanA(args, lds); } SEAM(5);
    if (IN(6)) { scanB(args, lds); } SEAM(6);
    if (IN(7)) { scanC(args); } SEAM(7);
    if (IN(8)) { pg8::Gemm g{(const pg8::bf16_t*)(args.ws + WS_YMIX), (const pg8::bf16_t*)(args.ws + WS_WOUT), MTOK, DM, DM}; pg8::StaticOrder S; S.init(MTOK, DM, G, (int)blockIdx.x);
        EpiResGate E{args.in[I_X], (const float*)(args.ws + WS_MOD) + 2 * DM, (float*)(args.ws + WS_X1)};
        pg8::gemm_phase<EpiResGate, pg8::StaticOrder, true, true>(lds, g, S, E); } SEAM(8);
    if (IN(9)) { phase8(args, lds); } SEAM(9);
    if (IN(10)) { phase9(args); } SEAM(10);
    if (IN(11)) { const int nrt = (int)__hip_atomic_load(ctl + CW_NRT, RLX_AGENT);
        pg8::Gemm g{(const pg8::bf16_t*)(args.ws + WS_H2P), (const pg8::bf16_t*)(args.ws + WS_WGU), nrt * 256, NEXP * 1024, DM}; GroupOrder S{ctl + CW_TE, nrt, 4, G, (int)blockIdx.x};
        EpiGateUp E{(const float*)(args.ws + WS_SW), (bf16*)(args.ws + WS_HG)};
        pg8::gemm_phase<EpiGateUp, GroupOrder, true, true>(lds, g, S, E); } SEAM(11);
    if (IN(12)) { const int nrt = (int)__hip_atomic_load(ctl + CW_NRT, RLX_AGENT);
        pg8::Gemm g{(const pg8::bf16_t*)(args.ws + WS_HG), (const pg8::bf16_t*)(args.ws + WS_WD), nrt * 256, NEXP * DM, FF}; GroupOrder S{ctl + CW_TE, nrt, 8, G, (int)blockIdx.x};
        EpiStoreBf16 E{(bf16*)(args.ws + WS_FP), DM, 7};
        pg8::gemm_phase<EpiStoreBf16, GroupOrder, true, true>(lds, g, S, E); } SEAM(12);
    if (IN(13)) { phase12(args); }
#ifdef STAMP_ID
    if (blockIdx.x == 0 && tid == 0 && IN(NPH - 1)) { const unsigned dly = __hip_atomic_load(ctl + CW_STAMP, RLX_AGENT); const unsigned long long t0_ = __builtin_amdgcn_s_memrealtime();
        while (__builtin_amdgcn_s_memrealtime() - t0_ < (unsigned long long)dly) __builtin_amdgcn_s_sleep(8); }
#endif
#ifdef EXTRA_BARRIERS
    if (multi) for (int i_ = 0; i_ < EXTRA_BARRIERS; ++i_) xcd_barrier(bar);
#endif
#undef IN
#undef SEAM
}

extern "C" void kernel_launch(void* const* d_in, const int* in_sizes, int n_in, void* d_out, int out_size, void* d_ws, size_t ws_size, hipStream_t stream) {
    static int grid = 0;
    if (grid == 0) {
        if (n_in != 30 || out_size != MTOK * DM || ws_size < WS_END) { fprintf(stderr, "kernel_launch: unexpected shapes (n_in %d, out %d, ws %zu)\n", n_in, out_size, ws_size); grid = -1; return; }
        int dev = 0, cus = 0, per_cu = 0;
        if (hipGetDevice(&dev) != hipSuccess || hipDeviceGetAttribute(&cus, hipDeviceAttributeMultiprocessorCount, dev) != hipSuccess) { grid = -1; return; }
        if (hipFuncSetAttribute((const void*)mega_fwd, hipFuncAttributeMaxDynamicSharedMemorySize, LDS_BYTES) != hipSuccess) { grid = -1; return; }
        if (hipOccupancyMaxActiveBlocksPerMultiprocessor(&per_cu, (const void*)mega_fwd, NTHR, LDS_BYTES) != hipSuccess || per_cu < 1) { fprintf(stderr, "kernel_launch: occupancy query says %d\n", per_cu); grid = -1; (void)hipGetLastError(); return; }
        grid = cus;
    }
    if (grid < 0) return;
    (void)hipMemsetAsync((char*)d_ws + WS_CTL, 0, CTL_ZERO_BYTES, stream);
    Args a{};
    for (int i = 0; i < 30; ++i) a.in[i] = (const float*)d_in[i];
    a.out = (float*)d_out; a.ws = (unsigned char*)d_ws;
#if MK_ONE_LAUNCH
#ifdef PROBE_PHASE
    const int cuts[3] = {0, PROBE_PHASE, NPH};
    for (int li = 0; li < 2; ++li) { a.ph_lo = cuts[li]; a.ph_hi = cuts[li + 1] + ((li == 0) ? PROBE_REPEAT : 0); a.li = li;
        void* kargs[] = {&a};
        hipError_t e = hipLaunchCooperativeKernel((const void*)mega_fwd, dim3(grid), dim3(NTHR), kargs, LDS_BYTES, stream);
        if (e != hipSuccess) fprintf(stderr, "cooperative launch failed: %s\n", hipGetErrorString(e)); }
#else
    a.ph_lo = 0; a.ph_hi = NPH;
    void* kargs[] = {&a};
    hipError_t e = hipLaunchCooperativeKernel((const void*)mega_fwd, dim3(grid), dim3(NTHR), kargs, LDS_BYTES, stream);
    if (e != hipSuccess) fprintf(stderr, "cooperative launch failed: %s\n", hipGetErrorString(e));
#endif
#else
    for (int p = 0; p < NPH; ++p) { a.ph_lo = p; a.ph_hi = p + 1; hipLaunchKernelGGL(mega_fwd, dim3(grid), dim3(NTHR), LDS_BYTES, stream, a); }
#endif
}
```

```cpp
#include <hip/hip_runtime.h>
#include <hip/hip_bf16.h>
#include <cstdio>
#include <cstdint>

constexpr int NWAVES = 8, NTHR = 512;
constexpr int BATCH = 2, SEQ = 4096, DM = 2048, MTOK = BATCH * SEQ;
constexpr int CW = 1024, NHEAD = 16, HD = 64;
constexpr int SHIFTW = 3360, PROJW = 6432, PROJP = 6656;
constexpr int LORA_K = 384, LORA_N = 3072;
constexpr int NEXP = 32, FF = 512;
constexpr int MAXSLOT = 24576;
constexpr float RMS_EPS = 1e-6f, GN_EPS = 64e-5f;
constexpr float LOG2E = 1.4426950408889634f;

constexpr size_t MiB = 1u << 20;
constexpr size_t WS_CTL = 0, CTL_ZERO_BYTES = 1 * MiB;
constexpr size_t WS_MOD = 1 * MiB;
constexpr size_t WS_ROUTE = 1 * MiB + 128 * 1024;
constexpr size_t WS_SW = 1 * MiB + 512 * 1024;
constexpr size_t WS_B36 = 1 * MiB + 96 * 1024;
constexpr size_t WS_RSTD = 1 * MiB + 640 * 1024;
constexpr size_t WS_W36 = 1 * MiB + 704 * 1024;
constexpr size_t WS_WIN = 2 * MiB;
constexpr size_t WS_WOUT = 28 * MiB;
constexpr size_t WS_WL = 36 * MiB;
constexpr size_t WS_WGU = 39 * MiB;
constexpr size_t WS_WD = 167 * MiB;
constexpr size_t B0 = 231 * MiB;
constexpr size_t WS_P = B0;
constexpr size_t WS_PLR = B0 + 96 * MiB;
constexpr size_t HM_PART = (size_t)BATCH * NHEAD * SEQ * HD, HM_BATCH = (size_t)NHEAD * SEQ * HD, HM_HEAD = (size_t)SEQ * HD;
constexpr size_t WS_HB = B0 + 104 * MiB;
constexpr size_t WS_AL = B0 + 136 * MiB;
constexpr size_t WS_LW = B0 + 142 * MiB;
constexpr size_t WS_AA = B0 + 174 * MiB;
constexpr size_t WS_GG = B0 + 190 * MiB;
constexpr size_t WS_R = B0 + 206 * MiB, WS_K2 = B0 + 222 * MiB, WS_V = B0 + 238 * MiB, WS_KK = B0 + 254 * MiB, WS_BB = B0 + 270 * MiB;
constexpr size_t WS_YMIX = B0 + 286 * MiB;
constexpr size_t WS_X1 = B0;
constexpr size_t WS_H2P = B0 + 136 * MiB;
constexpr size_t WS_HG = B0 + 232 * MiB;
constexpr size_t WS_FP = B0 + 136 * MiB;
constexpr size_t WS_HM = B0 + 104 * MiB, WS_Y1 = B0 + 254 * MiB, WS_GT = B0 + 318 * MiB, WS_RH = B0 + 334 * MiB, WS_PLV = B0 + 136 * MiB;
constexpr size_t WS_SF = B0 + 152 * MiB;
constexpr size_t WS_END = B0 + 350 * MiB;
constexpr int CW_CNT = 1024, CW_POS = 1088, CW_NRT = 1152, CW_TE = 1280, CW_BAR = 4096;

constexpr int CW_STAMP = 1200, CW_RDY = 1400;
#ifdef STAMP_ID
#ifndef STAMP_BLOCK
#define STAMP_BLOCK 0
#endif
#define STAMP_BEGIN(id) do { if ((id) == STAMP_ID && blockIdx.x == STAMP_BLOCK && threadIdx.x == 0) st_t0_ = __builtin_amdgcn_s_memrealtime(); } while (0)
#define STAMP_END(id) do { if ((id) == STAMP_ID && blockIdx.x == STAMP_BLOCK && threadIdx.x == 0) atomicAdd((unsigned*)(a.ws + WS_CTL) + CW_STAMP, (unsigned)(__builtin_amdgcn_s_memrealtime() - st_t0_)); } while (0)
#define STAMP_DECL unsigned long long st_t0_ = 0
#else
#define STAMP_BEGIN(id) do { } while (0)
#define STAMP_END(id) do { } while (0)
#define STAMP_DECL do { } while (0)
#endif
constexpr int RING_BYTES = 131072;
constexpr int LDSCTL_OFF = RING_BYTES, MISC_OFF = LDSCTL_OFF + 320;
constexpr int LDS_BYTES = 147456;

#define GAS __attribute__((address_space(1)))
#define LAS __attribute__((address_space(3)))
typedef unsigned short bf16;
typedef unsigned v4u __attribute__((ext_vector_type(4)));
typedef unsigned v2u __attribute__((ext_vector_type(2)));
typedef float f32x4 __attribute__((ext_vector_type(4)));
typedef short bf16x8 __attribute__((ext_vector_type(8)));
typedef short s16x4 __attribute__((ext_vector_type(4)));
typedef GAS unsigned gu32;
typedef GAS unsigned long long gu64;
#define RLX_AGENT __ATOMIC_RELAXED, __HIP_MEMORY_SCOPE_AGENT
#define LDS_WAIT() asm volatile("s_waitcnt lgkmcnt(0)" ::: "memory")
#define VM_WAIT() asm volatile("s_waitcnt vmcnt(0)" ::: "memory")
__device__ __forceinline__ unsigned f2bf(float f) { unsigned u = __builtin_bit_cast(unsigned, f); return (u + 0x7fffu + ((u >> 16) & 1u)) >> 16; }
typedef float f32x2_t __attribute__((ext_vector_type(2)));
typedef __bf16 bf16x2_t __attribute__((ext_vector_type(2)));
__device__ __forceinline__ unsigned pk2(float lo, float hi) { const f32x2_t v = {lo, hi}; return __builtin_bit_cast(unsigned, __builtin_convertvector(v, bf16x2_t)); }
__device__ __forceinline__ float bflo(unsigned u) { return __builtin_bit_cast(float, u << 16); }
__device__ __forceinline__ float bfhi(unsigned u) { return __builtin_bit_cast(float, u & 0xffff0000u); }
__device__ __forceinline__ float wave_sum(float v) {
#pragma unroll
    for (int o = 1; o < 64; o <<= 1) v += __shfl_xor(v, o);
    return v;
}
__device__ __forceinline__ float sigmoid_f(float x) { return 1.f / (1.f + __expf(-x)); }

struct Args { const float* in[30]; float* out; unsigned char* ws; int ph_lo, ph_hi, li, pad; };
enum { I_X = 0, I_C, I_WADA, I_BADA, I_N1G, I_WIN, I_MU, I_W0, I_WDEC, I_A0, I_WAAA, I_WGATEUP, I_KK, I_KA, I_RK, I_LNW, I_LNB, I_RELB, I_BETAR, I_BETAA,
       I_WOUT, I_N2G, I_WGRP, I_BGRP, I_WEXP, I_BEXP, I_WG, I_WU, I_WDN, I_NFG };
constexpr int NPH = 15;

namespace pg8 {
#define PG8_LAS __attribute__((address_space(3)))
typedef unsigned short bf16_t;
typedef short bf16x8 __attribute__((ext_vector_type(8)));
typedef float f32x4 __attribute__((ext_vector_type(4)));
typedef unsigned u32x4 __attribute__((ext_vector_type(4)));
constexpr int BM = 256, BK = 64, HALF = 128, HTB = HALF * BK * 2  , STAGE_BYTES = 8 * HTB, NXCD = 8, WGM = 8;

__host__ __device__ __forceinline__ int lds_byte(int r, int c) { const int st = (r >> 4) * 2 + (c >> 5), rr = r & 15, cc = c & 31, ob = rr * 64 + cc * 2; return st * 1024 + (ob ^ (((ob >> 9) & 1) << 5)); }
__host__ __device__ __forceinline__ void stage_rc(int b, int& R, int& C) { const int st = b / 1024, sb = b % 1024, swz = sb ^ (((sb >> 9) & 1) << 5); R = (st >> 1) * 16 + swz / 64; C = (st & 1) * 32 + (swz % 64) / 2; }
__host__ __device__ __forceinline__ int perm32(int rho) { const int n = rho >> 4, i = rho & 15; return 8 * (i >> 2) + 4 * n + (i & 3); }

struct Unit { int pm, pn; };
struct Gemm { const bf16_t* A; const bf16_t* Bt; int M, N, K; };

struct StaticOrder {
    int nM, nN, nwg, G, c;
    __host__ __device__ void init(int M, int N, int G_, int c_) { nM = M / BM; nN = N / BM; nwg = nM * nN; G = G_; c = c_; }
    __host__ __device__ bool next(int i, Unit& u) const {
        const long L = (long)i * G + c; if (L >= nwg) return false;
        int wgid = (int)L; { const int q = nwg / NXCD, r = nwg % NXCD, xcd = wgid % NXCD, off = wgid / NXCD; wgid = (xcd < r ? xcd * (q + 1) : r * (q + 1) + (xcd - r) * q) + off; }
        const int nig = WGM * nN, gid = wgid / nig, fm = gid * WGM, gsz = (nM - fm) < WGM ? (nM - fm) : WGM;
        u.pm = fm + ((wgid % nig) % gsz); u.pn = (wgid % nig) / gsz; return true;
    }
    __device__ __forceinline__ void a_ready(const Unit&) const {}
    __device__ __forceinline__ void done(const Unit&) const {}
};

__device__ __forceinline__ unsigned cvt_pk_bf16(float lo, float hi) { unsigned r; asm volatile("v_cvt_pk_bf16_f32 %0, %1, %2" : "=v"(r) : "v"(lo), "v"(hi)); return r; }
template <class Epi, class Sched, bool ALIGN_EPI = false, bool SP2 = false>
__device__ __forceinline__ void gemm_phase(PG8_LAS unsigned char* lds, const Gemm g, const Sched& S, const Epi& E) {
    const int tid = threadIdx.x, wid = __builtin_amdgcn_readfirstlane(tid >> 6), lane = tid & 63, wr = wid >> 2, wc = wid & 3, fr = lane & 15, fq = lane >> 4;
    const int K = g.K, nt = K / BK;
    unsigned voffA[2], voffB[2];
#pragma unroll
    for (int i = 0; i < 2; ++i) { int R, C; stage_rc(tid * 16 + i * 8192, R, C); const int Rb = Epi::PERM ? ((R & ~31) + perm32(R & 31)) : R;
        voffA[i] = (unsigned)(R * K + C) * 2u; voffB[i] = (unsigned)(Rb * K + C) * 2u; }
    const size_t kstep = (size_t)(BK * 2);
    const size_t hstep = (size_t)HALF * K * 2;
    const size_t tstep = 2 * hstep;
    const unsigned ldsw = (unsigned)wid * 1024u;
    const int aoff = lds_byte(wr * 64 + fr, fq * 8), boff = lds_byte(wc * 32 + fr, fq * 8);
#define PG8_SA(b, h) (((b) * 2 + (h)) * HTB)
#define PG8_SB(b, h) ((4 + (b) * 2 + (h)) * HTB)
#define PG8_STAGE(bufoff, gbase, voff) do { _Pragma("unroll") for (int _i = 0; _i < 2; ++_i) \
        __builtin_amdgcn_global_load_lds((const unsigned*)((const char*)(gbase) + (voff)[_i]), (PG8_LAS unsigned*)(lds + (bufoff) + ldsw + _i * 8192), 16, 0, 0); } while (0)
#define PG8_LDA(dst, b, h) do { _Pragma("unroll") for (int m = 0; m < 4; ++m) _Pragma("unroll") for (int k = 0; k < 2; ++k) dst[m][k] = *(const PG8_LAS bf16x8*)(lds + PG8_SA(b, h) + aoff + m * 2048 + k * 1024); } while (0)
#define PG8_LDB(dst, b, h) do { _Pragma("unroll") for (int n = 0; n < 2; ++n) _Pragma("unroll") for (int k = 0; k < 2; ++k) dst[n][k] = *(const PG8_LAS bf16x8*)(lds + PG8_SB(b, h) + boff + n * 2048 + k * 1024); } while (0)
#define PG8_MMA(ai, bj, At, Bt) do { __builtin_amdgcn_s_setprio(1); _Pragma("unroll") for (int m = 0; m < 4; ++m) _Pragma("unroll") for (int n = 0; n < 2; ++n) _Pragma("unroll") for (int k = 0; k < 2; ++k) \
        acc[ai][bj][m][n] = __builtin_amdgcn_mfma_f32_16x16x32_bf16(Bt[n][k], At[m][k], acc[ai][bj][m][n], 0, 0, 0); __builtin_amdgcn_s_setprio(0); } while (0)
#define PG8_WAIT_V(n) asm volatile("s_waitcnt vmcnt(" #n ")" ::: "memory")
#define PG8_WAIT_L(n) asm volatile("s_waitcnt lgkmcnt(" #n ")" ::: "memory")
#define PG8_BAR __builtin_amdgcn_s_barrier()
#define PG8_SCHED __builtin_amdgcn_sched_barrier(0)
    Unit cur, nxt; int ui = 0;
    if (!S.next(0, cur)) return;
    f32x4 acc[2][2][4][2];
#pragma unroll
    for (int a = 0; a < 2; ++a)
#pragma unroll
        for (int b = 0; b < 2; ++b)
#pragma unroll
            for (int m = 0; m < 4; ++m)
#pragma unroll
                for (int n = 0; n < 2; ++n) acc[a][b][m][n] = (f32x4){0.f, 0.f, 0.f, 0.f};
    bf16x8 At[4][2], B0[2][2], B1[2][2];
    const char* cA = (const char*)g.A + (size_t)cur.pm * tstep; const char* cB = (const char*)g.Bt + (size_t)cur.pn * tstep;
    S.a_ready(cur);
    if constexpr (SP2) {
        PG8_STAGE(PG8_SB(0, 0), cB, voffB); PG8_STAGE(PG8_SB(0, 1), cB + hstep, voffB); PG8_STAGE(PG8_SA(0, 0), cA, voffA); PG8_STAGE(PG8_SA(0, 1), cA + hstep, voffA);
        if (wr == 1) PG8_BAR;
        PG8_WAIT_V(2); PG8_BAR;
        PG8_STAGE(PG8_SB(1, 0), cB + kstep, voffB); PG8_STAGE(PG8_SA(1, 0), cA + kstep, voffA); PG8_STAGE(PG8_SB(1, 1), cB + hstep + kstep, voffB);
        PG8_WAIT_V(6); PG8_BAR;
    } else {
        PG8_STAGE(PG8_SB(0, 0), cB, voffB); PG8_STAGE(PG8_SA(0, 0), cA, voffA); PG8_STAGE(PG8_SB(0, 1), cB + hstep, voffB); PG8_STAGE(PG8_SA(0, 1), cA + hstep, voffA);
        if (wr == 1) PG8_BAR;
        PG8_WAIT_V(4); PG8_BAR;
        PG8_STAGE(PG8_SB(1, 0), cB + kstep, voffB); PG8_STAGE(PG8_SA(1, 0), cA + kstep, voffA); PG8_STAGE(PG8_SB(1, 1), cB + hstep + kstep, voffB);
        PG8_WAIT_V(6); PG8_BAR;
    }
    for (;;) {
        const bool has_next = S.next(ui + 1, nxt);
        const char* nA = has_next ? (const char*)g.A + (size_t)nxt.pm * tstep : cA; const char* nB = has_next ? (const char*)g.Bt + (size_t)nxt.pn * tstep : cB;
        for (int t = 0; t < nt; t += 2) {
            const bool last = (t == nt - 2);
            const char* a1 = cA + (size_t)(t + 1) * kstep;
            const char* a2 = last ? nA : cA + (size_t)(t + 2) * kstep; const char* b2 = last ? nB : cB + (size_t)(t + 2) * kstep;
            const char* a3 = a2 + kstep; const char* b3 = b2 + kstep;
            if (last && has_next) S.a_ready(nxt);
            if constexpr (SP2) {
            PG8_LDB(B0, 0, 0); PG8_LDB(B1, 0, 1); PG8_SCHED; PG8_LDA(At, 0, 0); PG8_STAGE(PG8_SA(1, 1), a1 + hstep, voffA);
            PG8_WAIT_V(8); PG8_WAIT_L(0); PG8_BAR; PG8_MMA(0, 0, At, B0); PG8_MMA(0, 1, At, B1); PG8_BAR; PG8_SCHED;
            PG8_LDA(At, 0, 1); PG8_STAGE(PG8_SB(0, 0), b2, voffB); PG8_STAGE(PG8_SB(0, 1), b2 + hstep, voffB); PG8_STAGE(PG8_SA(0, 0), a2, voffA);
            PG8_WAIT_V(8); PG8_WAIT_L(0); PG8_BAR; PG8_MMA(1, 0, At, B0); PG8_MMA(1, 1, At, B1); PG8_BAR; PG8_SCHED;
            PG8_LDB(B0, 1, 0); PG8_LDB(B1, 1, 1); PG8_SCHED; PG8_LDA(At, 1, 0); PG8_STAGE(PG8_SA(0, 1), a2 + hstep, voffA);
            PG8_WAIT_V(8); PG8_WAIT_L(0); PG8_BAR; PG8_MMA(0, 0, At, B0); PG8_MMA(0, 1, At, B1); PG8_BAR; PG8_SCHED;
            PG8_LDA(At, 1, 1); PG8_STAGE(PG8_SB(1, 0), b3, voffB); PG8_STAGE(PG8_SB(1, 1), b3 + hstep, voffB); PG8_STAGE(PG8_SA(1, 0), a3, voffA);
            PG8_WAIT_V(8); PG8_WAIT_L(0); PG8_BAR; PG8_MMA(1, 0, At, B0); PG8_MMA(1, 1, At, B1); PG8_BAR; PG8_SCHED;
            } else {
            PG8_LDB(B0, 0, 0); PG8_SCHED; PG8_LDA(At, 0, 0); PG8_STAGE(PG8_SA(1, 1), a1 + hstep, voffA);
            PG8_WAIT_L(8); PG8_BAR; PG8_WAIT_L(0); PG8_MMA(0, 0, At, B0); PG8_BAR; PG8_SCHED;
            PG8_LDB(B1, 0, 1); PG8_STAGE(PG8_SB(0, 0), b2, voffB);
            PG8_BAR; PG8_WAIT_L(0); PG8_MMA(0, 1, At, B1); PG8_BAR;
            PG8_LDA(At, 0, 1); PG8_STAGE(PG8_SA(0, 0), a2, voffA);
            PG8_BAR; PG8_WAIT_L(0); PG8_MMA(1, 0, At, B0); PG8_BAR; PG8_SCHED;
            PG8_STAGE(PG8_SB(0, 1), b2 + hstep, voffB);
            PG8_WAIT_V(6); PG8_BAR; PG8_MMA(1, 1, At, B1); PG8_BAR;
            PG8_LDB(B0, 1, 0); PG8_SCHED; PG8_LDA(At, 1, 0); PG8_STAGE(PG8_SA(0, 1), a2 + hstep, voffA);
            PG8_WAIT_L(8); PG8_BAR; PG8_WAIT_L(0); PG8_MMA(0, 0, At, B0); PG8_BAR; PG8_SCHED;
            PG8_LDB(B1, 1, 1); PG8_STAGE(PG8_SB(1, 0), b3, voffB);
            PG8_BAR; PG8_WAIT_L(0); PG8_MMA(0, 1, At, B1); PG8_BAR;
            PG8_LDA(At, 1, 1); PG8_STAGE(PG8_SA(1, 0), a3, voffA);
            PG8_BAR; PG8_WAIT_L(0); PG8_MMA(1, 0, At, B0); PG8_BAR; PG8_SCHED;
            PG8_STAGE(PG8_SB(1, 1), b3 + hstep, voffB);
            PG8_WAIT_V(6); PG8_BAR; PG8_MMA(1, 1, At, B1); PG8_BAR;
            }
        }
        if constexpr (ALIGN_EPI) { if (wr == 0) PG8_BAR; }
        if constexpr (!Epi::AFTER_DRAIN) { E(acc, cur, wr, wc, fr, fq); S.done(cur); }
        if (!has_next) break;
#pragma unroll
        for (int a = 0; a < 2; ++a)
#pragma unroll
            for (int b = 0; b < 2; ++b)
#pragma unroll
                for (int m = 0; m < 4; ++m)
#pragma unroll
                    for (int n = 0; n < 2; ++n) acc[a][b][m][n] = (f32x4){0.f, 0.f, 0.f, 0.f};
        cur = nxt; cA = nA; cB = nB; ++ui;
        if constexpr (ALIGN_EPI) { if (wr == 1) PG8_BAR; }
    }
    PG8_WAIT_V(0);
    if constexpr (!ALIGN_EPI) { if (wr == 0) PG8_BAR; }
    PG8_BAR;
    if constexpr (Epi::AFTER_DRAIN) { E.fused(acc, cur, wr, wc, fr, fq, lds, wid, lane); S.done(cur); }
#undef PG8_SA
#undef PG8_SB
#undef PG8_STAGE
#undef PG8_LDA
#undef PG8_LDB
#undef PG8_MMA
#undef PG8_WAIT_V
#undef PG8_WAIT_L
#undef PG8_BAR
#undef PG8_SCHED
}
}
#define XB_TMO      128
#define XB_XCNT(j)  (256  + 64 * (j))
#define XB_XSUB(j)  (1280 + 64 * (j))
#define XB_XGEN(j)  (2304 + 64 * (j))
#define XB_TOP      3328
#define XB_TOPGEN   3392
#define XCD_BAR_WORDS 3456
#define XB_SPIN_CAP (1u << 18)

__device__ __forceinline__ unsigned xb_ld(unsigned* p)              { return __hip_atomic_load(p, __ATOMIC_RELAXED, __HIP_MEMORY_SCOPE_AGENT); }
__device__ __forceinline__ unsigned xb_add(unsigned* p, unsigned v) { return __hip_atomic_fetch_add(p, v, __ATOMIC_RELAXED, __HIP_MEMORY_SCOPE_AGENT); }
__device__ __forceinline__ unsigned xb_xcc_id() { return (unsigned)__builtin_amdgcn_s_getreg((3 << 11) | 20) & 0xFu; }
#define XB_SPIN(cond, bar) do { unsigned _sp = 0; while (cond) { __builtin_amdgcn_s_sleep(1); \
    if ((++_sp & 255u) == 0u) { if (xb_ld(&(bar)[XB_TMO])) break; if (_sp > XB_SPIN_CAP) { atomicAdd(&(bar)[XB_TMO], 1u); break; } } } } while (0)

struct XcdBarrier {
    unsigned* bar; unsigned x;
    volatile LAS unsigned* st;
};

__device__ __forceinline__ XcdBarrier xcd_barrier_post(unsigned* bar, volatile LAS unsigned* st) {
    XcdBarrier b; b.bar = bar; b.x = xb_xcc_id(); b.st = st;
    if (threadIdx.x == 0) (void)xb_add(&bar[XB_XCNT(b.x)], 1u);
    return b;
}
__device__ __forceinline__ void xcd_barrier_complete(unsigned* bar, unsigned x, unsigned& nloc, unsigned& nx) {
    const unsigned G = gridDim.x * gridDim.y * gridDim.z;
    unsigned sum, cnt, mine, sp = 0u;
    for (;;) {
        sum = 0u; cnt = 0u; mine = 0u;
#pragma unroll
        for (unsigned j = 0; j < 16; ++j) { const unsigned c = xb_ld(&bar[XB_XCNT(j)]); sum += c; cnt += (c > 0u) ? 1u : 0u; mine = (j == x) ? c : mine; }
        if (sum == G) break;
        __builtin_amdgcn_s_sleep(1);
        if ((++sp & 255u) == 0u) { if (xb_ld(&bar[XB_TMO])) break; if (sp > XB_SPIN_CAP) { atomicAdd(&bar[XB_TMO], 1u); break; } }
    }
    nloc = mine > 0u ? mine : 1u; nx = cnt > 0u ? cnt : 1u;
}

__device__ __forceinline__ void xcd_barrier(const XcdBarrier& b) {
    asm volatile("s_waitcnt vmcnt(0)" ::: "memory");
    __syncthreads();
    if (threadIdx.x == 0) {
        unsigned* bar = b.bar;
        __builtin_amdgcn_s_waitcnt(0);
        unsigned nloc = b.st[0], nx = b.st[1];
        if (nloc == 0u) { xcd_barrier_complete(bar, b.x, nloc, nx); b.st[0] = nloc; b.st[1] = nx; }
        const unsigned old = xb_add(&bar[XB_XSUB(b.x)], 1u);
        const unsigned gen = old / nloc;
        if (old + 1u == (gen + 1u) * nloc) {
            __builtin_amdgcn_fence(__ATOMIC_RELEASE, "agent");
            asm volatile("s_waitcnt vmcnt(0)" ::: "memory");
            const unsigned og = xb_add(&bar[XB_TOP], 1u);
            const unsigned tg = og / nx;
            if (og + 1u == (tg + 1u) * nx) xb_add(&bar[XB_TOPGEN], 1u);
            else XB_SPIN(xb_ld(&bar[XB_TOPGEN]) == tg, bar);
            __builtin_amdgcn_fence(__ATOMIC_ACQUIRE, "agent");
            xb_add(&bar[XB_XGEN(b.x)], 1u);
            asm volatile("s_waitcnt vmcnt(0)" ::: "memory");
        } else {
            XB_SPIN(xb_ld(&bar[XB_XGEN(b.x)]) == gen, bar);
            __builtin_amdgcn_fence(__ATOMIC_ACQUIRE, "agent");
            asm volatile("s_waitcnt vmcnt(0)" ::: "memory");
        }
    }
    __syncthreads();
}

struct EpiStoreBf16 {
    static constexpr bool PERM = true, AFTER_DRAIN = false;
    bf16* O; int ldc; int pn_mask;
    __device__ __forceinline__ void operator()(const pg8::f32x4 (&acc)[2][2][4][2], const pg8::Unit& u, int wr, int wc, int fr_, int fq_) const {
        int t_ = threadIdx.x; asm volatile("" : "+v"(t_)); const int fr = t_ & 15, fq = (t_ >> 4) & 3; (void)fr_; (void)fq_;
        const int row0 = u.pm * 256 + wr * 64 + fr, col0 = (u.pn & pn_mask) * 256 + wc * 32 + 8 * fq;
#pragma unroll
        for (int ai = 0; ai < 2; ++ai)
#pragma unroll
            for (int m = 0; m < 4; ++m) { bf16* rowp = O + (size_t)(row0 + ai * 128 + m * 16) * ldc + col0;
#pragma unroll
                for (int bj = 0; bj < 2; ++bj) { const pg8::f32x4 v0 = acc[ai][bj][m][0], v1 = acc[ai][bj][m][1];
                    v4u w; w.x = pg8::cvt_pk_bf16(v0[0], v0[1]); w.y = pg8::cvt_pk_bf16(v0[2], v0[3]); w.z = pg8::cvt_pk_bf16(v1[0], v1[1]); w.w = pg8::cvt_pk_bf16(v1[2], v1[3]);
                    *(v4u*)(rowp + bj * 128) = w; } }
    }
};
struct EpiProj {
    static constexpr bool PERM = true, AFTER_DRAIN = false;
    bf16* HM; bf16* PLR;
    __device__ __forceinline__ void operator()(const pg8::f32x4 (&acc)[2][2][4][2], const pg8::Unit& u, int wr, int wc, int fr_, int fq_) const {
        int t_ = threadIdx.x; asm volatile("" : "+v"(t_)); const int fr = t_ & 15, fq = (t_ >> 4) & 3; (void)fr_; (void)fq_;
        const int row0 = u.pm * 256 + wr * 64 + fr, colb = u.pn * 256 + wc * 32 + 8 * fq;
#pragma unroll
        for (int bj = 0; bj < 2; ++bj) { const int col0 = colb + bj * 128;
            if (col0 >= PROJW) continue;
            const bool lora = col0 >= 3072 && col0 < SHIFTW;
            const int idx = col0 < 3072 ? col0 : col0 - (SHIFTW - 3072);
            const size_t hbase = (size_t)(idx >> 10) * HM_PART + (size_t)((idx >> 6) & 15) * HM_HEAD + (idx & 63);
#pragma unroll
            for (int ai = 0; ai < 2; ++ai)
#pragma unroll
                for (int m = 0; m < 4; ++m) { const int row = row0 + ai * 128 + m * 16;
                    bf16* dst = lora ? PLR + (size_t)row * 288 + (col0 - 3072) : HM + hbase + (size_t)(row >> 12) * HM_BATCH + (size_t)(row & (SEQ - 1)) * HD;
                    const pg8::f32x4 v0 = acc[ai][bj][m][0], v1 = acc[ai][bj][m][1];
                    v4u w; w.x = pg8::cvt_pk_bf16(v0[0], v0[1]); w.y = pg8::cvt_pk_bf16(v0[2], v0[3]); w.z = pg8::cvt_pk_bf16(v1[0], v1[1]); w.w = pg8::cvt_pk_bf16(v1[2], v1[3]);
                    *(v4u*)dst = w; } }
    }
};
struct EpiGateUp {
    static constexpr bool PERM = true, AFTER_DRAIN = false;
    const float* sw; bf16* HG;
    __device__ __forceinline__ void operator()(const pg8::f32x4 (&acc)[2][2][4][2], const pg8::Unit& u, int wr, int wc, int fr_, int fq_) const {
        int t_ = threadIdx.x; asm volatile("" : "+v"(t_)); const int fr = t_ & 15, fq = (t_ >> 4) & 3; (void)fr_; (void)fq_;
        const int pl = u.pn & 3, row0 = u.pm * 256 + wr * 64 + fr, col0 = pl * 128 + wc * 32 + 8 * fq;
#pragma unroll
        for (int ai = 0; ai < 2; ++ai)
#pragma unroll
            for (int m = 0; m < 4; ++m) { const int row = row0 + ai * 128 + m * 16; const float w = sw[row]; float h[8];
#pragma unroll
                for (int n = 0; n < 2; ++n)
#pragma unroll
                    for (int j = 0; j < 4; ++j) { const float g = acc[ai][0][m][n][j], up = acc[ai][1][m][n][j]; h[4 * n + j] = g * sigmoid_f(g) * up * w; }
                v4u o; o.x = pg8::cvt_pk_bf16(h[0], h[1]); o.y = pg8::cvt_pk_bf16(h[2], h[3]); o.z = pg8::cvt_pk_bf16(h[4], h[5]); o.w = pg8::cvt_pk_bf16(h[6], h[7]);
                *(v4u*)(HG + (size_t)row * FF + col0) = o; }
    }
};
struct EpiResGate {
    static constexpr bool PERM = true, AFTER_DRAIN = false;
    const float* x; const float* gate; float* X1;
    __device__ __forceinline__ void operator()(const pg8::f32x4 (&acc)[2][2][4][2], const pg8::Unit& u, int wr, int wc, int fr_, int fq_) const {
        int t_ = threadIdx.x; asm volatile("" : "+v"(t_)); const int fr = t_ & 15, fq = (t_ >> 4) & 3; (void)fr_; (void)fq_;
        const int row0 = u.pm * 256 + wr * 64 + fr, col0 = u.pn * 256 + wc * 32 + 8 * fq;
        const float* gp = gate + (size_t)((u.pm * 256) >> 12) * 12288;
#pragma unroll
        for (int bj = 0; bj < 2; ++bj) { const int c = col0 + bj * 128; const pg8::f32x4 g0 = *(const pg8::f32x4*)(gp + c), g1 = *(const pg8::f32x4*)(gp + c + 4);
#pragma unroll
            for (int ai = 0; ai < 2; ++ai)
#pragma unroll
                for (int m = 0; m < 4; ++m) { const size_t off = (size_t)(row0 + ai * 128 + m * 16) * DM + c;
                    const pg8::f32x4 x0 = *(const pg8::f32x4*)(x + off), x1 = *(const pg8::f32x4*)(x + off + 4);
                    *(pg8::f32x4*)(X1 + off) = x0 + g0 * acc[ai][bj][m][0]; *(pg8::f32x4*)(X1 + off + 4) = x1 + g1 * acc[ai][bj][m][1]; } }
    }
};
struct EpiLora {
    static constexpr bool PERM = false, AFTER_DRAIN = false;
    float* LW; bf16* AA; bf16* GG;
    __device__ __forceinline__ void operator()(const pg8::f32x4 (&acc)[2][2][4][2], const pg8::Unit& u, int wr, int wc, int fr_, int fq_) const {
        int t_ = threadIdx.x; asm volatile("" : "+v"(t_)); const int fr = t_ & 15, fq = (t_ >> 4) & 3; (void)fr_; (void)fq_;
        const int type = u.pn >> 2, row0 = u.pm * 256 + wr * 64 + fr, col0 = (u.pn & 3) * 256 + wc * 32 + 4 * fq;
        bf16* hb = (type == 1) ? AA : GG;
#pragma unroll
        for (int bj = 0; bj < 2; ++bj)
#pragma unroll
            for (int n = 0; n < 2; ++n) { const int c = col0 + bj * 128 + n * 16;
#pragma unroll
                for (int ai = 0; ai < 2; ++ai)
#pragma unroll
                    for (int m = 0; m < 4; ++m) { const size_t off = (size_t)(row0 + ai * 128 + m * 16) * CW + c; const pg8::f32x4 v = acc[ai][bj][m][n];
                        if (type == 0) *(pg8::f32x4*)(LW + off) = v;
                        else { v2u o; o.x = pg8::cvt_pk_bf16(v[0], v[1]); o.y = pg8::cvt_pk_bf16(v[2], v[3]); *(v2u*)(hb + off) = o; } } }
    }
};
struct GroupOrder {
    const unsigned* te; int nrt, ncol, G, c;
    __device__ __forceinline__ bool next(int i, pg8::Unit& u) const {
        const long L = (long)i * G + c; if (L >= (long)nrt * ncol) return false;
        const int rt = (int)(L / ncol), pl = (int)(L - (long)rt * ncol);
        u.pm = rt; u.pn = (int)te[rt] * ncol + pl; return true;
    }
    __device__ __forceinline__ void a_ready(const pg8::Unit&) const {}
    __device__ __forceinline__ void done(const pg8::Unit&) const {}
};

struct GroupOrder2 {
    const unsigned* te; int ncol, base, count, Gp, cp;
    __device__ __forceinline__ bool next(int i, pg8::Unit& u) const {
        const long k = (long)i * Gp + cp; if (cp < 0 || k >= count) return false;
        const int L = base + (int)k, rt = L / ncol, pl = L - rt * ncol;
        u.pm = rt; u.pn = (int)te[rt] * ncol + pl; return true;
    }
    __device__ __forceinline__ void a_ready(const pg8::Unit&) const {}
    __device__ __forceinline__ void done(const pg8::Unit&) const {}
};

#define MFMA16(a, b, c) __builtin_amdgcn_mfma_f32_16x16x16bf16_1k(a, b, c, 0, 0, 0)
constexpr int NUNIT = BATCH * NHEAD * (SEQ / 64);
constexpr int LA_GF = 0, LA_SEG = 16384, LA_PL = 18432, LA_RT = 20480, LA_QT = 28672, LA_KT = 36864, LA_BT = 45056, LA_VT = 53248,
              LA_AQB = 61440, LA_AQK = 69632, LA_ARB = 77824, LA_ARK = 86016, LA_DG = 94208, LA_DL = 98304, LA_PRM = 100352;
__device__ __forceinline__ int swz(int row, int chunk) { return row * 128 + ((chunk ^ ((row >> 1) & 7)) << 4); }
__device__ __forceinline__ s16x4 tr_read(LAS unsigned char* base, int r0, int cb, int n) {
    return __builtin_bit_cast(s16x4, __builtin_amdgcn_ds_read_tr16_b64_v4i16((LAS s16x4*)(base + swz(r0 + (n >> 2), 2 * cb + ((n & 3) >> 1)) + 8 * (n & 1)))); }
__device__ __forceinline__ s16x4 row_read4(LAS unsigned char* base, int row, int col0) {
    return *(const LAS s16x4*)(base + swz(row, col0 >> 3) + 2 * (col0 & 7)); }
__device__ __forceinline__ s16x4 pack4(const f32x4 v) { v2u w; w.x = pk2(v[0], v[1]); w.y = pk2(v[2], v[3]); return __builtin_bit_cast(s16x4, w); }
__device__ __forceinline__ s16x4 pack4n(const f32x4 v) { v2u w; w.x = pk2(-v[0], -v[1]); w.y = pk2(-v[2], -v[3]); return __builtin_bit_cast(s16x4, w); }
__device__ __forceinline__ f32x4 unpack4(const s16x4 s) { const v2u w = __builtin_bit_cast(v2u, s); return (f32x4){bflo(w.x), bfhi(w.x), bflo(w.y), bfhi(w.y)}; }

#define LGKM0() do { asm volatile("s_waitcnt lgkmcnt(0)" ::: "memory"); __builtin_amdgcn_sched_barrier(0); } while (0)
#define LDS_BARRIER() do { asm volatile("s_waitcnt lgkmcnt(0)" ::: "memory"); __builtin_amdgcn_s_barrier(); asm volatile("" ::: "memory"); } while (0)
__device__ __forceinline__ void scanA(const Args& a, LAS unsigned char* lds) {
    const int tid = threadIdx.x, lane = tid & 63, wave = __builtin_amdgcn_readfirstlane(tid >> 6), n = lane & 15, g = lane >> 4;
    LAS float* GF = (LAS float*)(lds + LA_GF); LAS float* SEG = (LAS float*)(lds + LA_SEG); LAS float* PLs = (LAS float*)(lds + LA_PL); LAS float* DG = (LAS float*)(lds + LA_DG);
    const int tk = tid >> 3, c8 = 8 * (tid & 7);
    v4u nr4, nk4, nv4, pr4, pk4, pv4, na4; f32x4 nl0, nl1;
#define SCANA_LOAD(U) do { const int bh_ = (U) >> 6, ck_ = (U) & 63, h_ = bh_ & 15; const size_t m_ = (size_t)(bh_ >> 4) * SEQ + 64 * ck_ + tk; \
        const bf16* pc_ = (const bf16*)(a.ws + WS_P) + (size_t)(bh_ >> 4) * HM_BATCH + (size_t)h_ * HM_HEAD + (size_t)(64 * ck_ + tk) * HD + c8; const bf16* pp_ = pc_ - ((64 * ck_ + tk) != 0 ? HD : 0); \
        nr4 = *(const v4u*)pc_; nk4 = *(const v4u*)(pc_ + HM_PART); nv4 = *(const v4u*)(pc_ + 2 * HM_PART); pr4 = *(const v4u*)pp_; pk4 = *(const v4u*)(pp_ + HM_PART); pv4 = *(const v4u*)(pp_ + 2 * HM_PART); \
        const size_t off_ = m_ * CW + h_ * 64 + c8; na4 = *(const v4u*)((const bf16*)(a.ws + WS_AA) + off_); \
        nl0 = *(const f32x4*)((const float*)(a.ws + WS_LW) + off_); nl1 = *(const f32x4*)((const float*)(a.ws + WS_LW) + off_ + 4); } while (0)
#define SCANA_UNIT(IDX) (((((IDX) >> 10) * 16 + ((IDX) & 15)) << 6) + (((IDX) >> 4) & 63))
    if ((int)blockIdx.x < NUNIT) SCANA_LOAD(SCANA_UNIT((int)blockIdx.x));
    STAMP_DECL;
    LAS float* PRM = (LAS float*)(lds + LA_PRM);
    int hcur = -1;
    for (int idx = blockIdx.x; idx < NUNIT; idx += gridDim.x) {
        const int unit = SCANA_UNIT(idx);
        int tid_o = threadIdx.x; asm volatile("" : "+v"(tid_o));
        const int tid = tid_o, lane = tid & 63, n = lane & 15, g = lane >> 4, tk = tid >> 3, c8 = 8 * (tid & 7);
        STAMP_BEGIN(5); STAMP_BEGIN(1);
        const int h = (unit >> 6) & 15, ch0 = h * 64 + c8; const bool first = ((unit & 63) == 0) && (tk == 0);
        if (h != hcur) { hcur = h;
            if (tid < 448) { const int which = tid >> 6, c = tid & 63; const float* src = (which == 0) ? a.in[I_MU] : (which == 1) ? a.in[I_MU] + 1024 : (which == 2) ? a.in[I_MU] + 2048 :
                    (which == 3) ? a.in[I_A0] : (which == 4) ? a.in[I_KK] : (which == 5) ? a.in[I_KA] : a.in[I_W0];
                PRM[tid] = src[h * 64 + c]; }
            LDS_BARRIER(); }
        float pmr[8], pmk[8], pmv[8], pa0[8], pkk[8], pka[8], pw0[8];
        { f32x4 pv[14];
#pragma unroll
          for (int q = 0; q < 7; ++q) { pv[2 * q] = *(const LAS f32x4*)(PRM + 64 * q + c8); pv[2 * q + 1] = *(const LAS f32x4*)(PRM + 64 * q + c8 + 4); }
          LGKM0();
#pragma unroll
          for (int i = 0; i < 8; ++i) { pmr[i] = pv[0 + (i >> 2)][i & 3]; pmk[i] = pv[2 + (i >> 2)][i & 3]; pmv[i] = pv[4 + (i >> 2)][i & 3]; pa0[i] = pv[6 + (i >> 2)][i & 3];
              pkk[i] = pv[8 + (i >> 2)][i & 3]; pka[i] = pv[10 + (i >> 2)][i & 3]; pw0[i] = pv[12 + (i >> 2)][i & 3]; } }
        float rf[8], kf[8], vf8[8], qf8[8], bf8[8]; f32x4 l0, l1;
        { float av[8], kkv[8]; float ssq = 0.f;
#pragma unroll
          for (int i = 0; i < 8; ++i) { const int wd = i >> 1; const bool hi = i & 1;
              const float cr = hi ? bfhi(nr4[wd]) : bflo(nr4[wd]), ckk = hi ? bfhi(nk4[wd]) : bflo(nk4[wd]), cv = hi ? bfhi(nv4[wd]) : bflo(nv4[wd]);
              const float qr = first ? 0.f : (hi ? bfhi(pr4[wd]) : bflo(pr4[wd])), qk = first ? 0.f : (hi ? bfhi(pk4[wd]) : bflo(pk4[wd])), qv = first ? 0.f : (hi ? bfhi(pv4[wd]) : bflo(pv4[wd]));
              rf[i] = cr + (qr - cr) * pmr[i]; kf[i] = ckk + (qk - ckk) * pmk[i]; vf8[i] = cv + (qv - cv) * pmv[i];
              av[i] = sigmoid_f((hi ? bfhi(na4[wd]) : bflo(na4[wd])) + pa0[i]);
              kkv[i] = kf[i] * pkk[i]; ssq += kkv[i] * kkv[i]; }
          ssq += __shfl_xor(ssq, 1); ssq += __shfl_xor(ssq, 2); ssq += __shfl_xor(ssq, 4);
          const float inv = 1.f / fmaxf(sqrtf(ssq), 1e-12f);
#pragma unroll
          for (int i = 0; i < 8; ++i) { qf8[i] = kkv[i] * inv; bf8[i] = qf8[i] * av[i]; kf[i] = kf[i] * (1.f + (av[i] - 1.f) * pka[i]); }
#pragma unroll
          for (int i = 0; i < 4; ++i) { const float z0 = -(nl0[i] + pw0[i]), z1 = -(nl1[i] + pw0[4 + i]);
              const float s0 = fmaxf(z0, 0.f) + __logf(1.f + __expf(-fabsf(z0))), s1 = fmaxf(z1, 0.f) + __logf(1.f + __expf(-fabsf(z1)));
              l0[i] = -__expf(-s0 - 0.5f); l1[i] = -__expf(-s1 - 0.5f); }
          const size_t off = ((size_t)(unit >> 10) * SEQ + 64 * (unit & 63) + tk) * CW + ch0; v4u w;
          w.x = pk2(rf[0], rf[1]); w.y = pk2(rf[2], rf[3]); w.z = pk2(rf[4], rf[5]); w.w = pk2(rf[6], rf[7]); *(v4u*)((bf16*)(a.ws + WS_R) + off) = w;
          w.x = pk2(kf[0], kf[1]); w.y = pk2(kf[2], kf[3]); w.z = pk2(kf[4], kf[5]); w.w = pk2(kf[6], kf[7]); *(v4u*)((bf16*)(a.ws + WS_K2) + off) = w;
          w.x = pk2(vf8[0], vf8[1]); w.y = pk2(vf8[2], vf8[3]); w.z = pk2(vf8[4], vf8[5]); w.w = pk2(vf8[6], vf8[7]); *(v4u*)((bf16*)(a.ws + WS_V) + off) = w; }
        *(LAS f32x4*)(GF + tk * 64 + c8) = l0; *(LAS f32x4*)(GF + tk * 64 + c8 + 4) = l1;
        LDS_BARRIER();
        { const int c = tid & 63, sg = tid >> 6; float gv[8], run = 0.f;
#pragma unroll
          for (int i = 0; i < 8; ++i) gv[i] = GF[(8 * sg + i) * 64 + c];
          LGKM0();
#pragma unroll
          for (int i = 0; i < 8; ++i) { run += gv[i]; GF[(8 * sg + i) * 64 + c] = run; }
          SEG[sg * 64 + c] = run; }
        LDS_BARRIER();
        { const int sg = tk >> 3; float gg[8], lw[8];
          f32x4 gq[2], sq[7][2];
          gq[0] = *(const LAS f32x4*)(GF + tk * 64 + c8); gq[1] = *(const LAS f32x4*)(GF + tk * 64 + c8 + 4);
#pragma unroll
          for (int s2 = 0; s2 < 7; ++s2) { sq[s2][0] = *(const LAS f32x4*)(SEG + s2 * 64 + c8); sq[s2][1] = *(const LAS f32x4*)(SEG + s2 * 64 + c8 + 4); }
          LGKM0();
#pragma unroll
          for (int i = 0; i < 8; ++i) { float x = gq[i >> 2][i & 3];
#pragma unroll
              for (int s2 = 0; s2 < 7; ++s2) x += (s2 < sg) ? sq[s2][i >> 2][i & 3] : 0.f;
              gg[i] = x; lw[i] = (i < 4) ? l0[i] : l1[i - 4]; }
          float rr[8], qq[8], kk[8], bb[8];
#pragma unroll
          for (int i = 0; i < 4; ++i) { const int e0 = 2 * i, e1 = 2 * i + 1;
              const float eg0 = __expf(gg[e0]), eg1 = __expf(gg[e1]), en0 = __expf(-gg[e0]), en1 = __expf(-gg[e1]), em0 = __expf(gg[e0] - lw[e0]), em1 = __expf(gg[e1] - lw[e1]);
              rr[e0] = rf[e0] * eg0; rr[e1] = rf[e1] * eg1; qq[e0] = qf8[e0] * em0; qq[e1] = qf8[e1] * em1;
              kk[e0] = kf[e0] * en0; kk[e1] = kf[e1] * en1; bb[e0] = bf8[e0] * en0; bb[e1] = bf8[e1] * en1;
              if (tk == 63) { PLs[c8 + e0] = eg0; PLs[c8 + e1] = eg1; } }
          const int so = swz(tk, tid & 7); v4u w;
          w.x = pk2(rr[0], rr[1]); w.y = pk2(rr[2], rr[3]); w.z = pk2(rr[4], rr[5]); w.w = pk2(rr[6], rr[7]); *(LAS v4u*)(lds + LA_RT + so) = w;
          w.x = pk2(qq[0], qq[1]); w.y = pk2(qq[2], qq[3]); w.z = pk2(qq[4], qq[5]); w.w = pk2(qq[6], qq[7]); *(LAS v4u*)(lds + LA_QT + so) = w;
          w.x = pk2(kk[0], kk[1]); w.y = pk2(kk[2], kk[3]); w.z = pk2(kk[4], kk[5]); w.w = pk2(kk[6], kk[7]); *(LAS v4u*)(lds + LA_KT + so) = w;
          w.x = pk2(bb[0], bb[1]); w.y = pk2(bb[2], bb[3]); w.z = pk2(bb[4], bb[5]); w.w = pk2(bb[6], bb[7]); *(LAS v4u*)(lds + LA_BT + so) = w;
          w.x = pk2(vf8[0], vf8[1]); w.y = pk2(vf8[2], vf8[3]); w.z = pk2(vf8[4], vf8[5]); w.w = pk2(vf8[6], vf8[7]); *(LAS v4u*)(lds + LA_VT + so) = w; }
        LDS_BARRIER();
        STAMP_END(1); STAMP_BEGIN(2);
        if (idx + (int)gridDim.x < NUNIT) SCANA_LOAD(SCANA_UNIT(idx + (int)gridDim.x));
        for (int id = wave; id < 40; id += NWAVES) {
            const int mat = id / 10, p = id - mat * 10, tb = p < 1 ? 0 : (p < 3 ? 1 : (p < 6 ? 2 : 3)), sb = p - tb * (tb + 1) / 2;
            LAS unsigned char* Lft = lds + ((mat & 1) ? LA_KT : LA_BT); LAS unsigned char* Rgt = lds + ((mat & 2) ? LA_RT : LA_QT);
            f32x4 acc = (f32x4){0.f, 0.f, 0.f, 0.f};
#pragma unroll
            for (int ks = 0; ks < 2; ++ks) { const bf16x8 af = *(const LAS bf16x8*)(Lft + swz(16 * sb + n, 4 * ks + g)), bfr = *(const LAS bf16x8*)(Rgt + swz(16 * tb + n, 4 * ks + g));
                acc = __builtin_amdgcn_mfma_f32_16x16x32_bf16(af, bfr, acc, 0, 0, 0); }
            const int t = 16 * tb + n, s0 = 16 * sb + 4 * g;
#pragma unroll
            for (int j = 0; j < 4; ++j) { const bool keep = (mat & 2) ? (s0 + j <= t) : (s0 + j < t); if (!keep) acc[j] = 0.f; }
            LAS unsigned char* dst = lds + (mat == 0 ? LA_AQB : (mat == 1 ? LA_AQK : (mat == 2 ? LA_ARB : LA_ARK)));
            v2u w; w.x = pk2(acc[0], acc[1]); w.y = pk2(acc[2], acc[3]);
            *(LAS v2u*)(dst + swz(t, s0 >> 3) + 2 * (s0 & 7)) = w;
            if (mat == 0 && sb == tb) *(LAS f32x4*)(DG + tb * 256 + n * 16 + 4 * g) = acc;
        }
        LDS_BARRIER();
        STAMP_END(2); STAMP_BEGIN(3);
        const bool isU = wave >= 4; const int cb = wave & 3;
        LAS unsigned char* AQB = lds + LA_AQB; LAS unsigned char* AQK = lds + LA_AQK; LAS unsigned char* ARB = lds + LA_ARB; LAS unsigned char* ARK = lds + LA_ARK;
        s16x4 vf[4], xn[4], fqb[6], frb[10], fbt[16];
        f32x4 rhs[4], y1a[4], hma[4], rti[4];
        if (isU) {
            s16x4 fqk[10], frk[10], fkt[16];
#pragma unroll
            for (int k = 0; k < 4; ++k) vf[k] = tr_read(lds + LA_VT, 16 * k + 4 * g, cb, n);
#pragma unroll
            for (int i = 0; i < 4; ++i)
#pragma unroll
                for (int k = 0; k < 4; ++k) { if (k <= i) { fqk[i * (i + 1) / 2 + k] = row_read4(AQK, 16 * i + n, 16 * k + 4 * g); frk[i * (i + 1) / 2 + k] = row_read4(ARK, 16 * i + n, 16 * k + 4 * g); }
                    fkt[4 * i + k] = tr_read(lds + LA_KT, 16 * k + 4 * g, i, n); }
            LGKM0();
#pragma unroll
            for (int i = 0; i < 4; ++i) { f32x4 acc = (f32x4){0.f, 0.f, 0.f, 0.f}, ac2 = acc, ac3 = acc;
#pragma unroll
                for (int k = 0; k < 4; ++k) { if (k <= i) { acc = MFMA16(fqk[i * (i + 1) / 2 + k], vf[k], acc); ac2 = MFMA16(frk[i * (i + 1) / 2 + k], vf[k], ac2); }
                    ac3 = MFMA16(vf[k], fkt[4 * i + k], ac3); }
                rhs[i] = acc; y1a[i] = ac2; hma[i] = ac3; rti[i] = acc; }
        } else {
            if (lane < 16) {
                const LAS float* A = DG + wave * 256; float x[16]; f32x4 ar[16][4];
                int lj = lane; asm volatile("" : "+v"(lj));
                x[0] = (lj == 0) ? 1.f : 0.f;
#pragma unroll
                for (int t = 1; t < 9; ++t)
#pragma unroll
                    for (int q = 0; q < 4; ++q) if (4 * q < t) ar[t][q] = *(const LAS f32x4*)(A + t * 16 + 4 * q);
                LGKM0();
#pragma unroll
                for (int t = 1; t < 9; ++t) { float a0 = (t == lj) ? 1.f : 0.f, a1 = 0.f;
#pragma unroll
                    for (int s2 = 0; s2 < t; ++s2) { if (s2 & 1) a1 -= ar[t][s2 >> 2][s2 & 3] * x[s2]; else a0 -= ar[t][s2 >> 2][s2 & 3] * x[s2]; }
                    x[t] = a0 + a1; }
#pragma unroll
                for (int t = 9; t < 13; ++t)
#pragma unroll
                    for (int q = 0; q < 4; ++q) if (4 * q < t) ar[t][q] = *(const LAS f32x4*)(A + t * 16 + 4 * q);
                LGKM0();
#pragma unroll
                for (int t = 9; t < 13; ++t) { float a0 = (t == lj) ? 1.f : 0.f, a1 = 0.f;
#pragma unroll
                    for (int s2 = 0; s2 < t; ++s2) { if (s2 & 1) a1 -= ar[t][s2 >> 2][s2 & 3] * x[s2]; else a0 -= ar[t][s2 >> 2][s2 & 3] * x[s2]; }
                    x[t] = a0 + a1; }
#pragma unroll
                for (int t = 13; t < 16; ++t)
#pragma unroll
                    for (int q = 0; q < 4; ++q) if (4 * q < t) ar[t][q] = *(const LAS f32x4*)(A + t * 16 + 4 * q);
                LGKM0();
#pragma unroll
                for (int t = 13; t < 16; ++t) { float a0 = (t == lj) ? 1.f : 0.f, a1 = 0.f;
#pragma unroll
                    for (int s2 = 0; s2 < t; ++s2) { if (s2 & 1) a1 -= ar[t][s2 >> 2][s2 & 3] * x[s2]; else a0 -= ar[t][s2 >> 2][s2 & 3] * x[s2]; }
                    x[t] = a0 + a1; }
                LAS bf16* D = (LAS bf16*)(lds + LA_DL) + wave * 256;
#pragma unroll
                for (int t = 0; t < 16; ++t) D[t * 16 + lane] = (bf16)f2bf(x[t]);
            }
#pragma unroll
            for (int i = 0; i < 4; ++i) { rhs[i] = unpack4(tr_read(lds + LA_QT, 16 * i + 4 * g, cb, n)); rti[i] = unpack4(tr_read(lds + LA_RT, 16 * i + 4 * g, cb, n)); vf[i] = (s16x4){0, 0, 0, 0}; y1a[i] = (f32x4){0.f, 0.f, 0.f, 0.f}; hma[i] = y1a[i]; }
        }
#pragma unroll
        for (int i = 0; i < 4; ++i)
#pragma unroll
            for (int k = 0; k < 4; ++k) { if (k < i) fqb[i * (i - 1) / 2 + k] = row_read4(AQB, 16 * i + n, 16 * k + 4 * g); if (k <= i) frb[i * (i + 1) / 2 + k] = row_read4(ARB, 16 * i + n, 16 * k + 4 * g);
                fbt[4 * i + k] = tr_read(lds + LA_BT, 16 * k + 4 * g, i, n); }
        LDS_BARRIER();
        STAMP_END(3); STAMP_BEGIN(4);
        {
            s16x4 df[4];
#pragma unroll
            for (int i = 0; i < 4; ++i) df[i] = *(const LAS s16x4*)(lds + LA_DL + i * 512 + n * 32 + 8 * g);
            const float plv[4] = {PLs[n], PLs[16 + n], PLs[32 + n], PLs[48 + n]};
            LGKM0();
#pragma unroll
            for (int i = 0; i < 4; ++i) { f32x4 acc = rhs[i];
#pragma unroll
                for (int k = 0; k < 4; ++k) if (k < i) acc = MFMA16(fqb[i * (i - 1) / 2 + k], xn[k], acc);
                const f32x4 xi = MFMA16(df[i], pack4(acc), ((f32x4){0.f, 0.f, 0.f, 0.f}));
                xn[i] = pack4n(xi); }
            if (!isU) {
                bf16* RH = (bf16*)(a.ws + WS_RH) + (size_t)unit * 4096;
#pragma unroll
                for (int i = 0; i < 4; ++i) { f32x4 acc = rti[i];
#pragma unroll
                    for (int k = 0; k < 4; ++k) if (k <= i) acc = MFMA16(frb[i * (i + 1) / 2 + k], xn[k], acc);
#pragma unroll
                    for (int j = 0; j < 4; ++j) RH[(16 * i + 4 * g + j) * 64 + 16 * cb + n] = (bf16)f2bf(acc[j]); }
                bf16* GT = (bf16*)(a.ws + WS_GT) + (size_t)unit * 4096;
#pragma unroll
                for (int c2b = 0; c2b < 4; ++c2b) { f32x4 acc = (f32x4){0.f, 0.f, 0.f, 0.f};
#pragma unroll
                    for (int k = 0; k < 4; ++k) acc = MFMA16(xn[k], fbt[4 * c2b + k], acc);
                    acc *= plv[c2b]; *(v2u*)(GT + (16 * c2b + n) * 64 + 16 * cb + 4 * g) = __builtin_bit_cast(v2u, pack4(acc)); }
            } else {
                float* Y1 = (float*)(a.ws + WS_Y1) + (size_t)unit * 4096;
#pragma unroll
                for (int i = 0; i < 4; ++i) { f32x4 acc = y1a[i];
#pragma unroll
                    for (int k = 0; k < 4; ++k) if (k <= i) acc = MFMA16(frb[i * (i + 1) / 2 + k], xn[k], acc);
#pragma unroll
                    for (int j = 0; j < 4; ++j) Y1[(16 * i + 4 * g + j) * 64 + 16 * cb + n] = acc[j]; }
                float* HM = (float*)(a.ws + WS_HM) + (size_t)unit * 4096;
#pragma unroll
                for (int c2b = 0; c2b < 4; ++c2b) { f32x4 acc = hma[c2b];
#pragma unroll
                    for (int k = 0; k < 4; ++k) acc = MFMA16(xn[k], fbt[4 * c2b + k], acc);
#pragma unroll
                    for (int j = 0; j < 4; ++j) HM[(16 * cb + 4 * g + j) * 64 + 16 * c2b + n] = acc[j] * plv[c2b]; }
            }
            if (wave == 0) ((float*)(a.ws + WS_PLV))[(size_t)unit * 64 + lane] = PLs[lane];
        }
        LDS_BARRIER();
        STAMP_END(4); STAMP_END(5);
    }
}

constexpr int LB_SLOT = 13312, LB_NPIECE = 13, LB_PER_WAVE = 4, LB_NSLOT = 8, LB_DIST = 7;
__device__ __forceinline__ void chainB_issue(const Args& a, LAS unsigned char* lds, size_t unit, int vb, int step, int lw, int lane) {
    const unsigned char* gt = a.ws + WS_GT + unit * 8192; const unsigned char* hm = a.ws + WS_HM + unit * 16384 + vb * 4096; const unsigned char* pv = a.ws + WS_PLV + unit * 256;
#pragma unroll
    for (int i = 0; i < LB_PER_WAVE; ++i) { int p = lw + 4 * i; p = p < LB_NPIECE - 1 ? p : LB_NPIECE - 1;
        const unsigned char* src = (p < 8) ? gt + p * 1024 : ((p < 12) ? hm + (p - 8) * 1024 : pv);
        __builtin_amdgcn_global_load_lds((const unsigned*)(src + lane * 16), (LAS unsigned*)(lds + (step & (LB_NSLOT - 1)) * LB_SLOT + p * 1024), 16, 0, 0); }
}
struct ChainOps { s16x4 gf[4][4]; f32x4 hm[4], pl[4]; };
__device__ __forceinline__ void chainB_read(ChainOps& o, LAS unsigned char* sl, int n, int g) {
#pragma unroll
    for (int i = 0; i < 4; ++i) { o.hm[i] = *(const LAS f32x4*)(sl + 8192 + (n * 64 + 16 * i + 4 * g) * 4); o.pl[i] = *(const LAS f32x4*)(sl + 12288 + (16 * i + 4 * g) * 4);
#pragma unroll
        for (int k = 0; k < 4; ++k) o.gf[i][k] = *(const LAS s16x4*)(sl + (16 * i + n) * 128 + (16 * k + 4 * g) * 2); }
}
__device__ __forceinline__ void chainB_step(const ChainOps& o, f32x4 (&acc)[4], v2u* SF) {
    s16x4 sb[4]; f32x4 nx[4];
#pragma unroll
    for (int k = 0; k < 4; ++k) { sb[k] = pack4(acc[k]); SF[k * 64] = __builtin_bit_cast(v2u, sb[k]); }
#pragma unroll
    for (int i = 0; i < 4; ++i) nx[i] = o.pl[i] * acc[i] + o.hm[i];
#pragma unroll
    for (int k = 0; k < 4; ++k)
#pragma unroll
        for (int i = 0; i < 4; ++i) nx[i] = MFMA16(o.gf[i][k], sb[k], nx[i]);
#pragma unroll
    for (int i = 0; i < 4; ++i) acc[i] = nx[i];
}
__device__ __forceinline__ void scanB(const Args& a, LAS unsigned char* lds) {
    const int tid = threadIdx.x, lane = tid & 63, wave = __builtin_amdgcn_readfirstlane(tid >> 6), n = lane & 15, g = lane >> 4;
    constexpr int NCK = SEQ / 64;
    for (int item = blockIdx.x; item < BATCH * NHEAD * 4; item += gridDim.x) {
        const int bh = item >> 2, vb = item & 3;
        const size_t u0 = (size_t)bh * 64;
        f32x4 acc[4];
#pragma unroll
        for (int i = 0; i < 4; ++i) acc[i] = (f32x4){0.f, 0.f, 0.f, 0.f};
        if (wave >= 4) {
#pragma unroll
            for (int s = 0; s < LB_DIST; ++s) chainB_issue(a, lds, u0 + s, vb, s, wave - 4, lane);
            asm volatile("s_waitcnt vmcnt(20)" ::: "memory"); }
        __builtin_amdgcn_s_barrier(); asm volatile("" ::: "memory");
        if (wave >= 4) {
            for (int ck = 0; ck < NCK; ++ck) {
                if (ck + LB_DIST < NCK) { chainB_issue(a, lds, u0 + ck + LB_DIST, vb, ck + LB_DIST, wave - 4, lane); asm volatile("s_waitcnt vmcnt(20)" ::: "memory"); }
                else asm volatile("s_waitcnt vmcnt(0)" ::: "memory");
                __builtin_amdgcn_s_barrier(); asm volatile("" ::: "memory");
            }
        } else if (wave == 0) {
            v2u* SF = (v2u*)(a.ws + WS_SF) + (u0 * 16 + vb * 4) * 64 + lane;
            ChainOps A, B;
            chainB_read(A, lds, n, g);
            for (int ck = 0; ck < NCK; ck += 2) {
                chainB_read(B, lds + ((ck + 1) & (LB_NSLOT - 1)) * LB_SLOT, n, g);
                chainB_step(A, acc, SF + (size_t)ck * 16 * 64);
                __builtin_amdgcn_s_barrier(); asm volatile("" ::: "memory");
                if (ck + 2 < NCK) chainB_read(A, lds + ((ck + 2) & (LB_NSLOT - 1)) * LB_SLOT, n, g);
                chainB_step(B, acc, SF + (size_t)(ck + 1) * 16 * 64);
                __builtin_amdgcn_s_barrier(); asm volatile("" ::: "memory");
            }
        } else {
            for (int ck = 0; ck < NCK; ++ck) { __builtin_amdgcn_s_barrier(); asm volatile("" ::: "memory"); }
        }
    }
}

__device__ __forceinline__ void scanC(const Args& a) {
    const int tid = threadIdx.x, lane = tid & 63, wave = tid >> 6, n = lane & 15, g = lane >> 4;
    const int gw = blockIdx.x * NWAVES + wave, NGW = gridDim.x * NWAVES;
    for (int task = gw; task < NUNIT * 4; task += NGW) {
        const int unit = task >> 2, i = task & 3, bh = unit >> 6, ck = unit & 63, b = bh >> 4, h = bh & 15;
        const v2u* SF = (const v2u*)(a.ws + WS_SF) + (size_t)unit * 16 * 64 + lane;
        const bf16* RH = (const bf16*)(a.ws + WS_RH) + (size_t)unit * 4096; const float* Y1 = (const float*)(a.ws + WS_Y1) + (size_t)unit * 4096;
        s16x4 rf[4]; f32x4 acc[4];
        const size_t m = (size_t)b * SEQ + 64 * ck + 16 * i + n;
        s16x4 rq[4], kq[4], vq[4], gq[4];
#pragma unroll
        for (int vb = 0; vb < 4; ++vb) { const size_t o = m * CW + h * 64 + 16 * vb + 4 * g;
            rq[vb] = *(const s16x4*)((const bf16*)(a.ws + WS_R) + o); kq[vb] = *(const s16x4*)((const bf16*)(a.ws + WS_K2) + o);
            vq[vb] = *(const s16x4*)((const bf16*)(a.ws + WS_V) + o); gq[vb] = *(const s16x4*)((const bf16*)(a.ws + WS_GG) + o); }
#pragma unroll
        for (int k = 0; k < 4; ++k) rf[k] = *(const s16x4*)(RH + (16 * i + n) * 64 + 16 * k + 4 * g);
#pragma unroll
        for (int vb = 0; vb < 4; ++vb) { acc[vb] = *(const f32x4*)(Y1 + (16 * i + n) * 64 + 16 * vb + 4 * g);
#pragma unroll
            for (int k = 0; k < 4; ++k) acc[vb] = MFMA16(__builtin_bit_cast(s16x4, SF[(vb * 4 + k) * 64]), rf[k], acc[vb]); }
        float s1 = 0.f;
#pragma unroll
        for (int vb = 0; vb < 4; ++vb) s1 += (acc[vb][0] + acc[vb][1]) + (acc[vb][2] + acc[vb][3]);
        s1 += __shfl_xor(s1, 16); s1 += __shfl_xor(s1, 32);
        const float mean = s1 * (1.f / 64.f); float s2 = 0.f;
#pragma unroll
        for (int vb = 0; vb < 4; ++vb)
#pragma unroll
            for (int j = 0; j < 4; ++j) { const float d = acc[vb][j] - mean; s2 += d * d; }
        s2 += __shfl_xor(s2, 16); s2 += __shfl_xor(s2, 32);
        const float rstd = 1.f / sqrtf(s2 * (1.f / 64.f) + GN_EPS);
        f32x4 rv[4], kv[4], vv[4], gv[4]; float dot = 0.f;
#pragma unroll
        for (int vb = 0; vb < 4; ++vb) { rv[vb] = unpack4(rq[vb]); kv[vb] = unpack4(kq[vb]); vv[vb] = unpack4(vq[vb]); gv[vb] = unpack4(gq[vb]);
            const f32x4 rk = *(const f32x4*)(a.in[I_RK] + h * 64 + 16 * vb + 4 * g);
#pragma unroll
            for (int j = 0; j < 4; ++j) dot += rv[vb][j] * kv[vb][j] * rk[j]; }
        dot += __shfl_xor(dot, 16); dot += __shfl_xor(dot, 32);
#pragma unroll
        for (int vb = 0; vb < 4; ++vb) { const int c = h * 64 + 16 * vb + 4 * g;
            const f32x4 lw = *(const f32x4*)(a.in[I_LNW] + c), lb = *(const f32x4*)(a.in[I_LNB] + c), be = *(const f32x4*)(a.in[I_BETAR] + c);
            const f32x4 o = ((acc[vb] - mean) * rstd * lw + lb + dot * vv[vb]) * gv[vb] * be;
            *(v2u*)((bf16*)(a.ws + WS_YMIX) + m * DM + c) = __builtin_bit_cast(v2u, pack4(o)); }
    }
}

struct ConvItem { const float* W; bf16* WT; int N, ldd, k0, n0; size_t drow0; };
__device__ __forceinline__ ConvItem conv_decode(const Args& a, int r) {
    constexpr int NI_IN = 32 * 201, NI_OUT = 32 * 64, NI_E = 32 * 512;
    ConvItem c; unsigned char* ws = a.ws;
    if (r < NI_IN) { const int kb = r / 201, nb = r - kb * 201; c.W = a.in[I_WIN]; c.N = PROJW; c.WT = (bf16*)(ws + WS_WIN); c.drow0 = (size_t)(32 * nb); c.ldd = DM; c.k0 = 64 * kb; c.n0 = 32 * nb; return c; } r -= NI_IN;
    if (r < NI_OUT) { const int kb = r >> 6, nb = r & 63; c.W = a.in[I_WOUT]; c.N = DM; c.WT = (bf16*)(ws + WS_WOUT); c.drow0 = (size_t)(32 * nb); c.ldd = DM; c.k0 = 64 * kb; c.n0 = 32 * nb; return c; } r -= NI_OUT;
    if (r < 2 * NI_E) { const int up = r >= NI_E; if (up) r -= NI_E; const int e = r >> 9, q = r & 511, kb = q >> 4, nb = q & 15, n0 = 32 * nb;
        c.W = a.in[up ? I_WU : I_WG] + (size_t)e * DM * FF; c.N = FF; c.WT = (bf16*)(ws + WS_WGU); c.drow0 = (size_t)e * 1024 + 256 * (n0 >> 7) + (n0 & 127) + (up ? 128 : 0); c.ldd = DM; c.k0 = 64 * kb; c.n0 = n0; return c; } r -= 2 * NI_E;
    { const int e = r >> 9, q = r & 511, kb = q >> 6, nb = q & 63;
        c.W = a.in[I_WDN] + (size_t)e * FF * DM; c.N = DM; c.WT = (bf16*)(ws + WS_WD); c.drow0 = (size_t)e * DM + 32 * nb; c.ldd = FF; c.k0 = 64 * kb; c.n0 = 32 * nb; return c; }
}
__device__ __forceinline__ void conv_load(const ConvItem& c, int lane, float (&v)[32]) {
    const float* p = c.W + (size_t)(c.k0 + (lane >> 5)) * c.N + c.n0 + (lane & 31);
#pragma unroll
    for (int i = 0; i < 32; ++i) v[i] = p[(size_t)(2 * i) * c.N];
}
__device__ __forceinline__ void conv_finish(const ConvItem& c, const float (&v)[32], LAS float* scr, int lane) {
#pragma unroll
    for (int i = 0; i < 32; ++i) { const int kk = 2 * i + (lane >> 5); scr[kk * 33 + (lane & 31)] = v[i]; }
    LDS_WAIT(); asm volatile("" ::: "memory");
    const int cc = lane & 7;
#pragma unroll
    for (int j = 0; j < 4; ++j) { const int n = (lane >> 3) + 8 * j; const LAS float* s = scr + (8 * cc) * 33 + n;
        v4u o; o.x = pk2(s[0 * 33], s[1 * 33]); o.y = pk2(s[2 * 33], s[3 * 33]); o.z = pk2(s[4 * 33], s[5 * 33]); o.w = pk2(s[6 * 33], s[7 * 33]);
        *(v4u*)(c.WT + (c.drow0 + n) * (size_t)c.ldd + c.k0 + 8 * cc) = o; }
    LDS_WAIT(); asm volatile("" ::: "memory");
}
__device__ __forceinline__ void phase0(const Args& a, LAS unsigned char* lds) {
    const int tid = threadIdx.x, lane = tid & 63, wave = __builtin_amdgcn_readfirstlane(tid >> 6), G = gridDim.x, bid = blockIdx.x;
    unsigned char* ws = a.ws;
    LAS float* cact = (LAS float*)lds;
    LAS float* red = (LAS float*)(lds + 16384);
    LAS float* scr = (LAS float*)(lds + 32768 + wave * 8448);
    if (bid < 192 || G < 192) {
        const float* c = a.in[I_C];
        for (int i = tid; i < 2 * DM; i += NTHR) { const float x = c[i]; cact[i] = x / (1.f + __expf(-x)); }
        __syncthreads();
        for (int item = bid; item < 192; item += G) {
            const int ro = lane >> 4, cq = lane & 15;
            const float* wp = a.in[I_WADA] + (size_t)(256 * wave + ro) * 12288 + 64 * item + 4 * cq;
            f32x4 acc0 = (f32x4){0.f, 0.f, 0.f, 0.f}, acc1 = acc0;
#pragma unroll 8
            for (int i = 0; i < 64; ++i) { const f32x4 wv = *(const f32x4*)(wp + (size_t)(4 * i) * 12288);
                const float c0 = cact[256 * wave + 4 * i + ro], c1 = cact[DM + 256 * wave + 4 * i + ro]; acc0 += c0 * wv; acc1 += c1 * wv; }
#pragma unroll
            for (int j = 0; j < 4; ++j) { float v0 = acc0[j], v1 = acc1[j]; v0 += __shfl_xor(v0, 16); v0 += __shfl_xor(v0, 32); v1 += __shfl_xor(v1, 16); v1 += __shfl_xor(v1, 32);
                if (ro == 0) { red[(wave * 2 + 0) * 64 + 4 * cq + j] = v0; red[(wave * 2 + 1) * 64 + 4 * cq + j] = v1; } }
            __syncthreads();
            if (tid < 128) { const int b = tid >> 6, cc = tid & 63; float s = a.in[I_BADA][64 * item + cc];
#pragma unroll
                for (int w2 = 0; w2 < 8; ++w2) s += red[(w2 * 2 + b) * 64 + cc];
                ((float*)(ws + WS_MOD))[b * 12288 + 64 * item + cc] = s; }
            __syncthreads();
        }
    }
    constexpr int NCONV = 32 * 201 + 32 * 64 + 3 * 32 * 512, NPRE = 4;
    const int gw = bid * NWAVES + wave, NGW = G * NWAVES;
    const bool pre = (G == 256), mine = pre && bid >= 192;
    const int pool0 = pre ? 64 * NWAVES * NPRE : 0;
    auto item_of = [&](int j) -> int { if (mine) { if (j < NPRE) return (bid - 192) * NWAVES + wave + 64 * NWAVES * j; j -= NPRE; } return pool0 + gw + NGW * j; };
    { float va[32], vb[32]; ConvItem ca, cb; int j = 0; int ia = item_of(0);
      if (ia < NCONV) { ca = conv_decode(a, ia); conv_load(ca, lane, va); }
      while (ia < NCONV) {
          const int ib = item_of(j + 1);
          if (ib < NCONV) { cb = conv_decode(a, ib); conv_load(cb, lane, vb); }
          conv_finish(ca, va, scr, lane);
          if (ib >= NCONV) break;
          const int ic = item_of(j + 2);
          if (ic < NCONV) { ca = conv_decode(a, ic); conv_load(ca, lane, va); }
          conv_finish(cb, vb, scr, lane);
          ia = ic; j += 2; } }
    const int gt = bid * NTHR + tid, NGT = G * NTHR;
    bf16* wl = (bf16*)(ws + WS_WL);
    for (int idx = gt; idx < LORA_N * LORA_K; idx += NGT) { const int n = idx / LORA_K, k = idx - n * LORA_K; float v = 0.f;
        if (n < 1024) { if (k < 64) v = a.in[I_WDEC][k * 1024 + n]; }
        else if (n < 2048) { if (k >= 64 && k < 128) v = a.in[I_WAAA][(k - 64) * 1024 + (n - 1024)]; }
        else { if (k >= 128 && k < 288) v = a.in[I_WGATEUP][(k - 128) * 1024 + (n - 2048)]; }
        wl[idx] = (bf16)f2bf(v); }
    float* w36 = (float*)(ws + WS_W36);
    for (int idx = gt; idx < DM * 36; idx += NGT) { const int e = idx >> 11, dd = idx & (DM - 1);
        w36[idx] = (e < 4) ? a.in[I_WGRP][dd * 4 + e] : a.in[I_WEXP][((size_t)((e - 4) >> 3) * DM + dd) * 8 + ((e - 4) & 7)]; }
    v4u* wz = (v4u*)(ws + WS_WIN + (size_t)PROJW * DM * 2);
    for (int idx = gt; idx < (PROJP - PROJW) * DM / 8; idx += NGT) wz[idx] = (v4u){0u, 0u, 0u, 0u};
}

__device__ __forceinline__ void phase1(const Args& a) {
    const int tid = threadIdx.x, lane = tid & 63, wave = tid >> 6;
    const int gw = blockIdx.x * NWAVES + wave, NGW = gridDim.x * NWAVES;
    const float* mod = (const float*)(a.ws + WS_MOD);
    for (int it = gw; it < 72; it += NGW) {
        const int b = it / 36, e = it - b * 36; const float* w36 = (const float*)(a.ws + WS_W36); float s = 0.f;
        for (int dd = lane; dd < DM; dd += 64) s += mod[b * 12288 + 3 * DM + dd] * w36[e * DM + dd];
        s = wave_sum(s) + ((e < 4) ? a.in[I_BGRP][e] : a.in[I_BEXP][e - 4]);
        if (lane == 0) ((float*)(a.ws + WS_B36))[it] = s; }
    auto ldrow = [&](int m, f32x4 (&v)[8]) { const f32x4* xr = (const f32x4*)(a.in[I_X] + (size_t)m * DM) + lane;
#pragma unroll
        for (int j = 0; j < 8; ++j) v[j] = xr[64 * j]; };
    auto dorow = [&](int m, f32x4 (&v)[8]) { const int b = m >> 12; float s = 0.f;
#pragma unroll
        for (int j = 0; j < 8; ++j) s += (v[j].x * v[j].x + v[j].y * v[j].y) + (v[j].z * v[j].z + v[j].w * v[j].w);
        const float rstd = 1.f / sqrtf(wave_sum(s) * (1.f / DM) + RMS_EPS);
        v2u* o8 = (v2u*)((bf16*)(a.ws + WS_HB) + (size_t)m * DM) + lane;
#pragma unroll
        for (int j = 0; j < 8; ++j) { const int c = 4 * (lane + 64 * j);
            const f32x4 g = *(const f32x4*)(a.in[I_N1G] + c), sh = *(const f32x4*)(mod + b * 12288 + c), sc = *(const f32x4*)(mod + b * 12288 + DM + c);
            const f32x4 h = v[j] * rstd * g * (1.f + sc) + sh; v2u o; o.x = pk2(h.x, h.y); o.y = pk2(h.z, h.w); o8[64 * j] = o; } };
    { f32x4 va[8], vb[8]; int m = gw; if (m < MTOK) ldrow(m, va);
      while (m < MTOK) { const int m2 = m + NGW; if (m2 < MTOK) ldrow(m2, vb); dorow(m, va); if (m2 >= MTOK) break;
          const int m3 = m2 + NGW; if (m3 < MTOK) ldrow(m3, va); dorow(m2, vb); m = m3; } }
}

__device__ __forceinline__ void phase3(const Args& a) {
    const int gt = blockIdx.x * NTHR + threadIdx.x, NGT = gridDim.x * NTHR;
    const bf16* P = (const bf16*)(a.ws + WS_PLR); bf16* AL = (bf16*)(a.ws + WS_AL);
    for (int idx = gt; idx < MTOK * 48; idx += NGT) { const int m = idx / 48, cj = idx - m * 48;
        v4u o = (v4u){0u, 0u, 0u, 0u};
        if (cj < 36) { const int col = 3072 + 8 * cj; const v4u pc = *(const v4u*)(P + (size_t)m * 288 + 8 * cj);
            v4u pp = (v4u){0u, 0u, 0u, 0u}; if ((m & (SEQ - 1)) != 0) pp = *(const v4u*)(P + (size_t)(m - 1) * 288 + 8 * cj);
            const float* mu = a.in[I_MU] + col; float r[8];
#pragma unroll
            for (int i = 0; i < 4; ++i) { const float c0 = bflo(pc[i]), c1 = bfhi(pc[i]), p0 = bflo(pp[i]), p1 = bfhi(pp[i]);
                r[2 * i] = c0 + (p0 - c0) * mu[2 * i]; r[2 * i + 1] = c1 + (p1 - c1) * mu[2 * i + 1]; }
            if (cj < 8) {
#pragma unroll
                for (int i = 0; i < 8; ++i) r[i] = tanhf(r[i]); }
            else if (cj >= 16) {
#pragma unroll
                for (int i = 0; i < 8; ++i) r[i] = sigmoid_f(r[i]); }
            o.x = pk2(r[0], r[1]); o.y = pk2(r[2], r[3]); o.z = pk2(r[4], r[5]); o.w = pk2(r[6], r[7]); }
        *(v4u*)(AL + (size_t)m * LORA_K + 8 * cj) = o; }
}

__device__ __forceinline__ int swz_off(int key, int chunk) { return key * 128 + ((chunk ^ ((key >> 1) & 7)) << 4); }
__device__ __forceinline__ void attn_issue_tile(const bf16* kcol, int key0, LAS unsigned char* buf, int wave) {
    __builtin_amdgcn_global_load_lds((const unsigned*)(kcol + (size_t)key0 * HD), (LAS unsigned*)(buf + wave * 1024), 16, 0, 0);
    __builtin_amdgcn_global_load_lds((const unsigned*)(kcol + HM_PART + (size_t)key0 * HD), (LAS unsigned*)(buf + 8192 + wave * 1024), 16, 0, 0);
}
__device__ __forceinline__ void phase5b(const Args& a, LAS unsigned char* lds) {
    STAMP_DECL;
    const int tid = threadIdx.x, lane = tid & 63, wave = __builtin_amdgcn_readfirstlane(tid >> 6), n = lane & 15, g = lane >> 4;
    const bf16* P = (const bf16*)(a.ws + WS_P); bf16* Y = (bf16*)(a.ws + WS_YMIX);
    LAS unsigned char* QL = lds + 65536; LAS float* biasA = (LAS float*)(lds + 81920);
    for (int i = tid; i < NHEAD * 257; i += NTHR) biasA[i] = a.in[I_RELB][i] * LOG2E;
    const float SC = 0.125f * LOG2E;
    const int skey = tid >> 3, sdcx = (tid & 7) ^ ((skey >> 1) & 7);
    LAS float* betaL = (LAS float*)(lds + 81920 + NHEAD * 257 * 4 + 64);
    for (int i = tid; i < CW; i += NTHR) betaL[i] = a.in[I_BETAA][i];
#define ATTN_PROLOGUE(U) do { const int cp_ = (U) & 31, h_ = ((U) >> 5) & 15, b_ = (U) >> 9; const int js_ = (8 - 2 * cp_) > 0 ? (8 - 2 * cp_) : 0, kb_ = 64 * (2 * cp_ - 8 + js_); \
        const bf16* Qh_ = P + 3 * HM_PART + (size_t)b_ * HM_BATCH + (size_t)h_ * HM_HEAD; const bf16* kc_ = Qh_ + HM_PART + (size_t)skey * HD + 8 * sdcx; \
        const bf16* qs_ = Qh_ + (size_t)(128 * cp_ + 16 * wave + (lane >> 3)) * HD + 8 * (lane & 7); \
        __builtin_amdgcn_global_load_lds((const unsigned*)qs_, (LAS unsigned*)(QL + wave * 2048), 16, 0, 0); \
        __builtin_amdgcn_global_load_lds((const unsigned*)(qs_ + (size_t)8 * HD), (LAS unsigned*)(QL + wave * 2048 + 1024), 16, 0, 0); \
        attn_issue_tile(kc_, kb_, lds, wave); attn_issue_tile(kc_, kb_ + 64, lds + 16384, wave); \
        if (js_ < 8) attn_issue_tile(kc_, kb_ + 128, lds + 32768, wave); } while (0)
    asm volatile("s_waitcnt vmcnt(0) lgkmcnt(0)" ::: "memory"); __builtin_amdgcn_s_barrier(); asm volatile("" ::: "memory");
    if ((int)blockIdx.x < BATCH * NHEAD * 32) ATTN_PROLOGUE((int)blockIdx.x);
    for (int u = blockIdx.x; u < BATCH * NHEAD * 32; u += gridDim.x) {
        const int cp = u & 31, h = (u >> 5) & 15, b = u >> 9;
        const int t0 = 128 * cp, qrow = t0 + 16 * wave + n;
        const bf16* Qh = P + 3 * HM_PART + (size_t)b * HM_BATCH + (size_t)h * HM_HEAD;
        const LAS float* biasL = biasA + h * 257;
        const int jstart = (8 - 2 * cp) > 0 ? (8 - 2 * cp) : 0, nt = 10 - jstart;
        const bf16* kcol = Qh + HM_PART + (size_t)skey * HD + 8 * sdcx;
        const int keyb = 64 * (2 * cp - 8 + jstart);
        if (nt > 2) asm volatile("s_waitcnt vmcnt(4)" ::: "memory"); else asm volatile("s_waitcnt vmcnt(2)" ::: "memory");
        __builtin_amdgcn_s_barrier(); asm volatile("" ::: "memory");
        bf16x8 qf[2]; qf[0] = *(const LAS bf16x8*)(QL + wave * 2048 + n * 128 + 16 * g); qf[1] = *(const LAS bf16x8*)(QL + wave * 2048 + n * 128 + 64 + 16 * g);
        float mrun = -1e30f, lrun = 0.f;
        f32x4 ot[4];
#pragma unroll
        for (int i = 0; i < 4; ++i) ot[i] = (f32x4){0.f, 0.f, 0.f, 0.f};
        const float bfar = biasL[256];
        for (int r = 0; r < nt; ++r) {
            const int j = jstart + r, key0 = keyb + 64 * r;
            if (r + 3 < nt) attn_issue_tile(kcol, key0 + 192, lds + ((r + 3) & 3) * 16384, wave);
            const bool active = (wave < 4) ? (j <= 8) : (j >= 1);
            STAMP_BEGIN(13);
            if (active) {
                LAS unsigned char* Kb = lds + (r & 3) * 16384; LAS unsigned char* Vb = Kb + 8192;
                f32x4 s[4];
                { bf16x8 kfr[4][2];
#pragma unroll
                  for (int st = 0; st < 4; ++st)
#pragma unroll
                      for (int ks = 0; ks < 2; ++ks) kfr[st][ks] = *(const LAS bf16x8*)(Kb + swz_off(16 * st + n, 4 * ks + g));
                  asm volatile("s_waitcnt lgkmcnt(0)" ::: "memory"); __builtin_amdgcn_sched_barrier(0);
#pragma unroll
                  for (int st = 0; st < 4; ++st) { s[st] = (f32x4){0.f, 0.f, 0.f, 0.f};
#pragma unroll
                      for (int ks = 0; ks < 2; ++ks) s[st] = __builtin_amdgcn_mfma_f32_16x16x32_bf16(kfr[st][ks], qf[ks], s[st], 0, 0, 0); } }
                s16x4 vtr[2][4][2];
                  const int q4 = n >> 2, p4 = n & 3;
#pragma unroll
                  for (int k2 = 0; k2 < 2; ++k2)
#pragma unroll
                      for (int nd = 0; nd < 4; ++nd) { const int ka = 32 * k2 + 4 * g + q4, ch = 2 * nd + (p4 >> 1);
                          vtr[k2][nd][0] = __builtin_bit_cast(s16x4, __builtin_amdgcn_ds_read_tr16_b64_v4i16((LAS s16x4*)(Vb + swz_off(ka, ch) + 8 * (p4 & 1))));
                          vtr[k2][nd][1] = __builtin_bit_cast(s16x4, __builtin_amdgcn_ds_read_tr16_b64_v4i16((LAS s16x4*)(Vb + swz_off(ka + 16, ch) + 8 * (p4 & 1)))); }
                const bool far = (t0 + 16 * wave) - (key0 + 63) >= 128;
                float mx = -1e30f;
                if (far) {
#pragma unroll
                    for (int st = 0; st < 4; ++st)
#pragma unroll
                        for (int jj = 0; jj < 4; ++jj) { const float sv = s[st][jj] * SC + bfar; s[st][jj] = sv; mx = fmaxf(mx, sv); }
                } else {
                    float bv[4][4];
#pragma unroll
                    for (int st = 0; st < 4; ++st)
#pragma unroll
                        for (int jj = 0; jj < 4; ++jj) { const int dist = qrow - (key0 + 16 * st + 4 * g + jj); bv[st][jj] = biasL[(dist < 128 ? dist : 128) + 128]; }
#pragma unroll
                    for (int st = 0; st < 4; ++st)
#pragma unroll
                        for (int jj = 0; jj < 4; ++jj) { const float sv = s[st][jj] * SC + bv[st][jj]; s[st][jj] = sv; mx = fmaxf(mx, sv); }
                }
                mx = fmaxf(mx, __shfl_xor(mx, 16)); mx = fmaxf(mx, __shfl_xor(mx, 32));
                const float mnew = fmaxf(mrun, mx), alpha = __builtin_amdgcn_exp2f(mrun - mnew); mrun = mnew;
                float ls = 0.f;
#pragma unroll
                for (int st = 0; st < 4; ++st)
#pragma unroll
                    for (int jj = 0; jj < 4; ++jj) { const float p = __builtin_amdgcn_exp2f(s[st][jj] - mnew); s[st][jj] = p; ls += p; }
                lrun = lrun * alpha + ls;
#pragma unroll
                for (int i = 0; i < 4; ++i) ot[i] *= alpha;
                {
                  asm volatile("s_waitcnt lgkmcnt(0)" ::: "memory"); __builtin_amdgcn_sched_barrier(0);
#pragma unroll
                  for (int k2 = 0; k2 < 2; ++k2) {
                      v4u pw; pw.x = pk2(s[2 * k2][0], s[2 * k2][1]); pw.y = pk2(s[2 * k2][2], s[2 * k2][3]); pw.z = pk2(s[2 * k2 + 1][0], s[2 * k2 + 1][1]); pw.w = pk2(s[2 * k2 + 1][2], s[2 * k2 + 1][3]);
                      const bf16x8 pf = __builtin_bit_cast(bf16x8, pw);
#pragma unroll
                      for (int nd = 0; nd < 4; ++nd) { const s16x4 v0 = vtr[k2][nd][0], v1 = vtr[k2][nd][1];
                          bf16x8 vf; vf[0] = v0[0]; vf[1] = v0[1]; vf[2] = v0[2]; vf[3] = v0[3]; vf[4] = v1[0]; vf[5] = v1[1]; vf[6] = v1[2]; vf[7] = v1[3];
                          ot[nd] = __builtin_amdgcn_mfma_f32_16x16x32_bf16(vf, pf, ot[nd], 0, 0, 0); } } }
            }
            STAMP_END(13); STAMP_BEGIN(12);
            if (r + 4 <= nt) asm volatile("s_waitcnt vmcnt(4)" ::: "memory"); else if (r + 3 == nt) asm volatile("s_waitcnt vmcnt(2)" ::: "memory"); else asm volatile("s_waitcnt vmcnt(0)" ::: "memory");
            asm volatile("s_waitcnt lgkmcnt(0)" ::: "memory"); __builtin_amdgcn_s_barrier(); asm volatile("" ::: "memory");
            STAMP_END(12);
        }
        if (u + (int)gridDim.x < BATCH * NHEAD * 32) ATTN_PROLOGUE(u + (int)gridDim.x);
        float lt = lrun; lt += __shfl_xor(lt, 16); lt += __shfl_xor(lt, 32);
        const float inv = __builtin_amdgcn_rcpf(lt);
        bf16* yp = Y + ((size_t)b * SEQ + qrow) * DM + 1024 + h * 64 + 4 * g;
        const LAS float* beta = betaL + h * 64 + 4 * g;
#pragma unroll
        for (int nd = 0; nd < 4; ++nd) { const f32x4 bt = *(const LAS f32x4*)(beta + 16 * nd); const f32x4 o = ot[nd] * inv * bt;
            v2u w; w.x = pk2(o[0], o[1]); w.y = pk2(o[2], o[3]); *(v2u*)(yp + 16 * nd) = w; }
    }
}

__device__ __forceinline__ void phase8(const Args& a, LAS unsigned char* lds) {
    const int tid = threadIdx.x, lane = tid & 63, wave = __builtin_amdgcn_readfirstlane(tid >> 6), n = lane & 15, g = lane >> 4;
    const float* mod = (const float*)(a.ws + WS_MOD); const float* W36 = (const float*)(a.ws + WS_W36); const float* X1 = (const float*)(a.ws + WS_X1);
    unsigned* ctl = (unsigned*)(a.ws + WS_CTL);
    LAS float* part = (LAS float*)lds;
    LAS float* ssp = (LAS float*)(lds + 24576);
    LAS float* lg = (LAS float*)(lds + 25088);
    for (int tile = blockIdx.x; tile < MTOK / 16; tile += gridDim.x) {
        const int m0 = 16 * tile, b = m0 >> 12;
        f32x4 acc[3]; float ss = 0.f;
#pragma unroll
        for (int ct = 0; ct < 3; ++ct) acc[ct] = (f32x4){0.f, 0.f, 0.f, 0.f};
        const float* xrow = X1 + (size_t)(m0 + n) * DM + 256 * wave + 4 * g;
        const float* w0p = W36 + (size_t)n * DM + 256 * wave + 4 * g; const float* w1p = w0p + (size_t)16 * DM; const float* w2p = w0p + (size_t)(n < 4 ? 32 : 0) * DM;
        const float* gp = a.in[I_N2G] + 256 * wave + 4 * g; const float* sp = mod + b * 12288 + 4 * DM + 256 * wave + 4 * g;
#pragma unroll 4
        for (int Q = 0; Q < 16; ++Q) {
            f32x4 xa = *(const f32x4*)(xrow + 16 * Q);
            const f32x4 ab = *(const f32x4*)(gp + 16 * Q) * (1.f + *(const f32x4*)(sp + 16 * Q));
            const f32x4 wa = *(const f32x4*)(w0p + 16 * Q), wb = *(const f32x4*)(w1p + 16 * Q); f32x4 wc = *(const f32x4*)(w2p + 16 * Q);
            if (n >= 4) wc = (f32x4){0.f, 0.f, 0.f, 0.f};
            ss += (xa[0] * xa[0] + xa[1] * xa[1]) + (xa[2] * xa[2] + xa[3] * xa[3]); xa *= ab;
#pragma unroll
            for (int r = 0; r < 4; ++r) { acc[0] = __builtin_amdgcn_mfma_f32_16x16x4f32(xa[r], wa[r], acc[0], 0, 0, 0); acc[1] = __builtin_amdgcn_mfma_f32_16x16x4f32(xa[r], wb[r], acc[1], 0, 0, 0);
                acc[2] = __builtin_amdgcn_mfma_f32_16x16x4f32(xa[r], wc[r], acc[2], 0, 0, 0); }
        }
        ss += __shfl_xor(ss, 16); ss += __shfl_xor(ss, 32);
#pragma unroll
        for (int ct = 0; ct < 3; ++ct) *(LAS f32x4*)(part + (wave * 64 + lane) * 12 + 4 * ct) = acc[ct];
        if (lane < 16) ssp[wave * 16 + lane] = ss;
        __syncthreads();
        { const int tk = tid >> 5, sl = tid & 31;
            float s2 = 0.f;
#pragma unroll
            for (int w = 0; w < 8; ++w) s2 += ssp[w * 16 + tk];
            const float rstd = 1.f / sqrtf(s2 * (1.f / DM) + RMS_EPS);
            const float* b36 = (const float*)(a.ws + WS_B36) + b * 36;
            { const int e = sl; float s = 0.f;
#pragma unroll
              for (int w = 0; w < 8; ++w) s += part[(w * 64 + 16 * (tk >> 2) + (e & 15)) * 12 + 4 * (e >> 4) + (tk & 3)];
              lg[tk * 40 + e] = s * rstd + b36[e]; }
            if (sl < 4) { const int e = 32 + sl; float s = 0.f;
#pragma unroll
              for (int w = 0; w < 8; ++w) s += part[(w * 64 + 16 * (tk >> 2) + (e & 15)) * 12 + 4 * (e >> 4) + (tk & 3)];
              lg[tk * 40 + e] = s * rstd + b36[e]; }
            if (sl == 0) ((float*)(a.ws + WS_RSTD))[m0 + tk] = rstd; }
        __syncthreads();
        if (tid < 16) {
            float l[36];
#pragma unroll
            for (int e = 0; e < 36; ++e) l[e] = lg[tid * 40 + e];
            int gi = 0; float gm = l[0];
#pragma unroll
            for (int i = 1; i < 4; ++i) if (l[i] > gm) { gm = l[i]; gi = i; }
            float gs = 0.f;
#pragma unroll
            for (int i = 0; i < 4; ++i) gs += expf(l[i] - gm);
            const float gwt = 1.f / gs;
            float el[8];
#pragma unroll
            for (int j = 0; j < 8; ++j) el[j] = (gi == 0) ? l[4 + j] : ((gi == 1) ? l[12 + j] : ((gi == 2) ? l[20 + j] : l[28 + j]));
            int i1 = 0; float m1 = el[0];
#pragma unroll
            for (int i = 1; i < 8; ++i) if (el[i] > m1) { m1 = el[i]; i1 = i; }
            int i2 = -1; float m2 = -3.0e38f;
#pragma unroll
            for (int i = 0; i < 8; ++i) if (i != i1 && el[i] > m2) { m2 = el[i]; i2 = i; }
            const float e2 = expf(m2 - m1); const float w1 = gwt / (1.f + e2), w2 = gwt * e2 / (1.f + e2);
            int* rt = (int*)(a.ws + WS_ROUTE) + (size_t)(m0 + tid) * 8; const int ge1 = gi * 8 + i1, ge2 = gi * 8 + i2;
            rt[0] = ge1; rt[1] = ge2; rt[2] = __float_as_int(w1); rt[3] = __float_as_int(w2);
            atomicAdd(ctl + CW_CNT + ge1, 1u); atomicAdd(ctl + CW_CNT + ge2, 1u);
        }
        __syncthreads();
    }
}

__device__ __forceinline__ void phase9(const Args& a) {
    const int tid = threadIdx.x, lane = tid & 63, wave = tid >> 6;
    const int gw = blockIdx.x * NWAVES + wave, NGW = gridDim.x * NWAVES;
    unsigned* ctl = (unsigned*)(a.ws + WS_CTL);
    const float* mod = (const float*)(a.ws + WS_MOD);
    unsigned cnt = (lane < NEXP) ? __hip_atomic_load(ctl + CW_CNT + lane, RLX_AGENT) : 0u;
    const unsigned pad = (cnt + 255u) & ~255u;
    unsigned incl = pad;
#pragma unroll
    for (int o = 1; o < 64; o <<= 1) { const unsigned t = __shfl_up(incl, o); if (lane >= o) incl += t; }
    const unsigned off = incl - pad;
    if (gw == 0) {
        if (lane < NEXP) for (unsigned t = off >> 8; t < (off + pad) >> 8; ++t) ctl[CW_TE + t] = (unsigned)lane;
        if (lane == 63) ctl[CW_NRT] = incl >> 8;
    }
    for (int task = gw; task < MTOK / 4; task += NGW) {
        const int m0 = 4 * task, b = m0 >> 12;
        int* rt = (int*)(a.ws + WS_ROUTE) + (size_t)(m0 + (lane & 3)) * 8;
        const int e1 = rt[0], e2 = rt[1];
        unsigned p1 = 0, p2 = 0;
        if (lane < 4) { p1 = atomicAdd(ctl + CW_POS + e1, 1u); p2 = atomicAdd(ctl + CW_POS + e2, 1u); }
        const unsigned s1v = __shfl(off, e1) + p1, s2v = __shfl(off, e2) + p2;
        if (lane < 4) { rt[4] = (int)s1v; rt[5] = (int)s2v; ((float*)(a.ws + WS_SW))[s1v] = __int_as_float(rt[2]); ((float*)(a.ws + WS_SW))[s2v] = __int_as_float(rt[3]); }
        f32x4 xa[8], xb[8];
        auto ldx = [&](int t, f32x4 (&x)[8]) { const f32x4* xr = (const f32x4*)((const float*)(a.ws + WS_X1) + (size_t)(m0 + t) * DM) + lane;
#pragma unroll
            for (int j = 0; j < 8; ++j) x[j] = xr[64 * j]; };
        auto dox = [&](int t, f32x4 (&x)[8]) { const unsigned s1 = __shfl(s1v, t), s2 = __shfl(s2v, t);
            const float rstd = ((const float*)(a.ws + WS_RSTD))[m0 + t];
            v2u* d1 = (v2u*)((bf16*)(a.ws + WS_H2P) + (size_t)s1 * DM) + lane; v2u* d2 = (v2u*)((bf16*)(a.ws + WS_H2P) + (size_t)s2 * DM) + lane;
#pragma unroll
            for (int j = 0; j < 8; ++j) { const int c = 4 * (lane + 64 * j);
                const f32x4 g = *(const f32x4*)(a.in[I_N2G] + c), sh = *(const f32x4*)(mod + b * 12288 + 3 * DM + c), sc = *(const f32x4*)(mod + b * 12288 + 4 * DM + c);
                const f32x4 h = x[j] * rstd * g * (1.f + sc) + sh; v2u o; o.x = pk2(h.x, h.y); o.y = pk2(h.z, h.w); d1[64 * j] = o; d2[64 * j] = o; } };
        ldx(0, xa); ldx(1, xb); dox(0, xa); ldx(2, xa); dox(1, xb); ldx(3, xb); dox(2, xa); dox(3, xb);
    }
}

__device__ __forceinline__ void phase12(const Args& a) {
    const int tid = threadIdx.x, lane = tid & 63, wave = tid >> 6;
    const int gw = blockIdx.x * NWAVES + wave, NGW = gridDim.x * NWAVES;
    const float* mod = (const float*)(a.ws + WS_MOD);
    struct Tok { f32x4 x[8]; v2u f1[8], f2[8]; };
    auto ldslots = [&](int m, int& s1, int& s2) { const int* rt = (const int*)(a.ws + WS_ROUTE) + (size_t)m * 8; s1 = rt[4]; s2 = rt[5]; };
    auto ldtok = [&](int m, int s1, int s2, Tok& t) { const f32x4* xr = (const f32x4*)((const float*)(a.ws + WS_X1) + (size_t)m * DM) + lane;
        const v2u* f1 = (const v2u*)((const bf16*)(a.ws + WS_FP) + (size_t)s1 * DM) + lane; const v2u* f2 = (const v2u*)((const bf16*)(a.ws + WS_FP) + (size_t)s2 * DM) + lane;
#pragma unroll
        for (int j = 0; j < 8; ++j) { t.x[j] = xr[64 * j]; t.f1[j] = f1[64 * j]; t.f2[j] = f2[64 * j]; } };
    auto dotok = [&](int m, Tok& t) { const int b = m >> 12; float s = 0.f; f32x4 v[8];
#pragma unroll
        for (int j = 0; j < 8; ++j) { const int c = 4 * (lane + 64 * j); const f32x4 g2 = *(const f32x4*)(mod + b * 12288 + 5 * DM + c);
            const v2u a1 = t.f1[j], a2 = t.f2[j]; f32x4 f;
            f.x = bflo(a1.x) + bflo(a2.x); f.y = bfhi(a1.x) + bfhi(a2.x); f.z = bflo(a1.y) + bflo(a2.y); f.w = bfhi(a1.y) + bfhi(a2.y);
            v[j] = t.x[j] + g2 * f; s += (v[j].x * v[j].x + v[j].y * v[j].y) + (v[j].z * v[j].z + v[j].w * v[j].w); }
        const float rstd = 1.f / sqrtf(wave_sum(s) * (1.f / DM) + RMS_EPS);
        f32x4* op = (f32x4*)(a.out + (size_t)m * DM) + lane;
#pragma unroll
        for (int j = 0; j < 8; ++j) { const int c = 4 * (lane + 64 * j); const f32x4 g = *(const f32x4*)(a.in[I_NFG] + c); op[64 * j] = v[j] * rstd * g; } };
    { Tok ta, tb; int m = gw, sa1 = 0, sa2 = 0, sb1 = 0, sb2 = 0;
      if (m < MTOK) { ldslots(m, sa1, sa2); if (m + NGW < MTOK) ldslots(m + NGW, sb1, sb2); ldtok(m, sa1, sa2, ta); }
      while (m < MTOK) { const int m2 = m + NGW, m3 = m2 + NGW, m4 = m3 + NGW;
          if (m3 < MTOK) ldslots(m3, sa1, sa2);
          if (m2 < MTOK) ldtok(m2, sb1, sb2, tb);
          dotok(m, ta); if (m2 >= MTOK) break;
          if (m4 < MTOK) ldslots(m4, sb1, sb2);
          if (m3 < MTOK) ldtok(m3, sa1, sa2, ta);
          dotok(m2, tb); m = m3; } }
}

#ifndef MK_ONE_LAUNCH
#define MK_ONE_LAUNCH 1
#endif
__global__ void __launch_bounds__(NTHR, 2) mega_fwd(Args args) {
    extern __shared__ __attribute__((aligned(16))) unsigned char lds_raw[];
    LAS unsigned char* lds = (LAS unsigned char*)lds_raw;
    const int tid = threadIdx.x;
    for (int u = tid; u < (LDS_BYTES - LDSCTL_OFF) / 4; u += NTHR) ((LAS unsigned*)(lds + LDSCTL_OFF))[u] = 0u;
    __syncthreads();
    volatile LAS unsigned* MISC = (volatile LAS unsigned*)(lds + MISC_OFF);
    unsigned* ctl = (unsigned*)(args.ws + WS_CTL);
    unsigned* barw = ctl + CW_BAR + args.li * XCD_BAR_WORDS;
    XcdBarrier bar; bar.bar = barw; bar.x = 0; bar.st = nullptr;
    const bool multi = (args.ph_hi - args.ph_lo) > 1;
    if (multi) bar = xcd_barrier_post(barw, MISC + 8);
    const int lo = args.ph_lo, hi = args.ph_hi, G = gridDim.x;
#define IN(k) (lo <= (k) && (k) < hi)
#define SEAM(k) do { if (IN(k) && IN((k) + 1)) xcd_barrier(bar); } while (0)
    if (IN(0)) { phase0(args, lds); } SEAM(0);
    if (IN(1)) { phase1(args); } SEAM(1);
    if (IN(2)) { pg8::Gemm g{(const pg8::bf16_t*)(args.ws + WS_HB), (const pg8::bf16_t*)(args.ws + WS_WIN), MTOK, PROJP, DM}; pg8::StaticOrder S; S.init(MTOK, PROJP, G, (int)blockIdx.x);
        EpiProj E{(bf16*)(args.ws + WS_P), (bf16*)(args.ws + WS_PLR)};
        pg8::gemm_phase<EpiProj, pg8::StaticOrder, true, true>(lds, g, S, E); } SEAM(2);
    if (IN(3)) { const Args& a = args; STAMP_DECL; STAMP_BEGIN(10); phase3(args); STAMP_END(10); STAMP_BEGIN(11); phase5b(args, lds); STAMP_END(11); } SEAM(3);
    if (IN(4)) { pg8::Gemm g{(const pg8::bf16_t*)(args.ws + WS_AL), (const pg8::bf16_t*)(args.ws + WS_WL), MTOK, LORA_N, LORA_K}; pg8::StaticOrder S; S.init(MTOK, LORA_N, G, (int)blockIdx.x);
        EpiLora E{(float*)(args.ws + WS_LW), (bf16*)(args.ws + WS_AA), (bf16*)(args.ws + WS_GG)};
        pg8::gemm_phase<EpiLora, pg8::StaticOrder, true, true>(lds, g, S, E); } SEAM(4);
    if (IN(5)) { scanA(args, lds); } SEAM(5);
    if (IN(6)) { scanB(args, lds); } SEAM(6);
    if (IN(7)) { scanC(args); } SEAM(7);
    if (IN(8)) { pg8::Gemm g{(const pg8::bf16_t*)(args.ws + WS_YMIX), (const pg8::bf16_t*)(args.ws + WS_WOUT), MTOK, DM, DM}; pg8::StaticOrder S; S.init(MTOK, DM, G, (int)blockIdx.x);
        EpiResGate E{args.in[I_X], (const float*)(args.ws + WS_MOD) + 2 * DM, (float*)(args.ws + WS_X1)};
        pg8::gemm_phase<EpiResGate, pg8::StaticOrder, true, true>(lds, g, S, E); } SEAM(8);
    if (IN(9)) { phase8(args, lds); } SEAM(9);
    if (IN(10)) { phase9(args); } SEAM(10);
    if (IN(11) || IN(12) || IN(13)) {
        const int nrt = (int)__hip_atomic_load(ctl + CW_NRT, RLX_AGENT), c = (int)blockIdx.x;
        const int Ugu = 4 * nrt, nB = Ugu > G ? Ugu - G : 0, R0 = (Ugu < G ? Ugu : G) / 4, E2 = (8 * R0 < 2 * (G - nB)) ? 8 * R0 : 2 * (G - nB);
        const pg8::Gemm gu{(const pg8::bf16_t*)(args.ws + WS_H2P), (const pg8::bf16_t*)(args.ws + WS_WGU), nrt * 256, NEXP * 1024, DM};
        const pg8::Gemm gd{(const pg8::bf16_t*)(args.ws + WS_HG), (const pg8::bf16_t*)(args.ws + WS_WD), nrt * 256, NEXP * DM, FF};
        const EpiGateUp Eu{(const float*)(args.ws + WS_SW), (bf16*)(args.ws + WS_HG)};
        const EpiStoreBf16 Ed{(bf16*)(args.ws + WS_FP), DM, 7};
        if (IN(11)) { GroupOrder2 S{ctl + CW_TE, 4, 0, Ugu < G ? Ugu : G, G, c}; pg8::gemm_phase<EpiGateUp, GroupOrder2, true, true>(lds, gu, S, Eu); } SEAM(11);
        if (IN(12)) { if (c < nB) { GroupOrder2 S{ctl + CW_TE, 4, G, nB, nB, c}; pg8::gemm_phase<EpiGateUp, GroupOrder2, true, true>(lds, gu, S, Eu); }
                      else { GroupOrder2 S{ctl + CW_TE, 8, 0, E2, G - nB, c - nB}; pg8::gemm_phase<EpiStoreBf16, GroupOrder2, true, true>(lds, gd, S, Ed); } } SEAM(12);
        if (IN(13)) { GroupOrder2 S{ctl + CW_TE, 8, E2, 8 * nrt - E2, G, c}; pg8::gemm_phase<EpiStoreBf16, GroupOrder2, true, true>(lds, gd, S, Ed); } SEAM(13);
    }
    if (IN(14)) { phase12(args); }
#ifdef STAMP_ID
    if (blockIdx.x == 0 && tid == 0 && IN(NPH - 1)) { const unsigned dly = __hip_atomic_load(ctl + CW_STAMP, RLX_AGENT); const unsigned long long t0_ = __builtin_amdgcn_s_memrealtime();
        while (__builtin_amdgcn_s_memrealtime() - t0_ < (unsigned long long)dly) __builtin_amdgcn_s_sleep(8); }
#endif
#ifdef EXTRA_BARRIERS
    if (multi) for (int i_ = 0; i_ < EXTRA_BARRIERS; ++i_) xcd_barrier(bar);
#endif
#undef IN
#undef SEAM
}

extern "C" void kernel_launch(void* const* d_in, const int* in_sizes, int n_in, void* d_out, int out_size, void* d_ws, size_t ws_size, hipStream_t stream) {
    static int grid = 0;
    if (grid == 0) {
        if (n_in != 30 || out_size != MTOK * DM || ws_size < WS_END) { fprintf(stderr, "kernel_launch: unexpected shapes (n_in %d, out %d, ws %zu)\n", n_in, out_size, ws_size); grid = -1; return; }
        int dev = 0, cus = 0, per_cu = 0;
        if (hipGetDevice(&dev) != hipSuccess || hipDeviceGetAttribute(&cus, hipDeviceAttributeMultiprocessorCount, dev) != hipSuccess) { grid = -1; return; }
        if (hipFuncSetAttribute((const void*)mega_fwd, hipFuncAttributeMaxDynamicSharedMemorySize, LDS_BYTES) != hipSuccess) { grid = -1; return; }
        if (hipOccupancyMaxActiveBlocksPerMultiprocessor(&per_cu, (const void*)mega_fwd, NTHR, LDS_BYTES) != hipSuccess || per_cu < 1) { fprintf(stderr, "kernel_launch: occupancy query says %d\n", per_cu); grid = -1; (void)hipGetLastError(); return; }
        grid = cus;
    }
    if (grid < 0) return;
    (void)hipMemsetAsync((char*)d_ws + WS_CTL, 0, CTL_ZERO_BYTES, stream);
    Args a{};
    for (int i = 0; i < 30; ++i) a.in[i] = (const float*)d_in[i];
    a.out = (float*)d_out; a.ws = (unsigned char*)d_ws;
#if MK_ONE_LAUNCH
#ifdef PROBE_PHASE
    const int cuts[3] = {0, PROBE_PHASE, NPH};
    for (int li = 0; li < 2; ++li) { a.ph_lo = cuts[li]; a.ph_hi = cuts[li + 1] + ((li == 0) ? PROBE_REPEAT : 0); a.li = li;
        void* kargs[] = {&a};
        hipError_t e = hipLaunchCooperativeKernel((const void*)mega_fwd, dim3(grid), dim3(NTHR), kargs, LDS_BYTES, stream);
        if (e != hipSuccess) fprintf(stderr, "cooperative launch failed: %s\n", hipGetErrorString(e)); }
#else
    a.ph_lo = 0; a.ph_hi = NPH;
    void* kargs[] = {&a};
    hipError_t e = hipLaunchCooperativeKernel((const void*)mega_fwd, dim3(grid), dim3(NTHR), kargs, LDS_BYTES, stream);
    if (e != hipSuccess) fprintf(stderr, "cooperative launch failed: %s\n", hipGetErrorString(e));
#endif
#else
    for (int p = 0; p < NPH; ++p) { a.ph_lo = p; a.ph_hi = p + 1; hipLaunchKernelGGL(mega_fwd, dim3(grid), dim3(NTHR), LDS_BYTES, stream, a); }
#endif
}
```

```cpp
#include <hip/hip_runtime.h>
#include <hip/hip_bf16.h>
#include <cstdio>
#include <cstdint>

constexpr int NWAVES = 8, NTHR = 512;
constexpr int BATCH = 2, SEQ = 4096, DM = 2048, MTOK = BATCH * SEQ;
constexpr int CW = 1024, NHEAD = 16, HD = 64;
constexpr int SHIFTW = 3360, PROJW = 6432, PROJP = 6656;
constexpr int LORA_K = 384, LORA_N = 3072;
constexpr int NEXP = 32, FF = 512;
constexpr int MAXSLOT = 24576;
constexpr float RMS_EPS = 1e-6f, GN_EPS = 64e-5f;
constexpr float LOG2E = 1.4426950408889634f;

constexpr size_t MiB = 1u << 20;
constexpr size_t WS_CTL = 0, CTL_ZERO_BYTES = 1 * MiB;
constexpr size_t WS_MOD = 1 * MiB;
constexpr size_t WS_ROUTE = 1 * MiB + 128 * 1024;
constexpr size_t WS_SW = 1 * MiB + 512 * 1024;
constexpr size_t WS_B36 = 1 * MiB + 96 * 1024;
constexpr size_t WS_RSTD = 1 * MiB + 640 * 1024;
constexpr size_t WS_W36 = 1 * MiB + 704 * 1024;
constexpr size_t WS_WIN = 2 * MiB;
constexpr size_t WS_WOUT = 28 * MiB;
constexpr size_t WS_WL = 36 * MiB;
constexpr size_t WS_WGU = 39 * MiB;
constexpr size_t WS_WD = 167 * MiB;
constexpr size_t B0 = 231 * MiB;
constexpr size_t WS_P = B0;
constexpr size_t WS_PLR = B0 + 96 * MiB;
constexpr size_t HM_PART = (size_t)BATCH * NHEAD * SEQ * HD, HM_BATCH = (size_t)NHEAD * SEQ * HD, HM_HEAD = (size_t)SEQ * HD;
constexpr size_t WS_HB = B0 + 104 * MiB;
constexpr size_t WS_AL = B0 + 136 * MiB;
constexpr size_t WS_LW = B0 + 142 * MiB;
constexpr size_t WS_AA = B0 + 174 * MiB;
constexpr size_t WS_GG = B0 + 190 * MiB;
constexpr size_t WS_R = B0 + 206 * MiB, WS_K2 = B0 + 222 * MiB, WS_V = B0 + 238 * MiB, WS_KK = B0 + 254 * MiB, WS_BB = B0 + 270 * MiB;
constexpr size_t WS_YMIX = B0 + 286 * MiB;
constexpr size_t WS_X1 = B0;
constexpr size_t WS_H2P = B0 + 136 * MiB;
constexpr size_t WS_HG = B0 + 232 * MiB;
constexpr size_t WS_FP = B0 + 136 * MiB;
constexpr size_t WS_HM = B0 + 104 * MiB, WS_Y1 = B0 + 254 * MiB, WS_GT = B0 + 318 * MiB, WS_RH = B0 + 334 * MiB, WS_PLV = B0 + 136 * MiB;
constexpr size_t WS_SF = B0 + 152 * MiB;
constexpr size_t WS_END = B0 + 350 * MiB;
constexpr int CW_NRT = 1152, CW_TE = 1280, CW_BAR = 4096;
constexpr int NSLICE = 64, CW_CNT = 16384, CW_POS = 16384 + NSLICE * 32;

constexpr int CW_STAMP = 1200, CW_RDY = 1400;
#ifdef STAMP_ID
#ifndef STAMP_BLOCK
#define STAMP_BLOCK 0
#endif
#ifndef STAMP_MULT
#define STAMP_MULT 1u
#endif
#define STAMP_BEGIN(id) do { if ((id) == STAMP_ID && blockIdx.x == STAMP_BLOCK && threadIdx.x == 0) st_t0_ = __builtin_amdgcn_s_memrealtime(); } while (0)
#define STAMP_END(id) do { if ((id) == STAMP_ID && blockIdx.x == STAMP_BLOCK && threadIdx.x == 0) atomicAdd((unsigned*)(a.ws + WS_CTL) + CW_STAMP, (unsigned)(__builtin_amdgcn_s_memrealtime() - st_t0_)); } while (0)
#define STAMP_DECL unsigned long long st_t0_ = 0
#else
#define STAMP_BEGIN(id) do { } while (0)
#define STAMP_END(id) do { } while (0)
#define STAMP_DECL do { } while (0)
#endif
constexpr int RING_BYTES = 131072;
constexpr int LDSCTL_OFF = RING_BYTES, MISC_OFF = LDSCTL_OFF + 320;
constexpr int LDS_BYTES = 147456;

#define GAS __attribute__((address_space(1)))
#define LAS __attribute__((address_space(3)))
typedef unsigned short bf16;
typedef unsigned v4u __attribute__((ext_vector_type(4)));
typedef unsigned v2u __attribute__((ext_vector_type(2)));
typedef float f32x4 __attribute__((ext_vector_type(4)));
typedef short bf16x8 __attribute__((ext_vector_type(8)));
typedef short s16x4 __attribute__((ext_vector_type(4)));
typedef GAS unsigned gu32;
typedef GAS unsigned long long gu64;
#define RLX_AGENT __ATOMIC_RELAXED, __HIP_MEMORY_SCOPE_AGENT
#define LDS_WAIT() asm volatile("s_waitcnt lgkmcnt(0)" ::: "memory")
#define VM_WAIT() asm volatile("s_waitcnt vmcnt(0)" ::: "memory")
__device__ __forceinline__ unsigned f2bf(float f) { unsigned u = __builtin_bit_cast(unsigned, f); return (u + 0x7fffu + ((u >> 16) & 1u)) >> 16; }
typedef float f32x2_t __attribute__((ext_vector_type(2)));
typedef __bf16 bf16x2_t __attribute__((ext_vector_type(2)));
__device__ __forceinline__ unsigned pk2(float lo, float hi) { const f32x2_t v = {lo, hi}; return __builtin_bit_cast(unsigned, __builtin_convertvector(v, bf16x2_t)); }
__device__ __forceinline__ float bflo(unsigned u) { return __builtin_bit_cast(float, u << 16); }
__device__ __forceinline__ float bfhi(unsigned u) { return __builtin_bit_cast(float, u & 0xffff0000u); }
__device__ __forceinline__ float wave_sum(float v) {
#pragma unroll
    for (int o = 1; o < 64; o <<= 1) v += __shfl_xor(v, o);
    return v;
}
__device__ __forceinline__ float sigmoid_f(float x) { return __builtin_amdgcn_rcpf(1.f + __expf(-x)); }

struct Args { const float* in[30]; float* out; unsigned char* ws; int ph_lo, ph_hi, li, pad; };
enum { I_X = 0, I_C, I_WADA, I_BADA, I_N1G, I_WIN, I_MU, I_W0, I_WDEC, I_A0, I_WAAA, I_WGATEUP, I_KK, I_KA, I_RK, I_LNW, I_LNB, I_RELB, I_BETAR, I_BETAA,
       I_WOUT, I_N2G, I_WGRP, I_BGRP, I_WEXP, I_BEXP, I_WG, I_WU, I_WDN, I_NFG };
constexpr int NPH = 15;

namespace pg8 {
#define PG8_LAS __attribute__((address_space(3)))
typedef unsigned short bf16_t;
typedef short bf16x8 __attribute__((ext_vector_type(8)));
typedef float f32x4 __attribute__((ext_vector_type(4)));
typedef unsigned u32x4 __attribute__((ext_vector_type(4)));
constexpr int BM = 256, BK = 64, HALF = 128, HTB = HALF * BK * 2  , STAGE_BYTES = 8 * HTB, NXCD = 8, WGM = 8;

__host__ __device__ __forceinline__ int lds_byte(int r, int c) { const int st = (r >> 4) * 2 + (c >> 5), rr = r & 15, cc = c & 31, ob = rr * 64 + cc * 2; return st * 1024 + (ob ^ (((ob >> 9) & 1) << 5)); }
__host__ __device__ __forceinline__ void stage_rc(int b, int& R, int& C) { const int st = b / 1024, sb = b % 1024, swz = sb ^ (((sb >> 9) & 1) << 5); R = (st >> 1) * 16 + swz / 64; C = (st & 1) * 32 + (swz % 64) / 2; }
__host__ __device__ __forceinline__ int perm32(int rho) { const int n = rho >> 4, i = rho & 15; return 8 * (i >> 2) + 4 * n + (i & 3); }

struct Unit { int pm, pn; };
struct Gemm { const bf16_t* A; const bf16_t* Bt; int M, N, K; };

struct StaticOrder {
    int nM, nN, nwg, G, c;
    __host__ __device__ void init(int M, int N, int G_, int c_) { nM = M / BM; nN = N / BM; nwg = nM * nN; G = G_; c = c_; }
    __host__ __device__ bool next(int i, Unit& u) const {
        const long L = (long)i * G + c; if (L >= nwg) return false;
        int wgid = (int)L; { const int q = nwg / NXCD, r = nwg % NXCD, xcd = wgid % NXCD, off = wgid / NXCD; wgid = (xcd < r ? xcd * (q + 1) : r * (q + 1) + (xcd - r) * q) + off; }
        const int nig = WGM * nN, gid = wgid / nig, fm = gid * WGM, gsz = (nM - fm) < WGM ? (nM - fm) : WGM;
        u.pm = fm + ((wgid % nig) % gsz); u.pn = (wgid % nig) / gsz; return true;
    }
    __device__ __forceinline__ void a_ready(const Unit&) const {}
    __device__ __forceinline__ void done(const Unit&) const {}
};

__device__ __forceinline__ unsigned cvt_pk_bf16(float lo, float hi) { unsigned r; asm volatile("v_cvt_pk_bf16_f32 %0, %1, %2" : "=v"(r) : "v"(lo), "v"(hi)); return r; }
template <class Epi, class Sched, bool ALIGN_EPI = false, bool SP2 = false>
__device__ __forceinline__ void gemm_phase(PG8_LAS unsigned char* lds, const Gemm g, const Sched& S, const Epi& E) {
    const int tid = threadIdx.x, wid = __builtin_amdgcn_readfirstlane(tid >> 6), lane = tid & 63, wr = wid >> 2, wc = wid & 3, fr = lane & 15, fq = lane >> 4;
    const int K = g.K, nt = K / BK;
    unsigned voffA[2], voffB[2];
#pragma unroll
    for (int i = 0; i < 2; ++i) { int R, C; stage_rc(tid * 16 + i * 8192, R, C); const int Rb = Epi::PERM ? ((R & ~31) + perm32(R & 31)) : R;
        voffA[i] = (unsigned)(R * K + C) * 2u; voffB[i] = (unsigned)(Rb * K + C) * 2u; }
    const size_t kstep = (size_t)(BK * 2);
    const size_t hstep = (size_t)HALF * K * 2;
    const size_t tstep = 2 * hstep;
    const unsigned ldsw = (unsigned)wid * 1024u;
    const int aoff = lds_byte(wr * 64 + fr, fq * 8), boff = lds_byte(wc * 32 + fr, fq * 8);
#define PG8_SA(b, h) (((b) * 2 + (h)) * HTB)
#define PG8_SB(b, h) ((4 + (b) * 2 + (h)) * HTB)
#define PG8_STAGE(bufoff, gbase, voff) do { _Pragma("unroll") for (int _i = 0; _i < 2; ++_i) \
        __builtin_amdgcn_global_load_lds((const unsigned*)((const char*)(gbase) + (voff)[_i]), (PG8_LAS unsigned*)(lds + (bufoff) + ldsw + _i * 8192), 16, 0, 0); } while (0)
#define PG8_LDA(dst, b, h) do { _Pragma("unroll") for (int m = 0; m < 4; ++m) _Pragma("unroll") for (int k = 0; k < 2; ++k) dst[m][k] = *(const PG8_LAS bf16x8*)(lds + PG8_SA(b, h) + aoff + m * 2048 + k * 1024); } while (0)
#define PG8_LDB(dst, b, h) do { _Pragma("unroll") for (int n = 0; n < 2; ++n) _Pragma("unroll") for (int k = 0; k < 2; ++k) dst[n][k] = *(const PG8_LAS bf16x8*)(lds + PG8_SB(b, h) + boff + n * 2048 + k * 1024); } while (0)
#define PG8_MMA(ai, bj, At, Bt) do { __builtin_amdgcn_s_setprio(1); _Pragma("unroll") for (int m = 0; m < 4; ++m) _Pragma("unroll") for (int n = 0; n < 2; ++n) _Pragma("unroll") for (int k = 0; k < 2; ++k) \
        acc[ai][bj][m][n] = __builtin_amdgcn_mfma_f32_16x16x32_bf16(Bt[n][k], At[m][k], acc[ai][bj][m][n], 0, 0, 0); __builtin_amdgcn_s_setprio(0); } while (0)
#define PG8_WAIT_V(n) asm volatile("s_waitcnt vmcnt(" #n ")" ::: "memory")
#define PG8_WAIT_L(n) asm volatile("s_waitcnt lgkmcnt(" #n ")" ::: "memory")
#define PG8_BAR __builtin_amdgcn_s_barrier()
#define PG8_SCHED __builtin_amdgcn_sched_barrier(0)
    Unit cur, nxt; int ui = 0;
    if (!S.next(0, cur)) return;
    f32x4 acc[2][2][4][2];
#pragma unroll
    for (int a = 0; a < 2; ++a)
#pragma unroll
        for (int b = 0; b < 2; ++b)
#pragma unroll
            for (int m = 0; m < 4; ++m)
#pragma unroll
                for (int n = 0; n < 2; ++n) acc[a][b][m][n] = (f32x4){0.f, 0.f, 0.f, 0.f};
    bf16x8 At[4][2], B0[2][2], B1[2][2];
    const char* cA = (const char*)g.A + (size_t)cur.pm * tstep; const char* cB = (const char*)g.Bt + (size_t)cur.pn * tstep;
    S.a_ready(cur);
    if constexpr (SP2) {
        PG8_STAGE(PG8_SB(0, 0), cB, voffB); PG8_STAGE(PG8_SB(0, 1), cB + hstep, voffB); PG8_STAGE(PG8_SA(0, 0), cA, voffA); PG8_STAGE(PG8_SA(0, 1), cA + hstep, voffA);
        if (wr == 1) PG8_BAR;
        PG8_WAIT_V(2); PG8_BAR;
        PG8_STAGE(PG8_SB(1, 0), cB + kstep, voffB); PG8_STAGE(PG8_SA(1, 0), cA + kstep, voffA); PG8_STAGE(PG8_SB(1, 1), cB + hstep + kstep, voffB);
        PG8_WAIT_V(6); PG8_BAR;
    } else {
        PG8_STAGE(PG8_SB(0, 0), cB, voffB); PG8_STAGE(PG8_SA(0, 0), cA, voffA); PG8_STAGE(PG8_SB(0, 1), cB + hstep, voffB); PG8_STAGE(PG8_SA(0, 1), cA + hstep, voffA);
        if (wr == 1) PG8_BAR;
        PG8_WAIT_V(4); PG8_BAR;
        PG8_STAGE(PG8_SB(1, 0), cB + kstep, voffB); PG8_STAGE(PG8_SA(1, 0), cA + kstep, voffA); PG8_STAGE(PG8_SB(1, 1), cB + hstep + kstep, voffB);
        PG8_WAIT_V(6); PG8_BAR;
    }
    for (;;) {
        const bool has_next = S.next(ui + 1, nxt);
        const char* nA = has_next ? (const char*)g.A + (size_t)nxt.pm * tstep : cA; const char* nB = has_next ? (const char*)g.Bt + (size_t)nxt.pn * tstep : cB;
        for (int t = 0; t < nt; t += 2) {
            const bool last = (t == nt - 2);
            const char* a1 = cA + (size_t)(t + 1) * kstep;
            const char* a2 = last ? nA : cA + (size_t)(t + 2) * kstep; const char* b2 = last ? nB : cB + (size_t)(t + 2) * kstep;
            const char* a3 = a2 + kstep; const char* b3 = b2 + kstep;
            if (last && has_next) S.a_ready(nxt);
            if constexpr (SP2) {
            PG8_LDB(B0, 0, 0); PG8_LDB(B1, 0, 1); PG8_SCHED; PG8_LDA(At, 0, 0); PG8_STAGE(PG8_SA(1, 1), a1 + hstep, voffA);
            PG8_WAIT_V(8); PG8_WAIT_L(0); PG8_BAR; PG8_MMA(0, 0, At, B0); PG8_MMA(0, 1, At, B1); PG8_BAR; PG8_SCHED;
            PG8_LDA(At, 0, 1); PG8_STAGE(PG8_SB(0, 0), b2, voffB); PG8_STAGE(PG8_SB(0, 1), b2 + hstep, voffB); PG8_STAGE(PG8_SA(0, 0), a2, voffA);
            PG8_WAIT_V(8); PG8_WAIT_L(0); PG8_BAR; PG8_MMA(1, 0, At, B0); PG8_MMA(1, 1, At, B1); PG8_BAR; PG8_SCHED;
            PG8_LDB(B0, 1, 0); PG8_LDB(B1, 1, 1); PG8_SCHED; PG8_LDA(At, 1, 0); PG8_STAGE(PG8_SA(0, 1), a2 + hstep, voffA);
            PG8_WAIT_V(8); PG8_WAIT_L(0); PG8_BAR; PG8_MMA(0, 0, At, B0); PG8_MMA(0, 1, At, B1); PG8_BAR; PG8_SCHED;
            PG8_LDA(At, 1, 1); PG8_STAGE(PG8_SB(1, 0), b3, voffB); PG8_STAGE(PG8_SB(1, 1), b3 + hstep, voffB); PG8_STAGE(PG8_SA(1, 0), a3, voffA);
            PG8_WAIT_V(8); PG8_WAIT_L(0); PG8_BAR; PG8_MMA(1, 0, At, B0); PG8_MMA(1, 1, At, B1); PG8_BAR; PG8_SCHED;
            } else {
            PG8_LDB(B0, 0, 0); PG8_SCHED; PG8_LDA(At, 0, 0); PG8_STAGE(PG8_SA(1, 1), a1 + hstep, voffA);
            PG8_WAIT_L(8); PG8_BAR; PG8_WAIT_L(0); PG8_MMA(0, 0, At, B0); PG8_BAR; PG8_SCHED;
            PG8_LDB(B1, 0, 1); PG8_STAGE(PG8_SB(0, 0), b2, voffB);
            PG8_BAR; PG8_WAIT_L(0); PG8_MMA(0, 1, At, B1); PG8_BAR;
            PG8_LDA(At, 0, 1); PG8_STAGE(PG8_SA(0, 0), a2, voffA);
            PG8_BAR; PG8_WAIT_L(0); PG8_MMA(1, 0, At, B0); PG8_BAR; PG8_SCHED;
            PG8_STAGE(PG8_SB(0, 1), b2 + hstep, voffB);
            PG8_WAIT_V(6); PG8_BAR; PG8_MMA(1, 1, At, B1); PG8_BAR;
            PG8_LDB(B0, 1, 0); PG8_SCHED; PG8_LDA(At, 1, 0); PG8_STAGE(PG8_SA(0, 1), a2 + hstep, voffA);
            PG8_WAIT_L(8); PG8_BAR; PG8_WAIT_L(0); PG8_MMA(0, 0, At, B0); PG8_BAR; PG8_SCHED;
            PG8_LDB(B1, 1, 1); PG8_STAGE(PG8_SB(1, 0), b3, voffB);
            PG8_BAR; PG8_WAIT_L(0); PG8_MMA(0, 1, At, B1); PG8_BAR;
            PG8_LDA(At, 1, 1); PG8_STAGE(PG8_SA(1, 0), a3, voffA);
            PG8_BAR; PG8_WAIT_L(0); PG8_MMA(1, 0, At, B0); PG8_BAR; PG8_SCHED;
            PG8_STAGE(PG8_SB(1, 1), b3 + hstep, voffB);
            PG8_WAIT_V(6); PG8_BAR; PG8_MMA(1, 1, At, B1); PG8_BAR;
            }
        }
        if constexpr (ALIGN_EPI) { if (wr == 0) PG8_BAR; }
        if constexpr (!Epi::AFTER_DRAIN) { E(acc, cur, wr, wc, fr, fq); S.done(cur); }
        if (!has_next) break;
#pragma unroll
        for (int a = 0; a < 2; ++a)
#pragma unroll
            for (int b = 0; b < 2; ++b)
#pragma unroll
                for (int m = 0; m < 4; ++m)
#pragma unroll
                    for (int n = 0; n < 2; ++n) acc[a][b][m][n] = (f32x4){0.f, 0.f, 0.f, 0.f};
        cur = nxt; cA = nA; cB = nB; ++ui;
        if constexpr (ALIGN_EPI) { if (wr == 1) PG8_BAR; }
    }
    PG8_WAIT_V(0);
    if constexpr (!ALIGN_EPI) { if (wr == 0) PG8_BAR; }
    PG8_BAR;
    if constexpr (Epi::AFTER_DRAIN) { E.fused(acc, cur, wr, wc, fr, fq, lds, wid, lane); S.done(cur); }
#undef PG8_SA
#undef PG8_SB
#undef PG8_STAGE
#undef PG8_LDA
#undef PG8_LDB
#undef PG8_MMA
#undef PG8_WAIT_V
#undef PG8_WAIT_L
#undef PG8_BAR
#undef PG8_SCHED
}
}
#define XB_TMO      128
#define XB_XCNT(j)  (256  + 64 * (j))
#define XB_XSUB(j)  (1280 + 64 * (j))
#define XB_XGEN(j)  (2304 + 64 * (j))
#define XB_TOP      3328
#define XB_TOPGEN   3392
#define XCD_BAR_WORDS 3456
#define XB_SPIN_CAP (1u << 18)

__device__ __forceinline__ unsigned xb_ld(unsigned* p)              { return __hip_atomic_load(p, __ATOMIC_RELAXED, __HIP_MEMORY_SCOPE_AGENT); }
__device__ __forceinline__ unsigned xb_add(unsigned* p, unsigned v) { return __hip_atomic_fetch_add(p, v, __ATOMIC_RELAXED, __HIP_MEMORY_SCOPE_AGENT); }
__device__ __forceinline__ unsigned xb_xcc_id() { return (unsigned)__builtin_amdgcn_s_getreg((3 << 11) | 20) & 0xFu; }
#define XB_SPIN(cond, bar) do { unsigned _sp = 0; while (cond) { __builtin_amdgcn_s_sleep(1); \
    if ((++_sp & 255u) == 0u) { if (xb_ld(&(bar)[XB_TMO])) break; if (_sp > XB_SPIN_CAP) { atomicAdd(&(bar)[XB_TMO], 1u); break; } } } } while (0)

struct XcdBarrier {
    unsigned* bar; unsigned x;
    volatile LAS unsigned* st;
};

__device__ __forceinline__ XcdBarrier xcd_barrier_post(unsigned* bar, volatile LAS unsigned* st) {
    XcdBarrier b; b.bar = bar; b.x = xb_xcc_id(); b.st = st;
    if (threadIdx.x == 0) (void)xb_add(&bar[XB_XCNT(b.x)], 1u);
    return b;
}
__device__ __forceinline__ void xcd_barrier_complete(unsigned* bar, unsigned x, unsigned& nloc, unsigned& nx) {
    const unsigned G = gridDim.x * gridDim.y * gridDim.z;
    unsigned sum, cnt, mine, sp = 0u;
    for (;;) {
        sum = 0u; cnt = 0u; mine = 0u;
#pragma unroll
        for (unsigned j = 0; j < 16; ++j) { const unsigned c = xb_ld(&bar[XB_XCNT(j)]); sum += c; cnt += (c > 0u) ? 1u : 0u; mine = (j == x) ? c : mine; }
        if (sum == G) break;
        __builtin_amdgcn_s_sleep(1);
        if ((++sp & 255u) == 0u) { if (xb_ld(&bar[XB_TMO])) break; if (sp > XB_SPIN_CAP) { atomicAdd(&bar[XB_TMO], 1u); break; } }
    }
    nloc = mine > 0u ? mine : 1u; nx = cnt > 0u ? cnt : 1u;
}

__device__ __forceinline__ void xcd_barrier(const XcdBarrier& b) {
    asm volatile("s_waitcnt vmcnt(0)" ::: "memory");
    __syncthreads();
    if (threadIdx.x == 0) {
        unsigned* bar = b.bar;
        __builtin_amdgcn_s_waitcnt(0);
        unsigned nloc = b.st[0], nx = b.st[1];
        if (nloc == 0u) { xcd_barrier_complete(bar, b.x, nloc, nx); b.st[0] = nloc; b.st[1] = nx; }
        const unsigned old = xb_add(&bar[XB_XSUB(b.x)], 1u);
        const unsigned gen = old / nloc;
        if (old + 1u == (gen + 1u) * nloc) {
            __builtin_amdgcn_fence(__ATOMIC_RELEASE, "agent");
            asm volatile("s_waitcnt vmcnt(0)" ::: "memory");
            const unsigned og = xb_add(&bar[XB_TOP], 1u);
            const unsigned tg = og / nx;
            if (og + 1u == (tg + 1u) * nx) xb_add(&bar[XB_TOPGEN], 1u);
            else XB_SPIN(xb_ld(&bar[XB_TOPGEN]) == tg, bar);
            __builtin_amdgcn_fence(__ATOMIC_ACQUIRE, "agent");
            xb_add(&bar[XB_XGEN(b.x)], 1u);
            asm volatile("s_waitcnt vmcnt(0)" ::: "memory");
        } else {
            XB_SPIN(xb_ld(&bar[XB_XGEN(b.x)]) == gen, bar);
            __builtin_amdgcn_fence(__ATOMIC_ACQUIRE, "agent");
            asm volatile("s_waitcnt vmcnt(0)" ::: "memory");
        }
    }
    __syncthreads();
}

struct EpiStoreBf16 {
    static constexpr bool PERM = true, AFTER_DRAIN = false;
    bf16* O; int ldc; int pn_mask;
    __device__ __forceinline__ void operator()(const pg8::f32x4 (&acc)[2][2][4][2], const pg8::Unit& u, int wr, int wc, int fr_, int fq_) const {
        int t_ = threadIdx.x; asm volatile("" : "+v"(t_)); const int fr = t_ & 15, fq = (t_ >> 4) & 3; (void)fr_; (void)fq_;
        const int row0 = u.pm * 256 + wr * 64 + fr, col0 = (u.pn & pn_mask) * 256 + wc * 32 + 8 * fq;
#pragma unroll
        for (int ai = 0; ai < 2; ++ai)
#pragma unroll
            for (int m = 0; m < 4; ++m) { bf16* rowp = O + (size_t)(row0 + ai * 128 + m * 16) * ldc + col0;
#pragma unroll
                for (int bj = 0; bj < 2; ++bj) { const pg8::f32x4 v0 = acc[ai][bj][m][0], v1 = acc[ai][bj][m][1];
                    v4u w; w.x = pg8::cvt_pk_bf16(v0[0], v0[1]); w.y = pg8::cvt_pk_bf16(v0[2], v0[3]); w.z = pg8::cvt_pk_bf16(v1[0], v1[1]); w.w = pg8::cvt_pk_bf16(v1[2], v1[3]);
                    *(v4u*)(rowp + bj * 128) = w; } }
    }
};
struct EpiProj {
    static constexpr bool PERM = true, AFTER_DRAIN = false;
    bf16* HM; bf16* PLR;
    __device__ __forceinline__ void operator()(const pg8::f32x4 (&acc)[2][2][4][2], const pg8::Unit& u, int wr, int wc, int fr_, int fq_) const {
        int t_ = threadIdx.x; asm volatile("" : "+v"(t_)); const int fr = t_ & 15, fq = (t_ >> 4) & 3; (void)fr_; (void)fq_;
        const int row0 = u.pm * 256 + wr * 64 + fr, colb = u.pn * 256 + wc * 32 + 8 * fq;
#pragma unroll
        for (int bj = 0; bj < 2; ++bj) { const int col0 = colb + bj * 128;
            if (col0 >= PROJW) continue;
            const bool lora = col0 >= 3072 && col0 < SHIFTW;
            const int idx = col0 < 3072 ? col0 : col0 - (SHIFTW - 3072);
            const size_t hbase = (size_t)(idx >> 10) * HM_PART + (size_t)((idx >> 6) & 15) * HM_HEAD + (idx & 63);
#pragma unroll
            for (int ai = 0; ai < 2; ++ai)
#pragma unroll
                for (int m = 0; m < 4; ++m) { const int row = row0 + ai * 128 + m * 16;
                    bf16* dst = lora ? PLR + (size_t)row * 288 + (col0 - 3072) : HM + hbase + (size_t)(row >> 12) * HM_BATCH + (size_t)(row & (SEQ - 1)) * HD;
                    const pg8::f32x4 v0 = acc[ai][bj][m][0], v1 = acc[ai][bj][m][1];
                    v4u w; w.x = pg8::cvt_pk_bf16(v0[0], v0[1]); w.y = pg8::cvt_pk_bf16(v0[2], v0[3]); w.z = pg8::cvt_pk_bf16(v1[0], v1[1]); w.w = pg8::cvt_pk_bf16(v1[2], v1[3]);
                    *(v4u*)dst = w; } }
    }
};
struct EpiGateUp {
    static constexpr bool PERM = true, AFTER_DRAIN = false;
    const float* sw; bf16* HG;
    __device__ __forceinline__ void operator()(const pg8::f32x4 (&acc)[2][2][4][2], const pg8::Unit& u, int wr, int wc, int fr_, int fq_) const {
        int t_ = threadIdx.x; asm volatile("" : "+v"(t_)); const int fr = t_ & 15, fq = (t_ >> 4) & 3; (void)fr_; (void)fq_;
        const int pl = u.pn & 3, row0 = u.pm * 256 + wr * 64 + fr, col0 = pl * 128 + wc * 32 + 8 * fq;
#pragma unroll
        for (int ai = 0; ai < 2; ++ai)
#pragma unroll
            for (int m = 0; m < 4; ++m) { const int row = row0 + ai * 128 + m * 16; const float w = sw[row]; float h[8];
#pragma unroll
                for (int n = 0; n < 2; ++n)
#pragma unroll
                    for (int j = 0; j < 4; ++j) { const float g = acc[ai][0][m][n][j], up = acc[ai][1][m][n][j]; h[4 * n + j] = g * sigmoid_f(g) * up * w; }
                v4u o; o.x = pg8::cvt_pk_bf16(h[0], h[1]); o.y = pg8::cvt_pk_bf16(h[2], h[3]); o.z = pg8::cvt_pk_bf16(h[4], h[5]); o.w = pg8::cvt_pk_bf16(h[6], h[7]);
                *(v4u*)(HG + (size_t)row * FF + col0) = o; }
    }
};
struct EpiResGate {
    static constexpr bool PERM = true, AFTER_DRAIN = false;
    const float* x; const float* gate; float* X1;
    __device__ __forceinline__ void operator()(const pg8::f32x4 (&acc)[2][2][4][2], const pg8::Unit& u, int wr, int wc, int fr_, int fq_) const {
        int t_ = threadIdx.x; asm volatile("" : "+v"(t_)); const int fr = t_ & 15, fq = (t_ >> 4) & 3; (void)fr_; (void)fq_;
        const int row0 = u.pm * 256 + wr * 64 + fr, col0 = u.pn * 256 + wc * 32 + 8 * fq;
        const float* gp = gate + (size_t)((u.pm * 256) >> 12) * 12288;
#pragma unroll
        for (int bj = 0; bj < 2; ++bj) { const int c = col0 + bj * 128; const pg8::f32x4 g0 = *(const pg8::f32x4*)(gp + c), g1 = *(const pg8::f32x4*)(gp + c + 4);
#pragma unroll
            for (int ai = 0; ai < 2; ++ai)
#pragma unroll
                for (int m = 0; m < 4; ++m) { const size_t off = (size_t)(row0 + ai * 128 + m * 16) * DM + c;
                    const pg8::f32x4 x0 = *(const pg8::f32x4*)(x + off), x1 = *(const pg8::f32x4*)(x + off + 4);
                    *(pg8::f32x4*)(X1 + off) = x0 + g0 * acc[ai][bj][m][0]; *(pg8::f32x4*)(X1 + off + 4) = x1 + g1 * acc[ai][bj][m][1]; } }
    }
};
struct EpiLora {
    static constexpr bool PERM = false, AFTER_DRAIN = false;
    float* LW; bf16* AA; bf16* GG;
    __device__ __forceinline__ void operator()(const pg8::f32x4 (&acc)[2][2][4][2], const pg8::Unit& u, int wr, int wc, int fr_, int fq_) const {
        int t_ = threadIdx.x; asm volatile("" : "+v"(t_)); const int fr = t_ & 15, fq = (t_ >> 4) & 3; (void)fr_; (void)fq_;
        const int type = u.pn >> 2, row0 = u.pm * 256 + wr * 64 + fr, col0 = (u.pn & 3) * 256 + wc * 32 + 4 * fq;
        bf16* hb = (type == 1) ? AA : GG;
#pragma unroll
        for (int bj = 0; bj < 2; ++bj)
#pragma unroll
            for (int n = 0; n < 2; ++n) { const int c = col0 + bj * 128 + n * 16;
#pragma unroll
                for (int ai = 0; ai < 2; ++ai)
#pragma unroll
                    for (int m = 0; m < 4; ++m) { const size_t off = (size_t)(row0 + ai * 128 + m * 16) * CW + c; const pg8::f32x4 v = acc[ai][bj][m][n];
                        if (type == 0) *(pg8::f32x4*)(LW + off) = v;
                        else { v2u o; o.x = pg8::cvt_pk_bf16(v[0], v[1]); o.y = pg8::cvt_pk_bf16(v[2], v[3]); *(v2u*)(hb + off) = o; } } }
    }
};
struct GroupOrder {
    const unsigned* te; int nrt, ncol, G, c;
    __device__ __forceinline__ bool next(int i, pg8::Unit& u) const {
        const long L = (long)i * G + c; if (L >= (long)nrt * ncol) return false;
        const int rt = (int)(L / ncol), pl = (int)(L - (long)rt * ncol);
        u.pm = rt; u.pn = (int)te[rt] * ncol + pl; return true;
    }
    __device__ __forceinline__ void a_ready(const pg8::Unit&) const {}
    __device__ __forceinline__ void done(const pg8::Unit&) const {}
};

struct GroupOrder2 {
    const unsigned* te; int ncol, base, count, Gp, cp;
    __device__ __forceinline__ bool next(int i, pg8::Unit& u) const {
        const long k = (long)i * Gp + cp; if (cp < 0 || k >= count) return false;
        const int L = base + (int)k, rt = L / ncol, pl = L - rt * ncol;
        u.pm = rt; u.pn = (int)te[rt] * ncol + pl; return true;
    }
    __device__ __forceinline__ void a_ready(const pg8::Unit&) const {}
    __device__ __forceinline__ void done(const pg8::Unit&) const {}
};

#define MFMA16(a, b, c) __builtin_amdgcn_mfma_f32_16x16x16bf16_1k(a, b, c, 0, 0, 0)
constexpr int NUNIT = BATCH * NHEAD * (SEQ / 64);
constexpr int LA_GF = 0, LA_SEG = 16384, LA_PL = 18432, LA_RT = 20480, LA_QT = 28672, LA_KT = 36864, LA_BT = 45056, LA_VT = 53248,
              LA_AQB = 61440, LA_AQK = 69632, LA_ARB = 77824, LA_ARK = 86016, LA_DG = 94208, LA_DL = 98304, LA_PRM = 100352;
__device__ __forceinline__ int swz(int row, int chunk) { return row * 128 + ((chunk ^ ((row >> 1) & 7)) << 4); }
__device__ __forceinline__ s16x4 tr_read(LAS unsigned char* base, int r0, int cb, int n) {
    return __builtin_bit_cast(s16x4, __builtin_amdgcn_ds_read_tr16_b64_v4i16((LAS s16x4*)(base + swz(r0 + (n >> 2), 2 * cb + ((n & 3) >> 1)) + 8 * (n & 1)))); }
__device__ __forceinline__ s16x4 row_read4(LAS unsigned char* base, int row, int col0) {
    return *(const LAS s16x4*)(base + swz(row, col0 >> 3) + 2 * (col0 & 7)); }
__device__ __forceinline__ s16x4 pack4(const f32x4 v) { v2u w; w.x = pk2(v[0], v[1]); w.y = pk2(v[2], v[3]); return __builtin_bit_cast(s16x4, w); }
__device__ __forceinline__ s16x4 pack4n(const f32x4 v) { v2u w; w.x = pk2(-v[0], -v[1]); w.y = pk2(-v[2], -v[3]); return __builtin_bit_cast(s16x4, w); }
__device__ __forceinline__ f32x4 unpack4(const s16x4 s) { const v2u w = __builtin_bit_cast(v2u, s); return (f32x4){bflo(w.x), bfhi(w.x), bflo(w.y), bfhi(w.y)}; }

#define LGKM0() do { asm volatile("s_waitcnt lgkmcnt(0)" ::: "memory"); __builtin_amdgcn_sched_barrier(0); } while (0)
#define LDS_BARRIER() do { asm volatile("s_waitcnt lgkmcnt(0)" ::: "memory"); __builtin_amdgcn_s_barrier(); asm volatile("" ::: "memory"); } while (0)
__device__ __forceinline__ void scanA(const Args& a, LAS unsigned char* lds) {
    const int tid = threadIdx.x, lane = tid & 63, wave = __builtin_amdgcn_readfirstlane(tid >> 6), n = lane & 15, g = lane >> 4;
    LAS float* GF = (LAS float*)(lds + LA_GF); LAS float* SEG = (LAS float*)(lds + LA_SEG); LAS float* PLs = (LAS float*)(lds + LA_PL); LAS float* DG = (LAS float*)(lds + LA_DG);
    const int tk = tid >> 3, c8 = 8 * (tid & 7);
    v4u nr4, nk4, nv4, pr4, pk4, pv4, na4; f32x4 nl0, nl1;
#define SCANA_LOAD(U) do { const int bh_ = (U) >> 6, ck_ = (U) & 63, h_ = bh_ & 15; const size_t m_ = (size_t)(bh_ >> 4) * SEQ + 64 * ck_ + tk; \
        const bf16* pc_ = (const bf16*)(a.ws + WS_P) + (size_t)(bh_ >> 4) * HM_BATCH + (size_t)h_ * HM_HEAD + (size_t)(64 * ck_ + tk) * HD + c8; const bf16* pp_ = pc_ - ((64 * ck_ + tk) != 0 ? HD : 0); \
        nr4 = *(const v4u*)pc_; nk4 = *(const v4u*)(pc_ + HM_PART); nv4 = *(const v4u*)(pc_ + 2 * HM_PART); pr4 = *(const v4u*)pp_; pk4 = *(const v4u*)(pp_ + HM_PART); pv4 = *(const v4u*)(pp_ + 2 * HM_PART); \
        const size_t off_ = m_ * CW + h_ * 64 + c8; na4 = *(const v4u*)((const bf16*)(a.ws + WS_AA) + off_); \
        nl0 = *(const f32x4*)((const float*)(a.ws + WS_LW) + off_); nl1 = *(const f32x4*)((const float*)(a.ws + WS_LW) + off_ + 4); } while (0)
#define SCANA_UNIT(IDX) (((((IDX) >> 10) * 16 + ((IDX) & 15)) << 6) + (((IDX) >> 4) & 63))
    if ((int)blockIdx.x < NUNIT) SCANA_LOAD(SCANA_UNIT((int)blockIdx.x));
    STAMP_DECL;
    LAS float* PRM = (LAS float*)(lds + LA_PRM);
    int hcur = -1;
    for (int idx = blockIdx.x; idx < NUNIT; idx += gridDim.x) {
        const int unit = SCANA_UNIT(idx);
        int tid_o = threadIdx.x; asm volatile("" : "+v"(tid_o));
        const int tid = tid_o, lane = tid & 63, n = lane & 15, g = lane >> 4, tk = tid >> 3, c8 = 8 * (tid & 7);
        STAMP_BEGIN(5); STAMP_BEGIN(1);
        const int h = (unit >> 6) & 15, ch0 = h * 64 + c8; const bool first = ((unit & 63) == 0) && (tk == 0);
        if (h != hcur) { hcur = h;
            if (tid < 448) { const int which = tid >> 6, c = tid & 63; const float* src = (which == 0) ? a.in[I_MU] : (which == 1) ? a.in[I_MU] + 1024 : (which == 2) ? a.in[I_MU] + 2048 :
                    (which == 3) ? a.in[I_A0] : (which == 4) ? a.in[I_KK] : (which == 5) ? a.in[I_KA] : a.in[I_W0];
                PRM[tid] = src[h * 64 + c]; }
            LDS_BARRIER(); }
        float pmr[8], pmk[8], pmv[8], pa0[8], pkk[8], pka[8], pw0[8];
        { f32x4 pv[14];
#pragma unroll
          for (int q = 0; q < 7; ++q) { pv[2 * q] = *(const LAS f32x4*)(PRM + 64 * q + c8); pv[2 * q + 1] = *(const LAS f32x4*)(PRM + 64 * q + c8 + 4); }
          LGKM0();
#pragma unroll
          for (int i = 0; i < 8; ++i) { pmr[i] = pv[0 + (i >> 2)][i & 3]; pmk[i] = pv[2 + (i >> 2)][i & 3]; pmv[i] = pv[4 + (i >> 2)][i & 3]; pa0[i] = pv[6 + (i >> 2)][i & 3];
              pkk[i] = pv[8 + (i >> 2)][i & 3]; pka[i] = pv[10 + (i >> 2)][i & 3]; pw0[i] = pv[12 + (i >> 2)][i & 3]; } }
        float rf[8], kf[8], vf8[8], qf8[8], bf8[8]; f32x4 l0, l1;
        { float av[8], kkv[8]; float ssq = 0.f;
#pragma unroll
          for (int i = 0; i < 8; ++i) { const int wd = i >> 1; const bool hi = i & 1;
              const float cr = hi ? bfhi(nr4[wd]) : bflo(nr4[wd]), ckk = hi ? bfhi(nk4[wd]) : bflo(nk4[wd]), cv = hi ? bfhi(nv4[wd]) : bflo(nv4[wd]);
              const float qr = first ? 0.f : (hi ? bfhi(pr4[wd]) : bflo(pr4[wd])), qk = first ? 0.f : (hi ? bfhi(pk4[wd]) : bflo(pk4[wd])), qv = first ? 0.f : (hi ? bfhi(pv4[wd]) : bflo(pv4[wd]));
              rf[i] = cr + (qr - cr) * pmr[i]; kf[i] = ckk + (qk - ckk) * pmk[i]; vf8[i] = cv + (qv - cv) * pmv[i];
              av[i] = sigmoid_f((hi ? bfhi(na4[wd]) : bflo(na4[wd])) + pa0[i]);
              kkv[i] = kf[i] * pkk[i]; ssq += kkv[i] * kkv[i]; }
          ssq += __shfl_xor(ssq, 1); ssq += __shfl_xor(ssq, 2); ssq += __shfl_xor(ssq, 4);
          const float inv = __builtin_amdgcn_rsqf(fmaxf(ssq, 1e-24f));
#pragma unroll
          for (int i = 0; i < 8; ++i) { qf8[i] = kkv[i] * inv; bf8[i] = qf8[i] * av[i]; kf[i] = kf[i] * (1.f + (av[i] - 1.f) * pka[i]); }
#pragma unroll
          for (int i = 0; i < 4; ++i) { const float z0 = -(nl0[i] + pw0[i]), z1 = -(nl1[i] + pw0[4 + i]);
              const float s0 = fmaxf(z0, 0.f) + __logf(1.f + __expf(-fabsf(z0))), s1 = fmaxf(z1, 0.f) + __logf(1.f + __expf(-fabsf(z1)));
              l0[i] = -__expf(-s0 - 0.5f); l1[i] = -__expf(-s1 - 0.5f); }
          const size_t off = ((size_t)(unit >> 10) * SEQ + 64 * (unit & 63) + tk) * CW + ch0; v4u w;
          w.x = pk2(rf[0], rf[1]); w.y = pk2(rf[2], rf[3]); w.z = pk2(rf[4], rf[5]); w.w = pk2(rf[6], rf[7]); *(v4u*)((bf16*)(a.ws + WS_R) + off) = w;
          w.x = pk2(kf[0], kf[1]); w.y = pk2(kf[2], kf[3]); w.z = pk2(kf[4], kf[5]); w.w = pk2(kf[6], kf[7]); *(v4u*)((bf16*)(a.ws + WS_K2) + off) = w;
          w.x = pk2(vf8[0], vf8[1]); w.y = pk2(vf8[2], vf8[3]); w.z = pk2(vf8[4], vf8[5]); w.w = pk2(vf8[6], vf8[7]); *(v4u*)((bf16*)(a.ws + WS_V) + off) = w; }
        *(LAS f32x4*)(GF + tk * 64 + c8) = l0; *(LAS f32x4*)(GF + tk * 64 + c8 + 4) = l1;
        LDS_BARRIER();
        { const int c = tid & 63, sg = tid >> 6; float gv[8], run = 0.f;
#pragma unroll
          for (int i = 0; i < 8; ++i) gv[i] = GF[(8 * sg + i) * 64 + c];
          LGKM0();
#pragma unroll
          for (int i = 0; i < 8; ++i) { run += gv[i]; GF[(8 * sg + i) * 64 + c] = run; }
          SEG[sg * 64 + c] = run; }
        LDS_BARRIER();
        { const int sg = tk >> 3; float gg[8], lw[8];
          f32x4 gq[2], sq[7][2];
          gq[0] = *(const LAS f32x4*)(GF + tk * 64 + c8); gq[1] = *(const LAS f32x4*)(GF + tk * 64 + c8 + 4);
#pragma unroll
          for (int s2 = 0; s2 < 7; ++s2) { sq[s2][0] = *(const LAS f32x4*)(SEG + s2 * 64 + c8); sq[s2][1] = *(const LAS f32x4*)(SEG + s2 * 64 + c8 + 4); }
          LGKM0();
#pragma unroll
          for (int i = 0; i < 8; ++i) { float x = gq[i >> 2][i & 3];
#pragma unroll
              for (int s2 = 0; s2 < 7; ++s2) x += (s2 < sg) ? sq[s2][i >> 2][i & 3] : 0.f;
              gg[i] = x; lw[i] = (i < 4) ? l0[i] : l1[i - 4]; }
          float rr[8], qq[8], kk[8], bb[8];
#pragma unroll
          for (int i = 0; i < 4; ++i) { const int e0 = 2 * i, e1 = 2 * i + 1;
              const float eg0 = __expf(gg[e0]), eg1 = __expf(gg[e1]), en0 = __expf(-gg[e0]), en1 = __expf(-gg[e1]), em0 = __expf(gg[e0] - lw[e0]), em1 = __expf(gg[e1] - lw[e1]);
              rr[e0] = rf[e0] * eg0; rr[e1] = rf[e1] * eg1; qq[e0] = qf8[e0] * em0; qq[e1] = qf8[e1] * em1;
              kk[e0] = kf[e0] * en0; kk[e1] = kf[e1] * en1; bb[e0] = bf8[e0] * en0; bb[e1] = bf8[e1] * en1;
              if (tk == 63) { PLs[c8 + e0] = eg0; PLs[c8 + e1] = eg1; } }
          const int so = swz(tk, tid & 7); v4u w;
          w.x = pk2(rr[0], rr[1]); w.y = pk2(rr[2], rr[3]); w.z = pk2(rr[4], rr[5]); w.w = pk2(rr[6], rr[7]); *(LAS v4u*)(lds + LA_RT + so) = w;
          w.x = pk2(qq[0], qq[1]); w.y = pk2(qq[2], qq[3]); w.z = pk2(qq[4], qq[5]); w.w = pk2(qq[6], qq[7]); *(LAS v4u*)(lds + LA_QT + so) = w;
          w.x = pk2(kk[0], kk[1]); w.y = pk2(kk[2], kk[3]); w.z = pk2(kk[4], kk[5]); w.w = pk2(kk[6], kk[7]); *(LAS v4u*)(lds + LA_KT + so) = w;
          w.x = pk2(bb[0], bb[1]); w.y = pk2(bb[2], bb[3]); w.z = pk2(bb[4], bb[5]); w.w = pk2(bb[6], bb[7]); *(LAS v4u*)(lds + LA_BT + so) = w;
          w.x = pk2(vf8[0], vf8[1]); w.y = pk2(vf8[2], vf8[3]); w.z = pk2(vf8[4], vf8[5]); w.w = pk2(vf8[6], vf8[7]); *(LAS v4u*)(lds + LA_VT + so) = w; }
        LDS_BARRIER();
        STAMP_END(1); STAMP_BEGIN(2);
        if (idx + (int)gridDim.x < NUNIT) SCANA_LOAD(SCANA_UNIT(idx + (int)gridDim.x));
        for (int id = wave; id < 40; id += NWAVES) {
            const int mat = id / 10, p = id - mat * 10, tb = p < 1 ? 0 : (p < 3 ? 1 : (p < 6 ? 2 : 3)), sb = p - tb * (tb + 1) / 2;
            LAS unsigned char* Lft = lds + ((mat & 1) ? LA_KT : LA_BT); LAS unsigned char* Rgt = lds + ((mat & 2) ? LA_RT : LA_QT);
            f32x4 acc = (f32x4){0.f, 0.f, 0.f, 0.f};
#pragma unroll
            for (int ks = 0; ks < 2; ++ks) { const bf16x8 af = *(const LAS bf16x8*)(Lft + swz(16 * sb + n, 4 * ks + g)), bfr = *(const LAS bf16x8*)(Rgt + swz(16 * tb + n, 4 * ks + g));
                acc = __builtin_amdgcn_mfma_f32_16x16x32_bf16(af, bfr, acc, 0, 0, 0); }
            const int t = 16 * tb + n, s0 = 16 * sb + 4 * g;
#pragma unroll
            for (int j = 0; j < 4; ++j) { const bool keep = (mat & 2) ? (s0 + j <= t) : (s0 + j < t); if (!keep) acc[j] = 0.f; }
            LAS unsigned char* dst = lds + (mat == 0 ? LA_AQB : (mat == 1 ? LA_AQK : (mat == 2 ? LA_ARB : LA_ARK)));
            v2u w; w.x = pk2(acc[0], acc[1]); w.y = pk2(acc[2], acc[3]);
            *(LAS v2u*)(dst + swz(t, s0 >> 3) + 2 * (s0 & 7)) = w;
            if (mat == 0 && sb == tb) *(LAS f32x4*)(DG + tb * 256 + n * 16 + 4 * g) = acc;
        }
        LDS_BARRIER();
        STAMP_END(2); STAMP_BEGIN(3);
        const bool isU = wave >= 4; const int cb = wave & 3;
        LAS unsigned char* AQB = lds + LA_AQB; LAS unsigned char* AQK = lds + LA_AQK; LAS unsigned char* ARB = lds + LA_ARB; LAS unsigned char* ARK = lds + LA_ARK;
        s16x4 vf[4], xn[4], fqb[6], frb[10], fbt[16];
        f32x4 rhs[4], y1a[4], hma[4], rti[4];
        if (isU) {
            s16x4 fqk[10], frk[10], fkt[16];
#pragma unroll
            for (int k = 0; k < 4; ++k) vf[k] = tr_read(lds + LA_VT, 16 * k + 4 * g, cb, n);
#pragma unroll
            for (int i = 0; i < 4; ++i)
#pragma unroll
                for (int k = 0; k < 4; ++k) { if (k <= i) { fqk[i * (i + 1) / 2 + k] = row_read4(AQK, 16 * i + n, 16 * k + 4 * g); frk[i * (i + 1) / 2 + k] = row_read4(ARK, 16 * i + n, 16 * k + 4 * g); }
                    fkt[4 * i + k] = tr_read(lds + LA_KT, 16 * k + 4 * g, i, n); }
            LGKM0();
#pragma unroll
            for (int i = 0; i < 4; ++i) { f32x4 acc = (f32x4){0.f, 0.f, 0.f, 0.f}, ac2 = acc, ac3 = acc;
#pragma unroll
                for (int k = 0; k < 4; ++k) { if (k <= i) { acc = MFMA16(fqk[i * (i + 1) / 2 + k], vf[k], acc); ac2 = MFMA16(frk[i * (i + 1) / 2 + k], vf[k], ac2); }
                    ac3 = MFMA16(vf[k], fkt[4 * i + k], ac3); }
                rhs[i] = acc; y1a[i] = ac2; hma[i] = ac3; rti[i] = acc; }
        } else {
            if (lane < 16) {
                const LAS float* A = DG + wave * 256; float x[16]; f32x4 ar[16][4];
                int lj = lane; asm volatile("" : "+v"(lj));
                x[0] = (lj == 0) ? 1.f : 0.f;
#pragma unroll
                for (int t = 1; t < 9; ++t)
#pragma unroll
                    for (int q = 0; q < 4; ++q) if (4 * q < t) ar[t][q] = *(const LAS f32x4*)(A + t * 16 + 4 * q);
                LGKM0();
#pragma unroll
                for (int t = 1; t < 9; ++t) { float a0 = (t == lj) ? 1.f : 0.f, a1 = 0.f;
#pragma unroll
                    for (int s2 = 0; s2 < t; ++s2) { if (s2 & 1) a1 -= ar[t][s2 >> 2][s2 & 3] * x[s2]; else a0 -= ar[t][s2 >> 2][s2 & 3] * x[s2]; }
                    x[t] = a0 + a1; }
#pragma unroll
                for (int t = 9; t < 13; ++t)
#pragma unroll
                    for (int q = 0; q < 4; ++q) if (4 * q < t) ar[t][q] = *(const LAS f32x4*)(A + t * 16 + 4 * q);
                LGKM0();
#pragma unroll
                for (int t = 9; t < 13; ++t) { float a0 = (t == lj) ? 1.f : 0.f, a1 = 0.f;
#pragma unroll
                    for (int s2 = 0; s2 < t; ++s2) { if (s2 & 1) a1 -= ar[t][s2 >> 2][s2 & 3] * x[s2]; else a0 -= ar[t][s2 >> 2][s2 & 3] * x[s2]; }
                    x[t] = a0 + a1; }
#pragma unroll
                for (int t = 13; t < 16; ++t)
#pragma unroll
                    for (int q = 0; q < 4; ++q) if (4 * q < t) ar[t][q] = *(const LAS f32x4*)(A + t * 16 + 4 * q);
                LGKM0();
#pragma unroll
                for (int t = 13; t < 16; ++t) { float a0 = (t == lj) ? 1.f : 0.f, a1 = 0.f;
#pragma unroll
                    for (int s2 = 0; s2 < t; ++s2) { if (s2 & 1) a1 -= ar[t][s2 >> 2][s2 & 3] * x[s2]; else a0 -= ar[t][s2 >> 2][s2 & 3] * x[s2]; }
                    x[t] = a0 + a1; }
                LAS bf16* D = (LAS bf16*)(lds + LA_DL) + wave * 256;
#pragma unroll
                for (int t = 0; t < 16; ++t) D[t * 16 + lane] = (bf16)f2bf(x[t]);
            }
#pragma unroll
            for (int i = 0; i < 4; ++i) { rhs[i] = unpack4(tr_read(lds + LA_QT, 16 * i + 4 * g, cb, n)); rti[i] = unpack4(tr_read(lds + LA_RT, 16 * i + 4 * g, cb, n)); vf[i] = (s16x4){0, 0, 0, 0}; y1a[i] = (f32x4){0.f, 0.f, 0.f, 0.f}; hma[i] = y1a[i]; }
        }
#pragma unroll
        for (int i = 0; i < 4; ++i)
#pragma unroll
            for (int k = 0; k < 4; ++k) { if (k < i) fqb[i * (i - 1) / 2 + k] = row_read4(AQB, 16 * i + n, 16 * k + 4 * g); if (k <= i) frb[i * (i + 1) / 2 + k] = row_read4(ARB, 16 * i + n, 16 * k + 4 * g);
                fbt[4 * i + k] = tr_read(lds + LA_BT, 16 * k + 4 * g, i, n); }
        LDS_BARRIER();
        STAMP_END(3); STAMP_BEGIN(4);
        {
            s16x4 df[4];
#pragma unroll
            for (int i = 0; i < 4; ++i) df[i] = *(const LAS s16x4*)(lds + LA_DL + i * 512 + n * 32 + 8 * g);
            const float plv[4] = {PLs[n], PLs[16 + n], PLs[32 + n], PLs[48 + n]};
            LGKM0();
#pragma unroll
            for (int i = 0; i < 4; ++i) { f32x4 acc = rhs[i];
#pragma unroll
                for (int k = 0; k < 4; ++k) if (k < i) acc = MFMA16(fqb[i * (i - 1) / 2 + k], xn[k], acc);
                const f32x4 xi = MFMA16(df[i], pack4(acc), ((f32x4){0.f, 0.f, 0.f, 0.f}));
                xn[i] = pack4n(xi); }
            if (!isU) {
                bf16* RH = (bf16*)(a.ws + WS_RH) + (size_t)unit * 4096;
#pragma unroll
                for (int i = 0; i < 4; ++i) { f32x4 acc = rti[i];
#pragma unroll
                    for (int k = 0; k < 4; ++k) if (k <= i) acc = MFMA16(frb[i * (i + 1) / 2 + k], xn[k], acc);
#pragma unroll
                    for (int j = 0; j < 4; ++j) RH[(16 * i + 4 * g + j) * 64 + 16 * cb + n] = (bf16)f2bf(acc[j]); }
                bf16* GT = (bf16*)(a.ws + WS_GT) + (size_t)unit * 4096;
#pragma unroll
                for (int c2b = 0; c2b < 4; ++c2b) { f32x4 acc = (f32x4){0.f, 0.f, 0.f, 0.f};
#pragma unroll
                    for (int k = 0; k < 4; ++k) acc = MFMA16(xn[k], fbt[4 * c2b + k], acc);
                    acc *= plv[c2b]; *(v2u*)(GT + (16 * c2b + n) * 64 + 16 * cb + 4 * g) = __builtin_bit_cast(v2u, pack4(acc)); }
            } else {
                float* Y1 = (float*)(a.ws + WS_Y1) + (size_t)unit * 4096;
#pragma unroll
                for (int i = 0; i < 4; ++i) { f32x4 acc = y1a[i];
#pragma unroll
                    for (int k = 0; k < 4; ++k) if (k <= i) acc = MFMA16(frb[i * (i + 1) / 2 + k], xn[k], acc);
#pragma unroll
                    for (int j = 0; j < 4; ++j) Y1[(16 * i + 4 * g + j) * 64 + 16 * cb + n] = acc[j]; }
                float* HM = (float*)(a.ws + WS_HM) + (size_t)unit * 4096;
#pragma unroll
                for (int c2b = 0; c2b < 4; ++c2b) { f32x4 acc = hma[c2b];
#pragma unroll
                    for (int k = 0; k < 4; ++k) acc = MFMA16(xn[k], fbt[4 * c2b + k], acc);
#pragma unroll
                    for (int j = 0; j < 4; ++j) HM[(16 * cb + 4 * g + j) * 64 + 16 * c2b + n] = acc[j] * plv[c2b]; }
            }
            if (wave == 0) ((float*)(a.ws + WS_PLV))[(size_t)unit * 64 + lane] = PLs[lane];
        }
        LDS_BARRIER();
        STAMP_END(4); STAMP_END(5);
    }
}

constexpr int LB_SLOT = 13312, LB_NPIECE = 13, LB_PER_WAVE = 4, LB_NSLOT = 8, LB_DIST = 7;
__device__ __forceinline__ void chainB_issue(const Args& a, LAS unsigned char* lds, size_t unit, int vb, int step, int lw, int lane) {
    const unsigned char* gt = a.ws + WS_GT + unit * 8192; const unsigned char* hm = a.ws + WS_HM + unit * 16384 + vb * 4096; const unsigned char* pv = a.ws + WS_PLV + unit * 256;
#pragma unroll
    for (int i = 0; i < LB_PER_WAVE; ++i) { int p = lw + 4 * i; p = p < LB_NPIECE - 1 ? p : LB_NPIECE - 1;
        const unsigned char* src = (p < 8) ? gt + p * 1024 : ((p < 12) ? hm + (p - 8) * 1024 : pv);
        __builtin_amdgcn_global_load_lds((const unsigned*)(src + lane * 16), (LAS unsigned*)(lds + (step & (LB_NSLOT - 1)) * LB_SLOT + p * 1024), 16, 0, 0); }
}
struct ChainOps { s16x4 gf[4][4]; f32x4 hm[4], pl[4]; };
__device__ __forceinline__ void chainB_read(ChainOps& o, LAS unsigned char* sl, int n, int g) {
#pragma unroll
    for (int i = 0; i < 4; ++i) { o.hm[i] = *(const LAS f32x4*)(sl + 8192 + (n * 64 + 16 * i + 4 * g) * 4); o.pl[i] = *(const LAS f32x4*)(sl + 12288 + (16 * i + 4 * g) * 4);
#pragma unroll
        for (int k = 0; k < 4; ++k) o.gf[i][k] = *(const LAS s16x4*)(sl + (16 * i + n) * 128 + (16 * k + 4 * g) * 2); }
}
__device__ __forceinline__ void chainB_step(const ChainOps& o, f32x4 (&acc)[4], v2u* SF) {
    s16x4 sb[4]; f32x4 nx[4];
#pragma unroll
    for (int k = 0; k < 4; ++k) { sb[k] = pack4(acc[k]); SF[k * 64] = __builtin_bit_cast(v2u, sb[k]); }
#pragma unroll
    for (int i = 0; i < 4; ++i) nx[i] = o.pl[i] * acc[i] + o.hm[i];
#pragma unroll
    for (int k = 0; k < 4; ++k)
#pragma unroll
        for (int i = 0; i < 4; ++i) nx[i] = MFMA16(o.gf[i][k], sb[k], nx[i]);
#pragma unroll
    for (int i = 0; i < 4; ++i) acc[i] = nx[i];
}
__device__ __forceinline__ void scanB(const Args& a, LAS unsigned char* lds) {
    const int tid = threadIdx.x, lane = tid & 63, wave = __builtin_amdgcn_readfirstlane(tid >> 6), n = lane & 15, g = lane >> 4;
    constexpr int NCK = SEQ / 64;
    for (int item = blockIdx.x; item < BATCH * NHEAD * 4; item += gridDim.x) {
        const int bh = item >> 2, vb = item & 3;
        const size_t u0 = (size_t)bh * 64;
        f32x4 acc[4];
#pragma unroll
        for (int i = 0; i < 4; ++i) acc[i] = (f32x4){0.f, 0.f, 0.f, 0.f};
        if (wave >= 4) {
#pragma unroll
            for (int s = 0; s < LB_DIST; ++s) chainB_issue(a, lds, u0 + s, vb, s, wave - 4, lane);
            asm volatile("s_waitcnt vmcnt(20)" ::: "memory"); }
        __builtin_amdgcn_s_barrier(); asm volatile("" ::: "memory");
        if (wave >= 4) {
            for (int ck = 0; ck < NCK; ++ck) {
                if (ck + LB_DIST < NCK) { chainB_issue(a, lds, u0 + ck + LB_DIST, vb, ck + LB_DIST, wave - 4, lane); asm volatile("s_waitcnt vmcnt(20)" ::: "memory"); }
                else asm volatile("s_waitcnt vmcnt(0)" ::: "memory");
                __builtin_amdgcn_s_barrier(); asm volatile("" ::: "memory");
            }
        } else if (wave == 0) {
            v2u* SF = (v2u*)(a.ws + WS_SF) + (u0 * 16 + vb * 4) * 64 + lane;
            ChainOps A, B;
            chainB_read(A, lds, n, g);
            for (int ck = 0; ck < NCK; ck += 2) {
                chainB_read(B, lds + ((ck + 1) & (LB_NSLOT - 1)) * LB_SLOT, n, g);
                chainB_step(A, acc, SF + (size_t)ck * 16 * 64);
                __builtin_amdgcn_s_barrier(); asm volatile("" ::: "memory");
                if (ck + 2 < NCK) chainB_read(A, lds + ((ck + 2) & (LB_NSLOT - 1)) * LB_SLOT, n, g);
                chainB_step(B, acc, SF + (size_t)(ck + 1) * 16 * 64);
                __builtin_amdgcn_s_barrier(); asm volatile("" ::: "memory");
            }
        } else {
            for (int ck = 0; ck < NCK; ++ck) { __builtin_amdgcn_s_barrier(); asm volatile("" ::: "memory"); }
        }
    }
}

__device__ __forceinline__ void scanC(const Args& a) {
    const int tid = threadIdx.x, lane = tid & 63, wave = tid >> 6, n = lane & 15, g = lane >> 4;
    const int gw = blockIdx.x * NWAVES + wave, NGW = gridDim.x * NWAVES;
    for (int task = gw; task < NUNIT * 4; task += NGW) {
        const int unit = task >> 2, i = task & 3, bh = unit >> 6, ck = unit & 63, b = bh >> 4, h = bh & 15;
        const v2u* SF = (const v2u*)(a.ws + WS_SF) + (size_t)unit * 16 * 64 + lane;
        const bf16* RH = (const bf16*)(a.ws + WS_RH) + (size_t)unit * 4096; const float* Y1 = (const float*)(a.ws + WS_Y1) + (size_t)unit * 4096;
        s16x4 rf[4]; f32x4 acc[4];
        const size_t m = (size_t)b * SEQ + 64 * ck + 16 * i + n;
        s16x4 rq[4], kq[4], vq[4], gq[4];
#pragma unroll
        for (int vb = 0; vb < 4; ++vb) { const size_t o = m * CW + h * 64 + 16 * vb + 4 * g;
            rq[vb] = *(const s16x4*)((const bf16*)(a.ws + WS_R) + o); kq[vb] = *(const s16x4*)((const bf16*)(a.ws + WS_K2) + o);
            vq[vb] = *(const s16x4*)((const bf16*)(a.ws + WS_V) + o); gq[vb] = *(const s16x4*)((const bf16*)(a.ws + WS_GG) + o); }
#pragma unroll
        for (int k = 0; k < 4; ++k) rf[k] = *(const s16x4*)(RH + (16 * i + n) * 64 + 16 * k + 4 * g);
#pragma unroll
        for (int vb = 0; vb < 4; ++vb) { acc[vb] = *(const f32x4*)(Y1 + (16 * i + n) * 64 + 16 * vb + 4 * g);
#pragma unroll
            for (int k = 0; k < 4; ++k) acc[vb] = MFMA16(__builtin_bit_cast(s16x4, SF[(vb * 4 + k) * 64]), rf[k], acc[vb]); }
        float s1 = 0.f;
#pragma unroll
        for (int vb = 0; vb < 4; ++vb) s1 += (acc[vb][0] + acc[vb][1]) + (acc[vb][2] + acc[vb][3]);
        s1 += __shfl_xor(s1, 16); s1 += __shfl_xor(s1, 32);
        const float mean = s1 * (1.f / 64.f); float s2 = 0.f;
#pragma unroll
        for (int vb = 0; vb < 4; ++vb)
#pragma unroll
            for (int j = 0; j < 4; ++j) { const float d = acc[vb][j] - mean; s2 += d * d; }
        s2 += __shfl_xor(s2, 16); s2 += __shfl_xor(s2, 32);
        const float rstd = 1.f / sqrtf(s2 * (1.f / 64.f) + GN_EPS);
        f32x4 rv[4], kv[4], vv[4], gv[4]; float dot = 0.f;
#pragma unroll
        for (int vb = 0; vb < 4; ++vb) { rv[vb] = unpack4(rq[vb]); kv[vb] = unpack4(kq[vb]); vv[vb] = unpack4(vq[vb]); gv[vb] = unpack4(gq[vb]);
            const f32x4 rk = *(const f32x4*)(a.in[I_RK] + h * 64 + 16 * vb + 4 * g);
#pragma unroll
            for (int j = 0; j < 4; ++j) dot += rv[vb][j] * kv[vb][j] * rk[j]; }
        dot += __shfl_xor(dot, 16); dot += __shfl_xor(dot, 32);
#pragma unroll
        for (int vb = 0; vb < 4; ++vb) { const int c = h * 64 + 16 * vb + 4 * g;
            const f32x4 lw = *(const f32x4*)(a.in[I_LNW] + c), lb = *(const f32x4*)(a.in[I_LNB] + c), be = *(const f32x4*)(a.in[I_BETAR] + c);
            const f32x4 o = ((acc[vb] - mean) * rstd * lw + lb + dot * vv[vb]) * gv[vb] * be;
            *(v2u*)((bf16*)(a.ws + WS_YMIX) + m * DM + c) = __builtin_bit_cast(v2u, pack4(o)); }
    }
}

struct ConvItem { const float* W; bf16* WT; int N, ldd, k0, n0; size_t drow0; };
__device__ __forceinline__ ConvItem conv_decode(const Args& a, int r) {
    constexpr int NI_IN = 32 * 201, NI_OUT = 32 * 64, NI_E = 32 * 512;
    ConvItem c; unsigned char* ws = a.ws;
    if (r < NI_IN) { const int kb = r / 201, nb = r - kb * 201; c.W = a.in[I_WIN]; c.N = PROJW; c.WT = (bf16*)(ws + WS_WIN); c.drow0 = (size_t)(32 * nb); c.ldd = DM; c.k0 = 64 * kb; c.n0 = 32 * nb; return c; } r -= NI_IN;
    if (r < NI_OUT) { const int kb = r >> 6, nb = r & 63; c.W = a.in[I_WOUT]; c.N = DM; c.WT = (bf16*)(ws + WS_WOUT); c.drow0 = (size_t)(32 * nb); c.ldd = DM; c.k0 = 64 * kb; c.n0 = 32 * nb; return c; } r -= NI_OUT;
    if (r < 2 * NI_E) { const int up = r >= NI_E; if (up) r -= NI_E; const int e = r >> 9, q = r & 511, kb = q >> 4, nb = q & 15, n0 = 32 * nb;
        c.W = a.in[up ? I_WU : I_WG] + (size_t)e * DM * FF; c.N = FF; c.WT = (bf16*)(ws + WS_WGU); c.drow0 = (size_t)e * 1024 + 256 * (n0 >> 7) + (n0 & 127) + (up ? 128 : 0); c.ldd = DM; c.k0 = 64 * kb; c.n0 = n0; return c; } r -= 2 * NI_E;
    { const int e = r >> 9, q = r & 511, kb = q >> 6, nb = q & 63;
        c.W = a.in[I_WDN] + (size_t)e * FF * DM; c.N = DM; c.WT = (bf16*)(ws + WS_WD); c.drow0 = (size_t)e * DM + 32 * nb; c.ldd = FF; c.k0 = 64 * kb; c.n0 = 32 * nb; return c; }
}
__device__ __forceinline__ void conv_load(const ConvItem& c, int lane, float (&v)[32]) {
    const float* p = c.W + (size_t)(c.k0 + (lane >> 5)) * c.N + c.n0 + (lane & 31);
#pragma unroll
    for (int i = 0; i < 32; ++i) v[i] = p[(size_t)(2 * i) * c.N];
}
__device__ __forceinline__ void conv_finish(const ConvItem& c, const float (&v)[32], LAS float* scr, int lane) {
#pragma unroll
    for (int i = 0; i < 32; ++i) { const int kk = 2 * i + (lane >> 5); scr[kk * 33 + (lane & 31)] = v[i]; }
    LDS_WAIT(); asm volatile("" ::: "memory");
    const int cc = lane & 7;
#pragma unroll
    for (int j = 0; j < 4; ++j) { const int n = (lane >> 3) + 8 * j; const LAS float* s = scr + (8 * cc) * 33 + n;
        v4u o; o.x = pk2(s[0 * 33], s[1 * 33]); o.y = pk2(s[2 * 33], s[3 * 33]); o.z = pk2(s[4 * 33], s[5 * 33]); o.w = pk2(s[6 * 33], s[7 * 33]);
        *(v4u*)(c.WT + (c.drow0 + n) * (size_t)c.ldd + c.k0 + 8 * cc) = o; }
    LDS_WAIT(); asm volatile("" ::: "memory");
}
__device__ __forceinline__ void phase0(const Args& a, LAS unsigned char* lds) {
    const int tid = threadIdx.x, lane = tid & 63, wave = __builtin_amdgcn_readfirstlane(tid >> 6), G = gridDim.x, bid = blockIdx.x;
    unsigned char* ws = a.ws;
    LAS float* cact = (LAS float*)lds;
    LAS float* red = (LAS float*)(lds + 16384);
    LAS float* scr = (LAS float*)(lds + 32768 + wave * 8448);
    if (bid < 192 || G < 192) {
        const float* c = a.in[I_C];
        for (int i = tid; i < 2 * DM; i += NTHR) { const float x = c[i]; cact[i] = x / (1.f + __expf(-x)); }
        __syncthreads();
        for (int item = bid; item < 192; item += G) {
            const int ro = lane >> 4, cq = lane & 15;
            const float* wp = a.in[I_WADA] + (size_t)(256 * wave + ro) * 12288 + 64 * item + 4 * cq;
            f32x4 acc0 = (f32x4){0.f, 0.f, 0.f, 0.f}, acc1 = acc0;
#pragma unroll 8
            for (int i = 0; i < 64; ++i) { const f32x4 wv = *(const f32x4*)(wp + (size_t)(4 * i) * 12288);
                const float c0 = cact[256 * wave + 4 * i + ro], c1 = cact[DM + 256 * wave + 4 * i + ro]; acc0 += c0 * wv; acc1 += c1 * wv; }
#pragma unroll
            for (int j = 0; j < 4; ++j) { float v0 = acc0[j], v1 = acc1[j]; v0 += __shfl_xor(v0, 16); v0 += __shfl_xor(v0, 32); v1 += __shfl_xor(v1, 16); v1 += __shfl_xor(v1, 32);
                if (ro == 0) { red[(wave * 2 + 0) * 64 + 4 * cq + j] = v0; red[(wave * 2 + 1) * 64 + 4 * cq + j] = v1; } }
            __syncthreads();
            if (tid < 128) { const int b = tid >> 6, cc = tid & 63; float s = a.in[I_BADA][64 * item + cc];
#pragma unroll
                for (int w2 = 0; w2 < 8; ++w2) s += red[(w2 * 2 + b) * 64 + cc];
                ((float*)(ws + WS_MOD))[b * 12288 + 64 * item + cc] = s; }
            __syncthreads();
        }
    }
    constexpr int NCONV = 32 * 201 + 32 * 64 + 3 * 32 * 512, NPRE = 4;
    const int gw = bid * NWAVES + wave, NGW = G * NWAVES;
    const bool pre = (G == 256), mine = pre && bid >= 192;
    const int pool0 = pre ? 64 * NWAVES * NPRE : 0;
    auto item_of = [&](int j) -> int { if (mine) { if (j < NPRE) return (bid - 192) * NWAVES + wave + 64 * NWAVES * j; j -= NPRE; } return pool0 + gw + NGW * j; };
    { float va[32], vb[32]; ConvItem ca, cb; int j = 0; int ia = item_of(0);
      if (ia < NCONV) { ca = conv_decode(a, ia); conv_load(ca, lane, va); }
      while (ia < NCONV) {
          const int ib = item_of(j + 1);
          if (ib < NCONV) { cb = conv_decode(a, ib); conv_load(cb, lane, vb); }
          conv_finish(ca, va, scr, lane);
          if (ib >= NCONV) break;
          const int ic = item_of(j + 2);
          if (ic < NCONV) { ca = conv_decode(a, ic); conv_load(ca, lane, va); }
          conv_finish(cb, vb, scr, lane);
          ia = ic; j += 2; } }
    const int gt = bid * NTHR + tid, NGT = G * NTHR;
    bf16* wl = (bf16*)(ws + WS_WL);
    for (int idx = gt; idx < LORA_N * LORA_K; idx += NGT) { const int n = idx / LORA_K, k = idx - n * LORA_K; float v = 0.f;
        if (n < 1024) { if (k < 64) v = a.in[I_WDEC][k * 1024 + n]; }
        else if (n < 2048) { if (k >= 64 && k < 128) v = a.in[I_WAAA][(k - 64) * 1024 + (n - 1024)]; }
        else { if (k >= 128 && k < 288) v = a.in[I_WGATEUP][(k - 128) * 1024 + (n - 2048)]; }
        wl[idx] = (bf16)f2bf(v); }
    float* w36 = (float*)(ws + WS_W36);
    for (int idx = gt; idx < DM * 36; idx += NGT) { const int e = idx >> 11, dd = idx & (DM - 1);
        w36[idx] = (e < 4) ? a.in[I_WGRP][dd * 4 + e] : a.in[I_WEXP][((size_t)((e - 4) >> 3) * DM + dd) * 8 + ((e - 4) & 7)]; }
    v4u* wz = (v4u*)(ws + WS_WIN + (size_t)PROJW * DM * 2);
    for (int idx = gt; idx < (PROJP - PROJW) * DM / 8; idx += NGT) wz[idx] = (v4u){0u, 0u, 0u, 0u};
}

__device__ __forceinline__ void phase1(const Args& a) {
    const int tid = threadIdx.x, lane = tid & 63, wave = tid >> 6;
    const int gw = blockIdx.x * NWAVES + wave, NGW = gridDim.x * NWAVES;
    const float* mod = (const float*)(a.ws + WS_MOD);
    for (int it = gw; it < 72; it += NGW) {
        const int b = it / 36, e = it - b * 36; const float* w36 = (const float*)(a.ws + WS_W36); float s = 0.f;
        for (int dd = lane; dd < DM; dd += 64) s += mod[b * 12288 + 3 * DM + dd] * w36[e * DM + dd];
        s = wave_sum(s) + ((e < 4) ? a.in[I_BGRP][e] : a.in[I_BEXP][e - 4]);
        if (lane == 0) ((float*)(a.ws + WS_B36))[it] = s; }
    auto ldrow = [&](int m, f32x4 (&v)[8]) { const f32x4* xr = (const f32x4*)(a.in[I_X] + (size_t)m * DM) + lane;
#pragma unroll
        for (int j = 0; j < 8; ++j) v[j] = xr[64 * j]; };
    auto dorow = [&](int m, f32x4 (&v)[8]) { const int b = m >> 12; float s = 0.f;
#pragma unroll
        for (int j = 0; j < 8; ++j) s += (v[j].x * v[j].x + v[j].y * v[j].y) + (v[j].z * v[j].z + v[j].w * v[j].w);
        const float rstd = 1.f / sqrtf(wave_sum(s) * (1.f / DM) + RMS_EPS);
        v2u* o8 = (v2u*)((bf16*)(a.ws + WS_HB) + (size_t)m * DM) + lane;
#pragma unroll
        for (int j = 0; j < 8; ++j) { const int c = 4 * (lane + 64 * j);
            const f32x4 g = *(const f32x4*)(a.in[I_N1G] + c), sh = *(const f32x4*)(mod + b * 12288 + c), sc = *(const f32x4*)(mod + b * 12288 + DM + c);
            const f32x4 h = v[j] * rstd * g * (1.f + sc) + sh; v2u o; o.x = pk2(h.x, h.y); o.y = pk2(h.z, h.w); o8[64 * j] = o; } };
    { f32x4 va[8], vb[8]; int m = gw; if (m < MTOK) ldrow(m, va);
      while (m < MTOK) { const int m2 = m + NGW; if (m2 < MTOK) ldrow(m2, vb); dorow(m, va); if (m2 >= MTOK) break;
          const int m3 = m2 + NGW; if (m3 < MTOK) ldrow(m3, va); dorow(m2, vb); m = m3; } }
}

__device__ __forceinline__ void phase3(const Args& a) {
    const int gt = blockIdx.x * NTHR + threadIdx.x, NGT = gridDim.x * NTHR;
    const bf16* P = (const bf16*)(a.ws + WS_PLR); bf16* AL = (bf16*)(a.ws + WS_AL);
    for (int idx = gt; idx < MTOK * 48; idx += NGT) { const int m = idx / 48, cj = idx - m * 48;
        v4u o = (v4u){0u, 0u, 0u, 0u};
        if (cj < 36) { const int col = 3072 + 8 * cj; const v4u pc = *(const v4u*)(P + (size_t)m * 288 + 8 * cj);
            v4u pp = (v4u){0u, 0u, 0u, 0u}; if ((m & (SEQ - 1)) != 0) pp = *(const v4u*)(P + (size_t)(m - 1) * 288 + 8 * cj);
            const float* mu = a.in[I_MU] + col; float r[8];
#pragma unroll
            for (int i = 0; i < 4; ++i) { const float c0 = bflo(pc[i]), c1 = bfhi(pc[i]), p0 = bflo(pp[i]), p1 = bfhi(pp[i]);
                r[2 * i] = c0 + (p0 - c0) * mu[2 * i]; r[2 * i + 1] = c1 + (p1 - c1) * mu[2 * i + 1]; }
            if (cj < 8) {
#pragma unroll
                for (int i = 0; i < 8; ++i) r[i] = tanhf(r[i]); }
            else if (cj >= 16) {
#pragma unroll
                for (int i = 0; i < 8; ++i) r[i] = sigmoid_f(r[i]); }
            o.x = pk2(r[0], r[1]); o.y = pk2(r[2], r[3]); o.z = pk2(r[4], r[5]); o.w = pk2(r[6], r[7]); }
        *(v4u*)(AL + (size_t)m * LORA_K + 8 * cj) = o; }
}

__device__ __forceinline__ int swz_off(int key, int chunk) { return key * 128 + ((chunk ^ ((key >> 1) & 7)) << 4); }
__device__ __forceinline__ void attn_issue_tile(const bf16* kcol, int key0, LAS unsigned char* buf, int wave) {
    __builtin_amdgcn_global_load_lds((const unsigned*)(kcol + (size_t)key0 * HD), (LAS unsigned*)(buf + wave * 1024), 16, 0, 0);
    __builtin_amdgcn_global_load_lds((const unsigned*)(kcol + HM_PART + (size_t)key0 * HD), (LAS unsigned*)(buf + 8192 + wave * 1024), 16, 0, 0);
}
__device__ __forceinline__ void phase5b(const Args& a, LAS unsigned char* lds) {
    STAMP_DECL;
    const int tid = threadIdx.x, lane = tid & 63, wave = __builtin_amdgcn_readfirstlane(tid >> 6), n = lane & 15, g = lane >> 4;
    const bf16* P = (const bf16*)(a.ws + WS_P); bf16* Y = (bf16*)(a.ws + WS_YMIX);
    LAS unsigned char* QL = lds + 65536; LAS float* biasA = (LAS float*)(lds + 81920);
    for (int i = tid; i < NHEAD * 257; i += NTHR) biasA[i] = a.in[I_RELB][i] * LOG2E;
    const float SC = 0.125f * LOG2E;
    const int skey = tid >> 3, sdcx = (tid & 7) ^ ((skey >> 1) & 7);
    LAS float* betaL = (LAS float*)(lds + 81920 + NHEAD * 257 * 4 + 64);
    for (int i = tid; i < CW; i += NTHR) betaL[i] = a.in[I_BETAA][i];
#define ATTN_PROLOGUE(U) do { const int cp_ = (U) & 31, h_ = ((U) >> 5) & 15, b_ = (U) >> 9; const int js_ = (8 - 2 * cp_) > 0 ? (8 - 2 * cp_) : 0, kb_ = 64 * (2 * cp_ - 8 + js_); \
        const bf16* Qh_ = P + 3 * HM_PART + (size_t)b_ * HM_BATCH + (size_t)h_ * HM_HEAD; const bf16* kc_ = Qh_ + HM_PART + (size_t)skey * HD + 8 * sdcx; \
        const bf16* qs_ = Qh_ + (size_t)(128 * cp_ + 16 * wave + (lane >> 3)) * HD + 8 * (lane & 7); \
        __builtin_amdgcn_global_load_lds((const unsigned*)qs_, (LAS unsigned*)(QL + wave * 2048), 16, 0, 0); \
        __builtin_amdgcn_global_load_lds((const unsigned*)(qs_ + (size_t)8 * HD), (LAS unsigned*)(QL + wave * 2048 + 1024), 16, 0, 0); \
        attn_issue_tile(kc_, kb_, lds, wave); attn_issue_tile(kc_, kb_ + 64, lds + 16384, wave); \
        if (js_ < 8) attn_issue_tile(kc_, kb_ + 128, lds + 32768, wave); } while (0)
    asm volatile("s_waitcnt vmcnt(0) lgkmcnt(0)" ::: "memory"); __builtin_amdgcn_s_barrier(); asm volatile("" ::: "memory");
    if ((int)blockIdx.x < BATCH * NHEAD * 32) ATTN_PROLOGUE((int)blockIdx.x);
    for (int u = blockIdx.x; u < BATCH * NHEAD * 32; u += gridDim.x) {
        const int cp = u & 31, h = (u >> 5) & 15, b = u >> 9;
        const int t0 = 128 * cp, qrow = t0 + 16 * wave + n;
        const bf16* Qh = P + 3 * HM_PART + (size_t)b * HM_BATCH + (size_t)h * HM_HEAD;
        const LAS float* biasL = biasA + h * 257;
        const int jstart = (8 - 2 * cp) > 0 ? (8 - 2 * cp) : 0, nt = 10 - jstart;
        const bf16* kcol = Qh + HM_PART + (size_t)skey * HD + 8 * sdcx;
        const int keyb = 64 * (2 * cp - 8 + jstart);
        if (nt > 2) asm volatile("s_waitcnt vmcnt(4)" ::: "memory"); else asm volatile("s_waitcnt vmcnt(2)" ::: "memory");
        __builtin_amdgcn_s_barrier(); asm volatile("" ::: "memory");
        bf16x8 qf[2]; qf[0] = *(const LAS bf16x8*)(QL + wave * 2048 + n * 128 + 16 * g); qf[1] = *(const LAS bf16x8*)(QL + wave * 2048 + n * 128 + 64 + 16 * g);
        float mrun = -1e30f, lrun = 0.f;
        f32x4 ot[4];
#pragma unroll
        for (int i = 0; i < 4; ++i) ot[i] = (f32x4){0.f, 0.f, 0.f, 0.f};
        const float bfar = biasL[256];
        for (int r = 0; r < nt; ++r) {
            const int j = jstart + r, key0 = keyb + 64 * r;
            if (r + 3 < nt) attn_issue_tile(kcol, key0 + 192, lds + ((r + 3) & 3) * 16384, wave);
            const bool active = (wave < 4) ? (j <= 8) : (j >= 1);
            STAMP_BEGIN(13);
            if (active) {
                LAS unsigned char* Kb = lds + (r & 3) * 16384; LAS unsigned char* Vb = Kb + 8192;
                f32x4 s[4];
                { bf16x8 kfr[4][2];
#pragma unroll
                  for (int st = 0; st < 4; ++st)
#pragma unroll
                      for (int ks = 0; ks < 2; ++ks) kfr[st][ks] = *(const LAS bf16x8*)(Kb + swz_off(16 * st + n, 4 * ks + g));
                  asm volatile("s_waitcnt lgkmcnt(0)" ::: "memory"); __builtin_amdgcn_sched_barrier(0);
#pragma unroll
                  for (int st = 0; st < 4; ++st) { s[st] = (f32x4){0.f, 0.f, 0.f, 0.f};
#pragma unroll
                      for (int ks = 0; ks < 2; ++ks) s[st] = __builtin_amdgcn_mfma_f32_16x16x32_bf16(kfr[st][ks], qf[ks], s[st], 0, 0, 0); } }
                s16x4 vtr[2][4][2];
                  const int q4 = n >> 2, p4 = n & 3;
#pragma unroll
                  for (int k2 = 0; k2 < 2; ++k2)
#pragma unroll
                      for (int nd = 0; nd < 4; ++nd) { const int ka = 32 * k2 + 4 * g + q4, ch = 2 * nd + (p4 >> 1);
                          vtr[k2][nd][0] = __builtin_bit_cast(s16x4, __builtin_amdgcn_ds_read_tr16_b64_v4i16((LAS s16x4*)(Vb + swz_off(ka, ch) + 8 * (p4 & 1))));
                          vtr[k2][nd][1] = __builtin_bit_cast(s16x4, __builtin_amdgcn_ds_read_tr16_b64_v4i16((LAS s16x4*)(Vb + swz_off(ka + 16, ch) + 8 * (p4 & 1)))); }
                const bool far = (t0 + 16 * wave) - (key0 + 63) >= 128;
                float mx = -1e30f;
                if (far) {
#pragma unroll
                    for (int st = 0; st < 4; ++st)
#pragma unroll
                        for (int jj = 0; jj < 4; ++jj) { const float sv = s[st][jj] * SC + bfar; s[st][jj] = sv; mx = fmaxf(mx, sv); }
                } else {
                    float bv[4][4];
#pragma unroll
                    for (int st = 0; st < 4; ++st)
#pragma unroll
                        for (int jj = 0; jj < 4; ++jj) { const int dist = qrow - (key0 + 16 * st + 4 * g + jj); bv[st][jj] = biasL[(dist < 128 ? dist : 128) + 128]; }
#pragma unroll
                    for (int st = 0; st < 4; ++st)
#pragma unroll
                        for (int jj = 0; jj < 4; ++jj) { const float sv = s[st][jj] * SC + bv[st][jj]; s[st][jj] = sv; mx = fmaxf(mx, sv); }
                }
                mx = fmaxf(mx, __shfl_xor(mx, 16)); mx = fmaxf(mx, __shfl_xor(mx, 32));
                const float mnew = fmaxf(mrun, mx), alpha = __builtin_amdgcn_exp2f(mrun - mnew); mrun = mnew;
                float ls = 0.f;
#pragma unroll
                for (int st = 0; st < 4; ++st)
#pragma unroll
                    for (int jj = 0; jj < 4; ++jj) { const float p = __builtin_amdgcn_exp2f(s[st][jj] - mnew); s[st][jj] = p; ls += p; }
                lrun = lrun * alpha + ls;
#pragma unroll
                for (int i = 0; i < 4; ++i) ot[i] *= alpha;
                {
                  asm volatile("s_waitcnt lgkmcnt(0)" ::: "memory"); __builtin_amdgcn_sched_barrier(0);
#pragma unroll
                  for (int k2 = 0; k2 < 2; ++k2) {
                      v4u pw; pw.x = pk2(s[2 * k2][0], s[2 * k2][1]); pw.y = pk2(s[2 * k2][2], s[2 * k2][3]); pw.z = pk2(s[2 * k2 + 1][0], s[2 * k2 + 1][1]); pw.w = pk2(s[2 * k2 + 1][2], s[2 * k2 + 1][3]);
                      const bf16x8 pf = __builtin_bit_cast(bf16x8, pw);
#pragma unroll
                      for (int nd = 0; nd < 4; ++nd) { const s16x4 v0 = vtr[k2][nd][0], v1 = vtr[k2][nd][1];
                          bf16x8 vf; vf[0] = v0[0]; vf[1] = v0[1]; vf[2] = v0[2]; vf[3] = v0[3]; vf[4] = v1[0]; vf[5] = v1[1]; vf[6] = v1[2]; vf[7] = v1[3];
                          ot[nd] = __builtin_amdgcn_mfma_f32_16x16x32_bf16(vf, pf, ot[nd], 0, 0, 0); } } }
            }
            STAMP_END(13); STAMP_BEGIN(12);
            if (r + 4 <= nt) asm volatile("s_waitcnt vmcnt(4)" ::: "memory"); else if (r + 3 == nt) asm volatile("s_waitcnt vmcnt(2)" ::: "memory"); else asm volatile("s_waitcnt vmcnt(0)" ::: "memory");
            asm volatile("s_waitcnt lgkmcnt(0)" ::: "memory"); __builtin_amdgcn_s_barrier(); asm volatile("" ::: "memory");
            STAMP_END(12);
        }
        if (u + (int)gridDim.x < BATCH * NHEAD * 32) ATTN_PROLOGUE(u + (int)gridDim.x);
        float lt = lrun; lt += __shfl_xor(lt, 16); lt += __shfl_xor(lt, 32);
        const float inv = __builtin_amdgcn_rcpf(lt);
        bf16* yp = Y + ((size_t)b * SEQ + qrow) * DM + 1024 + h * 64 + 4 * g;
        const LAS float* beta = betaL + h * 64 + 4 * g;
#pragma unroll
        for (int nd = 0; nd < 4; ++nd) { const f32x4 bt = *(const LAS f32x4*)(beta + 16 * nd); const f32x4 o = ot[nd] * inv * bt;
            v2u w; w.x = pk2(o[0], o[1]); w.y = pk2(o[2], o[3]); *(v2u*)(yp + 16 * nd) = w; }
    }
}

__device__ __forceinline__ void phase8(const Args& a, LAS unsigned char* lds) {
    const int tid = threadIdx.x, lane = tid & 63, wave = __builtin_amdgcn_readfirstlane(tid >> 6), n = lane & 15, g = lane >> 4;
    const float* mod = (const float*)(a.ws + WS_MOD); const float* W36 = (const float*)(a.ws + WS_W36); const float* X1 = (const float*)(a.ws + WS_X1);
    unsigned* ctl = (unsigned*)(a.ws + WS_CTL);
    LAS float* part = (LAS float*)lds;
    LAS float* ssp = (LAS float*)(lds + 24576);
    LAS float* lg = (LAS float*)(lds + 25088);
    for (int tile = blockIdx.x; tile < MTOK / 16; tile += gridDim.x) {
        const int m0 = 16 * tile, b = m0 >> 12;
        f32x4 acc[3]; float ss = 0.f;
#pragma unroll
        for (int ct = 0; ct < 3; ++ct) acc[ct] = (f32x4){0.f, 0.f, 0.f, 0.f};
        const float* xrow = X1 + (size_t)(m0 + n) * DM + 256 * wave + 4 * g;
        const float* w0p = W36 + (size_t)n * DM + 256 * wave + 4 * g; const float* w1p = w0p + (size_t)16 * DM; const float* w2p = w0p + (size_t)(n < 4 ? 32 : 0) * DM;
        const float* gp = a.in[I_N2G] + 256 * wave + 4 * g; const float* sp = mod + b * 12288 + 4 * DM + 256 * wave + 4 * g;
#pragma unroll 4
        for (int Q = 0; Q < 16; ++Q) {
            f32x4 xa = *(const f32x4*)(xrow + 16 * Q);
            const f32x4 ab = *(const f32x4*)(gp + 16 * Q) * (1.f + *(const f32x4*)(sp + 16 * Q));
            const f32x4 wa = *(const f32x4*)(w0p + 16 * Q), wb = *(const f32x4*)(w1p + 16 * Q); f32x4 wc = *(const f32x4*)(w2p + 16 * Q);
            if (n >= 4) wc = (f32x4){0.f, 0.f, 0.f, 0.f};
            ss += (xa[0] * xa[0] + xa[1] * xa[1]) + (xa[2] * xa[2] + xa[3] * xa[3]); xa *= ab;
#pragma unroll
            for (int r = 0; r < 4; ++r) { acc[0] = __builtin_amdgcn_mfma_f32_16x16x4f32(xa[r], wa[r], acc[0], 0, 0, 0); acc[1] = __builtin_amdgcn_mfma_f32_16x16x4f32(xa[r], wb[r], acc[1], 0, 0, 0);
                acc[2] = __builtin_amdgcn_mfma_f32_16x16x4f32(xa[r], wc[r], acc[2], 0, 0, 0); }
        }
        ss += __shfl_xor(ss, 16); ss += __shfl_xor(ss, 32);
#pragma unroll
        for (int ct = 0; ct < 3; ++ct) *(LAS f32x4*)(part + (wave * 64 + lane) * 12 + 4 * ct) = acc[ct];
        if (lane < 16) ssp[wave * 16 + lane] = ss;
        __syncthreads();
        { const int tk = tid >> 5, sl = tid & 31;
            float s2 = 0.f;
#pragma unroll
            for (int w = 0; w < 8; ++w) s2 += ssp[w * 16 + tk];
            const float rstd = 1.f / sqrtf(s2 * (1.f / DM) + RMS_EPS);
            const float* b36 = (const float*)(a.ws + WS_B36) + b * 36;
            { const int e = sl; float s = 0.f;
#pragma unroll
              for (int w = 0; w < 8; ++w) s += part[(w * 64 + 16 * (tk >> 2) + (e & 15)) * 12 + 4 * (e >> 4) + (tk & 3)];
              lg[tk * 40 + e] = s * rstd + b36[e]; }
            if (sl < 4) { const int e = 32 + sl; float s = 0.f;
#pragma unroll
              for (int w = 0; w < 8; ++w) s += part[(w * 64 + 16 * (tk >> 2) + (e & 15)) * 12 + 4 * (e >> 4) + (tk & 3)];
              lg[tk * 40 + e] = s * rstd + b36[e]; }
            if (sl == 0) ((float*)(a.ws + WS_RSTD))[m0 + tk] = rstd; }
        __syncthreads();
        if (tid < 16) {
            float l[36];
#pragma unroll
            for (int e = 0; e < 36; ++e) l[e] = lg[tid * 40 + e];
            int gi = 0; float gm = l[0];
#pragma unroll
            for (int i = 1; i < 4; ++i) if (l[i] > gm) { gm = l[i]; gi = i; }
            float gs = 0.f;
#pragma unroll
            for (int i = 0; i < 4; ++i) gs += expf(l[i] - gm);
            const float gwt = 1.f / gs;
            float el[8];
#pragma unroll
            for (int j = 0; j < 8; ++j) el[j] = (gi == 0) ? l[4 + j] : ((gi == 1) ? l[12 + j] : ((gi == 2) ? l[20 + j] : l[28 + j]));
            int i1 = 0; float m1 = el[0];
#pragma unroll
            for (int i = 1; i < 8; ++i) if (el[i] > m1) { m1 = el[i]; i1 = i; }
            int i2 = -1; float m2 = -3.0e38f;
#pragma unroll
            for (int i = 0; i < 8; ++i) if (i != i1 && el[i] > m2) { m2 = el[i]; i2 = i; }
            const float e2 = expf(m2 - m1); const float w1 = gwt / (1.f + e2), w2 = gwt * e2 / (1.f + e2);
            int* rt = (int*)(a.ws + WS_ROUTE) + (size_t)(m0 + tid) * 8; const int ge1 = gi * 8 + i1, ge2 = gi * 8 + i2;
            rt[0] = ge1; rt[1] = ge2; rt[2] = __float_as_int(w1); rt[3] = __float_as_int(w2);
            const int sl = (tile & (NSLICE - 1)) * 32;
            atomicAdd(ctl + CW_CNT + sl + ge1, 1u); atomicAdd(ctl + CW_CNT + sl + ge2, 1u);
        }
        __syncthreads();
    }
}

__device__ __forceinline__ void phase9(const Args& a) {
    const int tid = threadIdx.x, lane = tid & 63, wave = tid >> 6;
    const int gw = blockIdx.x * NWAVES + wave, NGW = gridDim.x * NWAVES;
    unsigned* ctl = (unsigned*)(a.ws + WS_CTL);
    const float* mod = (const float*)(a.ws + WS_MOD);
    unsigned cnt = 0u;
    if (lane < NEXP) for (int s = 0; s < NSLICE; ++s) cnt += __hip_atomic_load(ctl + CW_CNT + s * 32 + lane, RLX_AGENT);
    const unsigned pad = (cnt + 255u) & ~255u;
    unsigned incl = pad;
#pragma unroll
    for (int o = 1; o < 64; o <<= 1) { const unsigned t = __shfl_up(incl, o); if (lane >= o) incl += t; }
    const unsigned off = incl - pad;
    if (gw == 0) {
        if (lane < NEXP) for (unsigned t = off >> 8; t < (off + pad) >> 8; ++t) ctl[CW_TE + t] = (unsigned)lane;
        if (lane == 63) ctl[CW_NRT] = incl >> 8;
    }
    for (int task = gw; task < MTOK / 4; task += NGW) {
        const int m0 = 4 * task, b = m0 >> 12, slice = (m0 >> 4) & (NSLICE - 1);
        unsigned sbase = 0u;
        if (lane < NEXP) for (int s = 0; s < slice; ++s) sbase += __hip_atomic_load(ctl + CW_CNT + s * 32 + lane, RLX_AGENT);
        const unsigned offs = off + sbase;
        int* rt = (int*)(a.ws + WS_ROUTE) + (size_t)(m0 + (lane & 3)) * 8;
        const int e1 = rt[0], e2 = rt[1];
        unsigned p1 = 0, p2 = 0;
        if (lane < 4) { p1 = atomicAdd(ctl + CW_POS + slice * 32 + e1, 1u); p2 = atomicAdd(ctl + CW_POS + slice * 32 + e2, 1u); }
        const unsigned s1v = __shfl(offs, e1) + p1, s2v = __shfl(offs, e2) + p2;
        if (lane < 4) { rt[4] = (int)s1v; rt[5] = (int)s2v; ((float*)(a.ws + WS_SW))[s1v] = __int_as_float(rt[2]); ((float*)(a.ws + WS_SW))[s2v] = __int_as_float(rt[3]); }
        f32x4 xa[8], xb[8];
        auto ldx = [&](int t, f32x4 (&x)[8]) { const f32x4* xr = (const f32x4*)((const float*)(a.ws + WS_X1) + (size_t)(m0 + t) * DM) + lane;
#pragma unroll
            for (int j = 0; j < 8; ++j) x[j] = xr[64 * j]; };
        auto dox = [&](int t, f32x4 (&x)[8]) { const unsigned s1 = __shfl(s1v, t), s2 = __shfl(s2v, t);
            const float rstd = ((const float*)(a.ws + WS_RSTD))[m0 + t];
            v2u* d1 = (v2u*)((bf16*)(a.ws + WS_H2P) + (size_t)s1 * DM) + lane; v2u* d2 = (v2u*)((bf16*)(a.ws + WS_H2P) + (size_t)s2 * DM) + lane;
#pragma unroll
            for (int j = 0; j < 8; ++j) { const int c = 4 * (lane + 64 * j);
                const f32x4 g = *(const f32x4*)(a.in[I_N2G] + c), sh = *(const f32x4*)(mod + b * 12288 + 3 * DM + c), sc = *(const f32x4*)(mod + b * 12288 + 4 * DM + c);
                const f32x4 h = x[j] * rstd * g * (1.f + sc) + sh; v2u o; o.x = pk2(h.x, h.y); o.y = pk2(h.z, h.w); d1[64 * j] = o; d2[64 * j] = o; } };
        ldx(0, xa); ldx(1, xb); dox(0, xa); ldx(2, xa); dox(1, xb); ldx(3, xb); dox(2, xa); dox(3, xb);
    }
}

__device__ __forceinline__ void phase12(const Args& a) {
    const int tid = threadIdx.x, lane = tid & 63, wave = tid >> 6;
    const int gw = blockIdx.x * NWAVES + wave, NGW = gridDim.x * NWAVES;
    const float* mod = (const float*)(a.ws + WS_MOD);
    struct Tok { f32x4 x[8]; v2u f1[8], f2[8]; };
    auto ldslots = [&](int m, int& s1, int& s2) { const int* rt = (const int*)(a.ws + WS_ROUTE) + (size_t)m * 8; s1 = rt[4]; s2 = rt[5]; };
    auto ldtok = [&](int m, int s1, int s2, Tok& t) { const f32x4* xr = (const f32x4*)((const float*)(a.ws + WS_X1) + (size_t)m * DM) + lane;
        const v2u* f1 = (const v2u*)((const bf16*)(a.ws + WS_FP) + (size_t)s1 * DM) + lane; const v2u* f2 = (const v2u*)((const bf16*)(a.ws + WS_FP) + (size_t)s2 * DM) + lane;
#pragma unroll
        for (int j = 0; j < 8; ++j) { t.x[j] = xr[64 * j]; t.f1[j] = f1[64 * j]; t.f2[j] = f2[64 * j]; } };
    auto dotok = [&](int m, Tok& t) { const int b = m >> 12; float s = 0.f; f32x4 v[8];
#pragma unroll
        for (int j = 0; j < 8; ++j) { const int c = 4 * (lane + 64 * j); const f32x4 g2 = *(const f32x4*)(mod + b * 12288 + 5 * DM + c);
            const v2u a1 = t.f1[j], a2 = t.f2[j]; f32x4 f;
            f.x = bflo(a1.x) + bflo(a2.x); f.y = bfhi(a1.x) + bfhi(a2.x); f.z = bflo(a1.y) + bflo(a2.y); f.w = bfhi(a1.y) + bfhi(a2.y);
            v[j] = t.x[j] + g2 * f; s += (v[j].x * v[j].x + v[j].y * v[j].y) + (v[j].z * v[j].z + v[j].w * v[j].w); }
        const float rstd = 1.f / sqrtf(wave_sum(s) * (1.f / DM) + RMS_EPS);
        f32x4* op = (f32x4*)(a.out + (size_t)m * DM) + lane;
#pragma unroll
        for (int j = 0; j < 8; ++j) { const int c = 4 * (lane + 64 * j); const f32x4 g = *(const f32x4*)(a.in[I_NFG] + c); op[64 * j] = v[j] * rstd * g; } };
    { Tok ta, tb; int m = gw, sa1 = 0, sa2 = 0, sb1 = 0, sb2 = 0;
      if (m < MTOK) { ldslots(m, sa1, sa2); if (m + NGW < MTOK) ldslots(m + NGW, sb1, sb2); ldtok(m, sa1, sa2, ta); }
      while (m < MTOK) { const int m2 = m + NGW, m3 = m2 + NGW, m4 = m3 + NGW;
          if (m3 < MTOK) ldslots(m3, sa1, sa2);
          if (m2 < MTOK) ldtok(m2, sb1, sb2, tb);
          dotok(m, ta); if (m2 >= MTOK) break;
          if (m4 < MTOK) ldslots(m4, sb1, sb2);
          if (m3 < MTOK) ldtok(m3, sa1, sa2, ta);
          dotok(m2, tb); m = m3; } }
}

#ifndef MK_ONE_LAUNCH
#define MK_ONE_LAUNCH 1
#endif
__global__ void __launch_bounds__(NTHR, 2) mega_fwd(Args args) {
    extern __shared__ __attribute__((aligned(16))) unsigned char lds_raw[];
    LAS unsigned char* lds = (LAS unsigned char*)lds_raw;
    const int tid = threadIdx.x;
    for (int u = tid; u < (LDS_BYTES - LDSCTL_OFF) / 4; u += NTHR) ((LAS unsigned*)(lds + LDSCTL_OFF))[u] = 0u;
    __syncthreads();
    volatile LAS unsigned* MISC = (volatile LAS unsigned*)(lds + MISC_OFF);
    unsigned* ctl = (unsigned*)(args.ws + WS_CTL);
    unsigned* barw = ctl + CW_BAR + args.li * XCD_BAR_WORDS;
    XcdBarrier bar; bar.bar = barw; bar.x = 0; bar.st = nullptr;
    const bool multi = (args.ph_hi - args.ph_lo) > 1;
    if (multi) bar = xcd_barrier_post(barw, MISC + 8);
    const int lo = args.ph_lo, hi = args.ph_hi, G = gridDim.x;
#define IN(k) (lo <= (k) && (k) < hi)
#define SEAM(k) do { if (IN(k) && IN((k) + 1)) xcd_barrier(bar); } while (0)
    const Args& a = args; STAMP_DECL;
#define PH_BEGIN(k) STAMP_BEGIN(100 + (k))
#define PH_END(k) STAMP_END(100 + (k))
    if (IN(0)) { PH_BEGIN(0); phase0(args, lds); } SEAM(0); if (IN(0)) PH_END(0);
    if (IN(1)) { PH_BEGIN(1); phase1(args); } SEAM(1); if (IN(1)) PH_END(1);
    if (IN(2)) { PH_BEGIN(2); pg8::Gemm g{(const pg8::bf16_t*)(args.ws + WS_HB), (const pg8::bf16_t*)(args.ws + WS_WIN), MTOK, PROJP, DM}; pg8::StaticOrder S; S.init(MTOK, PROJP, G, (int)blockIdx.x);
        EpiProj E{(bf16*)(args.ws + WS_P), (bf16*)(args.ws + WS_PLR)};
        pg8::gemm_phase<EpiProj, pg8::StaticOrder, true, true>(lds, g, S, E); } SEAM(2); if (IN(2)) PH_END(2);
    if (IN(3)) { PH_BEGIN(3); STAMP_BEGIN(10); phase3(args); STAMP_END(10); STAMP_BEGIN(11); phase5b(args, lds); STAMP_END(11); } SEAM(3); if (IN(3)) PH_END(3);
    if (IN(4)) { PH_BEGIN(4); pg8::Gemm g{(const pg8::bf16_t*)(args.ws + WS_AL), (const pg8::bf16_t*)(args.ws + WS_WL), MTOK, LORA_N, LORA_K}; pg8::StaticOrder S; S.init(MTOK, LORA_N, G, (int)blockIdx.x);
        EpiLora E{(float*)(args.ws + WS_LW), (bf16*)(args.ws + WS_AA), (bf16*)(args.ws + WS_GG)};
        pg8::gemm_phase<EpiLora, pg8::StaticOrder, true, true>(lds, g, S, E); } SEAM(4); if (IN(4)) PH_END(4);
    if (IN(5)) { PH_BEGIN(5); scanA(args, lds); } SEAM(5); if (IN(5)) PH_END(5);
    if (IN(6)) { PH_BEGIN(6); scanB(args, lds); } SEAM(6); if (IN(6)) PH_END(6);
    if (IN(7)) { PH_BEGIN(7); scanC(args); } SEAM(7); if (IN(7)) PH_END(7);
    if (IN(8)) { PH_BEGIN(8); pg8::Gemm g{(const pg8::bf16_t*)(args.ws + WS_YMIX), (const pg8::bf16_t*)(args.ws + WS_WOUT), MTOK, DM, DM}; pg8::StaticOrder S; S.init(MTOK, DM, G, (int)blockIdx.x);
        EpiResGate E{args.in[I_X], (const float*)(args.ws + WS_MOD) + 2 * DM, (float*)(args.ws + WS_X1)};
        pg8::gemm_phase<EpiResGate, pg8::StaticOrder, true, true>(lds, g, S, E); } SEAM(8); if (IN(8)) PH_END(8);
    if (IN(9)) { PH_BEGIN(9); phase8(args, lds); } SEAM(9); if (IN(9)) PH_END(9);
    if (IN(10)) { PH_BEGIN(10); phase9(args); } SEAM(10); if (IN(10)) PH_END(10);
    if (IN(11) || IN(12) || IN(13)) {
        const int nrt = (int)__hip_atomic_load(ctl + CW_NRT, RLX_AGENT), c = (int)blockIdx.x;
        const int Ugu = 4 * nrt, nB = Ugu > G ? Ugu - G : 0, R0 = (Ugu < G ? Ugu : G) / 4, E2 = (8 * R0 < 2 * (G - nB)) ? 8 * R0 : 2 * (G - nB);
        const pg8::Gemm gu{(const pg8::bf16_t*)(args.ws + WS_H2P), (const pg8::bf16_t*)(args.ws + WS_WGU), nrt * 256, NEXP * 1024, DM};
        const pg8::Gemm gd{(const pg8::bf16_t*)(args.ws + WS_HG), (const pg8::bf16_t*)(args.ws + WS_WD), nrt * 256, NEXP * DM, FF};
        const EpiGateUp Eu{(const float*)(args.ws + WS_SW), (bf16*)(args.ws + WS_HG)};
        const EpiStoreBf16 Ed{(bf16*)(args.ws + WS_FP), DM, 7};
        if (IN(11)) { PH_BEGIN(11); GroupOrder2 S{ctl + CW_TE, 4, 0, Ugu < G ? Ugu : G, G, c}; pg8::gemm_phase<EpiGateUp, GroupOrder2, true, true>(lds, gu, S, Eu); } SEAM(11); if (IN(11)) PH_END(11);
        if (IN(12)) { PH_BEGIN(12); if (c < nB) { GroupOrder2 S{ctl + CW_TE, 4, G, nB, nB, c}; pg8::gemm_phase<EpiGateUp, GroupOrder2, true, true>(lds, gu, S, Eu); }
                      else { GroupOrder2 S{ctl + CW_TE, 8, 0, E2, G - nB, c - nB}; pg8::gemm_phase<EpiStoreBf16, GroupOrder2, true, true>(lds, gd, S, Ed); } } SEAM(12); if (IN(12)) PH_END(12);
        if (IN(13)) { PH_BEGIN(13); GroupOrder2 S{ctl + CW_TE, 8, E2, 8 * nrt - E2, G, c}; pg8::gemm_phase<EpiStoreBf16, GroupOrder2, true, true>(lds, gd, S, Ed); } SEAM(13); if (IN(13)) PH_END(13);
    }
    if (IN(14)) { PH_BEGIN(14); phase12(args); PH_END(14); }
#ifdef STAMP_ID
    if (blockIdx.x == 0 && tid == 0 && IN(NPH - 1)) { const unsigned dly = STAMP_MULT * __hip_atomic_load(ctl + CW_STAMP, RLX_AGENT); const unsigned long long t0_ = __builtin_amdgcn_s_memrealtime();
        while (__builtin_amdgcn_s_memrealtime() - t0_ < (unsigned long long)dly) __builtin_amdgcn_s_sleep(8); }
#endif
#ifdef EXTRA_BARRIERS
    if (multi) for (int i_ = 0; i_ < EXTRA_BARRIERS; ++i_) xcd_barrier(bar);
#endif
#undef IN
#undef SEAM
}

extern "C" void kernel_launch(void* const* d_in, const int* in_sizes, int n_in, void* d_out, int out_size, void* d_ws, size_t ws_size, hipStream_t stream) {
    static int grid = 0;
    if (grid == 0) {
        if (n_in != 30 || out_size != MTOK * DM || ws_size < WS_END) { fprintf(stderr, "kernel_launch: unexpected shapes (n_in %d, out %d, ws %zu)\n", n_in, out_size, ws_size); grid = -1; return; }
        int dev = 0, cus = 0, per_cu = 0;
        if (hipGetDevice(&dev) != hipSuccess || hipDeviceGetAttribute(&cus, hipDeviceAttributeMultiprocessorCount, dev) != hipSuccess) { grid = -1; return; }
        if (hipFuncSetAttribute((const void*)mega_fwd, hipFuncAttributeMaxDynamicSharedMemorySize, LDS_BYTES) != hipSuccess) { grid = -1; return; }
        if (hipOccupancyMaxActiveBlocksPerMultiprocessor(&per_cu, (const void*)mega_fwd, NTHR, LDS_BYTES) != hipSuccess || per_cu < 1) { fprintf(stderr, "kernel_launch: occupancy query says %d\n", per_cu); grid = -1; (void)hipGetLastError(); return; }
        grid = cus;
    }
    if (grid < 0) return;
    (void)hipMemsetAsync((char*)d_ws + WS_CTL, 0, CTL_ZERO_BYTES, stream);
    Args a{};
    for (int i = 0; i < 30; ++i) a.in[i] = (const float*)d_in[i];
    a.out = (float*)d_out; a.ws = (unsigned char*)d_ws;
#if MK_ONE_LAUNCH
#ifdef PROBE_PHASE
    const int cuts[3] = {0, PROBE_PHASE, NPH};
    for (int li = 0; li < 2; ++li) { a.ph_lo = cuts[li]; a.ph_hi = cuts[li + 1] + ((li == 0) ? PROBE_REPEAT : 0); a.li = li;
        void* kargs[] = {&a};
        hipError_t e = hipLaunchCooperativeKernel((const void*)mega_fwd, dim3(grid), dim3(NTHR), kargs, LDS_BYTES, stream);
        if (e != hipSuccess) fprintf(stderr, "cooperative launch failed: %s\n", hipGetErrorString(e)); }
#else
    a.ph_lo = 0; a.ph_hi = NPH;
    void* kargs[] = {&a};
    hipError_t e = hipLaunchCooperativeKernel((const void*)mega_fwd, dim3(grid), dim3(NTHR), kargs, LDS_BYTES, stream);
    if (e != hipSuccess) fprintf(stderr, "cooperative launch failed: %s\n", hipGetErrorString(e));
#endif
#else
    for (int p = 0; p < NPH; ++p) { a.ph_lo = p; a.ph_hi = p + 1; hipLaunchKernelGGL(mega_fwd, dim3(grid), dim3(NTHR), LDS_BYTES, stream, a); }
#endif
}
```

```cpp
#include <hip/hip_runtime.h>
#include <hip/hip_bf16.h>
#include <cstdio>
#include <cstdint>

constexpr int NWAVES = 8, NTHR = 512;
constexpr int BATCH = 2, SEQ = 4096, DM = 2048, MTOK = BATCH * SEQ;
constexpr int CW = 1024, NHEAD = 16, HD = 64;
constexpr int SHIFTW = 3360, PROJW = 6432, PROJP = 6656;
constexpr int LORA_K = 384, LORA_N = 3072;
constexpr int NEXP = 32, FF = 512;
constexpr int MAXSLOT = 24576;
constexpr float RMS_EPS = 1e-6f, GN_EPS = 64e-5f;
constexpr float LOG2E = 1.4426950408889634f;

constexpr size_t MiB = 1u << 20;
constexpr size_t WS_CTL = 0, CTL_ZERO_BYTES = 1 * MiB;
constexpr size_t WS_MOD = 1 * MiB;
constexpr size_t WS_ROUTE = 1 * MiB + 128 * 1024;
constexpr size_t WS_SW = 1 * MiB + 512 * 1024;
constexpr size_t WS_B36 = 1 * MiB + 96 * 1024;
constexpr size_t WS_RSTD = 1 * MiB + 640 * 1024;
constexpr size_t WS_W36 = 1 * MiB + 704 * 1024;
constexpr size_t WS_WIN = 2 * MiB;
constexpr size_t WS_WOUT = 28 * MiB;
constexpr size_t WS_WL = 36 * MiB;
constexpr size_t WS_WGU = 39 * MiB;
constexpr size_t WS_WD = 167 * MiB;
constexpr size_t B0 = 231 * MiB;
constexpr size_t WS_P = B0;
constexpr size_t WS_PLR = B0 + 96 * MiB;
constexpr size_t HM_PART = (size_t)BATCH * NHEAD * SEQ * HD, HM_BATCH = (size_t)NHEAD * SEQ * HD, HM_HEAD = (size_t)SEQ * HD;
constexpr size_t WS_HB = B0 + 104 * MiB;
constexpr size_t WS_AL = B0 + 136 * MiB;
constexpr size_t WS_LW = B0 + 142 * MiB;
constexpr size_t WS_AA = B0 + 174 * MiB;
constexpr size_t WS_GG = B0 + 190 * MiB;
constexpr size_t WS_R = B0 + 206 * MiB, WS_K2 = B0 + 222 * MiB, WS_V = B0 + 238 * MiB, WS_KK = B0 + 254 * MiB, WS_BB = B0 + 270 * MiB;
constexpr size_t WS_YMIX = B0 + 286 * MiB;
constexpr size_t WS_X1 = B0;
constexpr size_t WS_H2P = B0 + 136 * MiB;
constexpr size_t WS_HG = B0 + 232 * MiB;
constexpr size_t WS_FP = B0 + 136 * MiB;
constexpr size_t WS_HM = B0 + 104 * MiB, WS_Y1 = B0 + 254 * MiB, WS_GT = B0 + 318 * MiB, WS_RH = B0 + 334 * MiB, WS_PLV = B0 + 136 * MiB;
constexpr size_t WS_SF = B0 + 152 * MiB;
constexpr size_t WS_END = B0 + 350 * MiB;
constexpr int CW_NRT = 1152, CW_TE = 1280, CW_BAR = 4096;
constexpr int NSLICE = 64, CW_CNT = 16384, CW_POS = 16384 + NSLICE * 32;

constexpr int CW_STAMP = 1200, CW_RDY = 1400;
#ifdef STAMP_ID
#ifndef STAMP_BLOCK
#define STAMP_BLOCK 0
#endif
#ifndef STAMP_MULT
#define STAMP_MULT 1u
#endif
#define STAMP_BEGIN(id) do { if ((id) == STAMP_ID && blockIdx.x == STAMP_BLOCK && threadIdx.x == 0) st_t0_ = __builtin_amdgcn_s_memrealtime(); } while (0)
#define STAMP_END(id) do { if ((id) == STAMP_ID && blockIdx.x == STAMP_BLOCK && threadIdx.x == 0) atomicAdd((unsigned*)(a.ws + WS_CTL) + CW_STAMP, (unsigned)(__builtin_amdgcn_s_memrealtime() - st_t0_)); } while (0)
#define STAMP_DECL unsigned long long st_t0_ = 0
#else
#define STAMP_BEGIN(id) do { } while (0)
#define STAMP_END(id) do { } while (0)
#define STAMP_DECL do { } while (0)
#endif
constexpr int RING_BYTES = 131072;
constexpr int LDSCTL_OFF = RING_BYTES, MISC_OFF = LDSCTL_OFF + 320;
constexpr int LDS_BYTES = 147456;

#define GAS __attribute__((address_space(1)))
#define LAS __attribute__((address_space(3)))
typedef unsigned short bf16;
typedef unsigned v4u __attribute__((ext_vector_type(4)));
typedef unsigned v2u __attribute__((ext_vector_type(2)));
typedef float f32x4 __attribute__((ext_vector_type(4)));
typedef short bf16x8 __attribute__((ext_vector_type(8)));
typedef short s16x4 __attribute__((ext_vector_type(4)));
typedef GAS unsigned gu32;
typedef GAS unsigned long long gu64;
#define RLX_AGENT __ATOMIC_RELAXED, __HIP_MEMORY_SCOPE_AGENT
#define LDS_WAIT() asm volatile("s_waitcnt lgkmcnt(0)" ::: "memory")
#define VM_WAIT() asm volatile("s_waitcnt vmcnt(0)" ::: "memory")
__device__ __forceinline__ unsigned f2bf(float f) { unsigned u = __builtin_bit_cast(unsigned, f); return (u + 0x7fffu + ((u >> 16) & 1u)) >> 16; }
typedef float f32x2_t __attribute__((ext_vector_type(2)));
typedef __bf16 bf16x2_t __attribute__((ext_vector_type(2)));
__device__ __forceinline__ unsigned pk2(float lo, float hi) { const f32x2_t v = {lo, hi}; return __builtin_bit_cast(unsigned, __builtin_convertvector(v, bf16x2_t)); }
__device__ __forceinline__ float bflo(unsigned u) { return __builtin_bit_cast(float, u << 16); }
__device__ __forceinline__ float bfhi(unsigned u) { return __builtin_bit_cast(float, u & 0xffff0000u); }
__device__ __forceinline__ float wave_sum(float v) {
#pragma unroll
    for (int o = 1; o < 64; o <<= 1) v += __shfl_xor(v, o);
    return v;
}
__device__ __forceinline__ float sigmoid_f(float x) { return __builtin_amdgcn_rcpf(1.f + __expf(-x)); }

struct Args { const float* in[30]; float* out; unsigned char* ws; int ph_lo, ph_hi, li, pad; };
enum { I_X = 0, I_C, I_WADA, I_BADA, I_N1G, I_WIN, I_MU, I_W0, I_WDEC, I_A0, I_WAAA, I_WGATEUP, I_KK, I_KA, I_RK, I_LNW, I_LNB, I_RELB, I_BETAR, I_BETAA,
       I_WOUT, I_N2G, I_WGRP, I_BGRP, I_WEXP, I_BEXP, I_WG, I_WU, I_WDN, I_NFG };
constexpr int NPH = 15;

namespace pg8 {
#define PG8_LAS __attribute__((address_space(3)))
typedef unsigned short bf16_t;
typedef short bf16x8 __attribute__((ext_vector_type(8)));
typedef float f32x4 __attribute__((ext_vector_type(4)));
typedef unsigned u32x4 __attribute__((ext_vector_type(4)));
constexpr int BM = 256, BK = 64, HALF = 128, HTB = HALF * BK * 2  , STAGE_BYTES = 8 * HTB, NXCD = 8, WGM = 8;

__host__ __device__ __forceinline__ int lds_byte(int r, int c) { const int st = (r >> 4) * 2 + (c >> 5), rr = r & 15, cc = c & 31, ob = rr * 64 + cc * 2; return st * 1024 + (ob ^ (((ob >> 9) & 1) << 5)); }
__host__ __device__ __forceinline__ void stage_rc(int b, int& R, int& C) { const int st = b / 1024, sb = b % 1024, swz = sb ^ (((sb >> 9) & 1) << 5); R = (st >> 1) * 16 + swz / 64; C = (st & 1) * 32 + (swz % 64) / 2; }
__host__ __device__ __forceinline__ int perm32(int rho) { const int n = rho >> 4, i = rho & 15; return 8 * (i >> 2) + 4 * n + (i & 3); }

struct Unit { int pm, pn; };
struct Gemm { const bf16_t* A; const bf16_t* Bt; int M, N, K; };

struct StaticOrder {
    int nM, nN, nwg, G, c;
    __host__ __device__ void init(int M, int N, int G_, int c_) { nM = M / BM; nN = N / BM; nwg = nM * nN; G = G_; c = c_; }
    __host__ __device__ bool next(int i, Unit& u) const {
        const long L = (long)i * G + c; if (L >= nwg) return false;
        int wgid = (int)L; { const int q = nwg / NXCD, r = nwg % NXCD, xcd = wgid % NXCD, off = wgid / NXCD; wgid = (xcd < r ? xcd * (q + 1) : r * (q + 1) + (xcd - r) * q) + off; }
        const int nig = WGM * nN, gid = wgid / nig, fm = gid * WGM, gsz = (nM - fm) < WGM ? (nM - fm) : WGM;
        u.pm = fm + ((wgid % nig) % gsz); u.pn = (wgid % nig) / gsz; return true;
    }
    __device__ __forceinline__ void a_ready(const Unit&) const {}
    __device__ __forceinline__ void done(const Unit&) const {}
};

__device__ __forceinline__ unsigned cvt_pk_bf16(float lo, float hi) { unsigned r; asm volatile("v_cvt_pk_bf16_f32 %0, %1, %2" : "=v"(r) : "v"(lo), "v"(hi)); return r; }
template <class Epi, class Sched, bool ALIGN_EPI = false, bool SP2 = false>
__device__ __forceinline__ void gemm_phase(PG8_LAS unsigned char* lds, const Gemm g, const Sched& S, const Epi& E) {
    const int tid = threadIdx.x, wid = __builtin_amdgcn_readfirstlane(tid >> 6), lane = tid & 63, wr = wid >> 2, wc = wid & 3, fr = lane & 15, fq = lane >> 4;
    const int K = g.K, nt = K / BK;
    unsigned voffA[2], voffB[2];
#pragma unroll
    for (int i = 0; i < 2; ++i) { int R, C; stage_rc(tid * 16 + i * 8192, R, C); const int Rb = Epi::PERM ? ((R & ~31) + perm32(R & 31)) : R;
        voffA[i] = (unsigned)(R * K + C) * 2u; voffB[i] = (unsigned)(Rb * K + C) * 2u; }
    const size_t kstep = (size_t)(BK * 2);
    const size_t hstep = (size_t)HALF * K * 2;
    const size_t tstep = 2 * hstep;
    const unsigned ldsw = (unsigned)wid * 1024u;
    const int aoff = lds_byte(wr * 64 + fr, fq * 8), boff = lds_byte(wc * 32 + fr, fq * 8);
#define PG8_SA(b, h) (((b) * 2 + (h)) * HTB)
#define PG8_SB(b, h) ((4 + (b) * 2 + (h)) * HTB)
#define PG8_STAGE(bufoff, gbase, voff) do { _Pragma("unroll") for (int _i = 0; _i < 2; ++_i) \
        __builtin_amdgcn_global_load_lds((const unsigned*)((const char*)(gbase) + (voff)[_i]), (PG8_LAS unsigned*)(lds + (bufoff) + ldsw + _i * 8192), 16, 0, 0); } while (0)
#define PG8_LDA(dst, b, h) do { _Pragma("unroll") for (int m = 0; m < 4; ++m) _Pragma("unroll") for (int k = 0; k < 2; ++k) dst[m][k] = *(const PG8_LAS bf16x8*)(lds + PG8_SA(b, h) + aoff + m * 2048 + k * 1024); } while (0)
#define PG8_LDB(dst, b, h) do { _Pragma("unroll") for (int n = 0; n < 2; ++n) _Pragma("unroll") for (int k = 0; k < 2; ++k) dst[n][k] = *(const PG8_LAS bf16x8*)(lds + PG8_SB(b, h) + boff + n * 2048 + k * 1024); } while (0)
#define PG8_MMA(ai, bj, At, Bt) do { __builtin_amdgcn_s_setprio(1); _Pragma("unroll") for (int m = 0; m < 4; ++m) _Pragma("unroll") for (int n = 0; n < 2; ++n) _Pragma("unroll") for (int k = 0; k < 2; ++k) \
        acc[ai][bj][m][n] = __builtin_amdgcn_mfma_f32_16x16x32_bf16(Bt[n][k], At[m][k], acc[ai][bj][m][n], 0, 0, 0); __builtin_amdgcn_s_setprio(0); } while (0)
#define PG8_WAIT_V(n) asm volatile("s_waitcnt vmcnt(" #n ")" ::: "memory")
#define PG8_WAIT_L(n) asm volatile("s_waitcnt lgkmcnt(" #n ")" ::: "memory")
#define PG8_BAR __builtin_amdgcn_s_barrier()
#define PG8_SCHED __builtin_amdgcn_sched_barrier(0)
    Unit cur, nxt; int ui = 0;
    if (!S.next(0, cur)) return;
    f32x4 acc[2][2][4][2];
#pragma unroll
    for (int a = 0; a < 2; ++a)
#pragma unroll
        for (int b = 0; b < 2; ++b)
#pragma unroll
            for (int m = 0; m < 4; ++m)
#pragma unroll
                for (int n = 0; n < 2; ++n) acc[a][b][m][n] = (f32x4){0.f, 0.f, 0.f, 0.f};
    bf16x8 At[4][2], B0[2][2], B1[2][2];
    const char* cA = (const char*)g.A + (size_t)cur.pm * tstep; const char* cB = (const char*)g.Bt + (size_t)cur.pn * tstep;
    S.a_ready(cur);
    if constexpr (SP2) {
        PG8_STAGE(PG8_SB(0, 0), cB, voffB); PG8_STAGE(PG8_SB(0, 1), cB + hstep, voffB); PG8_STAGE(PG8_SA(0, 0), cA, voffA); PG8_STAGE(PG8_SA(0, 1), cA + hstep, voffA);
        if (wr == 1) PG8_BAR;
        PG8_WAIT_V(2); PG8_BAR;
        PG8_STAGE(PG8_SB(1, 0), cB + kstep, voffB); PG8_STAGE(PG8_SA(1, 0), cA + kstep, voffA); PG8_STAGE(PG8_SB(1, 1), cB + hstep + kstep, voffB);
        PG8_WAIT_V(6); PG8_BAR;
    } else {
        PG8_STAGE(PG8_SB(0, 0), cB, voffB); PG8_STAGE(PG8_SA(0, 0), cA, voffA); PG8_STAGE(PG8_SB(0, 1), cB + hstep, voffB); PG8_STAGE(PG8_SA(0, 1), cA + hstep, voffA);
        if (wr == 1) PG8_BAR;
        PG8_WAIT_V(4); PG8_BAR;
        PG8_STAGE(PG8_SB(1, 0), cB + kstep, voffB); PG8_STAGE(PG8_SA(1, 0), cA + kstep, voffA); PG8_STAGE(PG8_SB(1, 1), cB + hstep + kstep, voffB);
        PG8_WAIT_V(6); PG8_BAR;
    }
    for (;;) {
        const bool has_next = S.next(ui + 1, nxt);
        const char* nA = has_next ? (const char*)g.A + (size_t)nxt.pm * tstep : cA; const char* nB = has_next ? (const char*)g.Bt + (size_t)nxt.pn * tstep : cB;
        for (int t = 0; t < nt; t += 2) {
            const bool last = (t == nt - 2);
            const char* a1 = cA + (size_t)(t + 1) * kstep;
            const char* a2 = last ? nA : cA + (size_t)(t + 2) * kstep; const char* b2 = last ? nB : cB + (size_t)(t + 2) * kstep;
            const char* a3 = a2 + kstep; const char* b3 = b2 + kstep;
            if (last && has_next) S.a_ready(nxt);
            if constexpr (SP2) {
            PG8_LDB(B0, 0, 0); PG8_LDB(B1, 0, 1); PG8_SCHED; PG8_LDA(At, 0, 0); PG8_STAGE(PG8_SA(1, 1), a1 + hstep, voffA);
            PG8_WAIT_V(8); PG8_WAIT_L(0); PG8_BAR; PG8_MMA(0, 0, At, B0); PG8_MMA(0, 1, At, B1); PG8_BAR; PG8_SCHED;
            PG8_LDA(At, 0, 1); PG8_STAGE(PG8_SB(0, 0), b2, voffB); PG8_STAGE(PG8_SB(0, 1), b2 + hstep, voffB); PG8_STAGE(PG8_SA(0, 0), a2, voffA);
            PG8_WAIT_V(8); PG8_WAIT_L(0); PG8_BAR; PG8_MMA(1, 0, At, B0); PG8_MMA(1, 1, At, B1); PG8_BAR; PG8_SCHED;
            PG8_LDB(B0, 1, 0); PG8_LDB(B1, 1, 1); PG8_SCHED; PG8_LDA(At, 1, 0); PG8_STAGE(PG8_SA(0, 1), a2 + hstep, voffA);
            PG8_WAIT_V(8); PG8_WAIT_L(0); PG8_BAR; PG8_MMA(0, 0, At, B0); PG8_MMA(0, 1, At, B1); PG8_BAR; PG8_SCHED;
            PG8_LDA(At, 1, 1); PG8_STAGE(PG8_SB(1, 0), b3, voffB); PG8_STAGE(PG8_SB(1, 1), b3 + hstep, voffB); PG8_STAGE(PG8_SA(1, 0), a3, voffA);
            PG8_WAIT_V(8); PG8_WAIT_L(0); PG8_BAR; PG8_MMA(1, 0, At, B0); PG8_MMA(1, 1, At, B1); PG8_BAR; PG8_SCHED;
            } else {
            PG8_LDB(B0, 0, 0); PG8_SCHED; PG8_LDA(At, 0, 0); PG8_STAGE(PG8_SA(1, 1), a1 + hstep, voffA);
            PG8_WAIT_L(8); PG8_BAR; PG8_WAIT_L(0); PG8_MMA(0, 0, At, B0); PG8_BAR; PG8_SCHED;
            PG8_LDB(B1, 0, 1); PG8_STAGE(PG8_SB(0, 0), b2, voffB);
            PG8_BAR; PG8_WAIT_L(0); PG8_MMA(0, 1, At, B1); PG8_BAR;
            PG8_LDA(At, 0, 1); PG8_STAGE(PG8_SA(0, 0), a2, voffA);
            PG8_BAR; PG8_WAIT_L(0); PG8_MMA(1, 0, At, B0); PG8_BAR; PG8_SCHED;
            PG8_STAGE(PG8_SB(0, 1), b2 + hstep, voffB);
            PG8_WAIT_V(6); PG8_BAR; PG8_MMA(1, 1, At, B1); PG8_BAR;
            PG8_LDB(B0, 1, 0); PG8_SCHED; PG8_LDA(At, 1, 0); PG8_STAGE(PG8_SA(0, 1), a2 + hstep, voffA);
            PG8_WAIT_L(8); PG8_BAR; PG8_WAIT_L(0); PG8_MMA(0, 0, At, B0); PG8_BAR; PG8_SCHED;
            PG8_LDB(B1, 1, 1); PG8_STAGE(PG8_SB(1, 0), b3, voffB);
            PG8_BAR; PG8_WAIT_L(0); PG8_MMA(0, 1, At, B1); PG8_BAR;
            PG8_LDA(At, 1, 1); PG8_STAGE(PG8_SA(1, 0), a3, voffA);
            PG8_BAR; PG8_WAIT_L(0); PG8_MMA(1, 0, At, B0); PG8_BAR; PG8_SCHED;
            PG8_STAGE(PG8_SB(1, 1), b3 + hstep, voffB);
            PG8_WAIT_V(6); PG8_BAR; PG8_MMA(1, 1, At, B1); PG8_BAR;
            }
        }
        if constexpr (ALIGN_EPI) { if (wr == 0) PG8_BAR; }
        if constexpr (!Epi::AFTER_DRAIN) { E(acc, cur, wr, wc, fr, fq); S.done(cur); }
        if (!has_next) break;
#pragma unroll
        for (int a = 0; a < 2; ++a)
#pragma unroll
            for (int b = 0; b < 2; ++b)
#pragma unroll
                for (int m = 0; m < 4; ++m)
#pragma unroll
                    for (int n = 0; n < 2; ++n) acc[a][b][m][n] = (f32x4){0.f, 0.f, 0.f, 0.f};
        cur = nxt; cA = nA; cB = nB; ++ui;
        if constexpr (ALIGN_EPI) { if (wr == 1) PG8_BAR; }
    }
    PG8_WAIT_V(0);
    if constexpr (!ALIGN_EPI) { if (wr == 0) PG8_BAR; }
    PG8_BAR;
    if constexpr (Epi::AFTER_DRAIN) { E.fused(acc, cur, wr, wc, fr, fq, lds, wid, lane); S.done(cur); }
#undef PG8_SA
#undef PG8_SB
#undef PG8_STAGE
#undef PG8_LDA
#undef PG8_LDB
#undef PG8_MMA
#undef PG8_WAIT_V
#undef PG8_WAIT_L
#undef PG8_BAR
#undef PG8_SCHED
}
}
#define XB_TMO      128
#define XB_XCNT(j)  (256  + 64 * (j))
#define XB_XSUB(j)  (1280 + 64 * (j))
#define XB_XGEN(j)  (2304 + 64 * (j))
#define XB_TOP      3328
#define XB_TOPGEN   3392
#define XCD_BAR_WORDS 3456
#define XB_SPIN_CAP (1u << 18)

__device__ __forceinline__ unsigned xb_ld(unsigned* p)              { return __hip_atomic_load(p, __ATOMIC_RELAXED, __HIP_MEMORY_SCOPE_AGENT); }
__device__ __forceinline__ unsigned xb_add(unsigned* p, unsigned v) { return __hip_atomic_fetch_add(p, v, __ATOMIC_RELAXED, __HIP_MEMORY_SCOPE_AGENT); }
__device__ __forceinline__ unsigned xb_xcc_id() { return (unsigned)__builtin_amdgcn_s_getreg((3 << 11) | 20) & 0xFu; }
#define XB_SPIN(cond, bar) do { unsigned _sp = 0; while (cond) { __builtin_amdgcn_s_sleep(1); \
    if ((++_sp & 255u) == 0u) { if (xb_ld(&(bar)[XB_TMO])) break; if (_sp > XB_SPIN_CAP) { atomicAdd(&(bar)[XB_TMO], 1u); break; } } } } while (0)

struct XcdBarrier {
    unsigned* bar; unsigned x;
    volatile LAS unsigned* st;
};

__device__ __forceinline__ XcdBarrier xcd_barrier_post(unsigned* bar, volatile LAS unsigned* st) {
    XcdBarrier b; b.bar = bar; b.x = xb_xcc_id(); b.st = st;
    if (threadIdx.x == 0) (void)xb_add(&bar[XB_XCNT(b.x)], 1u);
    return b;
}
__device__ __forceinline__ void xcd_barrier_complete(unsigned* bar, unsigned x, unsigned& nloc, unsigned& nx) {
    const unsigned G = gridDim.x * gridDim.y * gridDim.z;
    unsigned sum, cnt, mine, sp = 0u;
    for (;;) {
        sum = 0u; cnt = 0u; mine = 0u;
#pragma unroll
        for (unsigned j = 0; j < 16; ++j) { const unsigned c = xb_ld(&bar[XB_XCNT(j)]); sum += c; cnt += (c > 0u) ? 1u : 0u; mine = (j == x) ? c : mine; }
        if (sum == G) break;
        __builtin_amdgcn_s_sleep(1);
        if ((++sp & 255u) == 0u) { if (xb_ld(&bar[XB_TMO])) break; if (sp > XB_SPIN_CAP) { atomicAdd(&bar[XB_TMO], 1u); break; } }
    }
    nloc = mine > 0u ? mine : 1u; nx = cnt > 0u ? cnt : 1u;
}

__device__ __forceinline__ void xcd_barrier(const XcdBarrier& b) {
    asm volatile("s_waitcnt vmcnt(0)" ::: "memory");
    __syncthreads();
    if (threadIdx.x == 0) {
        unsigned* bar = b.bar;
        __builtin_amdgcn_s_waitcnt(0);
        unsigned nloc = b.st[0], nx = b.st[1];
        if (nloc == 0u) { xcd_barrier_complete(bar, b.x, nloc, nx); b.st[0] = nloc; b.st[1] = nx; }
        const unsigned old = xb_add(&bar[XB_XSUB(b.x)], 1u);
        const unsigned gen = old / nloc;
        if (old + 1u == (gen + 1u) * nloc) {
            __builtin_amdgcn_fence(__ATOMIC_RELEASE, "agent");
            asm volatile("s_waitcnt vmcnt(0)" ::: "memory");
            const unsigned og = xb_add(&bar[XB_TOP], 1u);
            const unsigned tg = og / nx;
            if (og + 1u == (tg + 1u) * nx) xb_add(&bar[XB_TOPGEN], 1u);
            else XB_SPIN(xb_ld(&bar[XB_TOPGEN]) == tg, bar);
            __builtin_amdgcn_fence(__ATOMIC_ACQUIRE, "agent");
            xb_add(&bar[XB_XGEN(b.x)], 1u);
            asm volatile("s_waitcnt vmcnt(0)" ::: "memory");
        } else {
            XB_SPIN(xb_ld(&bar[XB_XGEN(b.x)]) == gen, bar);
            __builtin_amdgcn_fence(__ATOMIC_ACQUIRE, "agent");
            asm volatile("s_waitcnt vmcnt(0)" ::: "memory");
        }
    }
    __syncthreads();
}

struct EpiStoreBf16 {
    static constexpr bool PERM = true, AFTER_DRAIN = false;
    bf16* O; int ldc; int pn_mask;
    __device__ __forceinline__ void operator()(const pg8::f32x4 (&acc)[2][2][4][2], const pg8::Unit& u, int wr, int wc, int fr_, int fq_) const {
        int t_ = threadIdx.x; asm volatile("" : "+v"(t_)); const int fr = t_ & 15, fq = (t_ >> 4) & 3; (void)fr_; (void)fq_;
        const int row0 = u.pm * 256 + wr * 64 + fr, col0 = (u.pn & pn_mask) * 256 + wc * 32 + 8 * fq;
#pragma unroll
        for (int ai = 0; ai < 2; ++ai)
#pragma unroll
            for (int m = 0; m < 4; ++m) { bf16* rowp = O + (size_t)(row0 + ai * 128 + m * 16) * ldc + col0;
#pragma unroll
                for (int bj = 0; bj < 2; ++bj) { const pg8::f32x4 v0 = acc[ai][bj][m][0], v1 = acc[ai][bj][m][1];
                    v4u w; w.x = pg8::cvt_pk_bf16(v0[0], v0[1]); w.y = pg8::cvt_pk_bf16(v0[2], v0[3]); w.z = pg8::cvt_pk_bf16(v1[0], v1[1]); w.w = pg8::cvt_pk_bf16(v1[2], v1[3]);
                    *(v4u*)(rowp + bj * 128) = w; } }
    }
};
struct EpiProj {
    static constexpr bool PERM = true, AFTER_DRAIN = false;
    bf16* HM; bf16* PLR;
    __device__ __forceinline__ void operator()(const pg8::f32x4 (&acc)[2][2][4][2], const pg8::Unit& u, int wr, int wc, int fr_, int fq_) const {
        int t_ = threadIdx.x; asm volatile("" : "+v"(t_)); const int fr = t_ & 15, fq = (t_ >> 4) & 3; (void)fr_; (void)fq_;
        const int row0 = u.pm * 256 + wr * 64 + fr, colb = u.pn * 256 + wc * 32 + 8 * fq;
#pragma unroll
        for (int bj = 0; bj < 2; ++bj) { const int idx = colb + bj * 128;
            if (idx >= PROJW) continue;
            const bool lora = idx >= 6144;
            const size_t hbase = (size_t)(idx >> 10) * HM_PART + (size_t)((idx >> 6) & 15) * HM_HEAD + (idx & 63);
#pragma unroll
            for (int ai = 0; ai < 2; ++ai)
#pragma unroll
                for (int m = 0; m < 4; ++m) { const int row = row0 + ai * 128 + m * 16;
                    bf16* dst = lora ? PLR + (size_t)row * 288 + (idx - 6144) : HM + hbase + (size_t)(row >> 12) * HM_BATCH + (size_t)(row & (SEQ - 1)) * HD;
                    const pg8::f32x4 v0 = acc[ai][bj][m][0], v1 = acc[ai][bj][m][1];
                    v4u w; w.x = pg8::cvt_pk_bf16(v0[0], v0[1]); w.y = pg8::cvt_pk_bf16(v0[2], v0[3]); w.z = pg8::cvt_pk_bf16(v1[0], v1[1]); w.w = pg8::cvt_pk_bf16(v1[2], v1[3]);
                    *(v4u*)dst = w; } }
    }
};
struct EpiGateUp {
    static constexpr bool PERM = true, AFTER_DRAIN = false;
    const float* sw; bf16* HG;
    __device__ __forceinline__ void operator()(const pg8::f32x4 (&acc)[2][2][4][2], const pg8::Unit& u, int wr, int wc, int fr_, int fq_) const {
        int t_ = threadIdx.x; asm volatile("" : "+v"(t_)); const int fr = t_ & 15, fq = (t_ >> 4) & 3; (void)fr_; (void)fq_;
        const int pl = u.pn & 3, row0 = u.pm * 256 + wr * 64 + fr, col0 = pl * 128 + wc * 32 + 8 * fq;
#pragma unroll
        for (int ai = 0; ai < 2; ++ai)
#pragma unroll
            for (int m = 0; m < 4; ++m) { const int row = row0 + ai * 128 + m * 16; const float w = sw[row]; float h[8];
#pragma unroll
                for (int n = 0; n < 2; ++n)
#pragma unroll
                    for (int j = 0; j < 4; ++j) { const float g = acc[ai][0][m][n][j], up = acc[ai][1][m][n][j]; h[4 * n + j] = g * sigmoid_f(g) * up * w; }
                v4u o; o.x = pg8::cvt_pk_bf16(h[0], h[1]); o.y = pg8::cvt_pk_bf16(h[2], h[3]); o.z = pg8::cvt_pk_bf16(h[4], h[5]); o.w = pg8::cvt_pk_bf16(h[6], h[7]);
                *(v4u*)(HG + (size_t)row * FF + col0) = o; }
    }
};
struct EpiResGate {
    static constexpr bool PERM = true, AFTER_DRAIN = false;
    const float* x; const float* gate; float* X1;
    __device__ __forceinline__ void operator()(const pg8::f32x4 (&acc)[2][2][4][2], const pg8::Unit& u, int wr, int wc, int fr_, int fq_) const {
        int t_ = threadIdx.x; asm volatile("" : "+v"(t_)); const int fr = t_ & 15, fq = (t_ >> 4) & 3; (void)fr_; (void)fq_;
        const int row0 = u.pm * 256 + wr * 64 + fr, col0 = u.pn * 256 + wc * 32 + 8 * fq;
        const float* gp = gate + (size_t)((u.pm * 256) >> 12) * 12288;
#pragma unroll
        for (int bj = 0; bj < 2; ++bj) { const int c = col0 + bj * 128; const pg8::f32x4 g0 = *(const pg8::f32x4*)(gp + c), g1 = *(const pg8::f32x4*)(gp + c + 4);
#pragma unroll
            for (int ai = 0; ai < 2; ++ai)
#pragma unroll
                for (int m = 0; m < 4; ++m) { const size_t off = (size_t)(row0 + ai * 128 + m * 16) * DM + c;
                    const pg8::f32x4 x0 = *(const pg8::f32x4*)(x + off), x1 = *(const pg8::f32x4*)(x + off + 4);
                    *(pg8::f32x4*)(X1 + off) = x0 + g0 * acc[ai][bj][m][0]; *(pg8::f32x4*)(X1 + off + 4) = x1 + g1 * acc[ai][bj][m][1]; } }
    }
};
struct EpiLora {
    static constexpr bool PERM = false, AFTER_DRAIN = false;
    float* LW; bf16* AA; bf16* GG;
    __device__ __forceinline__ void operator()(const pg8::f32x4 (&acc)[2][2][4][2], const pg8::Unit& u, int wr, int wc, int fr_, int fq_) const {
        int t_ = threadIdx.x; asm volatile("" : "+v"(t_)); const int fr = t_ & 15, fq = (t_ >> 4) & 3; (void)fr_; (void)fq_;
        const int type = u.pn >> 2, row0 = u.pm * 256 + wr * 64 + fr, col0 = (u.pn & 3) * 256 + wc * 32 + 4 * fq;
        bf16* hb = (type == 1) ? AA : GG;
#pragma unroll
        for (int bj = 0; bj < 2; ++bj)
#pragma unroll
            for (int n = 0; n < 2; ++n) { const int c = col0 + bj * 128 + n * 16;
#pragma unroll
                for (int ai = 0; ai < 2; ++ai)
#pragma unroll
                    for (int m = 0; m < 4; ++m) { const size_t off = (size_t)(row0 + ai * 128 + m * 16) * CW + c; const pg8::f32x4 v = acc[ai][bj][m][n];
                        if (type == 0) *(pg8::f32x4*)(LW + off) = v;
                        else { v2u o; o.x = pg8::cvt_pk_bf16(v[0], v[1]); o.y = pg8::cvt_pk_bf16(v[2], v[3]); *(v2u*)(hb + off) = o; } } }
    }
};
struct GroupOrder {
    const unsigned* te; int nrt, ncol, G, c;
    __device__ __forceinline__ bool next(int i, pg8::Unit& u) const {
        const long L = (long)i * G + c; if (L >= (long)nrt * ncol) return false;
        const int rt = (int)(L / ncol), pl = (int)(L - (long)rt * ncol);
        u.pm = rt; u.pn = (int)te[rt] * ncol + pl; return true;
    }
    __device__ __forceinline__ void a_ready(const pg8::Unit&) const {}
    __device__ __forceinline__ void done(const pg8::Unit&) const {}
};

struct GroupOrder2 {
    const unsigned* te; int ncol, base, count, Gp, cp;
    __device__ __forceinline__ bool next(int i, pg8::Unit& u) const {
        const long k = (long)i * Gp + cp; if (cp < 0 || k >= count) return false;
        const int L = base + (int)k, rt = L / ncol, pl = L - rt * ncol;
        u.pm = rt; u.pn = (int)te[rt] * ncol + pl; return true;
    }
    __device__ __forceinline__ void a_ready(const pg8::Unit&) const {}
    __device__ __forceinline__ void done(const pg8::Unit&) const {}
};

#define MFMA16(a, b, c) __builtin_amdgcn_mfma_f32_16x16x16bf16_1k(a, b, c, 0, 0, 0)
constexpr int NUNIT = BATCH * NHEAD * (SEQ / 64);
constexpr int LA_GF = 0, LA_SEG = 16384, LA_PL = 18432, LA_RT = 20480, LA_QT = 28672, LA_KT = 36864, LA_BT = 45056, LA_VT = 53248,
              LA_AQB = 61440, LA_AQK = 69632, LA_ARB = 77824, LA_ARK = 86016, LA_DG = 94208, LA_DL = 98304, LA_PRM = 100352;
__device__ __forceinline__ int swz(int row, int chunk) { return row * 128 + ((chunk ^ ((row >> 1) & 7)) << 4); }
__device__ __forceinline__ s16x4 tr_read(LAS unsigned char* base, int r0, int cb, int n) {
    return __builtin_bit_cast(s16x4, __builtin_amdgcn_ds_read_tr16_b64_v4i16((LAS s16x4*)(base + swz(r0 + (n >> 2), 2 * cb + ((n & 3) >> 1)) + 8 * (n & 1)))); }
__device__ __forceinline__ s16x4 row_read4(LAS unsigned char* base, int row, int col0) {
    return *(const LAS s16x4*)(base + swz(row, col0 >> 3) + 2 * (col0 & 7)); }
__device__ __forceinline__ s16x4 pack4(const f32x4 v) { v2u w; w.x = pk2(v[0], v[1]); w.y = pk2(v[2], v[3]); return __builtin_bit_cast(s16x4, w); }
__device__ __forceinline__ s16x4 pack4n(const f32x4 v) { v2u w; w.x = pk2(-v[0], -v[1]); w.y = pk2(-v[2], -v[3]); return __builtin_bit_cast(s16x4, w); }
__device__ __forceinline__ f32x4 unpack4(const s16x4 s) { const v2u w = __builtin_bit_cast(v2u, s); return (f32x4){bflo(w.x), bfhi(w.x), bflo(w.y), bfhi(w.y)}; }

#define LGKM0() do { asm volatile("s_waitcnt lgkmcnt(0)" ::: "memory"); __builtin_amdgcn_sched_barrier(0); } while (0)
#define LDS_BARRIER() do { asm volatile("s_waitcnt lgkmcnt(0)" ::: "memory"); __builtin_amdgcn_s_barrier(); asm volatile("" ::: "memory"); } while (0)
__device__ __forceinline__ void scanA(const Args& a, LAS unsigned char* lds) {
    const int tid = threadIdx.x, lane = tid & 63, wave = __builtin_amdgcn_readfirstlane(tid >> 6), n = lane & 15, g = lane >> 4;
    LAS float* GF = (LAS float*)(lds + LA_GF); LAS float* SEG = (LAS float*)(lds + LA_SEG); LAS float* PLs = (LAS float*)(lds + LA_PL); LAS float* DG = (LAS float*)(lds + LA_DG);
    const int tk = tid >> 3, c8 = 8 * (tid & 7);
    v4u nr4, nk4, nv4, pr4, pk4, pv4, na4; f32x4 nl0, nl1;
#define SCANA_LOAD(U) do { const int bh_ = (U) >> 6, ck_ = (U) & 63, h_ = bh_ & 15; const size_t m_ = (size_t)(bh_ >> 4) * SEQ + 64 * ck_ + tk; \
        const bf16* pc_ = (const bf16*)(a.ws + WS_P) + (size_t)(bh_ >> 4) * HM_BATCH + (size_t)h_ * HM_HEAD + (size_t)(64 * ck_ + tk) * HD + c8; const bf16* pp_ = pc_ - ((64 * ck_ + tk) != 0 ? HD : 0); \
        nr4 = *(const v4u*)pc_; nk4 = *(const v4u*)(pc_ + HM_PART); nv4 = *(const v4u*)(pc_ + 2 * HM_PART); pr4 = *(const v4u*)pp_; pk4 = *(const v4u*)(pp_ + HM_PART); pv4 = *(const v4u*)(pp_ + 2 * HM_PART); \
        const size_t off_ = m_ * CW + h_ * 64 + c8; na4 = *(const v4u*)((const bf16*)(a.ws + WS_AA) + off_); \
        nl0 = *(const f32x4*)((const float*)(a.ws + WS_LW) + off_); nl1 = *(const f32x4*)((const float*)(a.ws + WS_LW) + off_ + 4); } while (0)
#define SCANA_UNIT(IDX) (((((IDX) >> 10) * 16 + ((IDX) & 15)) << 6) + (((IDX) >> 4) & 63))
    if ((int)blockIdx.x < NUNIT) SCANA_LOAD(SCANA_UNIT((int)blockIdx.x));
    STAMP_DECL;
    LAS float* PRM = (LAS float*)(lds + LA_PRM);
    int hcur = -1;
    for (int idx = blockIdx.x; idx < NUNIT; idx += gridDim.x) {
        const int unit = SCANA_UNIT(idx);
        int tid_o = threadIdx.x; asm volatile("" : "+v"(tid_o));
        const int tid = tid_o, lane = tid & 63, n = lane & 15, g = lane >> 4, tk = tid >> 3, c8 = 8 * (tid & 7);
        STAMP_BEGIN(5); STAMP_BEGIN(1);
        const int h = (unit >> 6) & 15, ch0 = h * 64 + c8; const bool first = ((unit & 63) == 0) && (tk == 0);
        if (h != hcur) { hcur = h;
            if (tid < 448) { const int which = tid >> 6, c = tid & 63; const float* src = (which == 0) ? a.in[I_MU] : (which == 1) ? a.in[I_MU] + 1024 : (which == 2) ? a.in[I_MU] + 2048 :
                    (which == 3) ? a.in[I_A0] : (which == 4) ? a.in[I_KK] : (which == 5) ? a.in[I_KA] : a.in[I_W0];
                PRM[tid] = src[h * 64 + c]; }
            LDS_BARRIER(); }
        float pmr[8], pmk[8], pmv[8], pa0[8], pkk[8], pka[8], pw0[8];
        { f32x4 pv[14];
#pragma unroll
          for (int q = 0; q < 7; ++q) { pv[2 * q] = *(const LAS f32x4*)(PRM + 64 * q + c8); pv[2 * q + 1] = *(const LAS f32x4*)(PRM + 64 * q + c8 + 4); }
          LGKM0();
#pragma unroll
          for (int i = 0; i < 8; ++i) { pmr[i] = pv[0 + (i >> 2)][i & 3]; pmk[i] = pv[2 + (i >> 2)][i & 3]; pmv[i] = pv[4 + (i >> 2)][i & 3]; pa0[i] = pv[6 + (i >> 2)][i & 3];
              pkk[i] = pv[8 + (i >> 2)][i & 3]; pka[i] = pv[10 + (i >> 2)][i & 3]; pw0[i] = pv[12 + (i >> 2)][i & 3]; } }
        float rf[8], kf[8], vf8[8], qf8[8], bf8[8]; f32x4 l0, l1;
        { float av[8], kkv[8]; float ssq = 0.f;
#pragma unroll
          for (int i = 0; i < 8; ++i) { const int wd = i >> 1; const bool hi = i & 1;
              const float cr = hi ? bfhi(nr4[wd]) : bflo(nr4[wd]), ckk = hi ? bfhi(nk4[wd]) : bflo(nk4[wd]), cv = hi ? bfhi(nv4[wd]) : bflo(nv4[wd]);
              const float qr = first ? 0.f : (hi ? bfhi(pr4[wd]) : bflo(pr4[wd])), qk = first ? 0.f : (hi ? bfhi(pk4[wd]) : bflo(pk4[wd])), qv = first ? 0.f : (hi ? bfhi(pv4[wd]) : bflo(pv4[wd]));
              rf[i] = cr + (qr - cr) * pmr[i]; kf[i] = ckk + (qk - ckk) * pmk[i]; vf8[i] = cv + (qv - cv) * pmv[i];
              av[i] = sigmoid_f((hi ? bfhi(na4[wd]) : bflo(na4[wd])) + pa0[i]);
              kkv[i] = kf[i] * pkk[i]; ssq += kkv[i] * kkv[i]; }
          ssq += __shfl_xor(ssq, 1); ssq += __shfl_xor(ssq, 2); ssq += __shfl_xor(ssq, 4);
          const float inv = __builtin_amdgcn_rsqf(fmaxf(ssq, 1e-24f));
#pragma unroll
          for (int i = 0; i < 8; ++i) { qf8[i] = kkv[i] * inv; bf8[i] = qf8[i] * av[i]; kf[i] = kf[i] * (1.f + (av[i] - 1.f) * pka[i]); }
#pragma unroll
          for (int i = 0; i < 4; ++i) { const float z0 = -(nl0[i] + pw0[i]), z1 = -(nl1[i] + pw0[4 + i]);
              const float s0 = fmaxf(z0, 0.f) + __logf(1.f + __expf(-fabsf(z0))), s1 = fmaxf(z1, 0.f) + __logf(1.f + __expf(-fabsf(z1)));
              l0[i] = -__expf(-s0 - 0.5f); l1[i] = -__expf(-s1 - 0.5f); }
          const size_t off = ((size_t)(unit >> 10) * SEQ + 64 * (unit & 63) + tk) * CW + ch0; v4u w;
          w.x = pk2(rf[0], rf[1]); w.y = pk2(rf[2], rf[3]); w.z = pk2(rf[4], rf[5]); w.w = pk2(rf[6], rf[7]); *(v4u*)((bf16*)(a.ws + WS_R) + off) = w;
          w.x = pk2(kf[0], kf[1]); w.y = pk2(kf[2], kf[3]); w.z = pk2(kf[4], kf[5]); w.w = pk2(kf[6], kf[7]); *(v4u*)((bf16*)(a.ws + WS_K2) + off) = w;
          w.x = pk2(vf8[0], vf8[1]); w.y = pk2(vf8[2], vf8[3]); w.z = pk2(vf8[4], vf8[5]); w.w = pk2(vf8[6], vf8[7]); *(v4u*)((bf16*)(a.ws + WS_V) + off) = w; }
        *(LAS f32x4*)(GF + tk * 64 + c8) = l0; *(LAS f32x4*)(GF + tk * 64 + c8 + 4) = l1;
        LDS_BARRIER();
        { const int c = tid & 63, sg = tid >> 6; float gv[8], run = 0.f;
#pragma unroll
          for (int i = 0; i < 8; ++i) gv[i] = GF[(8 * sg + i) * 64 + c];
          LGKM0();
#pragma unroll
          for (int i = 0; i < 8; ++i) { run += gv[i]; GF[(8 * sg + i) * 64 + c] = run; }
          SEG[sg * 64 + c] = run; }
        LDS_BARRIER();
        { const int sg = tk >> 3; float gg[8], lw[8];
          f32x4 gq[2], sq[7][2];
          gq[0] = *(const LAS f32x4*)(GF + tk * 64 + c8); gq[1] = *(const LAS f32x4*)(GF + tk * 64 + c8 + 4);
#pragma unroll
          for (int s2 = 0; s2 < 7; ++s2) { sq[s2][0] = *(const LAS f32x4*)(SEG + s2 * 64 + c8); sq[s2][1] = *(const LAS f32x4*)(SEG + s2 * 64 + c8 + 4); }
          LGKM0();
#pragma unroll
          for (int i = 0; i < 8; ++i) { float x = gq[i >> 2][i & 3];
#pragma unroll
              for (int s2 = 0; s2 < 7; ++s2) x += (s2 < sg) ? sq[s2][i >> 2][i & 3] : 0.f;
              gg[i] = x; lw[i] = (i < 4) ? l0[i] : l1[i - 4]; }
          float rr[8], qq[8], kk[8], bb[8];
#pragma unroll
          for (int i = 0; i < 4; ++i) { const int e0 = 2 * i, e1 = 2 * i + 1;
              const float eg0 = __expf(gg[e0]), eg1 = __expf(gg[e1]), en0 = __expf(-gg[e0]), en1 = __expf(-gg[e1]), em0 = __expf(gg[e0] - lw[e0]), em1 = __expf(gg[e1] - lw[e1]);
              rr[e0] = rf[e0] * eg0; rr[e1] = rf[e1] * eg1; qq[e0] = qf8[e0] * em0; qq[e1] = qf8[e1] * em1;
              kk[e0] = kf[e0] * en0; kk[e1] = kf[e1] * en1; bb[e0] = bf8[e0] * en0; bb[e1] = bf8[e1] * en1;
              if (tk == 63) { PLs[c8 + e0] = eg0; PLs[c8 + e1] = eg1; } }
          const int so = swz(tk, tid & 7); v4u w;
          w.x = pk2(rr[0], rr[1]); w.y = pk2(rr[2], rr[3]); w.z = pk2(rr[4], rr[5]); w.w = pk2(rr[6], rr[7]); *(LAS v4u*)(lds + LA_RT + so) = w;
          w.x = pk2(qq[0], qq[1]); w.y = pk2(qq[2], qq[3]); w.z = pk2(qq[4], qq[5]); w.w = pk2(qq[6], qq[7]); *(LAS v4u*)(lds + LA_QT + so) = w;
          w.x = pk2(kk[0], kk[1]); w.y = pk2(kk[2], kk[3]); w.z = pk2(kk[4], kk[5]); w.w = pk2(kk[6], kk[7]); *(LAS v4u*)(lds + LA_KT + so) = w;
          w.x = pk2(bb[0], bb[1]); w.y = pk2(bb[2], bb[3]); w.z = pk2(bb[4], bb[5]); w.w = pk2(bb[6], bb[7]); *(LAS v4u*)(lds + LA_BT + so) = w;
          w.x = pk2(vf8[0], vf8[1]); w.y = pk2(vf8[2], vf8[3]); w.z = pk2(vf8[4], vf8[5]); w.w = pk2(vf8[6], vf8[7]); *(LAS v4u*)(lds + LA_VT + so) = w; }
        LDS_BARRIER();
        STAMP_END(1); STAMP_BEGIN(2);
        if (idx + (int)gridDim.x < NUNIT) SCANA_LOAD(SCANA_UNIT(idx + (int)gridDim.x));
        for (int id = wave; id < 40; id += NWAVES) {
            const int mat = id / 10, p = id - mat * 10, tb = p < 1 ? 0 : (p < 3 ? 1 : (p < 6 ? 2 : 3)), sb = p - tb * (tb + 1) / 2;
            LAS unsigned char* Lft = lds + ((mat & 1) ? LA_KT : LA_BT); LAS unsigned char* Rgt = lds + ((mat & 2) ? LA_RT : LA_QT);
            f32x4 acc = (f32x4){0.f, 0.f, 0.f, 0.f};
#pragma unroll
            for (int ks = 0; ks < 2; ++ks) { const bf16x8 af = *(const LAS bf16x8*)(Lft + swz(16 * sb + n, 4 * ks + g)), bfr = *(const LAS bf16x8*)(Rgt + swz(16 * tb + n, 4 * ks + g));
                acc = __builtin_amdgcn_mfma_f32_16x16x32_bf16(af, bfr, acc, 0, 0, 0); }
            const int t = 16 * tb + n, s0 = 16 * sb + 4 * g;
#pragma unroll
            for (int j = 0; j < 4; ++j) { const bool keep = (mat & 2) ? (s0 + j <= t) : (s0 + j < t); if (!keep) acc[j] = 0.f; }
            LAS unsigned char* dst = lds + (mat == 0 ? LA_AQB : (mat == 1 ? LA_AQK : (mat == 2 ? LA_ARB : LA_ARK)));
            v2u w; w.x = pk2(acc[0], acc[1]); w.y = pk2(acc[2], acc[3]);
            *(LAS v2u*)(dst + swz(t, s0 >> 3) + 2 * (s0 & 7)) = w;
            if (mat == 0 && sb == tb) *(LAS f32x4*)(DG + tb * 256 + n * 16 + 4 * g) = acc;
        }
        LDS_BARRIER();
        STAMP_END(2); STAMP_BEGIN(3);
        const bool isU = wave >= 4; const int cb = wave & 3;
        LAS unsigned char* AQB = lds + LA_AQB; LAS unsigned char* AQK = lds + LA_AQK; LAS unsigned char* ARB = lds + LA_ARB; LAS unsigned char* ARK = lds + LA_ARK;
        s16x4 vf[4], xn[4], fqb[6], frb[10], fbt[16];
        f32x4 rhs[4], y1a[4], hma[4], rti[4];
        if (isU) {
            s16x4 fqk[10], frk[10], fkt[16];
#pragma unroll
            for (int k = 0; k < 4; ++k) vf[k] = tr_read(lds + LA_VT, 16 * k + 4 * g, cb, n);
#pragma unroll
            for (int i = 0; i < 4; ++i)
#pragma unroll
                for (int k = 0; k < 4; ++k) { if (k <= i) { fqk[i * (i + 1) / 2 + k] = row_read4(AQK, 16 * i + n, 16 * k + 4 * g); frk[i * (i + 1) / 2 + k] = row_read4(ARK, 16 * i + n, 16 * k + 4 * g); }
                    fkt[4 * i + k] = tr_read(lds + LA_KT, 16 * k + 4 * g, i, n); }
            LGKM0();
#pragma unroll
            for (int i = 0; i < 4; ++i) { f32x4 acc = (f32x4){0.f, 0.f, 0.f, 0.f}, ac2 = acc, ac3 = acc;
#pragma unroll
                for (int k = 0; k < 4; ++k) { if (k <= i) { acc = MFMA16(fqk[i * (i + 1) / 2 + k], vf[k], acc); ac2 = MFMA16(frk[i * (i + 1) / 2 + k], vf[k], ac2); }
                    ac3 = MFMA16(vf[k], fkt[4 * i + k], ac3); }
                rhs[i] = acc; y1a[i] = ac2; hma[i] = ac3; rti[i] = acc; }
        } else {
            if (lane < 16) {
                const LAS float* A = DG + wave * 256; float x[16]; f32x4 ar[16][4];
                int lj = lane; asm volatile("" : "+v"(lj));
                x[0] = (lj == 0) ? 1.f : 0.f;
#pragma unroll
                for (int t = 1; t < 9; ++t)
#pragma unroll
                    for (int q = 0; q < 4; ++q) if (4 * q < t) ar[t][q] = *(const LAS f32x4*)(A + t * 16 + 4 * q);
                LGKM0();
#pragma unroll
                for (int t = 1; t < 9; ++t) { float a0 = (t == lj) ? 1.f : 0.f, a1 = 0.f;
#pragma unroll
                    for (int s2 = 0; s2 < t; ++s2) { if (s2 & 1) a1 -= ar[t][s2 >> 2][s2 & 3] * x[s2]; else a0 -= ar[t][s2 >> 2][s2 & 3] * x[s2]; }
                    x[t] = a0 + a1; }
#pragma unroll
                for (int t = 9; t < 13; ++t)
#pragma unroll
                    for (int q = 0; q < 4; ++q) if (4 * q < t) ar[t][q] = *(const LAS f32x4*)(A + t * 16 + 4 * q);
                LGKM0();
#pragma unroll
                for (int t = 9; t < 13; ++t) { float a0 = (t == lj) ? 1.f : 0.f, a1 = 0.f;
#pragma unroll
                    for (int s2 = 0; s2 < t; ++s2) { if (s2 & 1) a1 -= ar[t][s2 >> 2][s2 & 3] * x[s2]; else a0 -= ar[t][s2 >> 2][s2 & 3] * x[s2]; }
                    x[t] = a0 + a1; }
#pragma unroll
                for (int t = 13; t < 16; ++t)
#pragma unroll
                    for (int q = 0; q < 4; ++q) if (4 * q < t) ar[t][q] = *(const LAS f32x4*)(A + t * 16 + 4 * q);
                LGKM0();
#pragma unroll
                for (int t = 13; t < 16; ++t) { float a0 = (t == lj) ? 1.f : 0.f, a1 = 0.f;
#pragma unroll
                    for (int s2 = 0; s2 < t; ++s2) { if (s2 & 1) a1 -= ar[t][s2 >> 2][s2 & 3] * x[s2]; else a0 -= ar[t][s2 >> 2][s2 & 3] * x[s2]; }
                    x[t] = a0 + a1; }
                LAS bf16* D = (LAS bf16*)(lds + LA_DL) + wave * 256;
#pragma unroll
                for (int t = 0; t < 16; ++t) D[t * 16 + lane] = (bf16)f2bf(x[t]);
            }
#pragma unroll
            for (int i = 0; i < 4; ++i) { rhs[i] = unpack4(tr_read(lds + LA_QT, 16 * i + 4 * g, cb, n)); rti[i] = unpack4(tr_read(lds + LA_RT, 16 * i + 4 * g, cb, n)); vf[i] = (s16x4){0, 0, 0, 0}; y1a[i] = (f32x4){0.f, 0.f, 0.f, 0.f}; hma[i] = y1a[i]; }
        }
#pragma unroll
        for (int i = 0; i < 4; ++i)
#pragma unroll
            for (int k = 0; k < 4; ++k) { if (k < i) fqb[i * (i - 1) / 2 + k] = row_read4(AQB, 16 * i + n, 16 * k + 4 * g); if (k <= i) frb[i * (i + 1) / 2 + k] = row_read4(ARB, 16 * i + n, 16 * k + 4 * g);
                fbt[4 * i + k] = tr_read(lds + LA_BT, 16 * k + 4 * g, i, n); }
        LDS_BARRIER();
        STAMP_END(3); STAMP_BEGIN(4);
        {
            s16x4 df[4];
#pragma unroll
            for (int i = 0; i < 4; ++i) df[i] = *(const LAS s16x4*)(lds + LA_DL + i * 512 + n * 32 + 8 * g);
            const float plv[4] = {PLs[n], PLs[16 + n], PLs[32 + n], PLs[48 + n]};
            LGKM0();
#pragma unroll
            for (int i = 0; i < 4; ++i) { f32x4 acc = rhs[i];
#pragma unroll
                for (int k = 0; k < 4; ++k) if (k < i) acc = MFMA16(fqb[i * (i - 1) / 2 + k], xn[k], acc);
                const f32x4 xi = MFMA16(df[i], pack4(acc), ((f32x4){0.f, 0.f, 0.f, 0.f}));
                xn[i] = pack4n(xi); }
            if (!isU) {
                bf16* RH = (bf16*)(a.ws + WS_RH) + (size_t)unit * 4096;
#pragma unroll
                for (int i = 0; i < 4; ++i) { f32x4 acc = rti[i];
#pragma unroll
                    for (int k = 0; k < 4; ++k) if (k <= i) acc = MFMA16(frb[i * (i + 1) / 2 + k], xn[k], acc);
#pragma unroll
                    for (int j = 0; j < 4; ++j) RH[(16 * i + 4 * g + j) * 64 + 16 * cb + n] = (bf16)f2bf(acc[j]); }
                bf16* GT = (bf16*)(a.ws + WS_GT) + (size_t)unit * 4096;
#pragma unroll
                for (int c2b = 0; c2b < 4; ++c2b) { f32x4 acc = (f32x4){0.f, 0.f, 0.f, 0.f};
#pragma unroll
                    for (int k = 0; k < 4; ++k) acc = MFMA16(xn[k], fbt[4 * c2b + k], acc);
                    acc *= plv[c2b]; *(v2u*)(GT + (16 * c2b + n) * 64 + 16 * cb + 4 * g) = __builtin_bit_cast(v2u, pack4(acc)); }
            } else {
                float* Y1 = (float*)(a.ws + WS_Y1) + (size_t)unit * 4096;
#pragma unroll
                for (int i = 0; i < 4; ++i) { f32x4 acc = y1a[i];
#pragma unroll
                    for (int k = 0; k < 4; ++k) if (k <= i) acc = MFMA16(frb[i * (i + 1) / 2 + k], xn[k], acc);
#pragma unroll
                    for (int j = 0; j < 4; ++j) Y1[(16 * i + 4 * g + j) * 64 + 16 * cb + n] = acc[j]; }
                float* HM = (float*)(a.ws + WS_HM) + (size_t)unit * 4096;
#pragma unroll
                for (int c2b = 0; c2b < 4; ++c2b) { f32x4 acc = hma[c2b];
#pragma unroll
                    for (int k = 0; k < 4; ++k) acc = MFMA16(xn[k], fbt[4 * c2b + k], acc);
#pragma unroll
                    for (int j = 0; j < 4; ++j) HM[(16 * cb + 4 * g + j) * 64 + 16 * c2b + n] = acc[j] * plv[c2b]; }
            }
            if (wave == 0) ((float*)(a.ws + WS_PLV))[(size_t)unit * 64 + lane] = PLs[lane];
        }
        LDS_BARRIER();
        STAMP_END(4); STAMP_END(5);
    }
}

constexpr int LB_SLOT = 13312, LB_NPIECE = 13, LB_PER_WAVE = 4, LB_NSLOT = 8, LB_DIST = 7;
__device__ __forceinline__ void chainB_issue(const Args& a, LAS unsigned char* lds, size_t unit, int vb, int step, int lw, int lane) {
    const unsigned char* gt = a.ws + WS_GT + unit * 8192; const unsigned char* hm = a.ws + WS_HM + unit * 16384 + vb * 4096; const unsigned char* pv = a.ws + WS_PLV + unit * 256;
#pragma unroll
    for (int i = 0; i < LB_PER_WAVE; ++i) { int p = lw + 4 * i; p = p < LB_NPIECE - 1 ? p : LB_NPIECE - 1;
        const unsigned char* src = (p < 8) ? gt + p * 1024 : ((p < 12) ? hm + (p - 8) * 1024 : pv);
        __builtin_amdgcn_global_load_lds((const unsigned*)(src + lane * 16), (LAS unsigned*)(lds + (step & (LB_NSLOT - 1)) * LB_SLOT + p * 1024), 16, 0, 0); }
}
struct ChainOps { s16x4 gf[4][4]; f32x4 hm[4], pl[4]; };
__device__ __forceinline__ void chainB_read(ChainOps& o, LAS unsigned char* sl, int n, int g) {
#pragma unroll
    for (int i = 0; i < 4; ++i) { o.hm[i] = *(const LAS f32x4*)(sl + 8192 + (n * 64 + 16 * i + 4 * g) * 4); o.pl[i] = *(const LAS f32x4*)(sl + 12288 + (16 * i + 4 * g) * 4);
#pragma unroll
        for (int k = 0; k < 4; ++k) o.gf[i][k] = *(const LAS s16x4*)(sl + (16 * i + n) * 128 + (16 * k + 4 * g) * 2); }
}
__device__ __forceinline__ void chainB_step(const ChainOps& o, f32x4 (&acc)[4], v2u* SF) {
    s16x4 sb[4]; f32x4 nx[4];
#pragma unroll
    for (int k = 0; k < 4; ++k) { sb[k] = pack4(acc[k]); SF[k * 64] = __builtin_bit_cast(v2u, sb[k]); }
#pragma unroll
    for (int i = 0; i < 4; ++i) nx[i] = o.pl[i] * acc[i] + o.hm[i];
#pragma unroll
    for (int k = 0; k < 4; ++k)
#pragma unroll
        for (int i = 0; i < 4; ++i) nx[i] = MFMA16(o.gf[i][k], sb[k], nx[i]);
#pragma unroll
    for (int i = 0; i < 4; ++i) acc[i] = nx[i];
}
__device__ __forceinline__ void scanB(const Args& a, LAS unsigned char* lds) {
    const int tid = threadIdx.x, lane = tid & 63, wave = __builtin_amdgcn_readfirstlane(tid >> 6), n = lane & 15, g = lane >> 4;
    constexpr int NCK = SEQ / 64;
    for (int item = blockIdx.x; item < BATCH * NHEAD * 4; item += gridDim.x) {
        const int bh = item >> 2, vb = item & 3;
        const size_t u0 = (size_t)bh * 64;
        f32x4 acc[4];
#pragma unroll
        for (int i = 0; i < 4; ++i) acc[i] = (f32x4){0.f, 0.f, 0.f, 0.f};
        if (wave >= 4) {
#pragma unroll
            for (int s = 0; s < LB_DIST; ++s) chainB_issue(a, lds, u0 + s, vb, s, wave - 4, lane);
            asm volatile("s_waitcnt vmcnt(20)" ::: "memory"); }
        __builtin_amdgcn_s_barrier(); asm volatile("" ::: "memory");
        if (wave >= 4) {
            for (int ck = 0; ck < NCK; ++ck) {
                if (ck + LB_DIST < NCK) { chainB_issue(a, lds, u0 + ck + LB_DIST, vb, ck + LB_DIST, wave - 4, lane); asm volatile("s_waitcnt vmcnt(20)" ::: "memory"); }
                else asm volatile("s_waitcnt vmcnt(0)" ::: "memory");
                __builtin_amdgcn_s_barrier(); asm volatile("" ::: "memory");
            }
        } else if (wave == 0) {
            v2u* SF = (v2u*)(a.ws + WS_SF) + (u0 * 16 + vb * 4) * 64 + lane;
            ChainOps A, B;
            chainB_read(A, lds, n, g);
            for (int ck = 0; ck < NCK; ck += 2) {
                chainB_read(B, lds + ((ck + 1) & (LB_NSLOT - 1)) * LB_SLOT, n, g);
                chainB_step(A, acc, SF + (size_t)ck * 16 * 64);
                __builtin_amdgcn_s_barrier(); asm volatile("" ::: "memory");
                if (ck + 2 < NCK) chainB_read(A, lds + ((ck + 2) & (LB_NSLOT - 1)) * LB_SLOT, n, g);
                chainB_step(B, acc, SF + (size_t)(ck + 1) * 16 * 64);
                __builtin_amdgcn_s_barrier(); asm volatile("" ::: "memory");
            }
        } else {
            for (int ck = 0; ck < NCK; ++ck) { __builtin_amdgcn_s_barrier(); asm volatile("" ::: "memory"); }
        }
    }
}

__device__ __forceinline__ void scanC(const Args& a) {
    const int tid = threadIdx.x, lane = tid & 63, wave = tid >> 6, n = lane & 15, g = lane >> 4;
    const int gw = blockIdx.x * NWAVES + wave, NGW = gridDim.x * NWAVES;
    for (int task = gw; task < NUNIT * 4; task += NGW) {
        const int unit = task >> 2, i = task & 3, bh = unit >> 6, ck = unit & 63, b = bh >> 4, h = bh & 15;
        const v2u* SF = (const v2u*)(a.ws + WS_SF) + (size_t)unit * 16 * 64 + lane;
        const bf16* RH = (const bf16*)(a.ws + WS_RH) + (size_t)unit * 4096; const float* Y1 = (const float*)(a.ws + WS_Y1) + (size_t)unit * 4096;
        s16x4 rf[4]; f32x4 acc[4];
        const size_t m = (size_t)b * SEQ + 64 * ck + 16 * i + n;
        s16x4 rq[4], kq[4], vq[4], gq[4];
#pragma unroll
        for (int vb = 0; vb < 4; ++vb) { const size_t o = m * CW + h * 64 + 16 * vb + 4 * g;
            rq[vb] = *(const s16x4*)((const bf16*)(a.ws + WS_R) + o); kq[vb] = *(const s16x4*)((const bf16*)(a.ws + WS_K2) + o);
            vq[vb] = *(const s16x4*)((const bf16*)(a.ws + WS_V) + o); gq[vb] = *(const s16x4*)((const bf16*)(a.ws + WS_GG) + o); }
#pragma unroll
        for (int k = 0; k < 4; ++k) rf[k] = *(const s16x4*)(RH + (16 * i + n) * 64 + 16 * k + 4 * g);
#pragma unroll
        for (int vb = 0; vb < 4; ++vb) { acc[vb] = *(const f32x4*)(Y1 + (16 * i + n) * 64 + 16 * vb + 4 * g);
#pragma unroll
            for (int k = 0; k < 4; ++k) acc[vb] = MFMA16(__builtin_bit_cast(s16x4, SF[(vb * 4 + k) * 64]), rf[k], acc[vb]); }
        float s1 = 0.f;
#pragma unroll
        for (int vb = 0; vb < 4; ++vb) s1 += (acc[vb][0] + acc[vb][1]) + (acc[vb][2] + acc[vb][3]);
        s1 += __shfl_xor(s1, 16); s1 += __shfl_xor(s1, 32);
        const float mean = s1 * (1.f / 64.f); float s2 = 0.f;
#pragma unroll
        for (int vb = 0; vb < 4; ++vb)
#pragma unroll
            for (int j = 0; j < 4; ++j) { const float d = acc[vb][j] - mean; s2 += d * d; }
        s2 += __shfl_xor(s2, 16); s2 += __shfl_xor(s2, 32);
        const float rstd = 1.f / sqrtf(s2 * (1.f / 64.f) + GN_EPS);
        f32x4 rv[4], kv[4], vv[4], gv[4]; float dot = 0.f;
#pragma unroll
        for (int vb = 0; vb < 4; ++vb) { rv[vb] = unpack4(rq[vb]); kv[vb] = unpack4(kq[vb]); vv[vb] = unpack4(vq[vb]); gv[vb] = unpack4(gq[vb]);
            const f32x4 rk = *(const f32x4*)(a.in[I_RK] + h * 64 + 16 * vb + 4 * g);
#pragma unroll
            for (int j = 0; j < 4; ++j) dot += rv[vb][j] * kv[vb][j] * rk[j]; }
        dot += __shfl_xor(dot, 16); dot += __shfl_xor(dot, 32);
#pragma unroll
        for (int vb = 0; vb < 4; ++vb) { const int c = h * 64 + 16 * vb + 4 * g;
            const f32x4 lw = *(const f32x4*)(a.in[I_LNW] + c), lb = *(const f32x4*)(a.in[I_LNB] + c), be = *(const f32x4*)(a.in[I_BETAR] + c);
            const f32x4 o = ((acc[vb] - mean) * rstd * lw + lb + dot * vv[vb]) * gv[vb] * be;
            *(v2u*)((bf16*)(a.ws + WS_YMIX) + m * DM + c) = __builtin_bit_cast(v2u, pack4(o)); }
    }
}

struct ConvItem { const float* W; bf16* WT; int N, ldd, k0, n0; size_t drow_lo, drow_hi; int win; };
__device__ __forceinline__ int win_row(int c) { return c < 3072 ? c : (c < SHIFTW ? 6144 + (c - 3072) : c - (SHIFTW - 3072)); }
constexpr int NCV_IN = 32 * 26, NCV_OUT = 32 * 8, NCV_E = 32 * 32 * 2, NCV_D = 32 * 8 * 8, NCONV = NCV_IN + NCV_OUT + 2 * NCV_E + NCV_D, CV_LDT = 528;
__device__ __forceinline__ ConvItem conv_decode(const Args& a, int r) {
    ConvItem c; unsigned char* ws = a.ws; c.win = 0;
    if (r < NCV_IN) { const int kb = r / 26, nb = r - kb * 26; c.W = a.in[I_WIN]; c.N = PROJW; c.WT = (bf16*)(ws + WS_WIN); c.ldd = DM; c.k0 = 64 * kb; c.n0 = 256 * nb; c.drow_lo = (size_t)c.n0; c.drow_hi = c.drow_lo + 128; c.win = 1; return c; } r -= NCV_IN;
    if (r < NCV_OUT) { const int kb = r >> 3, nb = r & 7; c.W = a.in[I_WOUT]; c.N = DM; c.WT = (bf16*)(ws + WS_WOUT); c.ldd = DM; c.k0 = 64 * kb; c.n0 = 256 * nb; c.drow_lo = (size_t)c.n0; c.drow_hi = c.drow_lo + 128; return c; } r -= NCV_OUT;
    if (r < 2 * NCV_E) { const int up = r >= NCV_E; if (up) r -= NCV_E; const int e = r >> 6, q = r & 63, kb = q >> 1, nb = q & 1;
        c.W = a.in[up ? I_WU : I_WG] + (size_t)e * DM * FF; c.N = FF; c.WT = (bf16*)(ws + WS_WGU); c.ldd = DM; c.k0 = 64 * kb; c.n0 = 256 * nb;
        c.drow_lo = (size_t)e * 1024 + 256 * (2 * nb) + (up ? 128 : 0); c.drow_hi = c.drow_lo + 256; return c; } r -= 2 * NCV_E;
    { const int e = r >> 6, q = r & 63, kb = q >> 3, nb = q & 7;
        c.W = a.in[I_WDN] + (size_t)e * FF * DM; c.N = DM; c.WT = (bf16*)(ws + WS_WD); c.ldd = FF; c.k0 = 64 * kb; c.n0 = 256 * nb; c.drow_lo = (size_t)e * DM + c.n0; c.drow_hi = c.drow_lo + 128; return c; }
}
__device__ __forceinline__ void conv_load(const ConvItem& c, int wave, int lane, f32x4 (&v)[8]) {
    const int col = c.n0 + 4 * lane; const float* p = c.W + (size_t)(c.k0 + 8 * wave) * c.N + col;
#pragma unroll
    for (int i = 0; i < 8; ++i) v[i] = (col < c.N) ? *(const f32x4*)(p + (size_t)i * c.N) : (f32x4){0.f, 0.f, 0.f, 0.f};
}
__device__ __forceinline__ void conv_finish(const ConvItem& c, const f32x4 (&v)[8], LAS unsigned char* tile, int wave, int lane) {
#pragma unroll
    for (int i = 0; i < 8; ++i) { v2u w; w.x = pk2(v[i][0], v[i][1]); w.y = pk2(v[i][2], v[i][3]); *(LAS v2u*)(tile + (8 * wave + i) * CV_LDT + 8 * lane) = w; }
    asm volatile("s_waitcnt lgkmcnt(0)" ::: "memory"); __builtin_amdgcn_s_barrier(); asm volatile("" ::: "memory");
    const int i16 = lane & 15, g = lane >> 4;
    s16x4 t[2][2][2];
#pragma unroll
    for (int cb = 0; cb < 2; ++cb)
#pragma unroll
        for (int h = 0; h < 2; ++h)
#pragma unroll
            for (int q = 0; q < 2; ++q) { const int r0 = 32 * h + 8 * g + 4 * q, c0 = 32 * wave + 16 * cb;
                t[cb][h][q] = __builtin_bit_cast(s16x4, __builtin_amdgcn_ds_read_tr16_b64_v4i16((LAS s16x4*)(tile + (r0 + (i16 >> 2)) * CV_LDT + (c0 + 4 * (i16 & 3)) * 2))); }
    asm volatile("s_waitcnt lgkmcnt(0)" ::: "memory");
#pragma unroll
    for (int cb = 0; cb < 2; ++cb) { const int col = 32 * wave + 16 * cb + i16;
        if (c.n0 + col < c.N) { const size_t drow = c.win ? (size_t)win_row(c.n0 + col) : (col < 128 ? c.drow_lo : c.drow_hi) + (col & 127);
            bf16* dst = c.WT + drow * (size_t)c.ldd + c.k0 + 8 * g;
#pragma unroll
            for (int h = 0; h < 2; ++h) { const v2u lo = __builtin_bit_cast(v2u, t[cb][h][0]), hi = __builtin_bit_cast(v2u, t[cb][h][1]); *(v4u*)(dst + 32 * h) = (v4u){lo.x, lo.y, hi.x, hi.y}; } } }
    __builtin_amdgcn_s_barrier(); asm volatile("" ::: "memory");
}
__device__ __forceinline__ void conv_range(const Args& a, LAS unsigned char* lds, int first, int count, int rank, int nranks) {
    const int tid = threadIdx.x, lane = tid & 63, wave = __builtin_amdgcn_readfirstlane(tid >> 6);
    LAS unsigned char* tile = lds + 32768;
    f32x4 va[8], vb[8]; ConvItem ca, cb; int k = rank;
    if (k < count) { ca = conv_decode(a, first + k); conv_load(ca, wave, lane, va); }
    while (k < count) {
        const int k2 = k + nranks;
        if (k2 < count) { cb = conv_decode(a, first + k2); conv_load(cb, wave, lane, vb); }
        conv_finish(ca, va, tile, wave, lane);
        if (k2 >= count) break;
        const int k3 = k2 + nranks;
        if (k3 < count) { ca = conv_decode(a, first + k3); conv_load(ca, wave, lane, va); }
        conv_finish(cb, vb, tile, wave, lane);
        k = k3; }
}
constexpr int CV_X2 = 192 * 6, CV_X6 = 128 * 9;
__device__ __forceinline__ void phase0(const Args& a, LAS unsigned char* lds) {
    const int tid = threadIdx.x, lane = tid & 63, wave = __builtin_amdgcn_readfirstlane(tid >> 6), G = gridDim.x, bid = blockIdx.x;
    unsigned char* ws = a.ws;
    LAS float* cact = (LAS float*)lds;
    LAS float* red = (LAS float*)(lds + 16384);
    if (bid < 192 || G < 192) {
        const float* c = a.in[I_C];
        for (int i = tid; i < 2 * DM; i += NTHR) { const float x = c[i]; cact[i] = x / (1.f + __expf(-x)); }
        __syncthreads();
        for (int item = bid; item < 192; item += G) {
            const int ro = lane >> 4, cq = lane & 15;
            const float* wp = a.in[I_WADA] + (size_t)(256 * wave + ro) * 12288 + 64 * item + 4 * cq;
            f32x4 acc0 = (f32x4){0.f, 0.f, 0.f, 0.f}, acc1 = acc0;
#pragma unroll 8
            for (int i = 0; i < 64; ++i) { const f32x4 wv = *(const f32x4*)(wp + (size_t)(4 * i) * 12288);
                const float c0 = cact[256 * wave + 4 * i + ro], c1 = cact[DM + 256 * wave + 4 * i + ro]; acc0 += c0 * wv; acc1 += c1 * wv; }
#pragma unroll
            for (int j = 0; j < 4; ++j) { float v0 = acc0[j], v1 = acc1[j]; v0 += __shfl_xor(v0, 16); v0 += __shfl_xor(v0, 32); v1 += __shfl_xor(v1, 16); v1 += __shfl_xor(v1, 32);
                if (ro == 0) { red[(wave * 2 + 0) * 64 + 4 * cq + j] = v0; red[(wave * 2 + 1) * 64 + 4 * cq + j] = v1; } }
            __syncthreads();
            if (tid < 128) { const int b = tid >> 6, cc = tid & 63; float s = a.in[I_BADA][64 * item + cc];
#pragma unroll
                for (int w2 = 0; w2 < 8; ++w2) s += red[(w2 * 2 + b) * 64 + cc];
                ((float*)(ws + WS_MOD))[b * 12288 + 64 * item + cc] = s; }
            __syncthreads();
        }
    }
    { constexpr int NPRE = 5;
      const bool pre = (G == 256), mine = pre && bid >= 192;
      const int ncv = pre ? NCONV - CV_X2 - CV_X6 : NCONV;
      const int pool0 = pre ? 64 * NPRE : 0;
      auto item_of = [&](int j) -> int { if (mine) { if (j < NPRE) return (bid - 192) + 64 * j; j -= NPRE; } return pool0 + bid + G * j; };
      LAS unsigned char* tile = lds + 32768;
      f32x4 va[8], vb[8]; ConvItem ca, cb; int j = 0; int ia = item_of(0);
      if (ia < ncv) { ca = conv_decode(a, ia); conv_load(ca, wave, lane, va); }
      while (ia < ncv) {
          const int ib = item_of(j + 1);
          if (ib < ncv) { cb = conv_decode(a, ib); conv_load(cb, wave, lane, vb); }
          conv_finish(ca, va, tile, wave, lane);
          if (ib >= ncv) break;
          const int ic = item_of(j + 2);
          if (ic < ncv) { ca = conv_decode(a, ic); conv_load(ca, wave, lane, va); }
          conv_finish(cb, vb, tile, wave, lane);
          ia = ic; j += 2; } }
    const int gt = bid * NTHR + tid, NGT = G * NTHR;
    bf16* wl = (bf16*)(ws + WS_WL);
    for (int idx = gt; idx < LORA_N * LORA_K; idx += NGT) { const int n = idx / LORA_K, k = idx - n * LORA_K; float v = 0.f;
        if (n < 1024) { if (k < 64) v = a.in[I_WDEC][k * 1024 + n]; }
        else if (n < 2048) { if (k >= 64 && k < 128) v = a.in[I_WAAA][(k - 64) * 1024 + (n - 1024)]; }
        else { if (k >= 128 && k < 288) v = a.in[I_WGATEUP][(k - 128) * 1024 + (n - 2048)]; }
        wl[idx] = (bf16)f2bf(v); }
    float* w36 = (float*)(ws + WS_W36);
    for (int idx = gt; idx < DM * 36; idx += NGT) { const int e = idx >> 11, dd = idx & (DM - 1);
        w36[idx] = (e < 4) ? a.in[I_WGRP][dd * 4 + e] : a.in[I_WEXP][((size_t)((e - 4) >> 3) * DM + dd) * 8 + ((e - 4) & 7)]; }
    v4u* wz = (v4u*)(ws + WS_WIN + (size_t)PROJW * DM * 2);
    for (int idx = gt; idx < (PROJP - PROJW) * DM / 8; idx += NGT) wz[idx] = (v4u){0u, 0u, 0u, 0u};
}

__device__ __forceinline__ void phase1(const Args& a) {
    const int tid = threadIdx.x, lane = tid & 63, wave = tid >> 6;
    const int gw = blockIdx.x * NWAVES + wave, NGW = gridDim.x * NWAVES;
    const float* mod = (const float*)(a.ws + WS_MOD);
    for (int it = gw; it < 72; it += NGW) {
        const int b = it / 36, e = it - b * 36; const float* w36 = (const float*)(a.ws + WS_W36); float s = 0.f;
        for (int dd = lane; dd < DM; dd += 64) s += mod[b * 12288 + 3 * DM + dd] * w36[e * DM + dd];
        s = wave_sum(s) + ((e < 4) ? a.in[I_BGRP][e] : a.in[I_BEXP][e - 4]);
        if (lane == 0) ((float*)(a.ws + WS_B36))[it] = s; }
    auto ldrow = [&](int m, f32x4 (&v)[8]) { const f32x4* xr = (const f32x4*)(a.in[I_X] + (size_t)m * DM) + lane;
#pragma unroll
        for (int j = 0; j < 8; ++j) v[j] = xr[64 * j]; };
    auto dorow = [&](int m, f32x4 (&v)[8]) { const int b = m >> 12; float s = 0.f;
#pragma unroll
        for (int j = 0; j < 8; ++j) s += (v[j].x * v[j].x + v[j].y * v[j].y) + (v[j].z * v[j].z + v[j].w * v[j].w);
        const float rstd = 1.f / sqrtf(wave_sum(s) * (1.f / DM) + RMS_EPS);
        v2u* o8 = (v2u*)((bf16*)(a.ws + WS_HB) + (size_t)m * DM) + lane;
#pragma unroll
        for (int j = 0; j < 8; ++j) { const int c = 4 * (lane + 64 * j);
            const f32x4 g = *(const f32x4*)(a.in[I_N1G] + c), sh = *(const f32x4*)(mod + b * 12288 + c), sc = *(const f32x4*)(mod + b * 12288 + DM + c);
            const f32x4 h = v[j] * rstd * g * (1.f + sc) + sh; v2u o; o.x = pk2(h.x, h.y); o.y = pk2(h.z, h.w); o8[64 * j] = o; } };
    { f32x4 va[8], vb[8]; int m = gw; if (m < MTOK) ldrow(m, va);
      while (m < MTOK) { const int m2 = m + NGW; if (m2 < MTOK) ldrow(m2, vb); dorow(m, va); if (m2 >= MTOK) break;
          const int m3 = m2 + NGW; if (m3 < MTOK) ldrow(m3, va); dorow(m2, vb); m = m3; } }
}

__device__ __forceinline__ void phase3(const Args& a) {
    const int gt = blockIdx.x * NTHR + threadIdx.x, NGT = gridDim.x * NTHR;
    const bf16* P = (const bf16*)(a.ws + WS_PLR); bf16* AL = (bf16*)(a.ws + WS_AL);
    for (int idx = gt; idx < MTOK * 48; idx += NGT) { const int m = idx / 48, cj = idx - m * 48;
        v4u o = (v4u){0u, 0u, 0u, 0u};
        if (cj < 36) { const int col = 3072 + 8 * cj; const v4u pc = *(const v4u*)(P + (size_t)m * 288 + 8 * cj);
            v4u pp = (v4u){0u, 0u, 0u, 0u}; if ((m & (SEQ - 1)) != 0) pp = *(const v4u*)(P + (size_t)(m - 1) * 288 + 8 * cj);
            const float* mu = a.in[I_MU] + col; float r[8];
#pragma unroll
            for (int i = 0; i < 4; ++i) { const float c0 = bflo(pc[i]), c1 = bfhi(pc[i]), p0 = bflo(pp[i]), p1 = bfhi(pp[i]);
                r[2 * i] = c0 + (p0 - c0) * mu[2 * i]; r[2 * i + 1] = c1 + (p1 - c1) * mu[2 * i + 1]; }
            if (cj < 8) {
#pragma unroll
                for (int i = 0; i < 8; ++i) r[i] = tanhf(r[i]); }
            else if (cj >= 16) {
#pragma unroll
                for (int i = 0; i < 8; ++i) r[i] = sigmoid_f(r[i]); }
            o.x = pk2(r[0], r[1]); o.y = pk2(r[2], r[3]); o.z = pk2(r[4], r[5]); o.w = pk2(r[6], r[7]); }
        *(v4u*)(AL + (size_t)m * LORA_K + 8 * cj) = o; }
}

__device__ __forceinline__ int swz_off(int key, int chunk) { return key * 128 + ((chunk ^ ((key >> 1) & 7)) << 4); }
__device__ __forceinline__ void attn_issue_tile(const bf16* kcol, int key0, LAS unsigned char* buf, int wave) {
    __builtin_amdgcn_global_load_lds((const unsigned*)(kcol + (size_t)key0 * HD), (LAS unsigned*)(buf + wave * 1024), 16, 0, 0);
    __builtin_amdgcn_global_load_lds((const unsigned*)(kcol + HM_PART + (size_t)key0 * HD), (LAS unsigned*)(buf + 8192 + wave * 1024), 16, 0, 0);
}
__device__ __forceinline__ void phase5b(const Args& a, LAS unsigned char* lds) {
    STAMP_DECL;
    const int tid = threadIdx.x, lane = tid & 63, wave = __builtin_amdgcn_readfirstlane(tid >> 6), n = lane & 15, g = lane >> 4;
    const bf16* P = (const bf16*)(a.ws + WS_P); bf16* Y = (bf16*)(a.ws + WS_YMIX);
    LAS unsigned char* QL = lds + 65536; LAS float* biasA = (LAS float*)(lds + 81920);
    for (int i = tid; i < NHEAD * 257; i += NTHR) biasA[i] = a.in[I_RELB][i] * LOG2E;
    const float SC = 0.125f * LOG2E;
    const int skey = tid >> 3, sdcx = (tid & 7) ^ ((skey >> 1) & 7);
    LAS float* betaL = (LAS float*)(lds + 81920 + NHEAD * 257 * 4 + 64);
    for (int i = tid; i < CW; i += NTHR) betaL[i] = a.in[I_BETAA][i];
#define ATTN_PROLOGUE(U) do { const int cp_ = (U) & 31, h_ = ((U) >> 5) & 15, b_ = (U) >> 9; const int js_ = (8 - 2 * cp_) > 0 ? (8 - 2 * cp_) : 0, kb_ = 64 * (2 * cp_ - 8 + js_); \
        const bf16* Qh_ = P + 3 * HM_PART + (size_t)b_ * HM_BATCH + (size_t)h_ * HM_HEAD; const bf16* kc_ = Qh_ + HM_PART + (size_t)skey * HD + 8 * sdcx; \
        const bf16* qs_ = Qh_ + (size_t)(128 * cp_ + 16 * wave + (lane >> 3)) * HD + 8 * (lane & 7); \
        __builtin_amdgcn_global_load_lds((const unsigned*)qs_, (LAS unsigned*)(QL + wave * 2048), 16, 0, 0); \
        __builtin_amdgcn_global_load_lds((const unsigned*)(qs_ + (size_t)8 * HD), (LAS unsigned*)(QL + wave * 2048 + 1024), 16, 0, 0); \
        attn_issue_tile(kc_, kb_, lds, wave); attn_issue_tile(kc_, kb_ + 64, lds + 16384, wave); \
        if (js_ < 8) attn_issue_tile(kc_, kb_ + 128, lds + 32768, wave); } while (0)
    asm volatile("s_waitcnt vmcnt(0) lgkmcnt(0)" ::: "memory"); __builtin_amdgcn_s_barrier(); asm volatile("" ::: "memory");
    if ((int)blockIdx.x < BATCH * NHEAD * 32) ATTN_PROLOGUE((int)blockIdx.x);
    for (int u = blockIdx.x; u < BATCH * NHEAD * 32; u += gridDim.x) {
        const int cp = u & 31, h = (u >> 5) & 15, b = u >> 9;
        const int t0 = 128 * cp, qrow = t0 + 16 * wave + n;
        const bf16* Qh = P + 3 * HM_PART + (size_t)b * HM_BATCH + (size_t)h * HM_HEAD;
        const LAS float* biasL = biasA + h * 257;
        const int jstart = (8 - 2 * cp) > 0 ? (8 - 2 * cp) : 0, nt = 10 - jstart;
        const bf16* kcol = Qh + HM_PART + (size_t)skey * HD + 8 * sdcx;
        const int keyb = 64 * (2 * cp - 8 + jstart);
        if (nt > 2) asm volatile("s_waitcnt vmcnt(4)" ::: "memory"); else asm volatile("s_waitcnt vmcnt(2)" ::: "memory");
        __builtin_amdgcn_s_barrier(); asm volatile("" ::: "memory");
        bf16x8 qf[2]; qf[0] = *(const LAS bf16x8*)(QL + wave * 2048 + n * 128 + 16 * g); qf[1] = *(const LAS bf16x8*)(QL + wave * 2048 + n * 128 + 64 + 16 * g);
        float mrun = -1e30f, lrun = 0.f;
        f32x4 ot[4];
#pragma unroll
        for (int i = 0; i < 4; ++i) ot[i] = (f32x4){0.f, 0.f, 0.f, 0.f};
        const float bfar = biasL[256];
        for (int r = 0; r < nt; ++r) {
            const int j = jstart + r, key0 = keyb + 64 * r;
            if (r + 3 < nt) attn_issue_tile(kcol, key0 + 192, lds + ((r + 3) & 3) * 16384, wave);
            const bool active = (wave < 4) ? (j <= 8) : (j >= 1);
            STAMP_BEGIN(13);
            if (active) {
                LAS unsigned char* Kb = lds + (r & 3) * 16384; LAS unsigned char* Vb = Kb + 8192;
                f32x4 s[4];
                { bf16x8 kfr[4][2];
#pragma unroll
                  for (int st = 0; st < 4; ++st)
#pragma unroll
                      for (int ks = 0; ks < 2; ++ks) kfr[st][ks] = *(const LAS bf16x8*)(Kb + swz_off(16 * st + n, 4 * ks + g));
                  asm volatile("s_waitcnt lgkmcnt(0)" ::: "memory"); __builtin_amdgcn_sched_barrier(0);
#pragma unroll
                  for (int st = 0; st < 4; ++st) { s[st] = (f32x4){0.f, 0.f, 0.f, 0.f};
#pragma unroll
                      for (int ks = 0; ks < 2; ++ks) s[st] = __builtin_amdgcn_mfma_f32_16x16x32_bf16(kfr[st][ks], qf[ks], s[st], 0, 0, 0); } }
                s16x4 vtr[2][4][2];
                  const int q4 = n >> 2, p4 = n & 3;
#pragma unroll
                  for (int k2 = 0; k2 < 2; ++k2)
#pragma unroll
                      for (int nd = 0; nd < 4; ++nd) { const int ka = 32 * k2 + 4 * g + q4, ch = 2 * nd + (p4 >> 1);
                          vtr[k2][nd][0] = __builtin_bit_cast(s16x4, __builtin_amdgcn_ds_read_tr16_b64_v4i16((LAS s16x4*)(Vb + swz_off(ka, ch) + 8 * (p4 & 1))));
                          vtr[k2][nd][1] = __builtin_bit_cast(s16x4, __builtin_amdgcn_ds_read_tr16_b64_v4i16((LAS s16x4*)(Vb + swz_off(ka + 16, ch) + 8 * (p4 & 1)))); }
                const bool far = (t0 + 16 * wave) - (key0 + 63) >= 128;
                float mx = -1e30f;
                if (far) {
#pragma unroll
                    for (int st = 0; st < 4; ++st)
#pragma unroll
                        for (int jj = 0; jj < 4; ++jj) { const float sv = s[st][jj] * SC + bfar; s[st][jj] = sv; mx = fmaxf(mx, sv); }
                } else {
                    float bv[4][4];
#pragma unroll
                    for (int st = 0; st < 4; ++st)
#pragma unroll
                        for (int jj = 0; jj < 4; ++jj) { const int dist = qrow - (key0 + 16 * st + 4 * g + jj); bv[st][jj] = biasL[(dist < 128 ? dist : 128) + 128]; }
#pragma unroll
                    for (int st = 0; st < 4; ++st)
#pragma unroll
                        for (int jj = 0; jj < 4; ++jj) { const float sv = s[st][jj] * SC + bv[st][jj]; s[st][jj] = sv; mx = fmaxf(mx, sv); }
                }
                mx = fmaxf(mx, __shfl_xor(mx, 16)); mx = fmaxf(mx, __shfl_xor(mx, 32));
                const float mnew = fmaxf(mrun, mx), alpha = __builtin_amdgcn_exp2f(mrun - mnew); mrun = mnew;
                float ls = 0.f;
#pragma unroll
                for (int st = 0; st < 4; ++st)
#pragma unroll
                    for (int jj = 0; jj < 4; ++jj) { const float p = __builtin_amdgcn_exp2f(s[st][jj] - mnew); s[st][jj] = p; ls += p; }
                lrun = lrun * alpha + ls;
#pragma unroll
                for (int i = 0; i < 4; ++i) ot[i] *= alpha;
                {
                  asm volatile("s_waitcnt lgkmcnt(0)" ::: "memory"); __builtin_amdgcn_sched_barrier(0);
#pragma unroll
                  for (int k2 = 0; k2 < 2; ++k2) {
                      v4u pw; pw.x = pk2(s[2 * k2][0], s[2 * k2][1]); pw.y = pk2(s[2 * k2][2], s[2 * k2][3]); pw.z = pk2(s[2 * k2 + 1][0], s[2 * k2 + 1][1]); pw.w = pk2(s[2 * k2 + 1][2], s[2 * k2 + 1][3]);
                      const bf16x8 pf = __builtin_bit_cast(bf16x8, pw);
#pragma unroll
                      for (int nd = 0; nd < 4; ++nd) { const s16x4 v0 = vtr[k2][nd][0], v1 = vtr[k2][nd][1];
                          bf16x8 vf; vf[0] = v0[0]; vf[1] = v0[1]; vf[2] = v0[2]; vf[3] = v0[3]; vf[4] = v1[0]; vf[5] = v1[1]; vf[6] = v1[2]; vf[7] = v1[3];
                          ot[nd] = __builtin_amdgcn_mfma_f32_16x16x32_bf16(vf, pf, ot[nd], 0, 0, 0); } } }
            }
            STAMP_END(13); STAMP_BEGIN(12);
            if (r + 4 <= nt) asm volatile("s_waitcnt vmcnt(4)" ::: "memory"); else if (r + 3 == nt) asm volatile("s_waitcnt vmcnt(2)" ::: "memory"); else asm volatile("s_waitcnt vmcnt(0)" ::: "memory");
            asm volatile("s_waitcnt lgkmcnt(0)" ::: "memory"); __builtin_amdgcn_s_barrier(); asm volatile("" ::: "memory");
            STAMP_END(12);
        }
        if (u + (int)gridDim.x < BATCH * NHEAD * 32) ATTN_PROLOGUE(u + (int)gridDim.x);
        float lt = lrun; lt += __shfl_xor(lt, 16); lt += __shfl_xor(lt, 32);
        const float inv = __builtin_amdgcn_rcpf(lt);
        bf16* yp = Y + ((size_t)b * SEQ + qrow) * DM + 1024 + h * 64 + 4 * g;
        const LAS float* beta = betaL + h * 64 + 4 * g;
#pragma unroll
        for (int nd = 0; nd < 4; ++nd) { const f32x4 bt = *(const LAS f32x4*)(beta + 16 * nd); const f32x4 o = ot[nd] * inv * bt;
            v2u w; w.x = pk2(o[0], o[1]); w.y = pk2(o[2], o[3]); *(v2u*)(yp + 16 * nd) = w; }
    }
}

__device__ __forceinline__ void phase8(const Args& a, LAS unsigned char* lds) {
    const int tid = threadIdx.x, lane = tid & 63, wave = __builtin_amdgcn_readfirstlane(tid >> 6), n = lane & 15, g = lane >> 4;
    const float* mod = (const float*)(a.ws + WS_MOD); const float* W36 = (const float*)(a.ws + WS_W36); const float* X1 = (const float*)(a.ws + WS_X1);
    unsigned* ctl = (unsigned*)(a.ws + WS_CTL);
    LAS float* part = (LAS float*)lds;
    LAS float* ssp = (LAS float*)(lds + 24576);
    LAS float* lg = (LAS float*)(lds + 25088);
    for (int tile = blockIdx.x; tile < MTOK / 16; tile += gridDim.x) {
        const int m0 = 16 * tile, b = m0 >> 12;
        f32x4 acc[3]; float ss = 0.f;
#pragma unroll
        for (int ct = 0; ct < 3; ++ct) acc[ct] = (f32x4){0.f, 0.f, 0.f, 0.f};
        const float* xrow = X1 + (size_t)(m0 + n) * DM + 256 * wave + 4 * g;
        const float* w0p = W36 + (size_t)n * DM + 256 * wave + 4 * g; const float* w1p = w0p + (size_t)16 * DM; const float* w2p = w0p + (size_t)(n < 4 ? 32 : 0) * DM;
        const float* gp = a.in[I_N2G] + 256 * wave + 4 * g; const float* sp = mod + b * 12288 + 4 * DM + 256 * wave + 4 * g;
#pragma unroll 4
        for (int Q = 0; Q < 16; ++Q) {
            f32x4 xa = *(const f32x4*)(xrow + 16 * Q);
            const f32x4 ab = *(const f32x4*)(gp + 16 * Q) * (1.f + *(const f32x4*)(sp + 16 * Q));
            const f32x4 wa = *(const f32x4*)(w0p + 16 * Q), wb = *(const f32x4*)(w1p + 16 * Q); f32x4 wc = *(const f32x4*)(w2p + 16 * Q);
            if (n >= 4) wc = (f32x4){0.f, 0.f, 0.f, 0.f};
            ss += (xa[0] * xa[0] + xa[1] * xa[1]) + (xa[2] * xa[2] + xa[3] * xa[3]); xa *= ab;
#pragma unroll
            for (int r = 0; r < 4; ++r) { acc[0] = __builtin_amdgcn_mfma_f32_16x16x4f32(xa[r], wa[r], acc[0], 0, 0, 0); acc[1] = __builtin_amdgcn_mfma_f32_16x16x4f32(xa[r], wb[r], acc[1], 0, 0, 0);
                acc[2] = __builtin_amdgcn_mfma_f32_16x16x4f32(xa[r], wc[r], acc[2], 0, 0, 0); }
        }
        ss += __shfl_xor(ss, 16); ss += __shfl_xor(ss, 32);
#pragma unroll
        for (int ct = 0; ct < 3; ++ct) *(LAS f32x4*)(part + (wave * 64 + lane) * 12 + 4 * ct) = acc[ct];
        if (lane < 16) ssp[wave * 16 + lane] = ss;
        __syncthreads();
        { const int tk = tid >> 5, sl = tid & 31;
            float s2 = 0.f;
#pragma unroll
            for (int w = 0; w < 8; ++w) s2 += ssp[w * 16 + tk];
            const float rstd = 1.f / sqrtf(s2 * (1.f / DM) + RMS_EPS);
            const float* b36 = (const float*)(a.ws + WS_B36) + b * 36;
            { const int e = sl; float s = 0.f;
#pragma unroll
              for (int w = 0; w < 8; ++w) s += part[(w * 64 + 16 * (tk >> 2) + (e & 15)) * 12 + 4 * (e >> 4) + (tk & 3)];
              lg[tk * 40 + e] = s * rstd + b36[e]; }
            if (sl < 4) { const int e = 32 + sl; float s = 0.f;
#pragma unroll
              for (int w = 0; w < 8; ++w) s += part[(w * 64 + 16 * (tk >> 2) + (e & 15)) * 12 + 4 * (e >> 4) + (tk & 3)];
              lg[tk * 40 + e] = s * rstd + b36[e]; }
            if (sl == 0) ((float*)(a.ws + WS_RSTD))[m0 + tk] = rstd; }
        __syncthreads();
        if (tid < 16) {
            float l[36];
#pragma unroll
            for (int e = 0; e < 36; ++e) l[e] = lg[tid * 40 + e];
            int gi = 0; float gm = l[0];
#pragma unroll
            for (int i = 1; i < 4; ++i) if (l[i] > gm) { gm = l[i]; gi = i; }
            float gs = 0.f;
#pragma unroll
            for (int i = 0; i < 4; ++i) gs += expf(l[i] - gm);
            const float gwt = 1.f / gs;
            float el[8];
#pragma unroll
            for (int j = 0; j < 8; ++j) el[j] = (gi == 0) ? l[4 + j] : ((gi == 1) ? l[12 + j] : ((gi == 2) ? l[20 + j] : l[28 + j]));
            int i1 = 0; float m1 = el[0];
#pragma unroll
            for (int i = 1; i < 8; ++i) if (el[i] > m1) { m1 = el[i]; i1 = i; }
            int i2 = -1; float m2 = -3.0e38f;
#pragma unroll
            for (int i = 0; i < 8; ++i) if (i != i1 && el[i] > m2) { m2 = el[i]; i2 = i; }
            const float e2 = expf(m2 - m1); const float w1 = gwt / (1.f + e2), w2 = gwt * e2 / (1.f + e2);
            int* rt = (int*)(a.ws + WS_ROUTE) + (size_t)(m0 + tid) * 8; const int ge1 = gi * 8 + i1, ge2 = gi * 8 + i2;
            rt[0] = ge1; rt[1] = ge2; rt[2] = __float_as_int(w1); rt[3] = __float_as_int(w2);
            const int sl = (tile & (NSLICE - 1)) * 32;
            atomicAdd(ctl + CW_CNT + sl + ge1, 1u); atomicAdd(ctl + CW_CNT + sl + ge2, 1u);
        }
        __syncthreads();
    }
}

__device__ __forceinline__ void phase9(const Args& a) {
    const int tid = threadIdx.x, lane = tid & 63, wave = tid >> 6;
    const int gw = blockIdx.x * NWAVES + wave, NGW = gridDim.x * NWAVES;
    unsigned* ctl = (unsigned*)(a.ws + WS_CTL);
    const float* mod = (const float*)(a.ws + WS_MOD);
    unsigned cnt = 0u;
    if (lane < NEXP) for (int s = 0; s < NSLICE; ++s) cnt += __hip_atomic_load(ctl + CW_CNT + s * 32 + lane, RLX_AGENT);
    const unsigned pad = (cnt + 255u) & ~255u;
    unsigned incl = pad;
#pragma unroll
    for (int o = 1; o < 64; o <<= 1) { const unsigned t = __shfl_up(incl, o); if (lane >= o) incl += t; }
    const unsigned off = incl - pad;
    if (gw == 0) {
        if (lane < NEXP) for (unsigned t = off >> 8; t < (off + pad) >> 8; ++t) ctl[CW_TE + t] = (unsigned)lane;
        if (lane == 63) ctl[CW_NRT] = incl >> 8;
    }
    for (int task = gw; task < MTOK / 4; task += NGW) {
        const int m0 = 4 * task, b = m0 >> 12, slice = (m0 >> 4) & (NSLICE - 1);
        unsigned sbase = 0u;
        if (lane < NEXP) for (int s = 0; s < slice; ++s) sbase += __hip_atomic_load(ctl + CW_CNT + s * 32 + lane, RLX_AGENT);
        const unsigned offs = off + sbase;
        int* rt = (int*)(a.ws + WS_ROUTE) + (size_t)(m0 + (lane & 3)) * 8;
        const int e1 = rt[0], e2 = rt[1];
        unsigned p1 = 0, p2 = 0;
        if (lane < 4) { p1 = atomicAdd(ctl + CW_POS + slice * 32 + e1, 1u); p2 = atomicAdd(ctl + CW_POS + slice * 32 + e2, 1u); }
        const unsigned s1v = __shfl(offs, e1) + p1, s2v = __shfl(offs, e2) + p2;
        if (lane < 4) { rt[4] = (int)s1v; rt[5] = (int)s2v; ((float*)(a.ws + WS_SW))[s1v] = __int_as_float(rt[2]); ((float*)(a.ws + WS_SW))[s2v] = __int_as_float(rt[3]); }
        f32x4 xa[8], xb[8];
        auto ldx = [&](int t, f32x4 (&x)[8]) { const f32x4* xr = (const f32x4*)((const float*)(a.ws + WS_X1) + (size_t)(m0 + t) * DM) + lane;
#pragma unroll
            for (int j = 0; j < 8; ++j) x[j] = xr[64 * j]; };
        auto dox = [&](int t, f32x4 (&x)[8]) { const unsigned s1 = __shfl(s1v, t), s2 = __shfl(s2v, t);
            const float rstd = ((const float*)(a.ws + WS_RSTD))[m0 + t];
            v2u* d1 = (v2u*)((bf16*)(a.ws + WS_H2P) + (size_t)s1 * DM) + lane; v2u* d2 = (v2u*)((bf16*)(a.ws + WS_H2P) + (size_t)s2 * DM) + lane;
#pragma unroll
            for (int j = 0; j < 8; ++j) { const int c = 4 * (lane + 64 * j);
                const f32x4 g = *(const f32x4*)(a.in[I_N2G] + c), sh = *(const f32x4*)(mod + b * 12288 + 3 * DM + c), sc = *(const f32x4*)(mod + b * 12288 + 4 * DM + c);
                const f32x4 h = x[j] * rstd * g * (1.f + sc) + sh; v2u o; o.x = pk2(h.x, h.y); o.y = pk2(h.z, h.w); d1[64 * j] = o; d2[64 * j] = o; } };
        ldx(0, xa); ldx(1, xb); dox(0, xa); ldx(2, xa); dox(1, xb); ldx(3, xb); dox(2, xa); dox(3, xb);
    }
}

__device__ __forceinline__ void phase12(const Args& a) {
    const int tid = threadIdx.x, lane = tid & 63, wave = tid >> 6;
    const int gw = blockIdx.x * NWAVES + wave, NGW = gridDim.x * NWAVES;
    const float* mod = (const float*)(a.ws + WS_MOD);
    struct Tok { f32x4 x[8]; v2u f1[8], f2[8]; };
    auto ldslots = [&](int m, int& s1, int& s2) { const int* rt = (const int*)(a.ws + WS_ROUTE) + (size_t)m * 8; s1 = rt[4]; s2 = rt[5]; };
    auto ldtok = [&](int m, int s1, int s2, Tok& t) { const f32x4* xr = (const f32x4*)((const float*)(a.ws + WS_X1) + (size_t)m * DM) + lane;
        const v2u* f1 = (const v2u*)((const bf16*)(a.ws + WS_FP) + (size_t)s1 * DM) + lane; const v2u* f2 = (const v2u*)((const bf16*)(a.ws + WS_FP) + (size_t)s2 * DM) + lane;
#pragma unroll
        for (int j = 0; j < 8; ++j) { t.x[j] = xr[64 * j]; t.f1[j] = f1[64 * j]; t.f2[j] = f2[64 * j]; } };
    auto dotok = [&](int m, Tok& t) { const int b = m >> 12; float s = 0.f; f32x4 v[8];
#pragma unroll
        for (int j = 0; j < 8; ++j) { const int c = 4 * (lane + 64 * j); const f32x4 g2 = *(const f32x4*)(mod + b * 12288 + 5 * DM + c);
            const v2u a1 = t.f1[j], a2 = t.f2[j]; f32x4 f;
            f.x = bflo(a1.x) + bflo(a2.x); f.y = bfhi(a1.x) + bfhi(a2.x); f.z = bflo(a1.y) + bflo(a2.y); f.w = bfhi(a1.y) + bfhi(a2.y);
            v[j] = t.x[j] + g2 * f; s += (v[j].x * v[j].x + v[j].y * v[j].y) + (v[j].z * v[j].z + v[j].w * v[j].w); }
        const float rstd = 1.f / sqrtf(wave_sum(s) * (1.f / DM) + RMS_EPS);
        f32x4* op = (f32x4*)(a.out + (size_t)m * DM) + lane;
#pragma unroll
        for (int j = 0; j < 8; ++j) { const int c = 4 * (lane + 64 * j); const f32x4 g = *(const f32x4*)(a.in[I_NFG] + c); op[64 * j] = v[j] * rstd * g; } };
    { Tok ta, tb; int m = gw, sa1 = 0, sa2 = 0, sb1 = 0, sb2 = 0;
      if (m < MTOK) { ldslots(m, sa1, sa2); if (m + NGW < MTOK) ldslots(m + NGW, sb1, sb2); ldtok(m, sa1, sa2, ta); }
      while (m < MTOK) { const int m2 = m + NGW, m3 = m2 + NGW, m4 = m3 + NGW;
          if (m3 < MTOK) ldslots(m3, sa1, sa2);
          if (m2 < MTOK) ldtok(m2, sb1, sb2, tb);
          dotok(m, ta); if (m2 >= MTOK) break;
          if (m4 < MTOK) ldslots(m4, sb1, sb2);
          if (m3 < MTOK) ldtok(m3, sa1, sa2, ta);
          dotok(m2, tb); m = m3; } }
}

#ifndef MK_ONE_LAUNCH
#define MK_ONE_LAUNCH 1
#endif
__global__ void __launch_bounds__(NTHR, 2) mega_fwd(Args args) {
    extern __shared__ __attribute__((aligned(16))) unsigned char lds_raw[];
    LAS unsigned char* lds = (LAS unsigned char*)lds_raw;
    const int tid = threadIdx.x;
    for (int u = tid; u < (LDS_BYTES - LDSCTL_OFF) / 4; u += NTHR) ((LAS unsigned*)(lds + LDSCTL_OFF))[u] = 0u;
    __syncthreads();
    volatile LAS unsigned* MISC = (volatile LAS unsigned*)(lds + MISC_OFF);
    unsigned* ctl = (unsigned*)(args.ws + WS_CTL);
    unsigned* barw = ctl + CW_BAR + args.li * XCD_BAR_WORDS;
    XcdBarrier bar; bar.bar = barw; bar.x = 0; bar.st = nullptr;
    const bool multi = (args.ph_hi - args.ph_lo) > 1;
    if (multi) bar = xcd_barrier_post(barw, MISC + 8);
    const int lo = args.ph_lo, hi = args.ph_hi, G = gridDim.x;
#define IN(k) (lo <= (k) && (k) < hi)
#define SEAM(k) do { if (IN(k) && IN((k) + 1)) xcd_barrier(bar); } while (0)
    const Args& a = args; STAMP_DECL;
#define PH_BEGIN(k) STAMP_BEGIN(100 + (k))
#define PH_END(k) STAMP_END(100 + (k))
    if (IN(0)) { PH_BEGIN(0); STAMP_BEGIN(20); phase0(args, lds); STAMP_END(20); } SEAM(0); if (IN(0)) PH_END(0);
    if (IN(1)) { PH_BEGIN(1); phase1(args); } SEAM(1); if (IN(1)) PH_END(1);
    if (IN(2)) { PH_BEGIN(2); pg8::Gemm g{(const pg8::bf16_t*)(args.ws + WS_HB), (const pg8::bf16_t*)(args.ws + WS_WIN), MTOK, PROJP, DM}; pg8::StaticOrder S; S.init(MTOK, PROJP, G, (int)blockIdx.x);
        EpiProj E{(bf16*)(args.ws + WS_P), (bf16*)(args.ws + WS_PLR)};
        pg8::gemm_phase<EpiProj, pg8::StaticOrder, true, true>(lds, g, S, E);
        if (G == 256 && (int)blockIdx.x >= 64) conv_range(args, lds, NCONV - CV_X2 - CV_X6, CV_X2, (int)blockIdx.x - 64, 192); } SEAM(2); if (IN(2)) PH_END(2);
    if (IN(3)) { PH_BEGIN(3); STAMP_BEGIN(10); phase3(args); STAMP_END(10); STAMP_BEGIN(11); phase5b(args, lds); STAMP_END(11); } SEAM(3); if (IN(3)) PH_END(3);
    if (IN(4)) { PH_BEGIN(4); pg8::Gemm g{(const pg8::bf16_t*)(args.ws + WS_AL), (const pg8::bf16_t*)(args.ws + WS_WL), MTOK, LORA_N, LORA_K}; pg8::StaticOrder S; S.init(MTOK, LORA_N, G, (int)blockIdx.x);
        EpiLora E{(float*)(args.ws + WS_LW), (bf16*)(args.ws + WS_AA), (bf16*)(args.ws + WS_GG)};
        pg8::gemm_phase<EpiLora, pg8::StaticOrder, true, true>(lds, g, S, E); } SEAM(4); if (IN(4)) PH_END(4);
    if (IN(5)) { PH_BEGIN(5); scanA(args, lds); } SEAM(5); if (IN(5)) PH_END(5);
    if (IN(6)) { PH_BEGIN(6); scanB(args, lds); if (G == 256 && (int)blockIdx.x >= 128) conv_range(args, lds, NCONV - CV_X6, CV_X6, (int)blockIdx.x - 128, 128); } SEAM(6); if (IN(6)) PH_END(6);
    if (IN(7)) { PH_BEGIN(7); scanC(args); } SEAM(7); if (IN(7)) PH_END(7);
    if (IN(8)) { PH_BEGIN(8); pg8::Gemm g{(const pg8::bf16_t*)(args.ws + WS_YMIX), (const pg8::bf16_t*)(args.ws + WS_WOUT), MTOK, DM, DM}; pg8::StaticOrder S; S.init(MTOK, DM, G, (int)blockIdx.x);
        EpiResGate E{args.in[I_X], (const float*)(args.ws + WS_MOD) + 2 * DM, (float*)(args.ws + WS_X1)};
        pg8::gemm_phase<EpiResGate, pg8::StaticOrder, true, true>(lds, g, S, E); } SEAM(8); if (IN(8)) PH_END(8);
    if (IN(9)) { PH_BEGIN(9); phase8(args, lds); } SEAM(9); if (IN(9)) PH_END(9);
    if (IN(10)) { PH_BEGIN(10); phase9(args); } SEAM(10); if (IN(10)) PH_END(10);
    if (IN(11) || IN(12) || IN(13)) {
        const int nrt = (int)__hip_atomic_load(ctl + CW_NRT, RLX_AGENT), c = (int)blockIdx.x;
        const int Ugu = 4 * nrt, nB = Ugu > G ? Ugu - G : 0, R0 = (Ugu < G ? Ugu : G) / 4, E2 = (8 * R0 < 2 * (G - nB)) ? 8 * R0 : 2 * (G - nB);
        const pg8::Gemm gu{(const pg8::bf16_t*)(args.ws + WS_H2P), (const pg8::bf16_t*)(args.ws + WS_WGU), nrt * 256, NEXP * 1024, DM};
        const pg8::Gemm gd{(const pg8::bf16_t*)(args.ws + WS_HG), (const pg8::bf16_t*)(args.ws + WS_WD), nrt * 256, NEXP * DM, FF};
        const EpiGateUp Eu{(const float*)(args.ws + WS_SW), (bf16*)(args.ws + WS_HG)};
        const EpiStoreBf16 Ed{(bf16*)(args.ws + WS_FP), DM, 7};
        if (IN(11)) { PH_BEGIN(11); GroupOrder2 S{ctl + CW_TE, 4, 0, Ugu < G ? Ugu : G, G, c}; pg8::gemm_phase<EpiGateUp, GroupOrder2, true, true>(lds, gu, S, Eu); } SEAM(11); if (IN(11)) PH_END(11);
        if (IN(12)) { PH_BEGIN(12); if (c < nB) { GroupOrder2 S{ctl + CW_TE, 4, G, nB, nB, c}; pg8::gemm_phase<EpiGateUp, GroupOrder2, true, true>(lds, gu, S, Eu); }
                      else { GroupOrder2 S{ctl + CW_TE, 8, 0, E2, G - nB, c - nB}; pg8::gemm_phase<EpiStoreBf16, GroupOrder2, true, true>(lds, gd, S, Ed); } } SEAM(12); if (IN(12)) PH_END(12);
        if (IN(13)) { PH_BEGIN(13); GroupOrder2 S{ctl + CW_TE, 8, E2, 8 * nrt - E2, G, c}; pg8::gemm_phase<EpiStoreBf16, GroupOrder2, true, true>(lds, gd, S, Ed); } SEAM(13); if (IN(13)) PH_END(13);
    }
    if (IN(14)) { PH_BEGIN(14); phase12(args); PH_END(14); }
#ifdef STAMP_ID
    if (blockIdx.x == 0 && tid == 0 && IN(NPH - 1)) { const unsigned dly = STAMP_MULT * __hip_atomic_load(ctl + CW_STAMP, RLX_AGENT); const unsigned long long t0_ = __builtin_amdgcn_s_memrealtime();
        while (__builtin_amdgcn_s_memrealtime() - t0_ < (unsigned long long)dly) __builtin_amdgcn_s_sleep(8); }
#endif
#ifdef EXTRA_BARRIERS
    if (multi) for (int i_ = 0; i_ < EXTRA_BARRIERS; ++i_) xcd_barrier(bar);
#endif
#undef IN
#undef SEAM
}

extern "C" void kernel_launch(void* const* d_in, const int* in_sizes, int n_in, void* d_out, int out_size, void* d_ws, size_t ws_size, hipStream_t stream) {
    static int grid = 0;
    if (grid == 0) {
        if (n_in != 30 || out_size != MTOK * DM || ws_size < WS_END) { fprintf(stderr, "kernel_launch: unexpected shapes (n_in %d, out %d, ws %zu)\n", n_in, out_size, ws_size); grid = -1; return; }
        int dev = 0, cus = 0, per_cu = 0;
        if (hipGetDevice(&dev) != hipSuccess || hipDeviceGetAttribute(&cus, hipDeviceAttributeMultiprocessorCount, dev) != hipSuccess) { grid = -1; return; }
        if (hipFuncSetAttribute((const void*)mega_fwd, hipFuncAttributeMaxDynamicSharedMemorySize, LDS_BYTES) != hipSuccess) { grid = -1; return; }
        if (hipOccupancyMaxActiveBlocksPerMultiprocessor(&per_cu, (const void*)mega_fwd, NTHR, LDS_BYTES) != hipSuccess || per_cu < 1) { fprintf(stderr, "kernel_launch: occupancy query says %d\n", per_cu); grid = -1; (void)hipGetLastError(); return; }
        grid = cus;
    }
    if (grid < 0) return;
    (void)hipMemsetAsync((char*)d_ws + WS_CTL, 0, CTL_ZERO_BYTES, stream);
    Args a{};
    for (int i = 0; i < 30; ++i) a.in[i] = (const float*)d_in[i];
    a.out = (float*)d_out; a.ws = (unsigned char*)d_ws;
#if MK_ONE_LAUNCH
#ifdef PROBE_PHASE
    const int cuts[3] = {0, PROBE_PHASE, NPH};
    for (int li = 0; li < 2; ++li) { a.ph_lo = cuts[li]; a.ph_hi = cuts[li + 1] + ((li == 0) ? PROBE_REPEAT : 0); a.li = li;
        void* kargs[] = {&a};
        hipError_t e = hipLaunchCooperativeKernel((const void*)mega_fwd, dim3(grid), dim3(NTHR), kargs, LDS_BYTES, stream);
        if (e != hipSuccess) fprintf(stderr, "cooperative launch failed: %s\n", hipGetErrorString(e)); }
#else
    a.ph_lo = 0; a.ph_hi = NPH;
    void* kargs[] = {&a};
    hipError_t e = hipLaunchCooperativeKernel((const void*)mega_fwd, dim3(grid), dim3(NTHR), kargs, LDS_BYTES, stream);
    if (e != hipSuccess) fprintf(stderr, "cooperative launch failed: %s\n", hipGetErrorString(e));
#endif
#else
    for (int p = 0; p < NPH; ++p) { a.ph_lo = p; a.ph_hi = p + 1; hipLaunchKernelGGL(mega_fwd, dim3(grid), dim3(NTHR), LDS_BYTES, stream, a); }
#endif
}
```

```cpp
#include <hip/hip_runtime.h>
#include <hip/hip_bf16.h>
#include <cstdio>
#include <cstdint>

constexpr int NWAVES = 8, NTHR = 512;
constexpr int BATCH = 2, SEQ = 4096, DM = 2048, MTOK = BATCH * SEQ;
constexpr int CW = 1024, NHEAD = 16, HD = 64;
constexpr int SHIFTW = 3360, PROJW = 6432, PROJP = 6656;
constexpr int LORA_K = 384, LORA_N = 3072;
constexpr int NEXP = 32, FF = 512;
constexpr int MAXSLOT = 24576;
constexpr float RMS_EPS = 1e-6f, GN_EPS = 64e-5f;
constexpr float LOG2E = 1.4426950408889634f;

constexpr size_t MiB = 1u << 20;
constexpr size_t WS_CTL = 0, CTL_ZERO_BYTES = 1 * MiB;
constexpr size_t WS_MOD = 1 * MiB;
constexpr size_t WS_ROUTE = 1 * MiB + 128 * 1024;
constexpr size_t WS_SW = 1 * MiB + 512 * 1024;
constexpr size_t WS_B36 = 1 * MiB + 96 * 1024;
constexpr size_t WS_RSTD = 1 * MiB + 640 * 1024;
constexpr size_t WS_W36 = 1 * MiB + 704 * 1024;
constexpr size_t WS_WIN = 2 * MiB;
constexpr size_t WS_WOUT = 28 * MiB;
constexpr size_t WS_WL = 36 * MiB;
constexpr size_t WS_WGU = 39 * MiB;
constexpr size_t WS_WD = 167 * MiB;
constexpr size_t B0 = 231 * MiB;
constexpr size_t WS_P = B0;
constexpr size_t WS_PLR = B0 + 96 * MiB;
constexpr size_t HM_PART = (size_t)BATCH * NHEAD * SEQ * HD, HM_BATCH = (size_t)NHEAD * SEQ * HD, HM_HEAD = (size_t)SEQ * HD;
constexpr size_t WS_HB = B0 + 104 * MiB;
constexpr size_t WS_AL = B0 + 136 * MiB;
constexpr size_t WS_LW = B0 + 142 * MiB;
constexpr size_t WS_AA = B0 + 174 * MiB;
constexpr size_t WS_GG = B0 + 190 * MiB;
constexpr size_t WS_R = B0 + 206 * MiB, WS_K2 = B0 + 222 * MiB, WS_V = B0 + 238 * MiB, WS_KK = B0 + 254 * MiB, WS_BB = B0 + 270 * MiB;
constexpr size_t WS_YMIX = B0 + 286 * MiB;
constexpr size_t WS_X1 = B0;
constexpr size_t WS_H2P = B0 + 136 * MiB;
constexpr size_t WS_HG = B0 + 232 * MiB;
constexpr size_t WS_FP = B0 + 136 * MiB;
constexpr size_t WS_HM = B0 + 104 * MiB, WS_Y1 = B0 + 254 * MiB, WS_GT = B0 + 318 * MiB, WS_RH = B0 + 334 * MiB, WS_PLV = B0 + 136 * MiB;
constexpr size_t WS_SF = B0 + 152 * MiB;
constexpr size_t WS_END = B0 + 350 * MiB;
constexpr int CW_NRT = 1152, CW_TE = 1280, CW_BAR = 4096;
constexpr int NSLICE = 64, CW_CNT = 16384, CW_POS = 16384 + NSLICE * 32;

constexpr int CW_STAMP = 1200, CW_RDY = 1400;
#ifdef STAMP_ID
#ifndef STAMP_BLOCK
#define STAMP_BLOCK 0
#endif
#ifndef STAMP_MULT
#define STAMP_MULT 1u
#endif
#define STAMP_BEGIN(id) do { if ((id) == STAMP_ID && blockIdx.x == STAMP_BLOCK && threadIdx.x == 0) st_t0_ = __builtin_amdgcn_s_memrealtime(); } while (0)
#define STAMP_END(id) do { if ((id) == STAMP_ID && blockIdx.x == STAMP_BLOCK && threadIdx.x == 0) atomicAdd((unsigned*)(a.ws + WS_CTL) + CW_STAMP, (unsigned)(__builtin_amdgcn_s_memrealtime() - st_t0_)); } while (0)
#define STAMP_DECL unsigned long long st_t0_ = 0
#else
#define STAMP_BEGIN(id) do { } while (0)
#define STAMP_END(id) do { } while (0)
#define STAMP_DECL do { } while (0)
#endif
constexpr int RING_BYTES = 131072;
constexpr int LDSCTL_OFF = RING_BYTES, MISC_OFF = LDSCTL_OFF + 320;
constexpr int LDS_BYTES = 147456;

#define GAS __attribute__((address_space(1)))
#define LAS __attribute__((address_space(3)))
typedef unsigned short bf16;
typedef unsigned v4u __attribute__((ext_vector_type(4)));
typedef unsigned v2u __attribute__((ext_vector_type(2)));
typedef float f32x4 __attribute__((ext_vector_type(4)));
typedef short bf16x8 __attribute__((ext_vector_type(8)));
typedef short s16x4 __attribute__((ext_vector_type(4)));
typedef GAS unsigned gu32;
typedef GAS unsigned long long gu64;
#define RLX_AGENT __ATOMIC_RELAXED, __HIP_MEMORY_SCOPE_AGENT
#define LDS_WAIT() asm volatile("s_waitcnt lgkmcnt(0)" ::: "memory")
#define VM_WAIT() asm volatile("s_waitcnt vmcnt(0)" ::: "memory")
__device__ __forceinline__ unsigned f2bf(float f) { unsigned u = __builtin_bit_cast(unsigned, f); return (u + 0x7fffu + ((u >> 16) & 1u)) >> 16; }
typedef float f32x2_t __attribute__((ext_vector_type(2)));
typedef __bf16 bf16x2_t __attribute__((ext_vector_type(2)));
__device__ __forceinline__ unsigned pk2(float lo, float hi) { const f32x2_t v = {lo, hi}; return __builtin_bit_cast(unsigned, __builtin_convertvector(v, bf16x2_t)); }
__device__ __forceinline__ float bflo(unsigned u) { return __builtin_bit_cast(float, u << 16); }
__device__ __forceinline__ float bfhi(unsigned u) { return __builtin_bit_cast(float, u & 0xffff0000u); }
__device__ __forceinline__ float wave_sum(float v) {
#pragma unroll
    for (int o = 1; o < 64; o <<= 1) v += __shfl_xor(v, o);
    return v;
}
__device__ __forceinline__ float sigmoid_f(float x) { return __builtin_amdgcn_rcpf(1.f + __expf(-x)); }

struct Args { const float* in[30]; float* out; unsigned char* ws; int ph_lo, ph_hi, li, pad; };
enum { I_X = 0, I_C, I_WADA, I_BADA, I_N1G, I_WIN, I_MU, I_W0, I_WDEC, I_A0, I_WAAA, I_WGATEUP, I_KK, I_KA, I_RK, I_LNW, I_LNB, I_RELB, I_BETAR, I_BETAA,
       I_WOUT, I_N2G, I_WGRP, I_BGRP, I_WEXP, I_BEXP, I_WG, I_WU, I_WDN, I_NFG };
constexpr int NPH = 15;

namespace pg8 {
#define PG8_LAS __attribute__((address_space(3)))
typedef unsigned short bf16_t;
typedef short bf16x8 __attribute__((ext_vector_type(8)));
typedef float f32x4 __attribute__((ext_vector_type(4)));
typedef unsigned u32x4 __attribute__((ext_vector_type(4)));
constexpr int BM = 256, BK = 64, HALF = 128, HTB = HALF * BK * 2  , STAGE_BYTES = 8 * HTB, NXCD = 8, WGM = 8;

__host__ __device__ __forceinline__ int lds_byte(int r, int c) { const int st = (r >> 4) * 2 + (c >> 5), rr = r & 15, cc = c & 31, ob = rr * 64 + cc * 2; return st * 1024 + (ob ^ (((ob >> 9) & 1) << 5)); }
__host__ __device__ __forceinline__ void stage_rc(int b, int& R, int& C) { const int st = b / 1024, sb = b % 1024, swz = sb ^ (((sb >> 9) & 1) << 5); R = (st >> 1) * 16 + swz / 64; C = (st & 1) * 32 + (swz % 64) / 2; }
__host__ __device__ __forceinline__ int perm32(int rho) { const int n = rho >> 4, i = rho & 15; return 8 * (i >> 2) + 4 * n + (i & 3); }

struct Unit { int pm, pn; };
struct Gemm { const bf16_t* A; const bf16_t* Bt; int M, N, K; };

struct StaticOrder {
    int nM, nN, nwg, G, c;
    __host__ __device__ void init(int M, int N, int G_, int c_) { nM = M / BM; nN = N / BM; nwg = nM * nN; G = G_; c = c_; }
    __host__ __device__ bool next(int i, Unit& u) const {
        const long L = (long)i * G + c; if (L >= nwg) return false;
        int wgid = (int)L; { const int q = nwg / NXCD, r = nwg % NXCD, xcd = wgid % NXCD, off = wgid / NXCD; wgid = (xcd < r ? xcd * (q + 1) : r * (q + 1) + (xcd - r) * q) + off; }
        const int nig = WGM * nN, gid = wgid / nig, fm = gid * WGM, gsz = (nM - fm) < WGM ? (nM - fm) : WGM;
        u.pm = fm + ((wgid % nig) % gsz); u.pn = (wgid % nig) / gsz; return true;
    }
    __device__ __forceinline__ void a_ready(const Unit&) const {}
    __device__ __forceinline__ void done(const Unit&) const {}
};

__device__ __forceinline__ unsigned cvt_pk_bf16(float lo, float hi) { unsigned r; asm volatile("v_cvt_pk_bf16_f32 %0, %1, %2" : "=v"(r) : "v"(lo), "v"(hi)); return r; }
template <class Epi, class Sched, bool ALIGN_EPI = false, bool SP2 = false>
__device__ __forceinline__ void gemm_phase(PG8_LAS unsigned char* lds, const Gemm g, const Sched& S, const Epi& E) {
    const int tid = threadIdx.x, wid = __builtin_amdgcn_readfirstlane(tid >> 6), lane = tid & 63, wr = wid >> 2, wc = wid & 3, fr = lane & 15, fq = lane >> 4;
    const int K = g.K, nt = K / BK;
    unsigned voffA[2], voffB[2];
#pragma unroll
    for (int i = 0; i < 2; ++i) { int R, C; stage_rc(tid * 16 + i * 8192, R, C); const int Rb = Epi::PERM ? ((R & ~31) + perm32(R & 31)) : R;
        voffA[i] = (unsigned)(R * K + C) * 2u; voffB[i] = (unsigned)(Rb * K + C) * 2u; }
    const size_t kstep = (size_t)(BK * 2);
    const size_t hstep = (size_t)HALF * K * 2;
    const size_t tstep = 2 * hstep;
    const unsigned ldsw = (unsigned)wid * 1024u;
    const int aoff = lds_byte(wr * 64 + fr, fq * 8), boff = lds_byte(wc * 32 + fr, fq * 8);
#define PG8_SA(b, h) (((b) * 2 + (h)) * HTB)
#define PG8_SB(b, h) ((4 + (b) * 2 + (h)) * HTB)
#define PG8_STAGE(bufoff, gbase, voff) do { _Pragma("unroll") for (int _i = 0; _i < 2; ++_i) \
        __builtin_amdgcn_global_load_lds((const unsigned*)((const char*)(gbase) + (voff)[_i]), (PG8_LAS unsigned*)(lds + (bufoff) + ldsw + _i * 8192), 16, 0, 0); } while (0)
#define PG8_LDA(dst, b, h) do { _Pragma("unroll") for (int m = 0; m < 4; ++m) _Pragma("unroll") for (int k = 0; k < 2; ++k) dst[m][k] = *(const PG8_LAS bf16x8*)(lds + PG8_SA(b, h) + aoff + m * 2048 + k * 1024); } while (0)
#define PG8_LDB(dst, b, h) do { _Pragma("unroll") for (int n = 0; n < 2; ++n) _Pragma("unroll") for (int k = 0; k < 2; ++k) dst[n][k] = *(const PG8_LAS bf16x8*)(lds + PG8_SB(b, h) + boff + n * 2048 + k * 1024); } while (0)
#define PG8_MMA(ai, bj, At, Bt) do { __builtin_amdgcn_s_setprio(1); _Pragma("unroll") for (int m = 0; m < 4; ++m) _Pragma("unroll") for (int n = 0; n < 2; ++n) _Pragma("unroll") for (int k = 0; k < 2; ++k) \
        acc[ai][bj][m][n] = __builtin_amdgcn_mfma_f32_16x16x32_bf16(Bt[n][k], At[m][k], acc[ai][bj][m][n], 0, 0, 0); __builtin_amdgcn_s_setprio(0); } while (0)
#define PG8_WAIT_V(n) asm volatile("s_waitcnt vmcnt(" #n ")" ::: "memory")
#define PG8_WAIT_L(n) asm volatile("s_waitcnt lgkmcnt(" #n ")" ::: "memory")
#define PG8_BAR __builtin_amdgcn_s_barrier()
#define PG8_SCHED __builtin_amdgcn_sched_barrier(0)
    Unit cur, nxt; int ui = 0;
    if (!S.next(0, cur)) return;
    f32x4 acc[2][2][4][2];
#pragma unroll
    for (int a = 0; a < 2; ++a)
#pragma unroll
        for (int b = 0; b < 2; ++b)
#pragma unroll
            for (int m = 0; m < 4; ++m)
#pragma unroll
                for (int n = 0; n < 2; ++n) acc[a][b][m][n] = (f32x4){0.f, 0.f, 0.f, 0.f};
    bf16x8 At[4][2], B0[2][2], B1[2][2];
    const char* cA = (const char*)g.A + (size_t)cur.pm * tstep; const char* cB = (const char*)g.Bt + (size_t)cur.pn * tstep;
    S.a_ready(cur);
    if constexpr (SP2) {
        PG8_STAGE(PG8_SB(0, 0), cB, voffB); PG8_STAGE(PG8_SB(0, 1), cB + hstep, voffB); PG8_STAGE(PG8_SA(0, 0), cA, voffA); PG8_STAGE(PG8_SA(0, 1), cA + hstep, voffA);
        if (wr == 1) PG8_BAR;
        PG8_WAIT_V(2); PG8_BAR;
        PG8_STAGE(PG8_SB(1, 0), cB + kstep, voffB); PG8_STAGE(PG8_SA(1, 0), cA + kstep, voffA); PG8_STAGE(PG8_SB(1, 1), cB + hstep + kstep, voffB);
        PG8_WAIT_V(6); PG8_BAR;
    } else {
        PG8_STAGE(PG8_SB(0, 0), cB, voffB); PG8_STAGE(PG8_SA(0, 0), cA, voffA); PG8_STAGE(PG8_SB(0, 1), cB + hstep, voffB); PG8_STAGE(PG8_SA(0, 1), cA + hstep, voffA);
        if (wr == 1) PG8_BAR;
        PG8_WAIT_V(4); PG8_BAR;
        PG8_STAGE(PG8_SB(1, 0), cB + kstep, voffB); PG8_STAGE(PG8_SA(1, 0), cA + kstep, voffA); PG8_STAGE(PG8_SB(1, 1), cB + hstep + kstep, voffB);
        PG8_WAIT_V(6); PG8_BAR;
    }
    for (;;) {
        const bool has_next = S.next(ui + 1, nxt);
        const char* nA = has_next ? (const char*)g.A + (size_t)nxt.pm * tstep : cA; const char* nB = has_next ? (const char*)g.Bt + (size_t)nxt.pn * tstep : cB;
        for (int t = 0; t < nt; t += 2) {
            const bool last = (t == nt - 2);
            const char* a1 = cA + (size_t)(t + 1) * kstep;
            const char* a2 = last ? nA : cA + (size_t)(t + 2) * kstep; const char* b2 = last ? nB : cB + (size_t)(t + 2) * kstep;
            const char* a3 = a2 + kstep; const char* b3 = b2 + kstep;
            if (last && has_next) S.a_ready(nxt);
            if constexpr (SP2) {
            PG8_LDB(B0, 0, 0); PG8_LDB(B1, 0, 1); PG8_SCHED; PG8_LDA(At, 0, 0); PG8_STAGE(PG8_SA(1, 1), a1 + hstep, voffA);
            PG8_WAIT_V(8); PG8_WAIT_L(0); PG8_BAR; PG8_MMA(0, 0, At, B0); PG8_MMA(0, 1, At, B1); PG8_BAR; PG8_SCHED;
            PG8_LDA(At, 0, 1); PG8_STAGE(PG8_SB(0, 0), b2, voffB); PG8_STAGE(PG8_SB(0, 1), b2 + hstep, voffB); PG8_STAGE(PG8_SA(0, 0), a2, voffA);
            PG8_WAIT_V(8); PG8_WAIT_L(0); PG8_BAR; PG8_MMA(1, 0, At, B0); PG8_MMA(1, 1, At, B1); PG8_BAR; PG8_SCHED;
            PG8_LDB(B0, 1, 0); PG8_LDB(B1, 1, 1); PG8_SCHED; PG8_LDA(At, 1, 0); PG8_STAGE(PG8_SA(0, 1), a2 + hstep, voffA);
            PG8_WAIT_V(8); PG8_WAIT_L(0); PG8_BAR; PG8_MMA(0, 0, At, B0); PG8_MMA(0, 1, At, B1); PG8_BAR; PG8_SCHED;
            PG8_LDA(At, 1, 1); PG8_STAGE(PG8_SB(1, 0), b3, voffB); PG8_STAGE(PG8_SB(1, 1), b3 + hstep, voffB); PG8_STAGE(PG8_SA(1, 0), a3, voffA);
            PG8_WAIT_V(8); PG8_WAIT_L(0); PG8_BAR; PG8_MMA(1, 0, At, B0); PG8_MMA(1, 1, At, B1); PG8_BAR; PG8_SCHED;
            } else {
            PG8_LDB(B0, 0, 0); PG8_SCHED; PG8_LDA(At, 0, 0); PG8_STAGE(PG8_SA(1, 1), a1 + hstep, voffA);
            PG8_WAIT_L(8); PG8_BAR; PG8_WAIT_L(0); PG8_MMA(0, 0, At, B0); PG8_BAR; PG8_SCHED;
            PG8_LDB(B1, 0, 1); PG8_STAGE(PG8_SB(0, 0), b2, voffB);
            PG8_BAR; PG8_WAIT_L(0); PG8_MMA(0, 1, At, B1); PG8_BAR;
            PG8_LDA(At, 0, 1); PG8_STAGE(PG8_SA(0, 0), a2, voffA);
            PG8_BAR; PG8_WAIT_L(0); PG8_MMA(1, 0, At, B0); PG8_BAR; PG8_SCHED;
            PG8_STAGE(PG8_SB(0, 1), b2 + hstep, voffB);
            PG8_WAIT_V(6); PG8_BAR; PG8_MMA(1, 1, At, B1); PG8_BAR;
            PG8_LDB(B0, 1, 0); PG8_SCHED; PG8_LDA(At, 1, 0); PG8_STAGE(PG8_SA(0, 1), a2 + hstep, voffA);
            PG8_WAIT_L(8); PG8_BAR; PG8_WAIT_L(0); PG8_MMA(0, 0, At, B0); PG8_BAR; PG8_SCHED;
            PG8_LDB(B1, 1, 1); PG8_STAGE(PG8_SB(1, 0), b3, voffB);
            PG8_BAR; PG8_WAIT_L(0); PG8_MMA(0, 1, At, B1); PG8_BAR;
            PG8_LDA(At, 1, 1); PG8_STAGE(PG8_SA(1, 0), a3, voffA);
            PG8_BAR; PG8_WAIT_L(0); PG8_MMA(1, 0, At, B0); PG8_BAR; PG8_SCHED;
            PG8_STAGE(PG8_SB(1, 1), b3 + hstep, voffB);
            PG8_WAIT_V(6); PG8_BAR; PG8_MMA(1, 1, At, B1); PG8_BAR;
            }
        }
        if constexpr (ALIGN_EPI) { if (wr == 0) PG8_BAR; }
        if constexpr (!Epi::AFTER_DRAIN) { E(acc, cur, wr, wc, fr, fq); S.done(cur); }
        if (!has_next) break;
#pragma unroll
        for (int a = 0; a < 2; ++a)
#pragma unroll
            for (int b = 0; b < 2; ++b)
#pragma unroll
                for (int m = 0; m < 4; ++m)
#pragma unroll
                    for (int n = 0; n < 2; ++n) acc[a][b][m][n] = (f32x4){0.f, 0.f, 0.f, 0.f};
        cur = nxt; cA = nA; cB = nB; ++ui;
        if constexpr (ALIGN_EPI) { if (wr == 1) PG8_BAR; }
    }
    PG8_WAIT_V(0);
    if constexpr (!ALIGN_EPI) { if (wr == 0) PG8_BAR; }
    PG8_BAR;
    if constexpr (Epi::AFTER_DRAIN) { E.fused(acc, cur, wr, wc, fr, fq, lds, wid, lane); S.done(cur); }
#undef PG8_SA
#undef PG8_SB
#undef PG8_STAGE
#undef PG8_LDA
#undef PG8_LDB
#undef PG8_MMA
#undef PG8_WAIT_V
#undef PG8_WAIT_L
#undef PG8_BAR
#undef PG8_SCHED
}
}
#define XB_TMO      128
#define XB_XCNT(j)  (256  + 64 * (j))
#define XB_XSUB(j)  (1280 + 64 * (j))
#define XB_XGEN(j)  (2304 + 64 * (j))
#define XB_TOP      3328
#define XB_TOPGEN   3392
#define XCD_BAR_WORDS 3456
#define XB_SPIN_CAP (1u << 18)

__device__ __forceinline__ unsigned xb_ld(unsigned* p)              { return __hip_atomic_load(p, __ATOMIC_RELAXED, __HIP_MEMORY_SCOPE_AGENT); }
__device__ __forceinline__ unsigned xb_add(unsigned* p, unsigned v) { return __hip_atomic_fetch_add(p, v, __ATOMIC_RELAXED, __HIP_MEMORY_SCOPE_AGENT); }
__device__ __forceinline__ unsigned xb_xcc_id() { return (unsigned)__builtin_amdgcn_s_getreg((3 << 11) | 20) & 0xFu; }
#define XB_SPIN(cond, bar) do { unsigned _sp = 0; while (cond) { __builtin_amdgcn_s_sleep(1); \
    if ((++_sp & 255u) == 0u) { if (xb_ld(&(bar)[XB_TMO])) break; if (_sp > XB_SPIN_CAP) { atomicAdd(&(bar)[XB_TMO], 1u); break; } } } } while (0)

struct XcdBarrier {
    unsigned* bar; unsigned x;
    volatile LAS unsigned* st;
};

__device__ __forceinline__ XcdBarrier xcd_barrier_post(unsigned* bar, volatile LAS unsigned* st) {
    XcdBarrier b; b.bar = bar; b.x = xb_xcc_id(); b.st = st;
    if (threadIdx.x == 0) (void)xb_add(&bar[XB_XCNT(b.x)], 1u);
    return b;
}
__device__ __forceinline__ void xcd_barrier_complete(unsigned* bar, unsigned x, unsigned& nloc, unsigned& nx) {
    const unsigned G = gridDim.x * gridDim.y * gridDim.z;
    unsigned sum, cnt, mine, sp = 0u;
    for (;;) {
        sum = 0u; cnt = 0u; mine = 0u;
#pragma unroll
        for (unsigned j = 0; j < 16; ++j) { const unsigned c = xb_ld(&bar[XB_XCNT(j)]); sum += c; cnt += (c > 0u) ? 1u : 0u; mine = (j == x) ? c : mine; }
        if (sum == G) break;
        __builtin_amdgcn_s_sleep(1);
        if ((++sp & 255u) == 0u) { if (xb_ld(&bar[XB_TMO])) break; if (sp > XB_SPIN_CAP) { atomicAdd(&bar[XB_TMO], 1u); break; } }
    }
    nloc = mine > 0u ? mine : 1u; nx = cnt > 0u ? cnt : 1u;
}

__device__ __forceinline__ void xcd_barrier(const XcdBarrier& b) {
    asm volatile("s_waitcnt vmcnt(0)" ::: "memory");
    __syncthreads();
    if (threadIdx.x == 0) {
        unsigned* bar = b.bar;
        __builtin_amdgcn_s_waitcnt(0);
        unsigned nloc = b.st[0], nx = b.st[1];
        if (nloc == 0u) { xcd_barrier_complete(bar, b.x, nloc, nx); b.st[0] = nloc; b.st[1] = nx; }
        const unsigned old = xb_add(&bar[XB_XSUB(b.x)], 1u);
        const unsigned gen = old / nloc;
        if (old + 1u == (gen + 1u) * nloc) {
            __builtin_amdgcn_fence(__ATOMIC_RELEASE, "agent");
            asm volatile("s_waitcnt vmcnt(0)" ::: "memory");
            const unsigned og = xb_add(&bar[XB_TOP], 1u);
            const unsigned tg = og / nx;
            if (og + 1u == (tg + 1u) * nx) xb_add(&bar[XB_TOPGEN], 1u);
            else XB_SPIN(xb_ld(&bar[XB_TOPGEN]) == tg, bar);
            __builtin_amdgcn_fence(__ATOMIC_ACQUIRE, "agent");
            xb_add(&bar[XB_XGEN(b.x)], 1u);
            asm volatile("s_waitcnt vmcnt(0)" ::: "memory");
        } else {
            XB_SPIN(xb_ld(&bar[XB_XGEN(b.x)]) == gen, bar);
            __builtin_amdgcn_fence(__ATOMIC_ACQUIRE, "agent");
            asm volatile("s_waitcnt vmcnt(0)" ::: "memory");
        }
    }
    __syncthreads();
}

struct EpiStoreBf16 {
    static constexpr bool PERM = true, AFTER_DRAIN = false;
    bf16* O; int ldc; int pn_mask;
    __device__ __forceinline__ void operator()(const pg8::f32x4 (&acc)[2][2][4][2], const pg8::Unit& u, int wr, int wc, int fr_, int fq_) const {
        int t_ = threadIdx.x; asm volatile("" : "+v"(t_)); const int fr = t_ & 15, fq = (t_ >> 4) & 3; (void)fr_; (void)fq_;
        const int row0 = u.pm * 256 + wr * 64 + fr, col0 = (u.pn & pn_mask) * 256 + wc * 32 + 8 * fq;
#pragma unroll
        for (int ai = 0; ai < 2; ++ai)
#pragma unroll
            for (int m = 0; m < 4; ++m) { bf16* rowp = O + (size_t)(row0 + ai * 128 + m * 16) * ldc + col0;
#pragma unroll
                for (int bj = 0; bj < 2; ++bj) { const pg8::f32x4 v0 = acc[ai][bj][m][0], v1 = acc[ai][bj][m][1];
                    v4u w; w.x = pg8::cvt_pk_bf16(v0[0], v0[1]); w.y = pg8::cvt_pk_bf16(v0[2], v0[3]); w.z = pg8::cvt_pk_bf16(v1[0], v1[1]); w.w = pg8::cvt_pk_bf16(v1[2], v1[3]);
                    *(v4u*)(rowp + bj * 128) = w; } }
    }
};
struct EpiProj {
    static constexpr bool PERM = true, AFTER_DRAIN = false;
    bf16* HM; bf16* PLR;
    __device__ __forceinline__ void operator()(const pg8::f32x4 (&acc)[2][2][4][2], const pg8::Unit& u, int wr, int wc, int fr_, int fq_) const {
        int t_ = threadIdx.x; asm volatile("" : "+v"(t_)); const int fr = t_ & 15, fq = (t_ >> 4) & 3; (void)fr_; (void)fq_;
        const int row0 = u.pm * 256 + wr * 64 + fr, colb = u.pn * 256 + wc * 32 + 8 * fq;
#pragma unroll
        for (int bj = 0; bj < 2; ++bj) { const int idx = colb + bj * 128;
            if (idx >= PROJW) continue;
            const bool lora = idx >= 6144;
            const size_t hbase = (size_t)(idx >> 10) * HM_PART + (size_t)((idx >> 6) & 15) * HM_HEAD + (idx & 63);
#pragma unroll
            for (int ai = 0; ai < 2; ++ai)
#pragma unroll
                for (int m = 0; m < 4; ++m) { const int row = row0 + ai * 128 + m * 16;
                    bf16* dst = lora ? PLR + (size_t)row * 288 + (idx - 6144) : HM + hbase + (size_t)(row >> 12) * HM_BATCH + (size_t)(row & (SEQ - 1)) * HD;
                    const pg8::f32x4 v0 = acc[ai][bj][m][0], v1 = acc[ai][bj][m][1];
                    v4u w; w.x = pg8::cvt_pk_bf16(v0[0], v0[1]); w.y = pg8::cvt_pk_bf16(v0[2], v0[3]); w.z = pg8::cvt_pk_bf16(v1[0], v1[1]); w.w = pg8::cvt_pk_bf16(v1[2], v1[3]);
                    *(v4u*)dst = w; } }
    }
};
struct EpiGateUp {
    static constexpr bool PERM = true, AFTER_DRAIN = false;
    const float* sw; bf16* HG;
    __device__ __forceinline__ void operator()(const pg8::f32x4 (&acc)[2][2][4][2], const pg8::Unit& u, int wr, int wc, int fr_, int fq_) const {
        int t_ = threadIdx.x; asm volatile("" : "+v"(t_)); const int fr = t_ & 15, fq = (t_ >> 4) & 3; (void)fr_; (void)fq_;
        const int pl = u.pn & 3, row0 = u.pm * 256 + wr * 64 + fr, col0 = pl * 128 + wc * 32 + 8 * fq;
#pragma unroll
        for (int ai = 0; ai < 2; ++ai)
#pragma unroll
            for (int m = 0; m < 4; ++m) { const int row = row0 + ai * 128 + m * 16; const float w = sw[row]; float h[8];
#pragma unroll
                for (int n = 0; n < 2; ++n)
#pragma unroll
                    for (int j = 0; j < 4; ++j) { const float g = acc[ai][0][m][n][j], up = acc[ai][1][m][n][j]; h[4 * n + j] = g * sigmoid_f(g) * up * w; }
                v4u o; o.x = pg8::cvt_pk_bf16(h[0], h[1]); o.y = pg8::cvt_pk_bf16(h[2], h[3]); o.z = pg8::cvt_pk_bf16(h[4], h[5]); o.w = pg8::cvt_pk_bf16(h[6], h[7]);
                *(v4u*)(HG + (size_t)row * FF + col0) = o; }
    }
};
struct EpiResGate {
    static constexpr bool PERM = true, AFTER_DRAIN = false;
    const float* x; const float* gate; bf16* X1;
    __device__ __forceinline__ void operator()(const pg8::f32x4 (&acc)[2][2][4][2], const pg8::Unit& u, int wr, int wc, int fr_, int fq_) const {
        int t_ = threadIdx.x; asm volatile("" : "+v"(t_)); const int fr = t_ & 15, fq = (t_ >> 4) & 3; (void)fr_; (void)fq_;
        const int row0 = u.pm * 256 + wr * 64 + fr, col0 = u.pn * 256 + wc * 32 + 8 * fq;
        const float* gp = gate + (size_t)((u.pm * 256) >> 12) * 12288;
#pragma unroll
        for (int bj = 0; bj < 2; ++bj) { const int c = col0 + bj * 128; const pg8::f32x4 g0 = *(const pg8::f32x4*)(gp + c), g1 = *(const pg8::f32x4*)(gp + c + 4);
#pragma unroll
            for (int ai = 0; ai < 2; ++ai)
#pragma unroll
                for (int m = 0; m < 4; ++m) { const size_t off = (size_t)(row0 + ai * 128 + m * 16) * DM + c;
                    const pg8::f32x4 x0 = *(const pg8::f32x4*)(x + off) + g0 * acc[ai][bj][m][0], x1 = *(const pg8::f32x4*)(x + off + 4) + g1 * acc[ai][bj][m][1];
                    v4u w; w.x = pg8::cvt_pk_bf16(x0[0], x0[1]); w.y = pg8::cvt_pk_bf16(x0[2], x0[3]); w.z = pg8::cvt_pk_bf16(x1[0], x1[1]); w.w = pg8::cvt_pk_bf16(x1[2], x1[3]);
                    *(v4u*)(X1 + off) = w; } }
    }
};
struct EpiLora {
    static constexpr bool PERM = false, AFTER_DRAIN = false;
    float* LW; bf16* AA; bf16* GG;
    __device__ __forceinline__ void operator()(const pg8::f32x4 (&acc)[2][2][4][2], const pg8::Unit& u, int wr, int wc, int fr_, int fq_) const {
        int t_ = threadIdx.x; asm volatile("" : "+v"(t_)); const int fr = t_ & 15, fq = (t_ >> 4) & 3; (void)fr_; (void)fq_;
        const int type = u.pn >> 2, row0 = u.pm * 256 + wr * 64 + fr, col0 = (u.pn & 3) * 256 + wc * 32 + 4 * fq;
        bf16* hb = (type == 1) ? AA : GG;
#pragma unroll
        for (int bj = 0; bj < 2; ++bj)
#pragma unroll
            for (int n = 0; n < 2; ++n) { const int c = col0 + bj * 128 + n * 16;
#pragma unroll
                for (int ai = 0; ai < 2; ++ai)
#pragma unroll
                    for (int m = 0; m < 4; ++m) { const size_t off = (size_t)(row0 + ai * 128 + m * 16) * CW + c; const pg8::f32x4 v = acc[ai][bj][m][n];
                        if (type == 0) *(pg8::f32x4*)(LW + off) = v;
                        else { v2u o; o.x = pg8::cvt_pk_bf16(v[0], v[1]); o.y = pg8::cvt_pk_bf16(v[2], v[3]); *(v2u*)(hb + off) = o; } } }
    }
};
struct GroupOrder {
    const unsigned* te; int nrt, ncol, G, c;
    __device__ __forceinline__ bool next(int i, pg8::Unit& u) const {
        const long L = (long)i * G + c; if (L >= (long)nrt * ncol) return false;
        const int rt = (int)(L / ncol), pl = (int)(L - (long)rt * ncol);
        u.pm = rt; u.pn = (int)te[rt] * ncol + pl; return true;
    }
    __device__ __forceinline__ void a_ready(const pg8::Unit&) const {}
    __device__ __forceinline__ void done(const pg8::Unit&) const {}
};

struct GroupOrder2 {
    const unsigned* te; int ncol, base, count, Gp, cp;
    __device__ __forceinline__ bool next(int i, pg8::Unit& u) const {
        const long k = (long)i * Gp + cp; if (cp < 0 || k >= count) return false;
        const int L = base + (int)k, rt = L / ncol, pl = L - rt * ncol;
        u.pm = rt; u.pn = (int)te[rt] * ncol + pl; return true;
    }
    __device__ __forceinline__ void a_ready(const pg8::Unit&) const {}
    __device__ __forceinline__ void done(const pg8::Unit&) const {}
};

#define MFMA16(a, b, c) __builtin_amdgcn_mfma_f32_16x16x16bf16_1k(a, b, c, 0, 0, 0)
constexpr int NUNIT = BATCH * NHEAD * (SEQ / 64);
constexpr int LA_GF = 0, LA_SEG = 16384, LA_PL = 18432, LA_RT = 20480, LA_QT = 28672, LA_KT = 36864, LA_BT = 45056, LA_VT = 53248,
              LA_AQB = 61440, LA_AQK = 69632, LA_ARB = 77824, LA_ARK = 86016, LA_DG = 94208, LA_DL = 98304, LA_PRM = 100352;
__device__ __forceinline__ int swz(int row, int chunk) { return row * 128 + ((chunk ^ ((row >> 1) & 7)) << 4); }
__device__ __forceinline__ s16x4 tr_read(LAS unsigned char* base, int r0, int cb, int n) {
    return __builtin_bit_cast(s16x4, __builtin_amdgcn_ds_read_tr16_b64_v4i16((LAS s16x4*)(base + swz(r0 + (n >> 2), 2 * cb + ((n & 3) >> 1)) + 8 * (n & 1)))); }
__device__ __forceinline__ s16x4 row_read4(LAS unsigned char* base, int row, int col0) {
    return *(const LAS s16x4*)(base + swz(row, col0 >> 3) + 2 * (col0 & 7)); }
__device__ __forceinline__ s16x4 pack4(const f32x4 v) { v2u w; w.x = pk2(v[0], v[1]); w.y = pk2(v[2], v[3]); return __builtin_bit_cast(s16x4, w); }
__device__ __forceinline__ s16x4 pack4n(const f32x4 v) { v2u w; w.x = pk2(-v[0], -v[1]); w.y = pk2(-v[2], -v[3]); return __builtin_bit_cast(s16x4, w); }
__device__ __forceinline__ f32x4 unpack4(const s16x4 s) { const v2u w = __builtin_bit_cast(v2u, s); return (f32x4){bflo(w.x), bfhi(w.x), bflo(w.y), bfhi(w.y)}; }

#define LGKM0() do { asm volatile("s_waitcnt lgkmcnt(0)" ::: "memory"); __builtin_amdgcn_sched_barrier(0); } while (0)
#define LDS_BARRIER() do { asm volatile("s_waitcnt lgkmcnt(0)" ::: "memory"); __builtin_amdgcn_s_barrier(); asm volatile("" ::: "memory"); } while (0)
__device__ __forceinline__ void scanA(const Args& a, LAS unsigned char* lds) {
    const int tid = threadIdx.x, lane = tid & 63, wave = __builtin_amdgcn_readfirstlane(tid >> 6), n = lane & 15, g = lane >> 4;
    LAS float* GF = (LAS float*)(lds + LA_GF); LAS float* SEG = (LAS float*)(lds + LA_SEG); LAS float* PLs = (LAS float*)(lds + LA_PL); LAS float* DG = (LAS float*)(lds + LA_DG);
    const int tk = tid >> 3, c8 = 8 * (tid & 7);
    v4u nr4, nk4, nv4, pr4, pk4, pv4, na4; f32x4 nl0, nl1;
#define SCANA_LOAD(U) do { const int bh_ = (U) >> 6, ck_ = (U) & 63, h_ = bh_ & 15; const size_t m_ = (size_t)(bh_ >> 4) * SEQ + 64 * ck_ + tk; \
        const bf16* pc_ = (const bf16*)(a.ws + WS_P) + (size_t)(bh_ >> 4) * HM_BATCH + (size_t)h_ * HM_HEAD + (size_t)(64 * ck_ + tk) * HD + c8; const bf16* pp_ = pc_ - ((64 * ck_ + tk) != 0 ? HD : 0); \
        nr4 = *(const v4u*)pc_; nk4 = *(const v4u*)(pc_ + HM_PART); nv4 = *(const v4u*)(pc_ + 2 * HM_PART); pr4 = *(const v4u*)pp_; pk4 = *(const v4u*)(pp_ + HM_PART); pv4 = *(const v4u*)(pp_ + 2 * HM_PART); \
        const size_t off_ = m_ * CW + h_ * 64 + c8; na4 = *(const v4u*)((const bf16*)(a.ws + WS_AA) + off_); \
        nl0 = *(const f32x4*)((const float*)(a.ws + WS_LW) + off_); nl1 = *(const f32x4*)((const float*)(a.ws + WS_LW) + off_ + 4); } while (0)
#define SCANA_UNIT(IDX) (((((IDX) >> 10) * 16 + ((IDX) & 15)) << 6) + (((IDX) >> 4) & 63))
    if ((int)blockIdx.x < NUNIT) SCANA_LOAD(SCANA_UNIT((int)blockIdx.x));
    STAMP_DECL;
    LAS float* PRM = (LAS float*)(lds + LA_PRM);
    int hcur = -1;
    for (int idx = blockIdx.x; idx < NUNIT; idx += gridDim.x) {
        const int unit = SCANA_UNIT(idx);
        int tid_o = threadIdx.x; asm volatile("" : "+v"(tid_o));
        const int tid = tid_o, lane = tid & 63, n = lane & 15, g = lane >> 4, tk = tid >> 3, c8 = 8 * (tid & 7);
        STAMP_BEGIN(5); STAMP_BEGIN(1);
        const int h = (unit >> 6) & 15, ch0 = h * 64 + c8; const bool first = ((unit & 63) == 0) && (tk == 0);
        if (h != hcur) { hcur = h;
            if (tid < 448) { const int which = tid >> 6, c = tid & 63; const float* src = (which == 0) ? a.in[I_MU] : (which == 1) ? a.in[I_MU] + 1024 : (which == 2) ? a.in[I_MU] + 2048 :
                    (which == 3) ? a.in[I_A0] : (which == 4) ? a.in[I_KK] : (which == 5) ? a.in[I_KA] : a.in[I_W0];
                PRM[tid] = src[h * 64 + c]; }
            LDS_BARRIER(); }
        float pmr[8], pmk[8], pmv[8], pa0[8], pkk[8], pka[8], pw0[8];
        { f32x4 pv[14];
#pragma unroll
          for (int q = 0; q < 7; ++q) { pv[2 * q] = *(const LAS f32x4*)(PRM + 64 * q + c8); pv[2 * q + 1] = *(const LAS f32x4*)(PRM + 64 * q + c8 + 4); }
          LGKM0();
#pragma unroll
          for (int i = 0; i < 8; ++i) { pmr[i] = pv[0 + (i >> 2)][i & 3]; pmk[i] = pv[2 + (i >> 2)][i & 3]; pmv[i] = pv[4 + (i >> 2)][i & 3]; pa0[i] = pv[6 + (i >> 2)][i & 3];
              pkk[i] = pv[8 + (i >> 2)][i & 3]; pka[i] = pv[10 + (i >> 2)][i & 3]; pw0[i] = pv[12 + (i >> 2)][i & 3]; } }
        float rf[8], kf[8], vf8[8], qf8[8], bf8[8]; f32x4 l0, l1;
        { float av[8], kkv[8]; float ssq = 0.f;
#pragma unroll
          for (int i = 0; i < 8; ++i) { const int wd = i >> 1; const bool hi = i & 1;
              const float cr = hi ? bfhi(nr4[wd]) : bflo(nr4[wd]), ckk = hi ? bfhi(nk4[wd]) : bflo(nk4[wd]), cv = hi ? bfhi(nv4[wd]) : bflo(nv4[wd]);
              const float qr = first ? 0.f : (hi ? bfhi(pr4[wd]) : bflo(pr4[wd])), qk = first ? 0.f : (hi ? bfhi(pk4[wd]) : bflo(pk4[wd])), qv = first ? 0.f : (hi ? bfhi(pv4[wd]) : bflo(pv4[wd]));
              rf[i] = cr + (qr - cr) * pmr[i]; kf[i] = ckk + (qk - ckk) * pmk[i]; vf8[i] = cv + (qv - cv) * pmv[i];
              av[i] = sigmoid_f((hi ? bfhi(na4[wd]) : bflo(na4[wd])) + pa0[i]);
              kkv[i] = kf[i] * pkk[i]; ssq += kkv[i] * kkv[i]; }
          ssq += __shfl_xor(ssq, 1); ssq += __shfl_xor(ssq, 2); ssq += __shfl_xor(ssq, 4);
          const float inv = __builtin_amdgcn_rsqf(fmaxf(ssq, 1e-24f));
#pragma unroll
          for (int i = 0; i < 8; ++i) { qf8[i] = kkv[i] * inv; bf8[i] = qf8[i] * av[i]; kf[i] = kf[i] * (1.f + (av[i] - 1.f) * pka[i]); }
#pragma unroll
          for (int i = 0; i < 4; ++i) { const float z0 = -(nl0[i] + pw0[i]), z1 = -(nl1[i] + pw0[4 + i]);
              const float s0 = fmaxf(z0, 0.f) + __logf(1.f + __expf(-fabsf(z0))), s1 = fmaxf(z1, 0.f) + __logf(1.f + __expf(-fabsf(z1)));
              l0[i] = -__expf(-s0 - 0.5f); l1[i] = -__expf(-s1 - 0.5f); }
          const size_t off = ((size_t)(unit >> 10) * SEQ + 64 * (unit & 63) + tk) * CW + ch0; v4u w;
          w.x = pk2(rf[0], rf[1]); w.y = pk2(rf[2], rf[3]); w.z = pk2(rf[4], rf[5]); w.w = pk2(rf[6], rf[7]); *(v4u*)((bf16*)(a.ws + WS_R) + off) = w;
          w.x = pk2(kf[0], kf[1]); w.y = pk2(kf[2], kf[3]); w.z = pk2(kf[4], kf[5]); w.w = pk2(kf[6], kf[7]); *(v4u*)((bf16*)(a.ws + WS_K2) + off) = w;
          w.x = pk2(vf8[0], vf8[1]); w.y = pk2(vf8[2], vf8[3]); w.z = pk2(vf8[4], vf8[5]); w.w = pk2(vf8[6], vf8[7]); *(v4u*)((bf16*)(a.ws + WS_V) + off) = w; }
        *(LAS f32x4*)(GF + tk * 64 + c8) = l0; *(LAS f32x4*)(GF + tk * 64 + c8 + 4) = l1;
        LDS_BARRIER();
        { const int c = tid & 63, sg = tid >> 6; float gv[8], run = 0.f;
#pragma unroll
          for (int i = 0; i < 8; ++i) gv[i] = GF[(8 * sg + i) * 64 + c];
          LGKM0();
#pragma unroll
          for (int i = 0; i < 8; ++i) { run += gv[i]; GF[(8 * sg + i) * 64 + c] = run; }
          SEG[sg * 64 + c] = run; }
        LDS_BARRIER();
        { const int sg = tk >> 3; float gg[8], lw[8];
          f32x4 gq[2], sq[7][2];
          gq[0] = *(const LAS f32x4*)(GF + tk * 64 + c8); gq[1] = *(const LAS f32x4*)(GF + tk * 64 + c8 + 4);
#pragma unroll
          for (int s2 = 0; s2 < 7; ++s2) { sq[s2][0] = *(const LAS f32x4*)(SEG + s2 * 64 + c8); sq[s2][1] = *(const LAS f32x4*)(SEG + s2 * 64 + c8 + 4); }
          LGKM0();
#pragma unroll
          for (int i = 0; i < 8; ++i) { float x = gq[i >> 2][i & 3];
#pragma unroll
              for (int s2 = 0; s2 < 7; ++s2) x += (s2 < sg) ? sq[s2][i >> 2][i & 3] : 0.f;
              gg[i] = x; lw[i] = (i < 4) ? l0[i] : l1[i - 4]; }
          float rr[8], qq[8], kk[8], bb[8];
#pragma unroll
          for (int i = 0; i < 4; ++i) { const int e0 = 2 * i, e1 = 2 * i + 1;
              const float eg0 = __expf(gg[e0]), eg1 = __expf(gg[e1]), en0 = __expf(-gg[e0]), en1 = __expf(-gg[e1]), em0 = __expf(gg[e0] - lw[e0]), em1 = __expf(gg[e1] - lw[e1]);
              rr[e0] = rf[e0] * eg0; rr[e1] = rf[e1] * eg1; qq[e0] = qf8[e0] * em0; qq[e1] = qf8[e1] * em1;
              kk[e0] = kf[e0] * en0; kk[e1] = kf[e1] * en1; bb[e0] = bf8[e0] * en0; bb[e1] = bf8[e1] * en1;
              if (tk == 63) { PLs[c8 + e0] = eg0; PLs[c8 + e1] = eg1; } }
          const int so = swz(tk, tid & 7); v4u w;
          w.x = pk2(rr[0], rr[1]); w.y = pk2(rr[2], rr[3]); w.z = pk2(rr[4], rr[5]); w.w = pk2(rr[6], rr[7]); *(LAS v4u*)(lds + LA_RT + so) = w;
          w.x = pk2(qq[0], qq[1]); w.y = pk2(qq[2], qq[3]); w.z = pk2(qq[4], qq[5]); w.w = pk2(qq[6], qq[7]); *(LAS v4u*)(lds + LA_QT + so) = w;
          w.x = pk2(kk[0], kk[1]); w.y = pk2(kk[2], kk[3]); w.z = pk2(kk[4], kk[5]); w.w = pk2(kk[6], kk[7]); *(LAS v4u*)(lds + LA_KT + so) = w;
          w.x = pk2(bb[0], bb[1]); w.y = pk2(bb[2], bb[3]); w.z = pk2(bb[4], bb[5]); w.w = pk2(bb[6], bb[7]); *(LAS v4u*)(lds + LA_BT + so) = w;
          w.x = pk2(vf8[0], vf8[1]); w.y = pk2(vf8[2], vf8[3]); w.z = pk2(vf8[4], vf8[5]); w.w = pk2(vf8[6], vf8[7]); *(LAS v4u*)(lds + LA_VT + so) = w; }
        LDS_BARRIER();
        STAMP_END(1); STAMP_BEGIN(2);
        if (idx + (int)gridDim.x < NUNIT) SCANA_LOAD(SCANA_UNIT(idx + (int)gridDim.x));
        for (int id = wave; id < 40; id += NWAVES) {
            const int mat = id / 10, p = id - mat * 10, tb = p < 1 ? 0 : (p < 3 ? 1 : (p < 6 ? 2 : 3)), sb = p - tb * (tb + 1) / 2;
            LAS unsigned char* Lft = lds + ((mat & 1) ? LA_KT : LA_BT); LAS unsigned char* Rgt = lds + ((mat & 2) ? LA_RT : LA_QT);
            f32x4 acc = (f32x4){0.f, 0.f, 0.f, 0.f};
#pragma unroll
            for (int ks = 0; ks < 2; ++ks) { const bf16x8 af = *(const LAS bf16x8*)(Lft + swz(16 * sb + n, 4 * ks + g)), bfr = *(const LAS bf16x8*)(Rgt + swz(16 * tb + n, 4 * ks + g));
                acc = __builtin_amdgcn_mfma_f32_16x16x32_bf16(af, bfr, acc, 0, 0, 0); }
            const int t = 16 * tb + n, s0 = 16 * sb + 4 * g;
#pragma unroll
            for (int j = 0; j < 4; ++j) { const bool keep = (mat & 2) ? (s0 + j <= t) : (s0 + j < t); if (!keep) acc[j] = 0.f; }
            LAS unsigned char* dst = lds + (mat == 0 ? LA_AQB : (mat == 1 ? LA_AQK : (mat == 2 ? LA_ARB : LA_ARK)));
            v2u w; w.x = pk2(acc[0], acc[1]); w.y = pk2(acc[2], acc[3]);
            *(LAS v2u*)(dst + swz(t, s0 >> 3) + 2 * (s0 & 7)) = w;
            if (mat == 0 && sb == tb) *(LAS f32x4*)(DG + tb * 256 + n * 16 + 4 * g) = acc;
        }
        LDS_BARRIER();
        STAMP_END(2); STAMP_BEGIN(3);
        const bool isU = wave >= 4; const int cb = wave & 3;
        LAS unsigned char* AQB = lds + LA_AQB; LAS unsigned char* AQK = lds + LA_AQK; LAS unsigned char* ARB = lds + LA_ARB; LAS unsigned char* ARK = lds + LA_ARK;
        s16x4 vf[4], xn[4], fqb[6], frb[10], fbt[16];
        f32x4 rhs[4], y1a[4], hma[4], rti[4];
        if (isU) {
            s16x4 fqk[10], frk[10], fkt[16];
#pragma unroll
            for (int k = 0; k < 4; ++k) vf[k] = tr_read(lds + LA_VT, 16 * k + 4 * g, cb, n);
#pragma unroll
            for (int i = 0; i < 4; ++i)
#pragma unroll
                for (int k = 0; k < 4; ++k) { if (k <= i) { fqk[i * (i + 1) / 2 + k] = row_read4(AQK, 16 * i + n, 16 * k + 4 * g); frk[i * (i + 1) / 2 + k] = row_read4(ARK, 16 * i + n, 16 * k + 4 * g); }
                    fkt[4 * i + k] = tr_read(lds + LA_KT, 16 * k + 4 * g, i, n); }
            LGKM0();
#pragma unroll
            for (int i = 0; i < 4; ++i) { f32x4 acc = (f32x4){0.f, 0.f, 0.f, 0.f}, ac2 = acc, ac3 = acc;
#pragma unroll
                for (int k = 0; k < 4; ++k) { if (k <= i) { acc = MFMA16(fqk[i * (i + 1) / 2 + k], vf[k], acc); ac2 = MFMA16(frk[i * (i + 1) / 2 + k], vf[k], ac2); }
                    ac3 = MFMA16(vf[k], fkt[4 * i + k], ac3); }
                rhs[i] = acc; y1a[i] = ac2; hma[i] = ac3; rti[i] = acc; }
        } else {
            if (lane < 16) {
                const LAS float* A = DG + wave * 256; float x[16]; f32x4 ar[16][4];
                int lj = lane; asm volatile("" : "+v"(lj));
                x[0] = (lj == 0) ? 1.f : 0.f;
#pragma unroll
                for (int t = 1; t < 9; ++t)
#pragma unroll
                    for (int q = 0; q < 4; ++q) if (4 * q < t) ar[t][q] = *(const LAS f32x4*)(A + t * 16 + 4 * q);
                LGKM0();
#pragma unroll
                for (int t = 1; t < 9; ++t) { float a0 = (t == lj) ? 1.f : 0.f, a1 = 0.f;
#pragma unroll
                    for (int s2 = 0; s2 < t; ++s2) { if (s2 & 1) a1 -= ar[t][s2 >> 2][s2 & 3] * x[s2]; else a0 -= ar[t][s2 >> 2][s2 & 3] * x[s2]; }
                    x[t] = a0 + a1; }
#pragma unroll
                for (int t = 9; t < 13; ++t)
#pragma unroll
                    for (int q = 0; q < 4; ++q) if (4 * q < t) ar[t][q] = *(const LAS f32x4*)(A + t * 16 + 4 * q);
                LGKM0();
#pragma unroll
                for (int t = 9; t < 13; ++t) { float a0 = (t == lj) ? 1.f : 0.f, a1 = 0.f;
#pragma unroll
                    for (int s2 = 0; s2 < t; ++s2) { if (s2 & 1) a1 -= ar[t][s2 >> 2][s2 & 3] * x[s2]; else a0 -= ar[t][s2 >> 2][s2 & 3] * x[s2]; }
                    x[t] = a0 + a1; }
#pragma unroll
                for (int t = 13; t < 16; ++t)
#pragma unroll
                    for (int q = 0; q < 4; ++q) if (4 * q < t) ar[t][q] = *(const LAS f32x4*)(A + t * 16 + 4 * q);
                LGKM0();
#pragma unroll
                for (int t = 13; t < 16; ++t) { float a0 = (t == lj) ? 1.f : 0.f, a1 = 0.f;
#pragma unroll
                    for (int s2 = 0; s2 < t; ++s2) { if (s2 & 1) a1 -= ar[t][s2 >> 2][s2 & 3] * x[s2]; else a0 -= ar[t][s2 >> 2][s2 & 3] * x[s2]; }
                    x[t] = a0 + a1; }
                LAS bf16* D = (LAS bf16*)(lds + LA_DL) + wave * 256;
#pragma unroll
                for (int t = 0; t < 16; ++t) D[t * 16 + lane] = (bf16)f2bf(x[t]);
            }
#pragma unroll
            for (int i = 0; i < 4; ++i) { rhs[i] = unpack4(tr_read(lds + LA_QT, 16 * i + 4 * g, cb, n)); rti[i] = unpack4(tr_read(lds + LA_RT, 16 * i + 4 * g, cb, n)); vf[i] = (s16x4){0, 0, 0, 0}; y1a[i] = (f32x4){0.f, 0.f, 0.f, 0.f}; hma[i] = y1a[i]; }
        }
#pragma unroll
        for (int i = 0; i < 4; ++i)
#pragma unroll
            for (int k = 0; k < 4; ++k) { if (k < i) fqb[i * (i - 1) / 2 + k] = row_read4(AQB, 16 * i + n, 16 * k + 4 * g); if (k <= i) frb[i * (i + 1) / 2 + k] = row_read4(ARB, 16 * i + n, 16 * k + 4 * g);
                fbt[4 * i + k] = tr_read(lds + LA_BT, 16 * k + 4 * g, i, n); }
        LDS_BARRIER();
        STAMP_END(3); STAMP_BEGIN(4);
        {
            s16x4 df[4];
#pragma unroll
            for (int i = 0; i < 4; ++i) df[i] = *(const LAS s16x4*)(lds + LA_DL + i * 512 + n * 32 + 8 * g);
            const float plv[4] = {PLs[n], PLs[16 + n], PLs[32 + n], PLs[48 + n]};
            LGKM0();
#pragma unroll
            for (int i = 0; i < 4; ++i) { f32x4 acc = rhs[i];
#pragma unroll
                for (int k = 0; k < 4; ++k) if (k < i) acc = MFMA16(fqb[i * (i - 1) / 2 + k], xn[k], acc);
                const f32x4 xi = MFMA16(df[i], pack4(acc), ((f32x4){0.f, 0.f, 0.f, 0.f}));
                xn[i] = pack4n(xi); }
            if (!isU) {
                bf16* RH = (bf16*)(a.ws + WS_RH) + (size_t)unit * 4096;
#pragma unroll
                for (int i = 0; i < 4; ++i) { f32x4 acc = rti[i];
#pragma unroll
                    for (int k = 0; k < 4; ++k) if (k <= i) acc = MFMA16(frb[i * (i + 1) / 2 + k], xn[k], acc);
#pragma unroll
                    for (int j = 0; j < 4; ++j) RH[(16 * i + 4 * g + j) * 64 + 16 * cb + n] = (bf16)f2bf(acc[j]); }
                bf16* GT = (bf16*)(a.ws + WS_GT) + (size_t)unit * 4096;
#pragma unroll
                for (int c2b = 0; c2b < 4; ++c2b) { f32x4 acc = (f32x4){0.f, 0.f, 0.f, 0.f};
#pragma unroll
                    for (int k = 0; k < 4; ++k) acc = MFMA16(xn[k], fbt[4 * c2b + k], acc);
                    acc *= plv[c2b]; *(v2u*)(GT + (16 * c2b + n) * 64 + 16 * cb + 4 * g) = __builtin_bit_cast(v2u, pack4(acc)); }
            } else {
                float* Y1 = (float*)(a.ws + WS_Y1) + (size_t)unit * 4096;
#pragma unroll
                for (int i = 0; i < 4; ++i) { f32x4 acc = y1a[i];
#pragma unroll
                    for (int k = 0; k < 4; ++k) if (k <= i) acc = MFMA16(frb[i * (i + 1) / 2 + k], xn[k], acc);
#pragma unroll
                    for (int j = 0; j < 4; ++j) Y1[(16 * i + 4 * g + j) * 64 + 16 * cb + n] = acc[j]; }
                float* HM = (float*)(a.ws + WS_HM) + (size_t)unit * 4096;
#pragma unroll
                for (int c2b = 0; c2b < 4; ++c2b) { f32x4 acc = hma[c2b];
#pragma unroll
                    for (int k = 0; k < 4; ++k) acc = MFMA16(xn[k], fbt[4 * c2b + k], acc);
#pragma unroll
                    for (int j = 0; j < 4; ++j) HM[(16 * cb + 4 * g + j) * 64 + 16 * c2b + n] = acc[j] * plv[c2b]; }
            }
            if (wave == 0) ((float*)(a.ws + WS_PLV))[(size_t)unit * 64 + lane] = PLs[lane];
        }
        LDS_BARRIER();
        STAMP_END(4); STAMP_END(5);
    }
}

constexpr int LB_SLOT = 13312, LB_NPIECE = 13, LB_PER_WAVE = 4, LB_NSLOT = 8, LB_DIST = 7;
__device__ __forceinline__ void chainB_issue(const Args& a, LAS unsigned char* lds, size_t unit, int vb, int step, int lw, int lane) {
    const unsigned char* gt = a.ws + WS_GT + unit * 8192; const unsigned char* hm = a.ws + WS_HM + unit * 16384 + vb * 4096; const unsigned char* pv = a.ws + WS_PLV + unit * 256;
#pragma unroll
    for (int i = 0; i < LB_PER_WAVE; ++i) { int p = lw + 4 * i; p = p < LB_NPIECE - 1 ? p : LB_NPIECE - 1;
        const unsigned char* src = (p < 8) ? gt + p * 1024 : ((p < 12) ? hm + (p - 8) * 1024 : pv);
        __builtin_amdgcn_global_load_lds((const unsigned*)(src + lane * 16), (LAS unsigned*)(lds + (step & (LB_NSLOT - 1)) * LB_SLOT + p * 1024), 16, 0, 0); }
}
struct ChainOps { s16x4 gf[4][4]; f32x4 hm[4], pl[4]; };
__device__ __forceinline__ void chainB_read(ChainOps& o, LAS unsigned char* sl, int n, int g) {
#pragma unroll
    for (int i = 0; i < 4; ++i) { o.hm[i] = *(const LAS f32x4*)(sl + 8192 + (n * 64 + 16 * i + 4 * g) * 4); o.pl[i] = *(const LAS f32x4*)(sl + 12288 + (16 * i + 4 * g) * 4);
#pragma unroll
        for (int k = 0; k < 4; ++k) o.gf[i][k] = *(const LAS s16x4*)(sl + (16 * i + n) * 128 + (16 * k + 4 * g) * 2); }
}
__device__ __forceinline__ void chainB_step(const ChainOps& o, f32x4 (&acc)[4], v2u* SF) {
    s16x4 sb[4]; f32x4 nx[4];
#pragma unroll
    for (int k = 0; k < 4; ++k) { sb[k] = pack4(acc[k]); SF[k * 64] = __builtin_bit_cast(v2u, sb[k]); }
#pragma unroll
    for (int i = 0; i < 4; ++i) nx[i] = o.pl[i] * acc[i] + o.hm[i];
#pragma unroll
    for (int k = 0; k < 4; ++k)
#pragma unroll
        for (int i = 0; i < 4; ++i) nx[i] = MFMA16(o.gf[i][k], sb[k], nx[i]);
#pragma unroll
    for (int i = 0; i < 4; ++i) acc[i] = nx[i];
}
__device__ __forceinline__ void scanB(const Args& a, LAS unsigned char* lds) {
    const int tid = threadIdx.x, lane = tid & 63, wave = __builtin_amdgcn_readfirstlane(tid >> 6), n = lane & 15, g = lane >> 4;
    constexpr int NCK = SEQ / 64;
    for (int item = blockIdx.x; item < BATCH * NHEAD * 4; item += gridDim.x) {
        const int bh = item >> 2, vb = item & 3;
        const size_t u0 = (size_t)bh * 64;
        f32x4 acc[4];
#pragma unroll
        for (int i = 0; i < 4; ++i) acc[i] = (f32x4){0.f, 0.f, 0.f, 0.f};
        if (wave >= 4) {
#pragma unroll
            for (int s = 0; s < LB_DIST; ++s) chainB_issue(a, lds, u0 + s, vb, s, wave - 4, lane);
            asm volatile("s_waitcnt vmcnt(20)" ::: "memory"); }
        __builtin_amdgcn_s_barrier(); asm volatile("" ::: "memory");
        if (wave >= 4) {
            for (int ck = 0; ck < NCK; ++ck) {
                if (ck + LB_DIST < NCK) { chainB_issue(a, lds, u0 + ck + LB_DIST, vb, ck + LB_DIST, wave - 4, lane); asm volatile("s_waitcnt vmcnt(20)" ::: "memory"); }
                else asm volatile("s_waitcnt vmcnt(0)" ::: "memory");
                __builtin_amdgcn_s_barrier(); asm volatile("" ::: "memory");
            }
        } else if (wave == 0) {
            v2u* SF = (v2u*)(a.ws + WS_SF) + (u0 * 16 + vb * 4) * 64 + lane;
            ChainOps A, B;
            chainB_read(A, lds, n, g);
            for (int ck = 0; ck < NCK; ck += 2) {
                chainB_read(B, lds + ((ck + 1) & (LB_NSLOT - 1)) * LB_SLOT, n, g);
                chainB_step(A, acc, SF + (size_t)ck * 16 * 64);
                __builtin_amdgcn_s_barrier(); asm volatile("" ::: "memory");
                if (ck + 2 < NCK) chainB_read(A, lds + ((ck + 2) & (LB_NSLOT - 1)) * LB_SLOT, n, g);
                chainB_step(B, acc, SF + (size_t)(ck + 1) * 16 * 64);
                __builtin_amdgcn_s_barrier(); asm volatile("" ::: "memory");
            }
        } else {
            for (int ck = 0; ck < NCK; ++ck) { __builtin_amdgcn_s_barrier(); asm volatile("" ::: "memory"); }
        }
    }
}

__device__ __forceinline__ void scanC(const Args& a) {
    const int tid = threadIdx.x, lane = tid & 63, wave = tid >> 6, n = lane & 15, g = lane >> 4;
    const int gw = blockIdx.x * NWAVES + wave, NGW = gridDim.x * NWAVES;
    for (int task = gw; task < NUNIT * 4; task += NGW) {
        const int unit = task >> 2, i = task & 3, bh = unit >> 6, ck = unit & 63, b = bh >> 4, h = bh & 15;
        const v2u* SF = (const v2u*)(a.ws + WS_SF) + (size_t)unit * 16 * 64 + lane;
        const bf16* RH = (const bf16*)(a.ws + WS_RH) + (size_t)unit * 4096; const float* Y1 = (const float*)(a.ws + WS_Y1) + (size_t)unit * 4096;
        s16x4 rf[4]; f32x4 acc[4];
        const size_t m = (size_t)b * SEQ + 64 * ck + 16 * i + n;
        s16x4 rq[4], kq[4], vq[4], gq[4];
#pragma unroll
        for (int vb = 0; vb < 4; ++vb) { const size_t o = m * CW + h * 64 + 16 * vb + 4 * g;
            rq[vb] = *(const s16x4*)((const bf16*)(a.ws + WS_R) + o); kq[vb] = *(const s16x4*)((const bf16*)(a.ws + WS_K2) + o);
            vq[vb] = *(const s16x4*)((const bf16*)(a.ws + WS_V) + o); gq[vb] = *(const s16x4*)((const bf16*)(a.ws + WS_GG) + o); }
#pragma unroll
        for (int k = 0; k < 4; ++k) rf[k] = *(const s16x4*)(RH + (16 * i + n) * 64 + 16 * k + 4 * g);
#pragma unroll
        for (int vb = 0; vb < 4; ++vb) { acc[vb] = *(const f32x4*)(Y1 + (16 * i + n) * 64 + 16 * vb + 4 * g);
#pragma unroll
            for (int k = 0; k < 4; ++k) acc[vb] = MFMA16(__builtin_bit_cast(s16x4, SF[(vb * 4 + k) * 64]), rf[k], acc[vb]); }
        float s1 = 0.f;
#pragma unroll
        for (int vb = 0; vb < 4; ++vb) s1 += (acc[vb][0] + acc[vb][1]) + (acc[vb][2] + acc[vb][3]);
        s1 += __shfl_xor(s1, 16); s1 += __shfl_xor(s1, 32);
        const float mean = s1 * (1.f / 64.f); float s2 = 0.f;
#pragma unroll
        for (int vb = 0; vb < 4; ++vb)
#pragma unroll
            for (int j = 0; j < 4; ++j) { const float d = acc[vb][j] - mean; s2 += d * d; }
        s2 += __shfl_xor(s2, 16); s2 += __shfl_xor(s2, 32);
        const float rstd = 1.f / sqrtf(s2 * (1.f / 64.f) + GN_EPS);
        f32x4 rv[4], kv[4], vv[4], gv[4]; float dot = 0.f;
#pragma unroll
        for (int vb = 0; vb < 4; ++vb) { rv[vb] = unpack4(rq[vb]); kv[vb] = unpack4(kq[vb]); vv[vb] = unpack4(vq[vb]); gv[vb] = unpack4(gq[vb]);
            const f32x4 rk = *(const f32x4*)(a.in[I_RK] + h * 64 + 16 * vb + 4 * g);
#pragma unroll
            for (int j = 0; j < 4; ++j) dot += rv[vb][j] * kv[vb][j] * rk[j]; }
        dot += __shfl_xor(dot, 16); dot += __shfl_xor(dot, 32);
#pragma unroll
        for (int vb = 0; vb < 4; ++vb) { const int c = h * 64 + 16 * vb + 4 * g;
            const f32x4 lw = *(const f32x4*)(a.in[I_LNW] + c), lb = *(const f32x4*)(a.in[I_LNB] + c), be = *(const f32x4*)(a.in[I_BETAR] + c);
            const f32x4 o = ((acc[vb] - mean) * rstd * lw + lb + dot * vv[vb]) * gv[vb] * be;
            *(v2u*)((bf16*)(a.ws + WS_YMIX) + m * DM + c) = __builtin_bit_cast(v2u, pack4(o)); }
    }
}

struct ConvItem { const float* W; bf16* WT; int N, ldd, k0, n0; size_t drow_lo, drow_hi; int win; };
__device__ __forceinline__ int win_row(int c) { return c < 3072 ? c : (c < SHIFTW ? 6144 + (c - 3072) : c - (SHIFTW - 3072)); }
constexpr int NCV_IN = 32 * 26, NCV_OUT = 32 * 8, NCV_E = 32 * 32 * 2, NCV_D = 32 * 8 * 8, NCONV = NCV_IN + NCV_OUT + 2 * NCV_E + NCV_D, CV_LDT = 528;
__device__ __forceinline__ ConvItem conv_decode(const Args& a, int r) {
    ConvItem c; unsigned char* ws = a.ws; c.win = 0;
    if (r < NCV_IN) { const int kb = r / 26, nb = r - kb * 26; c.W = a.in[I_WIN]; c.N = PROJW; c.WT = (bf16*)(ws + WS_WIN); c.ldd = DM; c.k0 = 64 * kb; c.n0 = 256 * nb; c.drow_lo = (size_t)c.n0; c.drow_hi = c.drow_lo + 128; c.win = 1; return c; } r -= NCV_IN;
    if (r < NCV_OUT) { const int kb = r >> 3, nb = r & 7; c.W = a.in[I_WOUT]; c.N = DM; c.WT = (bf16*)(ws + WS_WOUT); c.ldd = DM; c.k0 = 64 * kb; c.n0 = 256 * nb; c.drow_lo = (size_t)c.n0; c.drow_hi = c.drow_lo + 128; return c; } r -= NCV_OUT;
    if (r < 2 * NCV_E) { const int up = r >= NCV_E; if (up) r -= NCV_E; const int e = r >> 6, q = r & 63, kb = q >> 1, nb = q & 1;
        c.W = a.in[up ? I_WU : I_WG] + (size_t)e * DM * FF; c.N = FF; c.WT = (bf16*)(ws + WS_WGU); c.ldd = DM; c.k0 = 64 * kb; c.n0 = 256 * nb;
        c.drow_lo = (size_t)e * 1024 + 256 * (2 * nb) + (up ? 128 : 0); c.drow_hi = c.drow_lo + 256; return c; } r -= 2 * NCV_E;
    { const int e = r >> 6, q = r & 63, kb = q >> 3, nb = q & 7;
        c.W = a.in[I_WDN] + (size_t)e * FF * DM; c.N = DM; c.WT = (bf16*)(ws + WS_WD); c.ldd = FF; c.k0 = 64 * kb; c.n0 = 256 * nb; c.drow_lo = (size_t)e * DM + c.n0; c.drow_hi = c.drow_lo + 128; return c; }
}
__device__ __forceinline__ void conv_load(const ConvItem& c, int wave, int lane, f32x4 (&v)[8]) {
    const int col = c.n0 + 4 * lane; const float* p = c.W + (size_t)(c.k0 + 8 * wave) * c.N + col;
#pragma unroll
    for (int i = 0; i < 8; ++i) v[i] = (col < c.N) ? *(const f32x4*)(p + (size_t)i * c.N) : (f32x4){0.f, 0.f, 0.f, 0.f};
}
__device__ __forceinline__ void conv_finish(const ConvItem& c, const f32x4 (&v)[8], LAS unsigned char* tile, int wave, int lane) {
#pragma unroll
    for (int i = 0; i < 8; ++i) { v2u w; w.x = pk2(v[i][0], v[i][1]); w.y = pk2(v[i][2], v[i][3]); *(LAS v2u*)(tile + (8 * wave + i) * CV_LDT + 8 * lane) = w; }
    asm volatile("s_waitcnt lgkmcnt(0)" ::: "memory"); __builtin_amdgcn_s_barrier(); asm volatile("" ::: "memory");
    const int i16 = lane & 15, g = lane >> 4;
    s16x4 t[2][2][2];
#pragma unroll
    for (int cb = 0; cb < 2; ++cb)
#pragma unroll
        for (int h = 0; h < 2; ++h)
#pragma unroll
            for (int q = 0; q < 2; ++q) { const int r0 = 32 * h + 8 * g + 4 * q, c0 = 32 * wave + 16 * cb;
                t[cb][h][q] = __builtin_bit_cast(s16x4, __builtin_amdgcn_ds_read_tr16_b64_v4i16((LAS s16x4*)(tile + (r0 + (i16 >> 2)) * CV_LDT + (c0 + 4 * (i16 & 3)) * 2))); }
    asm volatile("s_waitcnt lgkmcnt(0)" ::: "memory");
#pragma unroll
    for (int cb = 0; cb < 2; ++cb) { const int col = 32 * wave + 16 * cb + i16;
        if (c.n0 + col < c.N) { const size_t drow = c.win ? (size_t)win_row(c.n0 + col) : (col < 128 ? c.drow_lo : c.drow_hi) + (col & 127);
            bf16* dst = c.WT + drow * (size_t)c.ldd + c.k0 + 8 * g;
#pragma unroll
            for (int h = 0; h < 2; ++h) { const v2u lo = __builtin_bit_cast(v2u, t[cb][h][0]), hi = __builtin_bit_cast(v2u, t[cb][h][1]); *(v4u*)(dst + 32 * h) = (v4u){lo.x, lo.y, hi.x, hi.y}; } } }
    __builtin_amdgcn_s_barrier(); asm volatile("" ::: "memory");
}
__device__ __forceinline__ void conv_range(const Args& a, LAS unsigned char* lds, int first, int count, int rank, int nranks) {
    const int tid = threadIdx.x, lane = tid & 63, wave = __builtin_amdgcn_readfirstlane(tid >> 6);
    LAS unsigned char* tile = lds + 32768;
    f32x4 va[8], vb[8]; ConvItem ca, cb; int k = rank;
    if (k < count) { ca = conv_decode(a, first + k); conv_load(ca, wave, lane, va); }
    while (k < count) {
        const int k2 = k + nranks;
        if (k2 < count) { cb = conv_decode(a, first + k2); conv_load(cb, wave, lane, vb); }
        conv_finish(ca, va, tile, wave, lane);
        if (k2 >= count) break;
        const int k3 = k2 + nranks;
        if (k3 < count) { ca = conv_decode(a, first + k3); conv_load(ca, wave, lane, va); }
        conv_finish(cb, vb, tile, wave, lane);
        k = k3; }
}
constexpr int CV_X2 = 192 * 6, CV_X6 = 128 * 9;
__device__ __forceinline__ void phase0(const Args& a, LAS unsigned char* lds) {
    const int tid = threadIdx.x, lane = tid & 63, wave = __builtin_amdgcn_readfirstlane(tid >> 6), G = gridDim.x, bid = blockIdx.x;
    unsigned char* ws = a.ws;
    LAS float* cact = (LAS float*)lds;
    LAS float* red = (LAS float*)(lds + 16384);
    if (bid < 192 || G < 192) {
        const float* c = a.in[I_C];
        for (int i = tid; i < 2 * DM; i += NTHR) { const float x = c[i]; cact[i] = x / (1.f + __expf(-x)); }
        __syncthreads();
        for (int item = bid; item < 192; item += G) {
            const int ro = lane >> 4, cq = lane & 15;
            const float* wp = a.in[I_WADA] + (size_t)(256 * wave + ro) * 12288 + 64 * item + 4 * cq;
            f32x4 acc0 = (f32x4){0.f, 0.f, 0.f, 0.f}, acc1 = acc0;
#pragma unroll 8
            for (int i = 0; i < 64; ++i) { const f32x4 wv = *(const f32x4*)(wp + (size_t)(4 * i) * 12288);
                const float c0 = cact[256 * wave + 4 * i + ro], c1 = cact[DM + 256 * wave + 4 * i + ro]; acc0 += c0 * wv; acc1 += c1 * wv; }
#pragma unroll
            for (int j = 0; j < 4; ++j) { float v0 = acc0[j], v1 = acc1[j]; v0 += __shfl_xor(v0, 16); v0 += __shfl_xor(v0, 32); v1 += __shfl_xor(v1, 16); v1 += __shfl_xor(v1, 32);
                if (ro == 0) { red[(wave * 2 + 0) * 64 + 4 * cq + j] = v0; red[(wave * 2 + 1) * 64 + 4 * cq + j] = v1; } }
            __syncthreads();
            if (tid < 128) { const int b = tid >> 6, cc = tid & 63; float s = a.in[I_BADA][64 * item + cc];
#pragma unroll
                for (int w2 = 0; w2 < 8; ++w2) s += red[(w2 * 2 + b) * 64 + cc];
                ((float*)(ws + WS_MOD))[b * 12288 + 64 * item + cc] = s; }
            __syncthreads();
        }
    }
    { constexpr int NPRE = 5;
      const bool pre = (G == 256), mine = pre && bid >= 192;
      const int ncv = pre ? NCONV - CV_X2 - CV_X6 : NCONV;
      const int pool0 = pre ? 64 * NPRE : 0;
      auto item_of = [&](int j) -> int { if (mine) { if (j < NPRE) return (bid - 192) + 64 * j; j -= NPRE; } return pool0 + bid + G * j; };
      LAS unsigned char* tile = lds + 32768;
      f32x4 va[8], vb[8]; ConvItem ca, cb; int j = 0; int ia = item_of(0);
      if (ia < ncv) { ca = conv_decode(a, ia); conv_load(ca, wave, lane, va); }
      while (ia < ncv) {
          const int ib = item_of(j + 1);
          if (ib < ncv) { cb = conv_decode(a, ib); conv_load(cb, wave, lane, vb); }
          conv_finish(ca, va, tile, wave, lane);
          if (ib >= ncv) break;
          const int ic = item_of(j + 2);
          if (ic < ncv) { ca = conv_decode(a, ic); conv_load(ca, wave, lane, va); }
          conv_finish(cb, vb, tile, wave, lane);
          ia = ic; j += 2; } }
    const int gt = bid * NTHR + tid, NGT = G * NTHR;
    bf16* wl = (bf16*)(ws + WS_WL);
    for (int idx = gt; idx < LORA_N * LORA_K; idx += NGT) { const int n = idx / LORA_K, k = idx - n * LORA_K; float v = 0.f;
        if (n < 1024) { if (k < 64) v = a.in[I_WDEC][k * 1024 + n]; }
        else if (n < 2048) { if (k >= 64 && k < 128) v = a.in[I_WAAA][(k - 64) * 1024 + (n - 1024)]; }
        else { if (k >= 128 && k < 288) v = a.in[I_WGATEUP][(k - 128) * 1024 + (n - 2048)]; }
        wl[idx] = (bf16)f2bf(v); }
    float* w36 = (float*)(ws + WS_W36);
    for (int idx = gt; idx < DM * 36; idx += NGT) { const int e = idx >> 11, dd = idx & (DM - 1);
        w36[idx] = (e < 4) ? a.in[I_WGRP][dd * 4 + e] : a.in[I_WEXP][((size_t)((e - 4) >> 3) * DM + dd) * 8 + ((e - 4) & 7)]; }
    v4u* wz = (v4u*)(ws + WS_WIN + (size_t)PROJW * DM * 2);
    for (int idx = gt; idx < (PROJP - PROJW) * DM / 8; idx += NGT) wz[idx] = (v4u){0u, 0u, 0u, 0u};
}

__device__ __forceinline__ void phase1(const Args& a) {
    const int tid = threadIdx.x, lane = tid & 63, wave = tid >> 6;
    const int gw = blockIdx.x * NWAVES + wave, NGW = gridDim.x * NWAVES;
    const float* mod = (const float*)(a.ws + WS_MOD);
    auto ldrow = [&](int m, f32x4 (&v)[8]) { const f32x4* xr = (const f32x4*)(a.in[I_X] + (size_t)m * DM) + lane;
#pragma unroll
        for (int j = 0; j < 8; ++j) v[j] = xr[64 * j]; };
    auto dorow = [&](int m, f32x4 (&v)[8]) { const int b = m >> 12; float s = 0.f;
#pragma unroll
        for (int j = 0; j < 8; ++j) s += (v[j].x * v[j].x + v[j].y * v[j].y) + (v[j].z * v[j].z + v[j].w * v[j].w);
        const float rstd = 1.f / sqrtf(wave_sum(s) * (1.f / DM) + RMS_EPS);
        v2u* o8 = (v2u*)((bf16*)(a.ws + WS_HB) + (size_t)m * DM) + lane;
#pragma unroll
        for (int j = 0; j < 8; ++j) { const int c = 4 * (lane + 64 * j);
            const f32x4 g = *(const f32x4*)(a.in[I_N1G] + c), sh = *(const f32x4*)(mod + b * 12288 + c), sc = *(const f32x4*)(mod + b * 12288 + DM + c);
            const f32x4 h = v[j] * rstd * g * (1.f + sc) + sh; v2u o; o.x = pk2(h.x, h.y); o.y = pk2(h.z, h.w); o8[64 * j] = o; } };
    { f32x4 va[8], vb[8]; int m = gw; if (m < MTOK) ldrow(m, va);
      while (m < MTOK) { const int m2 = m + NGW; if (m2 < MTOK) ldrow(m2, vb); dorow(m, va); if (m2 >= MTOK) break;
          const int m3 = m2 + NGW; if (m3 < MTOK) ldrow(m3, va); dorow(m2, vb); m = m3; } }
}

__device__ __forceinline__ void router_bias(const Args& a, int w0, int nw) {
    const int lane = threadIdx.x & 63; const float* mod = (const float*)(a.ws + WS_MOD); const float* w36 = (const float*)(a.ws + WS_W36);
    for (int it = w0; it < 72; it += nw) { const int b = it / 36, e = it - b * 36; float s = 0.f;
#pragma unroll 8
        for (int dd = lane; dd < DM; dd += 64) s += mod[b * 12288 + 3 * DM + dd] * w36[e * DM + dd];
        s = wave_sum(s) + ((e < 4) ? a.in[I_BGRP][e] : a.in[I_BEXP][e - 4]);
        if (lane == 0) ((float*)(a.ws + WS_B36))[it] = s; }
}

__device__ __forceinline__ void phase3(const Args& a) {
    const int gt = blockIdx.x * NTHR + threadIdx.x, NGT = gridDim.x * NTHR;
    const bf16* P = (const bf16*)(a.ws + WS_PLR); bf16* AL = (bf16*)(a.ws + WS_AL);
    for (int idx = gt; idx < MTOK * 48; idx += NGT) { const int m = idx / 48, cj = idx - m * 48;
        v4u o = (v4u){0u, 0u, 0u, 0u};
        if (cj < 36) { const int col = 3072 + 8 * cj; const v4u pc = *(const v4u*)(P + (size_t)m * 288 + 8 * cj);
            v4u pp = (v4u){0u, 0u, 0u, 0u}; if ((m & (SEQ - 1)) != 0) pp = *(const v4u*)(P + (size_t)(m - 1) * 288 + 8 * cj);
            const float* mu = a.in[I_MU] + col; float r[8];
#pragma unroll
            for (int i = 0; i < 4; ++i) { const float c0 = bflo(pc[i]), c1 = bfhi(pc[i]), p0 = bflo(pp[i]), p1 = bfhi(pp[i]);
                r[2 * i] = c0 + (p0 - c0) * mu[2 * i]; r[2 * i + 1] = c1 + (p1 - c1) * mu[2 * i + 1]; }
            if (cj < 8) {
#pragma unroll
                for (int i = 0; i < 8; ++i) r[i] = tanhf(r[i]); }
            else if (cj >= 16) {
#pragma unroll
                for (int i = 0; i < 8; ++i) r[i] = sigmoid_f(r[i]); }
            o.x = pk2(r[0], r[1]); o.y = pk2(r[2], r[3]); o.z = pk2(r[4], r[5]); o.w = pk2(r[6], r[7]); }
        *(v4u*)(AL + (size_t)m * LORA_K + 8 * cj) = o; }
}

__device__ __forceinline__ int swz_off(int key, int chunk) { return key * 128 + ((chunk ^ ((key >> 1) & 7)) << 4); }
__device__ __forceinline__ void attn_issue_tile(const bf16* kcol, int key0, LAS unsigned char* buf, int wave) {
    __builtin_amdgcn_global_load_lds((const unsigned*)(kcol + (size_t)key0 * HD), (LAS unsigned*)(buf + wave * 1024), 16, 0, 0);
    __builtin_amdgcn_global_load_lds((const unsigned*)(kcol + HM_PART + (size_t)key0 * HD), (LAS unsigned*)(buf + 8192 + wave * 1024), 16, 0, 0);
}
__device__ __forceinline__ void phase5b(const Args& a, LAS unsigned char* lds) {
    STAMP_DECL;
    const int tid = threadIdx.x, lane = tid & 63, wave = __builtin_amdgcn_readfirstlane(tid >> 6), n = lane & 15, g = lane >> 4;
    const bf16* P = (const bf16*)(a.ws + WS_P); bf16* Y = (bf16*)(a.ws + WS_YMIX);
    LAS unsigned char* QL = lds + 65536; LAS float* biasA = (LAS float*)(lds + 81920);
    for (int i = tid; i < NHEAD * 257; i += NTHR) biasA[i] = a.in[I_RELB][i] * LOG2E;
    const float SC = 0.125f * LOG2E;
    const int skey = tid >> 3, sdcx = (tid & 7) ^ ((skey >> 1) & 7);
    LAS float* betaL = (LAS float*)(lds + 81920 + NHEAD * 257 * 4 + 64);
    for (int i = tid; i < CW; i += NTHR) betaL[i] = a.in[I_BETAA][i];
#define ATTN_PROLOGUE(U) do { const int cp_ = (U) & 31, h_ = ((U) >> 5) & 15, b_ = (U) >> 9; const int js_ = (8 - 2 * cp_) > 0 ? (8 - 2 * cp_) : 0, kb_ = 64 * (2 * cp_ - 8 + js_); \
        const bf16* Qh_ = P + 3 * HM_PART + (size_t)b_ * HM_BATCH + (size_t)h_ * HM_HEAD; const bf16* kc_ = Qh_ + HM_PART + (size_t)skey * HD + 8 * sdcx; \
        const bf16* qs_ = Qh_ + (size_t)(128 * cp_ + 16 * wave + (lane >> 3)) * HD + 8 * (lane & 7); \
        __builtin_amdgcn_global_load_lds((const unsigned*)qs_, (LAS unsigned*)(QL + wave * 2048), 16, 0, 0); \
        __builtin_amdgcn_global_load_lds((const unsigned*)(qs_ + (size_t)8 * HD), (LAS unsigned*)(QL + wave * 2048 + 1024), 16, 0, 0); \
        attn_issue_tile(kc_, kb_, lds, wave); attn_issue_tile(kc_, kb_ + 64, lds + 16384, wave); \
        if (js_ < 8) attn_issue_tile(kc_, kb_ + 128, lds + 32768, wave); } while (0)
    asm volatile("s_waitcnt vmcnt(0) lgkmcnt(0)" ::: "memory"); __builtin_amdgcn_s_barrier(); asm volatile("" ::: "memory");
    if ((int)blockIdx.x < BATCH * NHEAD * 32) ATTN_PROLOGUE((int)blockIdx.x);
    for (int u = blockIdx.x; u < BATCH * NHEAD * 32; u += gridDim.x) {
        const int cp = u & 31, h = (u >> 5) & 15, b = u >> 9;
        const int t0 = 128 * cp, qrow = t0 + 16 * wave + n;
        const bf16* Qh = P + 3 * HM_PART + (size_t)b * HM_BATCH + (size_t)h * HM_HEAD;
        const LAS float* biasL = biasA + h * 257;
        const int jstart = (8 - 2 * cp) > 0 ? (8 - 2 * cp) : 0, nt = 10 - jstart;
        const bf16* kcol = Qh + HM_PART + (size_t)skey * HD + 8 * sdcx;
        const int keyb = 64 * (2 * cp - 8 + jstart);
        if (nt > 2) asm volatile("s_waitcnt vmcnt(4)" ::: "memory"); else asm volatile("s_waitcnt vmcnt(2)" ::: "memory");
        __builtin_amdgcn_s_barrier(); asm volatile("" ::: "memory");
        bf16x8 qf[2]; qf[0] = *(const LAS bf16x8*)(QL + wave * 2048 + n * 128 + 16 * g); qf[1] = *(const LAS bf16x8*)(QL + wave * 2048 + n * 128 + 64 + 16 * g);
        float mrun = -1e30f, lrun = 0.f;
        f32x4 ot[4];
#pragma unroll
        for (int i = 0; i < 4; ++i) ot[i] = (f32x4){0.f, 0.f, 0.f, 0.f};
        const float bfar = biasL[256];
        for (int r = 0; r < nt; ++r) {
            const int j = jstart + r, key0 = keyb + 64 * r;
            if (r + 3 < nt) attn_issue_tile(kcol, key0 + 192, lds + ((r + 3) & 3) * 16384, wave);
            const bool active = (wave < 4) ? (j <= 8) : (j >= 1);
            STAMP_BEGIN(13);
            if (active) {
                LAS unsigned char* Kb = lds + (r & 3) * 16384; LAS unsigned char* Vb = Kb + 8192;
                f32x4 s[4];
                { bf16x8 kfr[4][2];
#pragma unroll
                  for (int st = 0; st < 4; ++st)
#pragma unroll
                      for (int ks = 0; ks < 2; ++ks) kfr[st][ks] = *(const LAS bf16x8*)(Kb + swz_off(16 * st + n, 4 * ks + g));
                  asm volatile("s_waitcnt lgkmcnt(0)" ::: "memory"); __builtin_amdgcn_sched_barrier(0);
#pragma unroll
                  for (int st = 0; st < 4; ++st) { s[st] = (f32x4){0.f, 0.f, 0.f, 0.f};
#pragma unroll
                      for (int ks = 0; ks < 2; ++ks) s[st] = __builtin_amdgcn_mfma_f32_16x16x32_bf16(kfr[st][ks], qf[ks], s[st], 0, 0, 0); } }
                s16x4 vtr[2][4][2];
                  const int q4 = n >> 2, p4 = n & 3;
#pragma unroll
                  for (int k2 = 0; k2 < 2; ++k2)
#pragma unroll
                      for (int nd = 0; nd < 4; ++nd) { const int ka = 32 * k2 + 4 * g + q4, ch = 2 * nd + (p4 >> 1);
                          vtr[k2][nd][0] = __builtin_bit_cast(s16x4, __builtin_amdgcn_ds_read_tr16_b64_v4i16((LAS s16x4*)(Vb + swz_off(ka, ch) + 8 * (p4 & 1))));
                          vtr[k2][nd][1] = __builtin_bit_cast(s16x4, __builtin_amdgcn_ds_read_tr16_b64_v4i16((LAS s16x4*)(Vb + swz_off(ka + 16, ch) + 8 * (p4 & 1)))); }
                const bool far = (t0 + 16 * wave) - (key0 + 63) >= 128;
                float mx = -1e30f;
                if (far) {
#pragma unroll
                    for (int st = 0; st < 4; ++st)
#pragma unroll
                        for (int jj = 0; jj < 4; ++jj) { const float sv = s[st][jj] * SC + bfar; s[st][jj] = sv; mx = fmaxf(mx, sv); }
                } else {
                    float bv[4][4];
#pragma unroll
                    for (int st = 0; st < 4; ++st)
#pragma unroll
                        for (int jj = 0; jj < 4; ++jj) { const int dist = qrow - (key0 + 16 * st + 4 * g + jj); bv[st][jj] = biasL[(dist < 128 ? dist : 128) + 128]; }
#pragma unroll
                    for (int st = 0; st < 4; ++st)
#pragma unroll
                        for (int jj = 0; jj < 4; ++jj) { const float sv = s[st][jj] * SC + bv[st][jj]; s[st][jj] = sv; mx = fmaxf(mx, sv); }
                }
                mx = fmaxf(mx, __shfl_xor(mx, 16)); mx = fmaxf(mx, __shfl_xor(mx, 32));
                const float mnew = fmaxf(mrun, mx), alpha = __builtin_amdgcn_exp2f(mrun - mnew); mrun = mnew;
                float ls = 0.f;
#pragma unroll
                for (int st = 0; st < 4; ++st)
#pragma unroll
                    for (int jj = 0; jj < 4; ++jj) { const float p = __builtin_amdgcn_exp2f(s[st][jj] - mnew); s[st][jj] = p; ls += p; }
                lrun = lrun * alpha + ls;
#pragma unroll
                for (int i = 0; i < 4; ++i) ot[i] *= alpha;
                {
                  asm volatile("s_waitcnt lgkmcnt(0)" ::: "memory"); __builtin_amdgcn_sched_barrier(0);
#pragma unroll
                  for (int k2 = 0; k2 < 2; ++k2) {
                      v4u pw; pw.x = pk2(s[2 * k2][0], s[2 * k2][1]); pw.y = pk2(s[2 * k2][2], s[2 * k2][3]); pw.z = pk2(s[2 * k2 + 1][0], s[2 * k2 + 1][1]); pw.w = pk2(s[2 * k2 + 1][2], s[2 * k2 + 1][3]);
                      const bf16x8 pf = __builtin_bit_cast(bf16x8, pw);
#pragma unroll
                      for (int nd = 0; nd < 4; ++nd) { const s16x4 v0 = vtr[k2][nd][0], v1 = vtr[k2][nd][1];
                          bf16x8 vf; vf[0] = v0[0]; vf[1] = v0[1]; vf[2] = v0[2]; vf[3] = v0[3]; vf[4] = v1[0]; vf[5] = v1[1]; vf[6] = v1[2]; vf[7] = v1[3];
                          ot[nd] = __builtin_amdgcn_mfma_f32_16x16x32_bf16(vf, pf, ot[nd], 0, 0, 0); } } }
            }
            STAMP_END(13); STAMP_BEGIN(12);
            if (r + 4 <= nt) asm volatile("s_waitcnt vmcnt(4)" ::: "memory"); else if (r + 3 == nt) asm volatile("s_waitcnt vmcnt(2)" ::: "memory"); else asm volatile("s_waitcnt vmcnt(0)" ::: "memory");
            asm volatile("s_waitcnt lgkmcnt(0)" ::: "memory"); __builtin_amdgcn_s_barrier(); asm volatile("" ::: "memory");
            STAMP_END(12);
        }
        if (u + (int)gridDim.x < BATCH * NHEAD * 32) ATTN_PROLOGUE(u + (int)gridDim.x);
        float lt = lrun; lt += __shfl_xor(lt, 16); lt += __shfl_xor(lt, 32);
        const float inv = __builtin_amdgcn_rcpf(lt);
        bf16* yp = Y + ((size_t)b * SEQ + qrow) * DM + 1024 + h * 64 + 4 * g;
        const LAS float* beta = betaL + h * 64 + 4 * g;
#pragma unroll
        for (int nd = 0; nd < 4; ++nd) { const f32x4 bt = *(const LAS f32x4*)(beta + 16 * nd); const f32x4 o = ot[nd] * inv * bt;
            v2u w; w.x = pk2(o[0], o[1]); w.y = pk2(o[2], o[3]); *(v2u*)(yp + 16 * nd) = w; }
    }
}

__device__ __forceinline__ void phase8(const Args& a, LAS unsigned char* lds) {
    const int tid = threadIdx.x, lane = tid & 63, wave = __builtin_amdgcn_readfirstlane(tid >> 6), n = lane & 15, g = lane >> 4;
    const float* mod = (const float*)(a.ws + WS_MOD); const float* W36 = (const float*)(a.ws + WS_W36); const bf16* X1 = (const bf16*)(a.ws + WS_X1);
    unsigned* ctl = (unsigned*)(a.ws + WS_CTL);
    LAS float* part = (LAS float*)lds;
    LAS float* ssp = (LAS float*)(lds + 24576);
    LAS float* lg = (LAS float*)(lds + 25088);
    for (int tile = blockIdx.x; tile < MTOK / 16; tile += gridDim.x) {
        const int m0 = 16 * tile, b = m0 >> 12;
        f32x4 acc[3]; float ss = 0.f;
#pragma unroll
        for (int ct = 0; ct < 3; ++ct) acc[ct] = (f32x4){0.f, 0.f, 0.f, 0.f};
        const bf16* xrow = X1 + (size_t)(m0 + n) * DM + 256 * wave + 8 * g;
        const float* w0p = W36 + (size_t)n * DM + 256 * wave + 8 * g; const float* w1p = w0p + (size_t)16 * DM; const float* w2p = w0p + (size_t)(n < 4 ? 32 : 0) * DM;
        const float* gp = a.in[I_N2G] + 256 * wave + 8 * g; const float* sp = mod + b * 12288 + 4 * DM + 256 * wave + 8 * g;
#pragma unroll 2
        for (int Q = 0; Q < 8; ++Q) {
            const v4u xb = *(const v4u*)(xrow + 32 * Q);
#pragma unroll
            for (int hf = 0; hf < 2; ++hf) {
                f32x4 xa = (f32x4){bflo(xb[2 * hf]), bfhi(xb[2 * hf]), bflo(xb[2 * hf + 1]), bfhi(xb[2 * hf + 1])};
                const f32x4 ab = *(const f32x4*)(gp + 32 * Q + 4 * hf) * (1.f + *(const f32x4*)(sp + 32 * Q + 4 * hf));
                const f32x4 wa = *(const f32x4*)(w0p + 32 * Q + 4 * hf), wb = *(const f32x4*)(w1p + 32 * Q + 4 * hf); f32x4 wc = *(const f32x4*)(w2p + 32 * Q + 4 * hf);
                if (n >= 4) wc = (f32x4){0.f, 0.f, 0.f, 0.f};
                ss += (xa[0] * xa[0] + xa[1] * xa[1]) + (xa[2] * xa[2] + xa[3] * xa[3]); xa *= ab;
#pragma unroll
                for (int r = 0; r < 4; ++r) { acc[0] = __builtin_amdgcn_mfma_f32_16x16x4f32(xa[r], wa[r], acc[0], 0, 0, 0); acc[1] = __builtin_amdgcn_mfma_f32_16x16x4f32(xa[r], wb[r], acc[1], 0, 0, 0);
                    acc[2] = __builtin_amdgcn_mfma_f32_16x16x4f32(xa[r], wc[r], acc[2], 0, 0, 0); } }
        }
        ss += __shfl_xor(ss, 16); ss += __shfl_xor(ss, 32);
#pragma unroll
        for (int ct = 0; ct < 3; ++ct) *(LAS f32x4*)(part + (wave * 64 + lane) * 12 + 4 * ct) = acc[ct];
        if (lane < 16) ssp[wave * 16 + lane] = ss;
        __syncthreads();
        { const int tk = tid >> 5, sl = tid & 31;
            float s2 = 0.f;
#pragma unroll
            for (int w = 0; w < 8; ++w) s2 += ssp[w * 16 + tk];
            const float rstd = 1.f / sqrtf(s2 * (1.f / DM) + RMS_EPS);
            const float* b36 = (const float*)(a.ws + WS_B36) + b * 36;
            { const int e = sl; float s = 0.f;
#pragma unroll
              for (int w = 0; w < 8; ++w) s += part[(w * 64 + 16 * (tk >> 2) + (e & 15)) * 12 + 4 * (e >> 4) + (tk & 3)];
              lg[tk * 40 + e] = s * rstd + b36[e]; }
            if (sl < 4) { const int e = 32 + sl; float s = 0.f;
#pragma unroll
              for (int w = 0; w < 8; ++w) s += part[(w * 64 + 16 * (tk >> 2) + (e & 15)) * 12 + 4 * (e >> 4) + (tk & 3)];
              lg[tk * 40 + e] = s * rstd + b36[e]; }
            if (sl == 0) ((float*)(a.ws + WS_RSTD))[m0 + tk] = rstd; }
        __syncthreads();
        if (tid < 16) {
            float l[36];
#pragma unroll
            for (int e = 0; e < 36; ++e) l[e] = lg[tid * 40 + e];
            int gi = 0; float gm = l[0];
#pragma unroll
            for (int i = 1; i < 4; ++i) if (l[i] > gm) { gm = l[i]; gi = i; }
            float gs = 0.f;
#pragma unroll
            for (int i = 0; i < 4; ++i) gs += expf(l[i] - gm);
            const float gwt = 1.f / gs;
            float el[8];
#pragma unroll
            for (int j = 0; j < 8; ++j) el[j] = (gi == 0) ? l[4 + j] : ((gi == 1) ? l[12 + j] : ((gi == 2) ? l[20 + j] : l[28 + j]));
            int i1 = 0; float m1 = el[0];
#pragma unroll
            for (int i = 1; i < 8; ++i) if (el[i] > m1) { m1 = el[i]; i1 = i; }
            int i2 = -1; float m2 = -3.0e38f;
#pragma unroll
            for (int i = 0; i < 8; ++i) if (i != i1 && el[i] > m2) { m2 = el[i]; i2 = i; }
            const float e2 = expf(m2 - m1); const float w1 = gwt / (1.f + e2), w2 = gwt * e2 / (1.f + e2);
            int* rt = (int*)(a.ws + WS_ROUTE) + (size_t)(m0 + tid) * 8; const int ge1 = gi * 8 + i1, ge2 = gi * 8 + i2;
            rt[0] = ge1; rt[1] = ge2; rt[2] = __float_as_int(w1); rt[3] = __float_as_int(w2);
            const int sl = (tile & (NSLICE - 1)) * 32;
            atomicAdd(ctl + CW_CNT + sl + ge1, 1u); atomicAdd(ctl + CW_CNT + sl + ge2, 1u);
        }
        __syncthreads();
    }
}

__device__ __forceinline__ void phase9(const Args& a) {
    const int tid = threadIdx.x, lane = tid & 63, wave = tid >> 6;
    const int gw = blockIdx.x * NWAVES + wave, NGW = gridDim.x * NWAVES;
    unsigned* ctl = (unsigned*)(a.ws + WS_CTL);
    const float* mod = (const float*)(a.ws + WS_MOD);
    unsigned cnt = 0u;
    if (lane < NEXP) for (int s = 0; s < NSLICE; ++s) cnt += __hip_atomic_load(ctl + CW_CNT + s * 32 + lane, RLX_AGENT);
    const unsigned pad = (cnt + 255u) & ~255u;
    unsigned incl = pad;
#pragma unroll
    for (int o = 1; o < 64; o <<= 1) { const unsigned t = __shfl_up(incl, o); if (lane >= o) incl += t; }
    const unsigned off = incl - pad;
    if (gw == 0) {
        if (lane < NEXP) for (unsigned t = off >> 8; t < (off + pad) >> 8; ++t) ctl[CW_TE + t] = (unsigned)lane;
        if (lane == 63) ctl[CW_NRT] = incl >> 8;
    }
    for (int task = gw; task < MTOK / 4; task += NGW) {
        const int m0 = 4 * task, b = m0 >> 12, slice = (m0 >> 4) & (NSLICE - 1);
        unsigned sbase = 0u;
        if (lane < NEXP) for (int s = 0; s < slice; ++s) sbase += __hip_atomic_load(ctl + CW_CNT + s * 32 + lane, RLX_AGENT);
        const unsigned offs = off + sbase;
        int* rt = (int*)(a.ws + WS_ROUTE) + (size_t)(m0 + (lane & 3)) * 8;
        const int e1 = rt[0], e2 = rt[1];
        unsigned p1 = 0, p2 = 0;
        if (lane < 4) { p1 = atomicAdd(ctl + CW_POS + slice * 32 + e1, 1u); p2 = atomicAdd(ctl + CW_POS + slice * 32 + e2, 1u); }
        const unsigned s1v = __shfl(offs, e1) + p1, s2v = __shfl(offs, e2) + p2;
        if (lane < 4) { rt[4] = (int)s1v; rt[5] = (int)s2v; ((float*)(a.ws + WS_SW))[s1v] = __int_as_float(rt[2]); ((float*)(a.ws + WS_SW))[s2v] = __int_as_float(rt[3]); }
        v4u xa[4], xb[4];
        auto ldx = [&](int t, v4u (&x)[4]) { const v4u* xr = (const v4u*)((const bf16*)(a.ws + WS_X1) + (size_t)(m0 + t) * DM) + lane;
#pragma unroll
            for (int j = 0; j < 4; ++j) x[j] = xr[64 * j]; };
        auto dox = [&](int t, v4u (&x)[4]) { const unsigned s1 = __shfl(s1v, t), s2 = __shfl(s2v, t);
            const float rstd = ((const float*)(a.ws + WS_RSTD))[m0 + t];
            v4u* d1 = (v4u*)((bf16*)(a.ws + WS_H2P) + (size_t)s1 * DM) + lane; v4u* d2 = (v4u*)((bf16*)(a.ws + WS_H2P) + (size_t)s2 * DM) + lane;
#pragma unroll
            for (int j = 0; j < 4; ++j) { const int c = 8 * (lane + 64 * j); v4u o;
#pragma unroll
                for (int hf = 0; hf < 2; ++hf) { const int cc = c + 4 * hf;
                    const f32x4 g = *(const f32x4*)(a.in[I_N2G] + cc), sh = *(const f32x4*)(mod + b * 12288 + 3 * DM + cc), sc = *(const f32x4*)(mod + b * 12288 + 4 * DM + cc);
                    const f32x4 xv = (f32x4){bflo(x[j][2 * hf]), bfhi(x[j][2 * hf]), bflo(x[j][2 * hf + 1]), bfhi(x[j][2 * hf + 1])};
                    const f32x4 h = xv * rstd * g * (1.f + sc) + sh; o[2 * hf] = pk2(h.x, h.y); o[2 * hf + 1] = pk2(h.z, h.w); }
                d1[64 * j] = o; d2[64 * j] = o; } };
        ldx(0, xa); ldx(1, xb); dox(0, xa); ldx(2, xa); dox(1, xb); ldx(3, xb); dox(2, xa); dox(3, xb);
    }
}

__device__ __forceinline__ void phase12(const Args& a) {
    const int tid = threadIdx.x, lane = tid & 63, wave = tid >> 6;
    const int gw = blockIdx.x * NWAVES + wave, NGW = gridDim.x * NWAVES;
    const float* mod = (const float*)(a.ws + WS_MOD);
    struct Tok { v2u x[8]; v2u f1[8], f2[8]; };
    auto ldslots = [&](int m, int& s1, int& s2) { const int* rt = (const int*)(a.ws + WS_ROUTE) + (size_t)m * 8; s1 = rt[4]; s2 = rt[5]; };
    auto ldtok = [&](int m, int s1, int s2, Tok& t) { const v2u* xr = (const v2u*)((const bf16*)(a.ws + WS_X1) + (size_t)m * DM) + lane;
        const v2u* f1 = (const v2u*)((const bf16*)(a.ws + WS_FP) + (size_t)s1 * DM) + lane; const v2u* f2 = (const v2u*)((const bf16*)(a.ws + WS_FP) + (size_t)s2 * DM) + lane;
#pragma unroll
        for (int j = 0; j < 8; ++j) { t.x[j] = xr[64 * j]; t.f1[j] = f1[64 * j]; t.f2[j] = f2[64 * j]; } };
    auto dotok = [&](int m, Tok& t) { const int b = m >> 12; float s = 0.f; f32x4 v[8];
#pragma unroll
        for (int j = 0; j < 8; ++j) { const int c = 4 * (lane + 64 * j); const f32x4 g2 = *(const f32x4*)(mod + b * 12288 + 5 * DM + c);
            const v2u a1 = t.f1[j], a2 = t.f2[j]; f32x4 f;
            f.x = bflo(a1.x) + bflo(a2.x); f.y = bfhi(a1.x) + bfhi(a2.x); f.z = bflo(a1.y) + bflo(a2.y); f.w = bfhi(a1.y) + bfhi(a2.y);
            v[j] = (f32x4){bflo(t.x[j].x), bfhi(t.x[j].x), bflo(t.x[j].y), bfhi(t.x[j].y)} + g2 * f; s += (v[j].x * v[j].x + v[j].y * v[j].y) + (v[j].z * v[j].z + v[j].w * v[j].w); }
        const float rstd = 1.f / sqrtf(wave_sum(s) * (1.f / DM) + RMS_EPS);
        f32x4* op = (f32x4*)(a.out + (size_t)m * DM) + lane;
#pragma unroll
        for (int j = 0; j < 8; ++j) { const int c = 4 * (lane + 64 * j); const f32x4 g = *(const f32x4*)(a.in[I_NFG] + c); op[64 * j] = v[j] * rstd * g; } };
    { Tok ta, tb; int m = gw, sa1 = 0, sa2 = 0, sb1 = 0, sb2 = 0;
      if (m < MTOK) { ldslots(m, sa1, sa2); if (m + NGW < MTOK) ldslots(m + NGW, sb1, sb2); ldtok(m, sa1, sa2, ta); }
      while (m < MTOK) { const int m2 = m + NGW, m3 = m2 + NGW, m4 = m3 + NGW;
          if (m3 < MTOK) ldslots(m3, sa1, sa2);
          if (m2 < MTOK) ldtok(m2, sb1, sb2, tb);
          dotok(m, ta); if (m2 >= MTOK) break;
          if (m4 < MTOK) ldslots(m4, sb1, sb2);
          if (m3 < MTOK) ldtok(m3, sa1, sa2, ta);
          dotok(m2, tb); m = m3; } }
}

#ifndef MK_ONE_LAUNCH
#define MK_ONE_LAUNCH 1
#endif
__global__ void __launch_bounds__(NTHR, 2) mega_fwd(Args args) {
    extern __shared__ __attribute__((aligned(16))) unsigned char lds_raw[];
    LAS unsigned char* lds = (LAS unsigned char*)lds_raw;
    const int tid = threadIdx.x;
    for (int u = tid; u < (LDS_BYTES - LDSCTL_OFF) / 4; u += NTHR) ((LAS unsigned*)(lds + LDSCTL_OFF))[u] = 0u;
    __syncthreads();
    volatile LAS unsigned* MISC = (volatile LAS unsigned*)(lds + MISC_OFF);
    unsigned* ctl = (unsigned*)(args.ws + WS_CTL);
    unsigned* barw = ctl + CW_BAR + args.li * XCD_BAR_WORDS;
    XcdBarrier bar; bar.bar = barw; bar.x = 0; bar.st = nullptr;
    const bool multi = (args.ph_hi - args.ph_lo) > 1;
    if (multi) bar = xcd_barrier_post(barw, MISC + 8);
    const int lo = args.ph_lo, hi = args.ph_hi, G = gridDim.x;
#define IN(k) (lo <= (k) && (k) < hi)
#define SEAM(k) do { if (IN(k) && IN((k) + 1)) xcd_barrier(bar); } while (0)
    const Args& a = args; STAMP_DECL;
#define PH_BEGIN(k) STAMP_BEGIN(100 + (k))
#define PH_END(k) STAMP_END(100 + (k))
    if (IN(0)) { PH_BEGIN(0); STAMP_BEGIN(20); phase0(args, lds); STAMP_END(20); } SEAM(0); if (IN(0)) PH_END(0);
    if (IN(1)) { PH_BEGIN(1); phase1(args); } SEAM(1); if (IN(1)) PH_END(1);
    if (IN(2)) { PH_BEGIN(2); pg8::Gemm g{(const pg8::bf16_t*)(args.ws + WS_HB), (const pg8::bf16_t*)(args.ws + WS_WIN), MTOK, PROJP, DM}; pg8::StaticOrder S; S.init(MTOK, PROJP, G, (int)blockIdx.x);
        EpiProj E{(bf16*)(args.ws + WS_P), (bf16*)(args.ws + WS_PLR)};
        pg8::gemm_phase<EpiProj, pg8::StaticOrder, true, true>(lds, g, S, E);
        if (G == 256 && (int)blockIdx.x >= 64) conv_range(args, lds, NCONV - CV_X2 - CV_X6, CV_X2, (int)blockIdx.x - 64, 192); } SEAM(2); if (IN(2)) PH_END(2);
    if (IN(3)) { PH_BEGIN(3); STAMP_BEGIN(10); phase3(args); STAMP_END(10); STAMP_BEGIN(11); phase5b(args, lds); STAMP_END(11); } SEAM(3); if (IN(3)) PH_END(3);
    if (IN(4)) { PH_BEGIN(4); pg8::Gemm g{(const pg8::bf16_t*)(args.ws + WS_AL), (const pg8::bf16_t*)(args.ws + WS_WL), MTOK, LORA_N, LORA_K}; pg8::StaticOrder S; S.init(MTOK, LORA_N, G, (int)blockIdx.x);
        EpiLora E{(float*)(args.ws + WS_LW), (bf16*)(args.ws + WS_AA), (bf16*)(args.ws + WS_GG)};
        pg8::gemm_phase<EpiLora, pg8::StaticOrder, true, true>(lds, g, S, E); } SEAM(4); if (IN(4)) PH_END(4);
    if (IN(5)) { PH_BEGIN(5); scanA(args, lds); } SEAM(5); if (IN(5)) PH_END(5);
    if (IN(6)) { PH_BEGIN(6); scanB(args, lds); if ((int)blockIdx.x >= (int)gridDim.x - 9) router_bias(args, ((int)gridDim.x - 1 - (int)blockIdx.x) * NWAVES + (tid >> 6), 9 * NWAVES); if (G == 256 && (int)blockIdx.x >= 128) conv_range(args, lds, NCONV - CV_X6, CV_X6, (int)blockIdx.x - 128, 128); } SEAM(6); if (IN(6)) PH_END(6);
    if (IN(7)) { PH_BEGIN(7); scanC(args); } SEAM(7); if (IN(7)) PH_END(7);
    if (IN(8)) { PH_BEGIN(8); pg8::Gemm g{(const pg8::bf16_t*)(args.ws + WS_YMIX), (const pg8::bf16_t*)(args.ws + WS_WOUT), MTOK, DM, DM}; pg8::StaticOrder S; S.init(MTOK, DM, G, (int)blockIdx.x);
        EpiResGate E{args.in[I_X], (const float*)(args.ws + WS_MOD) + 2 * DM, (bf16*)(args.ws + WS_X1)};
        pg8::gemm_phase<EpiResGate, pg8::StaticOrder, true, true>(lds, g, S, E); } SEAM(8); if (IN(8)) PH_END(8);
    if (IN(9)) { PH_BEGIN(9); phase8(args, lds); } SEAM(9); if (IN(9)) PH_END(9);
    if (IN(10)) { PH_BEGIN(10); phase9(args); } SEAM(10); if (IN(10)) PH_END(10);
    if (IN(11) || IN(12) || IN(13)) {
        const int nrt = (int)__hip_atomic_load(ctl + CW_NRT, RLX_AGENT), c = (int)blockIdx.x;
        const int Ugu = 4 * nrt, nB = Ugu > G ? Ugu - G : 0, R0 = (Ugu < G ? Ugu : G) / 4, E2 = (8 * R0 < 2 * (G - nB)) ? 8 * R0 : 2 * (G - nB);
        const pg8::Gemm gu{(const pg8::bf16_t*)(args.ws + WS_H2P), (const pg8::bf16_t*)(args.ws + WS_WGU), nrt * 256, NEXP * 1024, DM};
        const pg8::Gemm gd{(const pg8::bf16_t*)(args.ws + WS_HG), (const pg8::bf16_t*)(args.ws + WS_WD), nrt * 256, NEXP * DM, FF};
        const EpiGateUp Eu{(const float*)(args.ws + WS_SW), (bf16*)(args.ws + WS_HG)};
        const EpiStoreBf16 Ed{(bf16*)(args.ws + WS_FP), DM, 7};
        if (IN(11)) { PH_BEGIN(11); GroupOrder2 S{ctl + CW_TE, 4, 0, Ugu < G ? Ugu : G, G, c}; pg8::gemm_phase<EpiGateUp, GroupOrder2, true, true>(lds, gu, S, Eu); } SEAM(11); if (IN(11)) PH_END(11);
        if (IN(12)) { PH_BEGIN(12); if (c < nB) { GroupOrder2 S{ctl + CW_TE, 4, G, nB, nB, c}; pg8::gemm_phase<EpiGateUp, GroupOrder2, true, true>(lds, gu, S, Eu); }
                      else { GroupOrder2 S{ctl + CW_TE, 8, 0, E2, G - nB, c - nB}; pg8::gemm_phase<EpiStoreBf16, GroupOrder2, true, true>(lds, gd, S, Ed); } } SEAM(12); if (IN(12)) PH_END(12);
        if (IN(13)) { PH_BEGIN(13); GroupOrder2 S{ctl + CW_TE, 8, E2, 8 * nrt - E2, G, c}; pg8::gemm_phase<EpiStoreBf16, GroupOrder2, true, true>(lds, gd, S, Ed); } SEAM(13); if (IN(13)) PH_END(13);
    }
    if (IN(14)) { PH_BEGIN(14); phase12(args); PH_END(14); }
#ifdef STAMP_ID
    if (blockIdx.x == 0 && tid == 0 && IN(NPH - 1)) { const unsigned dly = STAMP_MULT * __hip_atomic_load(ctl + CW_STAMP, RLX_AGENT); const unsigned long long t0_ = __builtin_amdgcn_s_memrealtime();
        while (__builtin_amdgcn_s_memrealtime() - t0_ < (unsigned long long)dly) __builtin_amdgcn_s_sleep(8); }
#endif
#ifdef EXTRA_BARRIERS
    if (multi) for (int i_ = 0; i_ < EXTRA_BARRIERS; ++i_) xcd_barrier(bar);
#endif
#undef IN
#undef SEAM
}

extern "C" void kernel_launch(void* const* d_in, const int* in_sizes, int n_in, void* d_out, int out_size, void* d_ws, size_t ws_size, hipStream_t stream) {
    static int grid = 0;
    if (grid == 0) {
        if (n_in != 30 || out_size != MTOK * DM || ws_size < WS_END) { fprintf(stderr, "kernel_launch: unexpected shapes (n_in %d, out %d, ws %zu)\n", n_in, out_size, ws_size); grid = -1; return; }
        int dev = 0, cus = 0, per_cu = 0;
        if (hipGetDevice(&dev) != hipSuccess || hipDeviceGetAttribute(&cus, hipDeviceAttributeMultiprocessorCount, dev) != hipSuccess) { grid = -1; return; }
        if (hipFuncSetAttribute((const void*)mega_fwd, hipFuncAttributeMaxDynamicSharedMemorySize, LDS_BYTES) != hipSuccess) { grid = -1; return; }
        if (hipOccupancyMaxActiveBlocksPerMultiprocessor(&per_cu, (const void*)mega_fwd, NTHR, LDS_BYTES) != hipSuccess || per_cu < 1) { fprintf(stderr, "kernel_launch: occupancy query says %d\n", per_cu); grid = -1; (void)hipGetLastError(); return; }
        grid = cus;
    }
    if (grid < 0) return;
    (void)hipMemsetAsync((char*)d_ws + WS_CTL, 0, CTL_ZERO_BYTES, stream);
    Args a{};
    for (int i = 0; i < 30; ++i) a.in[i] = (const float*)d_in[i];
    a.out = (float*)d_out; a.ws = (unsigned char*)d_ws;
#if MK_ONE_LAUNCH
#ifdef PROBE_PHASE
    const int cuts[3] = {0, PROBE_PHASE, NPH};
    for (int li = 0; li < 2; ++li) { a.ph_lo = cuts[li]; a.ph_hi = cuts[li + 1] + ((li == 0) ? PROBE_REPEAT : 0); a.li = li;
        void* kargs[] = {&a};
        hipError_t e = hipLaunchCooperativeKernel((const void*)mega_fwd, dim3(grid), dim3(NTHR), kargs, LDS_BYTES, stream);
        if (e != hipSuccess) fprintf(stderr, "cooperative launch failed: %s\n", hipGetErrorString(e)); }
#else
    a.ph_lo = 0; a.ph_hi = NPH;
    void* kargs[] = {&a};
    hipError_t e = hipLaunchCooperativeKernel((const void*)mega_fwd, dim3(grid), dim3(NTHR), kargs, LDS_BYTES, stream);
    if (e != hipSuccess) fprintf(stderr, "cooperative launch failed: %s\n", hipGetErrorString(e));
#endif
#else
    for (int p = 0; p < NPH; ++p) { a.ph_lo = p; a.ph_hi = p + 1; hipLaunchKernelGGL(mega_fwd, dim3(grid), dim3(NTHR), LDS_BYTES, stream, a); }
#endif
}
```

```cpp
#include <hip/hip_runtime.h>
#include <hip/hip_bf16.h>
#include <cstdio>
#include <cstdint>

constexpr int NWAVES = 8, NTHR = 512;
constexpr int BATCH = 2, SEQ = 4096, DM = 2048, MTOK = BATCH * SEQ;
constexpr int CW = 1024, NHEAD = 16, HD = 64;
constexpr int SHIFTW = 3360, PROJW = 6432, PROJP = 6656;
constexpr int LORA_K = 384, LORA_N = 3072;
constexpr int NEXP = 32, FF = 512;
constexpr int MAXSLOT = 24576;
constexpr float RMS_EPS = 1e-6f, GN_EPS = 64e-5f;
constexpr float LOG2E = 1.4426950408889634f;

constexpr size_t MiB = 1u << 20;
constexpr size_t WS_CTL = 0, CTL_ZERO_BYTES = 1 * MiB;
constexpr size_t WS_MOD = 1 * MiB;
constexpr size_t WS_ROUTE = 1 * MiB + 128 * 1024;
constexpr size_t WS_SW = 1 * MiB + 512 * 1024;
constexpr size_t WS_B36 = 1 * MiB + 96 * 1024;
constexpr size_t WS_RSTD = 1 * MiB + 640 * 1024;
constexpr size_t WS_W36 = 1 * MiB + 704 * 1024;
constexpr size_t WS_WIN = 2 * MiB;
constexpr size_t WS_WOUT = 28 * MiB;
constexpr size_t WS_WL = 36 * MiB;
constexpr size_t WS_WGU = 39 * MiB;
constexpr size_t WS_WD = 167 * MiB;
constexpr size_t B0 = 231 * MiB;
constexpr size_t WS_P = B0;
constexpr size_t WS_PLR = B0 + 96 * MiB;
constexpr size_t HM_PART = (size_t)BATCH * NHEAD * SEQ * HD, HM_BATCH = (size_t)NHEAD * SEQ * HD, HM_HEAD = (size_t)SEQ * HD;
constexpr size_t WS_HB = B0 + 104 * MiB;
constexpr size_t WS_AL = B0 + 136 * MiB;
constexpr size_t WS_LW = B0 + 142 * MiB;
constexpr size_t WS_AA = B0 + 174 * MiB;
constexpr size_t WS_GG = B0 + 190 * MiB;
constexpr size_t WS_R = B0 + 206 * MiB, WS_K2 = B0 + 222 * MiB, WS_V = B0 + 238 * MiB, WS_KK = B0 + 254 * MiB, WS_BB = B0 + 270 * MiB;
constexpr size_t WS_YMIX = B0 + 286 * MiB;
constexpr size_t WS_X1 = B0;
constexpr size_t WS_H2P = B0 + 136 * MiB;
constexpr size_t WS_HG = B0 + 232 * MiB;
constexpr size_t WS_FP = B0 + 136 * MiB;
constexpr size_t WS_HM = B0 + 104 * MiB, WS_Y1 = B0 + 254 * MiB, WS_GT = B0 + 318 * MiB, WS_RH = B0 + 334 * MiB, WS_PLV = B0 + 136 * MiB;
constexpr size_t WS_SF = B0 + 152 * MiB;
constexpr size_t WS_END = B0 + 350 * MiB;
constexpr int CW_NRT = 1152, CW_TE = 1280, CW_BAR = 4096;
constexpr int NSLICE = 64, CW_CNT = 16384, CW_POS = 16384 + NSLICE * 32;

constexpr int CW_STAMP = 1200, CW_RDY = 1400;
#ifdef STAMP_ID
#ifndef STAMP_BLOCK
#define STAMP_BLOCK 0
#endif
#ifndef STAMP_MULT
#define STAMP_MULT 1u
#endif
#define STAMP_BEGIN(id) do { if ((id) == STAMP_ID && blockIdx.x == STAMP_BLOCK && threadIdx.x == 0) st_t0_ = __builtin_amdgcn_s_memrealtime(); } while (0)
#define STAMP_END(id) do { if ((id) == STAMP_ID && blockIdx.x == STAMP_BLOCK && threadIdx.x == 0) atomicAdd((unsigned*)(a.ws + WS_CTL) + CW_STAMP, (unsigned)(__builtin_amdgcn_s_memrealtime() - st_t0_)); } while (0)
#define STAMP_DECL unsigned long long st_t0_ = 0
#else
#define STAMP_BEGIN(id) do { } while (0)
#define STAMP_END(id) do { } while (0)
#define STAMP_DECL do { } while (0)
#endif
constexpr int RING_BYTES = 131072;
constexpr int LDSCTL_OFF = RING_BYTES, MISC_OFF = LDSCTL_OFF + 320;
constexpr int LDS_BYTES = 147456;

#define GAS __attribute__((address_space(1)))
#define LAS __attribute__((address_space(3)))
typedef unsigned short bf16;
typedef unsigned v4u __attribute__((ext_vector_type(4)));
typedef unsigned v2u __attribute__((ext_vector_type(2)));
typedef float f32x4 __attribute__((ext_vector_type(4)));
typedef short bf16x8 __attribute__((ext_vector_type(8)));
typedef short s16x4 __attribute__((ext_vector_type(4)));
typedef GAS unsigned gu32;
typedef GAS unsigned long long gu64;
#define RLX_AGENT __ATOMIC_RELAXED, __HIP_MEMORY_SCOPE_AGENT
#define LDS_WAIT() asm volatile("s_waitcnt lgkmcnt(0)" ::: "memory")
#define VM_WAIT() asm volatile("s_waitcnt vmcnt(0)" ::: "memory")
__device__ __forceinline__ unsigned f2bf(float f) { unsigned u = __builtin_bit_cast(unsigned, f); return (u + 0x7fffu + ((u >> 16) & 1u)) >> 16; }
typedef float f32x2_t __attribute__((ext_vector_type(2)));
typedef __bf16 bf16x2_t __attribute__((ext_vector_type(2)));
__device__ __forceinline__ unsigned pk2(float lo, float hi) { const f32x2_t v = {lo, hi}; return __builtin_bit_cast(unsigned, __builtin_convertvector(v, bf16x2_t)); }
__device__ __forceinline__ float bflo(unsigned u) { return __builtin_bit_cast(float, u << 16); }
__device__ __forceinline__ float bfhi(unsigned u) { return __builtin_bit_cast(float, u & 0xffff0000u); }
__device__ __forceinline__ float wave_sum(float v) {
#pragma unroll
    for (int o = 1; o < 64; o <<= 1) v += __shfl_xor(v, o);
    return v;
}
__device__ __forceinline__ float sigmoid_f(float x) { return __builtin_amdgcn_rcpf(1.f + __expf(-x)); }

struct Args { const float* in[30]; float* out; unsigned char* ws; int ph_lo, ph_hi, li, pad; };
enum { I_X = 0, I_C, I_WADA, I_BADA, I_N1G, I_WIN, I_MU, I_W0, I_WDEC, I_A0, I_WAAA, I_WGATEUP, I_KK, I_KA, I_RK, I_LNW, I_LNB, I_RELB, I_BETAR, I_BETAA,
       I_WOUT, I_N2G, I_WGRP, I_BGRP, I_WEXP, I_BEXP, I_WG, I_WU, I_WDN, I_NFG };
constexpr int NPH = 15;

namespace pg8 {
#define PG8_LAS __attribute__((address_space(3)))
typedef unsigned short bf16_t;
typedef short bf16x8 __attribute__((ext_vector_type(8)));
typedef float f32x4 __attribute__((ext_vector_type(4)));
typedef unsigned u32x4 __attribute__((ext_vector_type(4)));
constexpr int BM = 256, BK = 64, HALF = 128, HTB = HALF * BK * 2  , STAGE_BYTES = 8 * HTB, NXCD = 8, WGM = 8;

__host__ __device__ __forceinline__ int lds_byte(int r, int c) { const int st = (r >> 4) * 2 + (c >> 5), rr = r & 15, cc = c & 31, ob = rr * 64 + cc * 2; return st * 1024 + (ob ^ (((ob >> 9) & 1) << 5)); }
__host__ __device__ __forceinline__ void stage_rc(int b, int& R, int& C) { const int st = b / 1024, sb = b % 1024, swz = sb ^ (((sb >> 9) & 1) << 5); R = (st >> 1) * 16 + swz / 64; C = (st & 1) * 32 + (swz % 64) / 2; }
__host__ __device__ __forceinline__ int perm32(int rho) { const int n = rho >> 4, i = rho & 15; return 8 * (i >> 2) + 4 * n + (i & 3); }

struct Unit { int pm, pn; };
struct Gemm { const bf16_t* A; const bf16_t* Bt; int M, N, K; };

struct StaticOrder {
    int nM, nN, nwg, G, c;
    __host__ __device__ void init(int M, int N, int G_, int c_) { nM = M / BM; nN = N / BM; nwg = nM * nN; G = G_; c = c_; }
    __host__ __device__ bool next(int i, Unit& u) const {
        const long L = (long)i * G + c; if (L >= nwg) return false;
        int wgid = (int)L; { const int q = nwg / NXCD, r = nwg % NXCD, xcd = wgid % NXCD, off = wgid / NXCD; wgid = (xcd < r ? xcd * (q + 1) : r * (q + 1) + (xcd - r) * q) + off; }
        const int nig = WGM * nN, gid = wgid / nig, fm = gid * WGM, gsz = (nM - fm) < WGM ? (nM - fm) : WGM;
        u.pm = fm + ((wgid % nig) % gsz); u.pn = (wgid % nig) / gsz; return true;
    }
    __device__ __forceinline__ void a_ready(const Unit&) const {}
    __device__ __forceinline__ void done(const Unit&) const {}
};

__device__ __forceinline__ unsigned cvt_pk_bf16(float lo, float hi) { unsigned r; asm volatile("v_cvt_pk_bf16_f32 %0, %1, %2" : "=v"(r) : "v"(lo), "v"(hi)); return r; }
template <class Epi, class Sched, bool ALIGN_EPI = false, bool SP2 = false>
__device__ __forceinline__ void gemm_phase(PG8_LAS unsigned char* lds, const Gemm g, const Sched& S, const Epi& E) {
    const int tid = threadIdx.x, wid = __builtin_amdgcn_readfirstlane(tid >> 6), lane = tid & 63, wr = wid >> 2, wc = wid & 3, fr = lane & 15, fq = lane >> 4;
    const int K = g.K, nt = K / BK;
    unsigned voffA[2], voffB[2];
#pragma unroll
    for (int i = 0; i < 2; ++i) { int R, C; stage_rc(tid * 16 + i * 8192, R, C); const int Rb = Epi::PERM ? ((R & ~31) + perm32(R & 31)) : R;
        voffA[i] = (unsigned)(R * K + C) * 2u; voffB[i] = (unsigned)(Rb * K + C) * 2u; }
    const size_t kstep = (size_t)(BK * 2);
    const size_t hstep = (size_t)HALF * K * 2;
    const size_t tstep = 2 * hstep;
    const unsigned ldsw = (unsigned)wid * 1024u;
    const int aoff = lds_byte(wr * 64 + fr, fq * 8), boff = lds_byte(wc * 32 + fr, fq * 8);
#define PG8_SA(b, h) (((b) * 2 + (h)) * HTB)
#define PG8_SB(b, h) ((4 + (b) * 2 + (h)) * HTB)
#define PG8_STAGE(bufoff, gbase, voff) do { _Pragma("unroll") for (int _i = 0; _i < 2; ++_i) \
        __builtin_amdgcn_global_load_lds((const unsigned*)((const char*)(gbase) + (voff)[_i]), (PG8_LAS unsigned*)(lds + (bufoff) + ldsw + _i * 8192), 16, 0, 0); } while (0)
#define PG8_LDA(dst, b, h) do { _Pragma("unroll") for (int m = 0; m < 4; ++m) _Pragma("unroll") for (int k = 0; k < 2; ++k) dst[m][k] = *(const PG8_LAS bf16x8*)(lds + PG8_SA(b, h) + aoff + m * 2048 + k * 1024); } while (0)
#define PG8_LDB(dst, b, h) do { _Pragma("unroll") for (int n = 0; n < 2; ++n) _Pragma("unroll") for (int k = 0; k < 2; ++k) dst[n][k] = *(const PG8_LAS bf16x8*)(lds + PG8_SB(b, h) + boff + n * 2048 + k * 1024); } while (0)
#define PG8_MMA(ai, bj, At, Bt) do { __builtin_amdgcn_s_setprio(1); _Pragma("unroll") for (int m = 0; m < 4; ++m) _Pragma("unroll") for (int n = 0; n < 2; ++n) _Pragma("unroll") for (int k = 0; k < 2; ++k) \
        acc[ai][bj][m][n] = __builtin_amdgcn_mfma_f32_16x16x32_bf16(Bt[n][k], At[m][k], acc[ai][bj][m][n], 0, 0, 0); __builtin_amdgcn_s_setprio(0); } while (0)
#define PG8_WAIT_V(n) asm volatile("s_waitcnt vmcnt(" #n ")" ::: "memory")
#define PG8_WAIT_L(n) asm volatile("s_waitcnt lgkmcnt(" #n ")" ::: "memory")
#define PG8_BAR __builtin_amdgcn_s_barrier()
#define PG8_SCHED __builtin_amdgcn_sched_barrier(0)
    Unit cur, nxt; int ui = 0;
    if (!S.next(0, cur)) return;
    f32x4 acc[2][2][4][2];
#pragma unroll
    for (int a = 0; a < 2; ++a)
#pragma unroll
        for (int b = 0; b < 2; ++b)
#pragma unroll
            for (int m = 0; m < 4; ++m)
#pragma unroll
                for (int n = 0; n < 2; ++n) acc[a][b][m][n] = (f32x4){0.f, 0.f, 0.f, 0.f};
    bf16x8 At[4][2], B0[2][2], B1[2][2];
    const char* cA = (const char*)g.A + (size_t)cur.pm * tstep; const char* cB = (const char*)g.Bt + (size_t)cur.pn * tstep;
    S.a_ready(cur);
    if constexpr (SP2) {
        PG8_STAGE(PG8_SB(0, 0), cB, voffB); PG8_STAGE(PG8_SB(0, 1), cB + hstep, voffB); PG8_STAGE(PG8_SA(0, 0), cA, voffA); PG8_STAGE(PG8_SA(0, 1), cA + hstep, voffA);
        if (wr == 1) PG8_BAR;
        PG8_WAIT_V(2); PG8_BAR;
        PG8_STAGE(PG8_SB(1, 0), cB + kstep, voffB); PG8_STAGE(PG8_SA(1, 0), cA + kstep, voffA); PG8_STAGE(PG8_SB(1, 1), cB + hstep + kstep, voffB);
        PG8_WAIT_V(6); PG8_BAR;
    } else {
        PG8_STAGE(PG8_SB(0, 0), cB, voffB); PG8_STAGE(PG8_SA(0, 0), cA, voffA); PG8_STAGE(PG8_SB(0, 1), cB + hstep, voffB); PG8_STAGE(PG8_SA(0, 1), cA + hstep, voffA);
        if (wr == 1) PG8_BAR;
        PG8_WAIT_V(4); PG8_BAR;
        PG8_STAGE(PG8_SB(1, 0), cB + kstep, voffB); PG8_STAGE(PG8_SA(1, 0), cA + kstep, voffA); PG8_STAGE(PG8_SB(1, 1), cB + hstep + kstep, voffB);
        PG8_WAIT_V(6); PG8_BAR;
    }
    for (;;) {
        const bool has_next = S.next(ui + 1, nxt);
        const char* nA = has_next ? (const char*)g.A + (size_t)nxt.pm * tstep : cA; const char* nB = has_next ? (const char*)g.Bt + (size_t)nxt.pn * tstep : cB;
        for (int t = 0; t < nt; t += 2) {
            const bool last = (t == nt - 2);
            const char* a1 = cA + (size_t)(t + 1) * kstep;
            const char* a2 = last ? nA : cA + (size_t)(t + 2) * kstep; const char* b2 = last ? nB : cB + (size_t)(t + 2) * kstep;
            const char* a3 = a2 + kstep; const char* b3 = b2 + kstep;
            if (last && has_next) S.a_ready(nxt);
            if constexpr (SP2) {
            PG8_LDB(B0, 0, 0); PG8_LDB(B1, 0, 1); PG8_SCHED; PG8_LDA(At, 0, 0); PG8_STAGE(PG8_SA(1, 1), a1 + hstep, voffA);
            PG8_WAIT_V(8); PG8_WAIT_L(0); PG8_BAR; PG8_MMA(0, 0, At, B0); PG8_MMA(0, 1, At, B1); PG8_BAR; PG8_SCHED;
            PG8_LDA(At, 0, 1); PG8_STAGE(PG8_SB(0, 0), b2, voffB); PG8_STAGE(PG8_SB(0, 1), b2 + hstep, voffB); PG8_STAGE(PG8_SA(0, 0), a2, voffA);
            PG8_WAIT_V(8); PG8_WAIT_L(0); PG8_BAR; PG8_MMA(1, 0, At, B0); PG8_MMA(1, 1, At, B1); PG8_BAR; PG8_SCHED;
            PG8_LDB(B0, 1, 0); PG8_LDB(B1, 1, 1); PG8_SCHED; PG8_LDA(At, 1, 0); PG8_STAGE(PG8_SA(0, 1), a2 + hstep, voffA);
            PG8_WAIT_V(8); PG8_WAIT_L(0); PG8_BAR; PG8_MMA(0, 0, At, B0); PG8_MMA(0, 1, At, B1); PG8_BAR; PG8_SCHED;
            PG8_LDA(At, 1, 1); PG8_STAGE(PG8_SB(1, 0), b3, voffB); PG8_STAGE(PG8_SB(1, 1), b3 + hstep, voffB); PG8_STAGE(PG8_SA(1, 0), a3, voffA);
            PG8_WAIT_V(8); PG8_WAIT_L(0); PG8_BAR; PG8_MMA(1, 0, At, B0); PG8_MMA(1, 1, At, B1); PG8_BAR; PG8_SCHED;
            } else {
            PG8_LDB(B0, 0, 0); PG8_SCHED; PG8_LDA(At, 0, 0); PG8_STAGE(PG8_SA(1, 1), a1 + hstep, voffA);
            PG8_WAIT_L(8); PG8_BAR; PG8_WAIT_L(0); PG8_MMA(0, 0, At, B0); PG8_BAR; PG8_SCHED;
            PG8_LDB(B1, 0, 1); PG8_STAGE(PG8_SB(0, 0), b2, voffB);
            PG8_BAR; PG8_WAIT_L(0); PG8_MMA(0, 1, At, B1); PG8_BAR;
            PG8_LDA(At, 0, 1); PG8_STAGE(PG8_SA(0, 0), a2, voffA);
            PG8_BAR; PG8_WAIT_L(0); PG8_MMA(1, 0, At, B0); PG8_BAR; PG8_SCHED;
            PG8_STAGE(PG8_SB(0, 1), b2 + hstep, voffB);
            PG8_WAIT_V(6); PG8_BAR; PG8_MMA(1, 1, At, B1); PG8_BAR;
            PG8_LDB(B0, 1, 0); PG8_SCHED; PG8_LDA(At, 1, 0); PG8_STAGE(PG8_SA(0, 1), a2 + hstep, voffA);
            PG8_WAIT_L(8); PG8_BAR; PG8_WAIT_L(0); PG8_MMA(0, 0, At, B0); PG8_BAR; PG8_SCHED;
            PG8_LDB(B1, 1, 1); PG8_STAGE(PG8_SB(1, 0), b3, voffB);
            PG8_BAR; PG8_WAIT_L(0); PG8_MMA(0, 1, At, B1); PG8_BAR;
            PG8_LDA(At, 1, 1); PG8_STAGE(PG8_SA(1, 0), a3, voffA);
            PG8_BAR; PG8_WAIT_L(0); PG8_MMA(1, 0, At, B0); PG8_BAR; PG8_SCHED;
            PG8_STAGE(PG8_SB(1, 1), b3 + hstep, voffB);
            PG8_WAIT_V(6); PG8_BAR; PG8_MMA(1, 1, At, B1); PG8_BAR;
            }
        }
        if constexpr (ALIGN_EPI) { if (wr == 0) PG8_BAR; }
        if constexpr (!Epi::AFTER_DRAIN) { E(acc, cur, wr, wc, fr, fq); S.done(cur); }
        if (!has_next) break;
#pragma unroll
        for (int a = 0; a < 2; ++a)
#pragma unroll
            for (int b = 0; b < 2; ++b)
#pragma unroll
                for (int m = 0; m < 4; ++m)
#pragma unroll
                    for (int n = 0; n < 2; ++n) acc[a][b][m][n] = (f32x4){0.f, 0.f, 0.f, 0.f};
        cur = nxt; cA = nA; cB = nB; ++ui;
        if constexpr (ALIGN_EPI) { if (wr == 1) PG8_BAR; }
    }
    PG8_WAIT_V(0);
    if constexpr (!ALIGN_EPI) { if (wr == 0) PG8_BAR; }
    PG8_BAR;
    if constexpr (Epi::AFTER_DRAIN) { E.fused(acc, cur, wr, wc, fr, fq, lds, wid, lane); S.done(cur); }
#undef PG8_SA
#undef PG8_SB
#undef PG8_STAGE
#undef PG8_LDA
#undef PG8_LDB
#undef PG8_MMA
#undef PG8_WAIT_V
#undef PG8_WAIT_L
#undef PG8_BAR
#undef PG8_SCHED
}
}
#define XB_TMO      128
#define XB_XCNT(j)  (256  + 64 * (j))
#define XB_XSUB(j)  (1280 + 64 * (j))
#define XB_XGEN(j)  (2304 + 64 * (j))
#define XB_TOP      3328
#define XB_TOPGEN   3392
#define XCD_BAR_WORDS 3456
#define XB_SPIN_CAP (1u << 18)

__device__ __forceinline__ unsigned xb_ld(unsigned* p)              { return __hip_atomic_load(p, __ATOMIC_RELAXED, __HIP_MEMORY_SCOPE_AGENT); }
__device__ __forceinline__ unsigned xb_add(unsigned* p, unsigned v) { return __hip_atomic_fetch_add(p, v, __ATOMIC_RELAXED, __HIP_MEMORY_SCOPE_AGENT); }
__device__ __forceinline__ unsigned xb_xcc_id() { return (unsigned)__builtin_amdgcn_s_getreg((3 << 11) | 20) & 0xFu; }
#define XB_SPIN(cond, bar) do { unsigned _sp = 0; while (cond) { __builtin_amdgcn_s_sleep(1); \
    if ((++_sp & 255u) == 0u) { if (xb_ld(&(bar)[XB_TMO])) break; if (_sp > XB_SPIN_CAP) { atomicAdd(&(bar)[XB_TMO], 1u); break; } } } } while (0)

struct XcdBarrier {
    unsigned* bar; unsigned x;
    volatile LAS unsigned* st;
};

__device__ __forceinline__ XcdBarrier xcd_barrier_post(unsigned* bar, volatile LAS unsigned* st) {
    XcdBarrier b; b.bar = bar; b.x = xb_xcc_id(); b.st = st;
    if (threadIdx.x == 0) (void)xb_add(&bar[XB_XCNT(b.x)], 1u);
    return b;
}
__device__ __forceinline__ void xcd_barrier_complete(unsigned* bar, unsigned x, unsigned& nloc, unsigned& nx) {
    const unsigned G = gridDim.x * gridDim.y * gridDim.z;
    unsigned sum, cnt, mine, sp = 0u;
    for (;;) {
        sum = 0u; cnt = 0u; mine = 0u;
#pragma unroll
        for (unsigned j = 0; j < 16; ++j) { const unsigned c = xb_ld(&bar[XB_XCNT(j)]); sum += c; cnt += (c > 0u) ? 1u : 0u; mine = (j == x) ? c : mine; }
        if (sum == G) break;
        __builtin_amdgcn_s_sleep(1);
        if ((++sp & 255u) == 0u) { if (xb_ld(&bar[XB_TMO])) break; if (sp > XB_SPIN_CAP) { atomicAdd(&bar[XB_TMO], 1u); break; } }
    }
    nloc = mine > 0u ? mine : 1u; nx = cnt > 0u ? cnt : 1u;
}

__device__ __forceinline__ void xcd_barrier(const XcdBarrier& b) {
    asm volatile("s_waitcnt vmcnt(0)" ::: "memory");
    __syncthreads();
    if (threadIdx.x == 0) {
        unsigned* bar = b.bar;
        __builtin_amdgcn_s_waitcnt(0);
        unsigned nloc = b.st[0], nx = b.st[1];
        if (nloc == 0u) { xcd_barrier_complete(bar, b.x, nloc, nx); b.st[0] = nloc; b.st[1] = nx; }
        const unsigned old = xb_add(&bar[XB_XSUB(b.x)], 1u);
        const unsigned gen = old / nloc;
        if (old + 1u == (gen + 1u) * nloc) {
            __builtin_amdgcn_fence(__ATOMIC_RELEASE, "agent");
            asm volatile("s_waitcnt vmcnt(0)" ::: "memory");
            const unsigned og = xb_add(&bar[XB_TOP], 1u);
            const unsigned tg = og / nx;
            if (og + 1u == (tg + 1u) * nx) xb_add(&bar[XB_TOPGEN], 1u);
            else XB_SPIN(xb_ld(&bar[XB_TOPGEN]) == tg, bar);
            __builtin_amdgcn_fence(__ATOMIC_ACQUIRE, "agent");
            xb_add(&bar[XB_XGEN(b.x)], 1u);
            asm volatile("s_waitcnt vmcnt(0)" ::: "memory");
        } else {
            XB_SPIN(xb_ld(&bar[XB_XGEN(b.x)]) == gen, bar);
            __builtin_amdgcn_fence(__ATOMIC_ACQUIRE, "agent");
            asm volatile("s_waitcnt vmcnt(0)" ::: "memory");
        }
    }
    __syncthreads();
}

struct EpiStoreBf16 {
    static constexpr bool PERM = true, AFTER_DRAIN = false;
    bf16* O; int ldc; int pn_mask;
    __device__ __forceinline__ void operator()(const pg8::f32x4 (&acc)[2][2][4][2], const pg8::Unit& u, int wr, int wc, int fr_, int fq_) const {
        int t_ = threadIdx.x; asm volatile("" : "+v"(t_)); const int fr = t_ & 15, fq = (t_ >> 4) & 3; (void)fr_; (void)fq_;
        const int row0 = u.pm * 256 + wr * 64 + fr, col0 = (u.pn & pn_mask) * 256 + wc * 32 + 8 * fq;
#pragma unroll
        for (int ai = 0; ai < 2; ++ai)
#pragma unroll
            for (int m = 0; m < 4; ++m) { bf16* rowp = O + (size_t)(row0 + ai * 128 + m * 16) * ldc + col0;
#pragma unroll
                for (int bj = 0; bj < 2; ++bj) { const pg8::f32x4 v0 = acc[ai][bj][m][0], v1 = acc[ai][bj][m][1];
                    v4u w; w.x = pg8::cvt_pk_bf16(v0[0], v0[1]); w.y = pg8::cvt_pk_bf16(v0[2], v0[3]); w.z = pg8::cvt_pk_bf16(v1[0], v1[1]); w.w = pg8::cvt_pk_bf16(v1[2], v1[3]);
                    *(v4u*)(rowp + bj * 128) = w; } }
    }
};
struct EpiProj {
    static constexpr bool PERM = true, AFTER_DRAIN = false;
    bf16* HM; bf16* PLR;
    __device__ __forceinline__ void operator()(const pg8::f32x4 (&acc)[2][2][4][2], const pg8::Unit& u, int wr, int wc, int fr_, int fq_) const {
        int t_ = threadIdx.x; asm volatile("" : "+v"(t_)); const int fr = t_ & 15, fq = (t_ >> 4) & 3; (void)fr_; (void)fq_;
        const int row0 = u.pm * 256 + wr * 64 + fr, colb = u.pn * 256 + wc * 32 + 8 * fq;
#pragma unroll
        for (int bj = 0; bj < 2; ++bj) { const int idx = colb + bj * 128;
            if (idx >= PROJW) continue;
            const bool lora = idx >= 6144;
            const size_t hbase = (size_t)(idx >> 10) * HM_PART + (size_t)((idx >> 6) & 15) * HM_HEAD + (idx & 63);
#pragma unroll
            for (int ai = 0; ai < 2; ++ai)
#pragma unroll
                for (int m = 0; m < 4; ++m) { const int row = row0 + ai * 128 + m * 16;
                    bf16* dst = lora ? PLR + (size_t)row * 288 + (idx - 6144) : HM + hbase + (size_t)(row >> 12) * HM_BATCH + (size_t)(row & (SEQ - 1)) * HD;
                    const pg8::f32x4 v0 = acc[ai][bj][m][0], v1 = acc[ai][bj][m][1];
                    v4u w; w.x = pg8::cvt_pk_bf16(v0[0], v0[1]); w.y = pg8::cvt_pk_bf16(v0[2], v0[3]); w.z = pg8::cvt_pk_bf16(v1[0], v1[1]); w.w = pg8::cvt_pk_bf16(v1[2], v1[3]);
                    *(v4u*)dst = w; } }
    }
};
struct EpiGateUp {
    static constexpr bool PERM = true, AFTER_DRAIN = false;
    const float* sw; bf16* HG;
    __device__ __forceinline__ void operator()(const pg8::f32x4 (&acc)[2][2][4][2], const pg8::Unit& u, int wr, int wc, int fr_, int fq_) const {
        int t_ = threadIdx.x; asm volatile("" : "+v"(t_)); const int fr = t_ & 15, fq = (t_ >> 4) & 3; (void)fr_; (void)fq_;
        const int pl = u.pn & 3, row0 = u.pm * 256 + wr * 64 + fr, col0 = pl * 128 + wc * 32 + 8 * fq;
#pragma unroll
        for (int ai = 0; ai < 2; ++ai)
#pragma unroll
            for (int m = 0; m < 4; ++m) { const int row = row0 + ai * 128 + m * 16; const float w = sw[row]; float h[8];
#pragma unroll
                for (int n = 0; n < 2; ++n)
#pragma unroll
                    for (int j = 0; j < 4; ++j) { const float g = acc[ai][0][m][n][j], up = acc[ai][1][m][n][j]; h[4 * n + j] = g * sigmoid_f(g) * up * w; }
                v4u o; o.x = pg8::cvt_pk_bf16(h[0], h[1]); o.y = pg8::cvt_pk_bf16(h[2], h[3]); o.z = pg8::cvt_pk_bf16(h[4], h[5]); o.w = pg8::cvt_pk_bf16(h[6], h[7]);
                *(v4u*)(HG + (size_t)row * FF + col0) = o; }
    }
};
struct EpiResGate {
    static constexpr bool PERM = true, AFTER_DRAIN = false;
    const float* x; const float* gate; bf16* X1;
    __device__ __forceinline__ void operator()(const pg8::f32x4 (&acc)[2][2][4][2], const pg8::Unit& u, int wr, int wc, int fr_, int fq_) const {
        int t_ = threadIdx.x; asm volatile("" : "+v"(t_)); const int fr = t_ & 15, fq = (t_ >> 4) & 3; (void)fr_; (void)fq_;
        const int row0 = u.pm * 256 + wr * 64 + fr, col0 = u.pn * 256 + wc * 32 + 8 * fq;
        const float* gp = gate + (size_t)((u.pm * 256) >> 12) * 12288;
#pragma unroll
        for (int bj = 0; bj < 2; ++bj) { const int c = col0 + bj * 128; const pg8::f32x4 g0 = *(const pg8::f32x4*)(gp + c), g1 = *(const pg8::f32x4*)(gp + c + 4);
#pragma unroll
            for (int ai = 0; ai < 2; ++ai)
#pragma unroll
                for (int m = 0; m < 4; ++m) { const size_t off = (size_t)(row0 + ai * 128 + m * 16) * DM + c;
                    const pg8::f32x4 x0 = *(const pg8::f32x4*)(x + off) + g0 * acc[ai][bj][m][0], x1 = *(const pg8::f32x4*)(x + off + 4) + g1 * acc[ai][bj][m][1];
                    v4u w; w.x = pg8::cvt_pk_bf16(x0[0], x0[1]); w.y = pg8::cvt_pk_bf16(x0[2], x0[3]); w.z = pg8::cvt_pk_bf16(x1[0], x1[1]); w.w = pg8::cvt_pk_bf16(x1[2], x1[3]);
                    *(v4u*)(X1 + off) = w; } }
    }
};
struct EpiLora {
    static constexpr bool PERM = false, AFTER_DRAIN = false;
    float* LW; bf16* AA; bf16* GG;
    __device__ __forceinline__ void operator()(const pg8::f32x4 (&acc)[2][2][4][2], const pg8::Unit& u, int wr, int wc, int fr_, int fq_) const {
        int t_ = threadIdx.x; asm volatile("" : "+v"(t_)); const int fr = t_ & 15, fq = (t_ >> 4) & 3; (void)fr_; (void)fq_;
        const int type = u.pn >> 2, row0 = u.pm * 256 + wr * 64 + fr, col0 = (u.pn & 3) * 256 + wc * 32 + 4 * fq;
        bf16* hb = (type == 1) ? AA : GG;
#pragma unroll
        for (int bj = 0; bj < 2; ++bj)
#pragma unroll
            for (int n = 0; n < 2; ++n) { const int c = col0 + bj * 128 + n * 16;
#pragma unroll
                for (int ai = 0; ai < 2; ++ai)
#pragma unroll
                    for (int m = 0; m < 4; ++m) { const size_t off = (size_t)(row0 + ai * 128 + m * 16) * CW + c; const pg8::f32x4 v = acc[ai][bj][m][n];
                        if (type == 0) *(pg8::f32x4*)(LW + off) = v;
                        else { v2u o; o.x = pg8::cvt_pk_bf16(v[0], v[1]); o.y = pg8::cvt_pk_bf16(v[2], v[3]); *(v2u*)(hb + off) = o; } } }
    }
};
struct GroupOrder {
    const unsigned* te; int nrt, ncol, G, c;
    __device__ __forceinline__ bool next(int i, pg8::Unit& u) const {
        const long L = (long)i * G + c; if (L >= (long)nrt * ncol) return false;
        const int rt = (int)(L / ncol), pl = (int)(L - (long)rt * ncol);
        u.pm = rt; u.pn = (int)te[rt] * ncol + pl; return true;
    }
    __device__ __forceinline__ void a_ready(const pg8::Unit&) const {}
    __device__ __forceinline__ void done(const pg8::Unit&) const {}
};

struct GroupOrder2 {
    const unsigned* te; int ncol, base, count, Gp, cp;
    __device__ __forceinline__ bool next(int i, pg8::Unit& u) const {
        const long k = (long)i * Gp + cp; if (cp < 0 || k >= count) return false;
        const int L = base + (int)k, rt = L / ncol, pl = L - rt * ncol;
        u.pm = rt; u.pn = (int)te[rt] * ncol + pl; return true;
    }
    __device__ __forceinline__ void a_ready(const pg8::Unit&) const {}
    __device__ __forceinline__ void done(const pg8::Unit&) const {}
};

#define MFMA16(a, b, c) __builtin_amdgcn_mfma_f32_16x16x16bf16_1k(a, b, c, 0, 0, 0)
constexpr int NUNIT = BATCH * NHEAD * (SEQ / 64);
constexpr int LA_GF = 0, LA_SEG = 16384, LA_PL = 18432, LA_RT = 20480, LA_QT = 28672, LA_KT = 36864, LA_BT = 45056, LA_VT = 53248,
              LA_AQB = 61440, LA_AQK = 69632, LA_ARB = 77824, LA_ARK = 86016, LA_DG = 94208, LA_DL = 98304, LA_PRM = 100352;
__device__ __forceinline__ int swz(int row, int chunk) { return row * 128 + ((chunk ^ ((row >> 1) & 7)) << 4); }
__device__ __forceinline__ s16x4 tr_read(LAS unsigned char* base, int r0, int cb, int n) {
    return __builtin_bit_cast(s16x4, __builtin_amdgcn_ds_read_tr16_b64_v4i16((LAS s16x4*)(base + swz(r0 + (n >> 2), 2 * cb + ((n & 3) >> 1)) + 8 * (n & 1)))); }
__device__ __forceinline__ s16x4 row_read4(LAS unsigned char* base, int row, int col0) {
    return *(const LAS s16x4*)(base + swz(row, col0 >> 3) + 2 * (col0 & 7)); }
__device__ __forceinline__ s16x4 pack4(const f32x4 v) { v2u w; w.x = pk2(v[0], v[1]); w.y = pk2(v[2], v[3]); return __builtin_bit_cast(s16x4, w); }
__device__ __forceinline__ s16x4 pack4n(const f32x4 v) { v2u w; w.x = pk2(-v[0], -v[1]); w.y = pk2(-v[2], -v[3]); return __builtin_bit_cast(s16x4, w); }
__device__ __forceinline__ f32x4 unpack4(const s16x4 s) { const v2u w = __builtin_bit_cast(v2u, s); return (f32x4){bflo(w.x), bfhi(w.x), bflo(w.y), bfhi(w.y)}; }

#define LGKM0() do { asm volatile("s_waitcnt lgkmcnt(0)" ::: "memory"); __builtin_amdgcn_sched_barrier(0); } while (0)
#define LDS_BARRIER() do { asm volatile("s_waitcnt lgkmcnt(0)" ::: "memory"); __builtin_amdgcn_s_barrier(); asm volatile("" ::: "memory"); } while (0)
__device__ __forceinline__ void scanA(const Args& a, LAS unsigned char* lds) {
    const int tid = threadIdx.x, lane = tid & 63, wave = __builtin_amdgcn_readfirstlane(tid >> 6), n = lane & 15, g = lane >> 4;
    LAS float* GF = (LAS float*)(lds + LA_GF); LAS float* SEG = (LAS float*)(lds + LA_SEG); LAS float* PLs = (LAS float*)(lds + LA_PL); LAS float* DG = (LAS float*)(lds + LA_DG);
    const int tk = tid >> 3, c8 = 8 * (tid & 7);
    v4u nr4, nk4, nv4, pr4, pk4, pv4, na4; f32x4 nl0, nl1;
#define SCANA_LOAD(U) do { const int bh_ = (U) >> 6, ck_ = (U) & 63, h_ = bh_ & 15; const size_t m_ = (size_t)(bh_ >> 4) * SEQ + 64 * ck_ + tk; \
        const bf16* pc_ = (const bf16*)(a.ws + WS_P) + (size_t)(bh_ >> 4) * HM_BATCH + (size_t)h_ * HM_HEAD + (size_t)(64 * ck_ + tk) * HD + c8; const bf16* pp_ = pc_ - ((64 * ck_ + tk) != 0 ? HD : 0); \
        nr4 = *(const v4u*)pc_; nk4 = *(const v4u*)(pc_ + HM_PART); nv4 = *(const v4u*)(pc_ + 2 * HM_PART); pr4 = *(const v4u*)pp_; pk4 = *(const v4u*)(pp_ + HM_PART); pv4 = *(const v4u*)(pp_ + 2 * HM_PART); \
        const size_t off_ = m_ * CW + h_ * 64 + c8; na4 = *(const v4u*)((const bf16*)(a.ws + WS_AA) + off_); \
        nl0 = *(const f32x4*)((const float*)(a.ws + WS_LW) + off_); nl1 = *(const f32x4*)((const float*)(a.ws + WS_LW) + off_ + 4); } while (0)
#define SCANA_UNIT(IDX) (((((IDX) >> 10) * 16 + ((IDX) & 15)) << 6) + (((IDX) >> 4) & 63))
    if ((int)blockIdx.x < NUNIT) SCANA_LOAD(SCANA_UNIT((int)blockIdx.x));
    STAMP_DECL;
    LAS float* PRM = (LAS float*)(lds + LA_PRM);
    int hcur = -1;
    for (int idx = blockIdx.x; idx < NUNIT; idx += gridDim.x) {
        const int unit = SCANA_UNIT(idx);
        int tid_o = threadIdx.x; asm volatile("" : "+v"(tid_o));
        const int tid = tid_o, lane = tid & 63, n = lane & 15, g = lane >> 4, tk = tid >> 3, c8 = 8 * (tid & 7);
        STAMP_BEGIN(5); STAMP_BEGIN(1); STAMP_BEGIN(31);
        const int h = (unit >> 6) & 15, ch0 = h * 64 + c8; const bool first = ((unit & 63) == 0) && (tk == 0);
        if (h != hcur) { hcur = h;
            if (tid < 448) { const int which = tid >> 6, c = tid & 63; const float* src = (which == 0) ? a.in[I_MU] : (which == 1) ? a.in[I_MU] + 1024 : (which == 2) ? a.in[I_MU] + 2048 :
                    (which == 3) ? a.in[I_A0] : (which == 4) ? a.in[I_KK] : (which == 5) ? a.in[I_KA] : a.in[I_W0];
                PRM[tid] = src[h * 64 + c]; }
            LDS_BARRIER(); }
        float pmr[8], pmk[8], pmv[8], pa0[8], pkk[8], pka[8], pw0[8];
        { f32x4 pv[14];
#pragma unroll
          for (int q = 0; q < 7; ++q) { pv[2 * q] = *(const LAS f32x4*)(PRM + 64 * q + c8); pv[2 * q + 1] = *(const LAS f32x4*)(PRM + 64 * q + c8 + 4); }
          LGKM0();
#pragma unroll
          for (int i = 0; i < 8; ++i) { pmr[i] = pv[0 + (i >> 2)][i & 3]; pmk[i] = pv[2 + (i >> 2)][i & 3]; pmv[i] = pv[4 + (i >> 2)][i & 3]; pa0[i] = pv[6 + (i >> 2)][i & 3];
              pkk[i] = pv[8 + (i >> 2)][i & 3]; pka[i] = pv[10 + (i >> 2)][i & 3]; pw0[i] = pv[12 + (i >> 2)][i & 3]; } }
        float rf[8], kf[8], vf8[8], qf8[8], bf8[8]; f32x4 l0, l1;
        { float av[8], kkv[8]; float ssq = 0.f;
#pragma unroll
          for (int i = 0; i < 8; ++i) { const int wd = i >> 1; const bool hi = i & 1;
              const float cr = hi ? bfhi(nr4[wd]) : bflo(nr4[wd]), ckk = hi ? bfhi(nk4[wd]) : bflo(nk4[wd]), cv = hi ? bfhi(nv4[wd]) : bflo(nv4[wd]);
              const float qr = first ? 0.f : (hi ? bfhi(pr4[wd]) : bflo(pr4[wd])), qk = first ? 0.f : (hi ? bfhi(pk4[wd]) : bflo(pk4[wd])), qv = first ? 0.f : (hi ? bfhi(pv4[wd]) : bflo(pv4[wd]));
              rf[i] = cr + (qr - cr) * pmr[i]; kf[i] = ckk + (qk - ckk) * pmk[i]; vf8[i] = cv + (qv - cv) * pmv[i];
              av[i] = sigmoid_f((hi ? bfhi(na4[wd]) : bflo(na4[wd])) + pa0[i]);
              kkv[i] = kf[i] * pkk[i]; ssq += kkv[i] * kkv[i]; }
          ssq += __shfl_xor(ssq, 1); ssq += __shfl_xor(ssq, 2); ssq += __shfl_xor(ssq, 4);
          const float inv = __builtin_amdgcn_rsqf(fmaxf(ssq, 1e-24f));
#pragma unroll
          for (int i = 0; i < 8; ++i) { qf8[i] = kkv[i] * inv; bf8[i] = qf8[i] * av[i]; kf[i] = kf[i] * (1.f + (av[i] - 1.f) * pka[i]); }
#pragma unroll
          for (int i = 0; i < 4; ++i) {
              l0[i] = -0.60653066f * sigmoid_f(nl0[i] + pw0[i]); l1[i] = -0.60653066f * sigmoid_f(nl1[i] + pw0[4 + i]); }
          const size_t off = ((size_t)(unit >> 10) * SEQ + 64 * (unit & 63) + tk) * CW + ch0; v4u w;
          w.x = pk2(rf[0], rf[1]); w.y = pk2(rf[2], rf[3]); w.z = pk2(rf[4], rf[5]); w.w = pk2(rf[6], rf[7]); *(v4u*)((bf16*)(a.ws + WS_R) + off) = w;
          w.x = pk2(kf[0], kf[1]); w.y = pk2(kf[2], kf[3]); w.z = pk2(kf[4], kf[5]); w.w = pk2(kf[6], kf[7]); *(v4u*)((bf16*)(a.ws + WS_K2) + off) = w;
          w.x = pk2(vf8[0], vf8[1]); w.y = pk2(vf8[2], vf8[3]); w.z = pk2(vf8[4], vf8[5]); w.w = pk2(vf8[6], vf8[7]); *(v4u*)((bf16*)(a.ws + WS_V) + off) = w; }
        *(LAS f32x4*)(GF + tk * 64 + c8) = l0; *(LAS f32x4*)(GF + tk * 64 + c8 + 4) = l1;
        LDS_BARRIER();
        STAMP_END(31); STAMP_BEGIN(32);
        { const int c = tid & 63, sg = tid >> 6; float gv[8], run = 0.f;
#pragma unroll
          for (int i = 0; i < 8; ++i) gv[i] = GF[(8 * sg + i) * 64 + c];
          LGKM0();
#pragma unroll
          for (int i = 0; i < 8; ++i) { run += gv[i]; GF[(8 * sg + i) * 64 + c] = run; }
          SEG[sg * 64 + c] = run; }
        LDS_BARRIER();
        STAMP_END(32); STAMP_BEGIN(33);
        { const int sg = tk >> 3; float gg[8], lw[8];
          f32x4 gq[2], sq[7][2];
          gq[0] = *(const LAS f32x4*)(GF + tk * 64 + c8); gq[1] = *(const LAS f32x4*)(GF + tk * 64 + c8 + 4);
#pragma unroll
          for (int s2 = 0; s2 < 7; ++s2) { sq[s2][0] = *(const LAS f32x4*)(SEG + s2 * 64 + c8); sq[s2][1] = *(const LAS f32x4*)(SEG + s2 * 64 + c8 + 4); }
          LGKM0();
#pragma unroll
          for (int i = 0; i < 8; ++i) { float x = gq[i >> 2][i & 3];
#pragma unroll
              for (int s2 = 0; s2 < 7; ++s2) x += (s2 < sg) ? sq[s2][i >> 2][i & 3] : 0.f;
              gg[i] = x; lw[i] = (i < 4) ? l0[i] : l1[i - 4]; }
          float rr[8], qq[8], kk[8], bb[8];
#pragma unroll
          for (int i = 0; i < 4; ++i) { const int e0 = 2 * i, e1 = 2 * i + 1;
              const float eg0 = __expf(gg[e0]), eg1 = __expf(gg[e1]), en0 = __expf(-gg[e0]), en1 = __expf(-gg[e1]), em0 = __expf(gg[e0] - lw[e0]), em1 = __expf(gg[e1] - lw[e1]);
              rr[e0] = rf[e0] * eg0; rr[e1] = rf[e1] * eg1; qq[e0] = qf8[e0] * em0; qq[e1] = qf8[e1] * em1;
              kk[e0] = kf[e0] * en0; kk[e1] = kf[e1] * en1; bb[e0] = bf8[e0] * en0; bb[e1] = bf8[e1] * en1;
              if (tk == 63) { PLs[c8 + e0] = eg0; PLs[c8 + e1] = eg1; } }
          const int so = swz(tk, tid & 7); v4u w;
          w.x = pk2(rr[0], rr[1]); w.y = pk2(rr[2], rr[3]); w.z = pk2(rr[4], rr[5]); w.w = pk2(rr[6], rr[7]); *(LAS v4u*)(lds + LA_RT + so) = w;
          w.x = pk2(qq[0], qq[1]); w.y = pk2(qq[2], qq[3]); w.z = pk2(qq[4], qq[5]); w.w = pk2(qq[6], qq[7]); *(LAS v4u*)(lds + LA_QT + so) = w;
          w.x = pk2(kk[0], kk[1]); w.y = pk2(kk[2], kk[3]); w.z = pk2(kk[4], kk[5]); w.w = pk2(kk[6], kk[7]); *(LAS v4u*)(lds + LA_KT + so) = w;
          w.x = pk2(bb[0], bb[1]); w.y = pk2(bb[2], bb[3]); w.z = pk2(bb[4], bb[5]); w.w = pk2(bb[6], bb[7]); *(LAS v4u*)(lds + LA_BT + so) = w;
          w.x = pk2(vf8[0], vf8[1]); w.y = pk2(vf8[2], vf8[3]); w.z = pk2(vf8[4], vf8[5]); w.w = pk2(vf8[6], vf8[7]); *(LAS v4u*)(lds + LA_VT + so) = w; }
        LDS_BARRIER();
        STAMP_END(33); STAMP_END(1); STAMP_BEGIN(2);
        if (idx + (int)gridDim.x < NUNIT) SCANA_LOAD(SCANA_UNIT(idx + (int)gridDim.x));
        for (int id = wave; id < 40; id += NWAVES) {
            const int mat = id / 10, p = id - mat * 10, tb = p < 1 ? 0 : (p < 3 ? 1 : (p < 6 ? 2 : 3)), sb = p - tb * (tb + 1) / 2;
            LAS unsigned char* Lft = lds + ((mat & 1) ? LA_KT : LA_BT); LAS unsigned char* Rgt = lds + ((mat & 2) ? LA_RT : LA_QT);
            f32x4 acc = (f32x4){0.f, 0.f, 0.f, 0.f};
#pragma unroll
            for (int ks = 0; ks < 2; ++ks) { const bf16x8 af = *(const LAS bf16x8*)(Lft + swz(16 * sb + n, 4 * ks + g)), bfr = *(const LAS bf16x8*)(Rgt + swz(16 * tb + n, 4 * ks + g));
                acc = __builtin_amdgcn_mfma_f32_16x16x32_bf16(af, bfr, acc, 0, 0, 0); }
            const int t = 16 * tb + n, s0 = 16 * sb + 4 * g;
#pragma unroll
            for (int j = 0; j < 4; ++j) { const bool keep = (mat & 2) ? (s0 + j <= t) : (s0 + j < t); if (!keep) acc[j] = 0.f; }
            LAS unsigned char* dst = lds + (mat == 0 ? LA_AQB : (mat == 1 ? LA_AQK : (mat == 2 ? LA_ARB : LA_ARK)));
            v2u w; w.x = pk2(acc[0], acc[1]); w.y = pk2(acc[2], acc[3]);
            *(LAS v2u*)(dst + swz(t, s0 >> 3) + 2 * (s0 & 7)) = w;
            if (mat == 0 && sb == tb) *(LAS f32x4*)(DG + tb * 256 + n * 16 + 4 * g) = acc;
        }
        LDS_BARRIER();
        STAMP_END(2); STAMP_BEGIN(3);
        const bool isU = wave >= 4; const int cb = wave & 3;
        LAS unsigned char* AQB = lds + LA_AQB; LAS unsigned char* AQK = lds + LA_AQK; LAS unsigned char* ARB = lds + LA_ARB; LAS unsigned char* ARK = lds + LA_ARK;
        s16x4 vf[4], xn[4], fqb[6], frb[10], fbt[16];
        f32x4 rhs[4], y1a[4], hma[4], rti[4];
        if (isU) {
            s16x4 fqk[10], frk[10], fkt[16];
#pragma unroll
            for (int k = 0; k < 4; ++k) vf[k] = tr_read(lds + LA_VT, 16 * k + 4 * g, cb, n);
#pragma unroll
            for (int i = 0; i < 4; ++i)
#pragma unroll
                for (int k = 0; k < 4; ++k) { if (k <= i) { fqk[i * (i + 1) / 2 + k] = row_read4(AQK, 16 * i + n, 16 * k + 4 * g); frk[i * (i + 1) / 2 + k] = row_read4(ARK, 16 * i + n, 16 * k + 4 * g); }
                    fkt[4 * i + k] = tr_read(lds + LA_KT, 16 * k + 4 * g, i, n); }
            LGKM0();
#pragma unroll
            for (int i = 0; i < 4; ++i) { f32x4 acc = (f32x4){0.f, 0.f, 0.f, 0.f}, ac2 = acc, ac3 = acc;
#pragma unroll
                for (int k = 0; k < 4; ++k) { if (k <= i) { acc = MFMA16(fqk[i * (i + 1) / 2 + k], vf[k], acc); ac2 = MFMA16(frk[i * (i + 1) / 2 + k], vf[k], ac2); }
                    ac3 = MFMA16(vf[k], fkt[4 * i + k], ac3); }
                rhs[i] = acc; y1a[i] = ac2; hma[i] = ac3; rti[i] = acc; }
        } else {
            if (lane < 16) {
                const LAS float* A = DG + wave * 256; float x[16]; f32x4 ar[16][4];
                int lj = lane; asm volatile("" : "+v"(lj));
                x[0] = (lj == 0) ? 1.f : 0.f;
#pragma unroll
                for (int t = 1; t < 9; ++t)
#pragma unroll
                    for (int q = 0; q < 4; ++q) if (4 * q < t) ar[t][q] = *(const LAS f32x4*)(A + t * 16 + 4 * q);
                LGKM0();
#pragma unroll
                for (int t = 1; t < 9; ++t) { float a0 = (t == lj) ? 1.f : 0.f, a1 = 0.f;
#pragma unroll
                    for (int s2 = 0; s2 < t; ++s2) { if (s2 & 1) a1 -= ar[t][s2 >> 2][s2 & 3] * x[s2]; else a0 -= ar[t][s2 >> 2][s2 & 3] * x[s2]; }
                    x[t] = a0 + a1; }
#pragma unroll
                for (int t = 9; t < 13; ++t)
#pragma unroll
                    for (int q = 0; q < 4; ++q) if (4 * q < t) ar[t][q] = *(const LAS f32x4*)(A + t * 16 + 4 * q);
                LGKM0();
#pragma unroll
                for (int t = 9; t < 13; ++t) { float a0 = (t == lj) ? 1.f : 0.f, a1 = 0.f;
#pragma unroll
                    for (int s2 = 0; s2 < t; ++s2) { if (s2 & 1) a1 -= ar[t][s2 >> 2][s2 & 3] * x[s2]; else a0 -= ar[t][s2 >> 2][s2 & 3] * x[s2]; }
                    x[t] = a0 + a1; }
#pragma unroll
                for (int t = 13; t < 16; ++t)
#pragma unroll
                    for (int q = 0; q < 4; ++q) if (4 * q < t) ar[t][q] = *(const LAS f32x4*)(A + t * 16 + 4 * q);
                LGKM0();
#pragma unroll
                for (int t = 13; t < 16; ++t) { float a0 = (t == lj) ? 1.f : 0.f, a1 = 0.f;
#pragma unroll
                    for (int s2 = 0; s2 < t; ++s2) { if (s2 & 1) a1 -= ar[t][s2 >> 2][s2 & 3] * x[s2]; else a0 -= ar[t][s2 >> 2][s2 & 3] * x[s2]; }
                    x[t] = a0 + a1; }
                LAS bf16* D = (LAS bf16*)(lds + LA_DL) + wave * 256;
#pragma unroll
                for (int t = 0; t < 16; ++t) D[t * 16 + lane] = (bf16)f2bf(x[t]);
            }
#pragma unroll
            for (int i = 0; i < 4; ++i) { rhs[i] = unpack4(tr_read(lds + LA_QT, 16 * i + 4 * g, cb, n)); rti[i] = unpack4(tr_read(lds + LA_RT, 16 * i + 4 * g, cb, n)); vf[i] = (s16x4){0, 0, 0, 0}; y1a[i] = (f32x4){0.f, 0.f, 0.f, 0.f}; hma[i] = y1a[i]; }
        }
#pragma unroll
        for (int i = 0; i < 4; ++i)
#pragma unroll
            for (int k = 0; k < 4; ++k) { if (k < i) fqb[i * (i - 1) / 2 + k] = row_read4(AQB, 16 * i + n, 16 * k + 4 * g); if (k <= i) frb[i * (i + 1) / 2 + k] = row_read4(ARB, 16 * i + n, 16 * k + 4 * g);
                fbt[4 * i + k] = tr_read(lds + LA_BT, 16 * k + 4 * g, i, n); }
        LDS_BARRIER();
        STAMP_END(3); STAMP_BEGIN(4);
        {
            s16x4 df[4];
#pragma unroll
            for (int i = 0; i < 4; ++i) df[i] = *(const LAS s16x4*)(lds + LA_DL + i * 512 + n * 32 + 8 * g);
            const float plv[4] = {PLs[n], PLs[16 + n], PLs[32 + n], PLs[48 + n]};
            LGKM0();
#pragma unroll
            for (int i = 0; i < 4; ++i) { f32x4 acc = rhs[i];
#pragma unroll
                for (int k = 0; k < 4; ++k) if (k < i) acc = MFMA16(fqb[i * (i - 1) / 2 + k], xn[k], acc);
                const f32x4 xi = MFMA16(df[i], pack4(acc), ((f32x4){0.f, 0.f, 0.f, 0.f}));
                xn[i] = pack4n(xi); }
            if (!isU) {
                bf16* RH = (bf16*)(a.ws + WS_RH) + (size_t)unit * 4096;
#pragma unroll
                for (int i = 0; i < 4; ++i) { f32x4 acc = rti[i];
#pragma unroll
                    for (int k = 0; k < 4; ++k) if (k <= i) acc = MFMA16(frb[i * (i + 1) / 2 + k], xn[k], acc);
#pragma unroll
                    for (int j = 0; j < 4; ++j) RH[(16 * i + 4 * g + j) * 64 + 16 * cb + n] = (bf16)f2bf(acc[j]); }
                bf16* GT = (bf16*)(a.ws + WS_GT) + (size_t)unit * 4096;
#pragma unroll
                for (int c2b = 0; c2b < 4; ++c2b) { f32x4 acc = (f32x4){0.f, 0.f, 0.f, 0.f};
#pragma unroll
                    for (int k = 0; k < 4; ++k) acc = MFMA16(xn[k], fbt[4 * c2b + k], acc);
                    acc *= plv[c2b]; *(v2u*)(GT + (16 * c2b + n) * 64 + 16 * cb + 4 * g) = __builtin_bit_cast(v2u, pack4(acc)); }
            } else {
                float* Y1 = (float*)(a.ws + WS_Y1) + (size_t)unit * 4096;
#pragma unroll
                for (int i = 0; i < 4; ++i) { f32x4 acc = y1a[i];
#pragma unroll
                    for (int k = 0; k < 4; ++k) if (k <= i) acc = MFMA16(frb[i * (i + 1) / 2 + k], xn[k], acc);
#pragma unroll
                    for (int j = 0; j < 4; ++j) Y1[(16 * i + 4 * g + j) * 64 + 16 * cb + n] = acc[j]; }
                float* HM = (float*)(a.ws + WS_HM) + (size_t)unit * 4096;
#pragma unroll
                for (int c2b = 0; c2b < 4; ++c2b) { f32x4 acc = hma[c2b];
#pragma unroll
                    for (int k = 0; k < 4; ++k) acc = MFMA16(xn[k], fbt[4 * c2b + k], acc);
#pragma unroll
                    for (int j = 0; j < 4; ++j) HM[(16 * cb + 4 * g + j) * 64 + 16 * c2b + n] = acc[j] * plv[c2b]; }
            }
            if (wave == 0) ((float*)(a.ws + WS_PLV))[(size_t)unit * 64 + lane] = PLs[lane];
        }
        LDS_BARRIER();
        STAMP_END(4); STAMP_END(5);
    }
}

constexpr int LB_SLOT = 13312, LB_NPIECE = 13, LB_PER_WAVE = 4, LB_NSLOT = 8, LB_DIST = 7;
__device__ __forceinline__ void chainB_issue(const Args& a, LAS unsigned char* lds, size_t unit, int vb, int step, int lw, int lane) {
    const unsigned char* gt = a.ws + WS_GT + unit * 8192; const unsigned char* hm = a.ws + WS_HM + unit * 16384 + vb * 4096; const unsigned char* pv = a.ws + WS_PLV + unit * 256;
#pragma unroll
    for (int i = 0; i < LB_PER_WAVE; ++i) { int p = lw + 4 * i; p = p < LB_NPIECE - 1 ? p : LB_NPIECE - 1;
        const unsigned char* src = (p < 8) ? gt + p * 1024 : ((p < 12) ? hm + (p - 8) * 1024 : pv);
        __builtin_amdgcn_global_load_lds((const unsigned*)(src + lane * 16), (LAS unsigned*)(lds + (step & (LB_NSLOT - 1)) * LB_SLOT + p * 1024), 16, 0, 0); }
}
struct ChainOps { s16x4 gf[4][4]; f32x4 hm[4], pl[4]; };
__device__ __forceinline__ void chainB_read(ChainOps& o, LAS unsigned char* sl, int n, int g) {
#pragma unroll
    for (int i = 0; i < 4; ++i) { o.hm[i] = *(const LAS f32x4*)(sl + 8192 + (n * 64 + 16 * i + 4 * g) * 4); o.pl[i] = *(const LAS f32x4*)(sl + 12288 + (16 * i + 4 * g) * 4);
#pragma unroll
        for (int k = 0; k < 4; ++k) o.gf[i][k] = *(const LAS s16x4*)(sl + (16 * i + n) * 128 + (16 * k + 4 * g) * 2); }
}
__device__ __forceinline__ void chainB_step(const ChainOps& o, f32x4 (&acc)[4], v2u* SF) {
    s16x4 sb[4]; f32x4 nx[4];
#pragma unroll
    for (int k = 0; k < 4; ++k) { sb[k] = pack4(acc[k]); SF[k * 64] = __builtin_bit_cast(v2u, sb[k]); }
#pragma unroll
    for (int i = 0; i < 4; ++i) nx[i] = o.pl[i] * acc[i] + o.hm[i];
#pragma unroll
    for (int k = 0; k < 4; ++k)
#pragma unroll
        for (int i = 0; i < 4; ++i) nx[i] = MFMA16(o.gf[i][k], sb[k], nx[i]);
#pragma unroll
    for (int i = 0; i < 4; ++i) acc[i] = nx[i];
}
__device__ __forceinline__ void scanB(const Args& a, LAS unsigned char* lds) {
    const int tid = threadIdx.x, lane = tid & 63, wave = __builtin_amdgcn_readfirstlane(tid >> 6), n = lane & 15, g = lane >> 4;
    constexpr int NCK = SEQ / 64;
    for (int item = blockIdx.x; item < BATCH * NHEAD * 4; item += gridDim.x) {
        const int bh = item >> 2, vb = item & 3;
        const size_t u0 = (size_t)bh * 64;
        f32x4 acc[4];
#pragma unroll
        for (int i = 0; i < 4; ++i) acc[i] = (f32x4){0.f, 0.f, 0.f, 0.f};
        if (wave >= 4) {
#pragma unroll
            for (int s = 0; s < LB_DIST; ++s) chainB_issue(a, lds, u0 + s, vb, s, wave - 4, lane);
            asm volatile("s_waitcnt vmcnt(20)" ::: "memory"); }
        __builtin_amdgcn_s_barrier(); asm volatile("" ::: "memory");
        if (wave >= 4) {
            for (int ck = 0; ck < NCK; ++ck) {
                if (ck + LB_DIST < NCK) { chainB_issue(a, lds, u0 + ck + LB_DIST, vb, ck + LB_DIST, wave - 4, lane); asm volatile("s_waitcnt vmcnt(20)" ::: "memory"); }
                else asm volatile("s_waitcnt vmcnt(0)" ::: "memory");
                __builtin_amdgcn_s_barrier(); asm volatile("" ::: "memory");
            }
        } else if (wave == 0) {
            v2u* SF = (v2u*)(a.ws + WS_SF) + (u0 * 16 + vb * 4) * 64 + lane;
            ChainOps A, B;
            chainB_read(A, lds, n, g);
            for (int ck = 0; ck < NCK; ck += 2) {
                chainB_read(B, lds + ((ck + 1) & (LB_NSLOT - 1)) * LB_SLOT, n, g);
                chainB_step(A, acc, SF + (size_t)ck * 16 * 64);
                __builtin_amdgcn_s_barrier(); asm volatile("" ::: "memory");
                if (ck + 2 < NCK) chainB_read(A, lds + ((ck + 2) & (LB_NSLOT - 1)) * LB_SLOT, n, g);
                chainB_step(B, acc, SF + (size_t)(ck + 1) * 16 * 64);
                __builtin_amdgcn_s_barrier(); asm volatile("" ::: "memory");
            }
        } else {
            for (int ck = 0; ck < NCK; ++ck) { __builtin_amdgcn_s_barrier(); asm volatile("" ::: "memory"); }
        }
    }
}

__device__ __forceinline__ void scanC(const Args& a) {
    const int tid = threadIdx.x, lane = tid & 63, wave = tid >> 6, n = lane & 15, g = lane >> 4;
    const int gw = blockIdx.x * NWAVES + wave, NGW = gridDim.x * NWAVES;
    struct Blk { s16x4 rf[4], rq[4], kq[4], vq[4], gq[4]; f32x4 y1[4]; };
    for (int unit = gw; unit < NUNIT; unit += NGW) {
        const int bh = unit >> 6, ck = unit & 63, b = bh >> 4, h = bh & 15;
        const v2u* SF = (const v2u*)(a.ws + WS_SF) + (size_t)unit * 16 * 64 + lane;
        const bf16* RH = (const bf16*)(a.ws + WS_RH) + (size_t)unit * 4096; const float* Y1 = (const float*)(a.ws + WS_Y1) + (size_t)unit * 4096;
        const size_t mb = (size_t)b * SEQ + 64 * ck + n;
        s16x4 sf[16];
#pragma unroll
        for (int q = 0; q < 16; ++q) sf[q] = __builtin_bit_cast(s16x4, SF[q * 64]);
        auto ldblk = [&](int i, Blk& B) {
#pragma unroll
            for (int vb = 0; vb < 4; ++vb) { const size_t o = (mb + 16 * i) * CW + h * 64 + 16 * vb + 4 * g;
                B.rq[vb] = *(const s16x4*)((const bf16*)(a.ws + WS_R) + o); B.kq[vb] = *(const s16x4*)((const bf16*)(a.ws + WS_K2) + o);
                B.vq[vb] = *(const s16x4*)((const bf16*)(a.ws + WS_V) + o); B.gq[vb] = *(const s16x4*)((const bf16*)(a.ws + WS_GG) + o);
                B.y1[vb] = *(const f32x4*)(Y1 + (16 * i + n) * 64 + 16 * vb + 4 * g); B.rf[vb] = *(const s16x4*)(RH + (16 * i + n) * 64 + 16 * vb + 4 * g); } };
        auto doblk = [&](int i, Blk& B) {
            f32x4 acc[4];
#pragma unroll
            for (int vb = 0; vb < 4; ++vb) { acc[vb] = B.y1[vb];
#pragma unroll
                for (int k = 0; k < 4; ++k) acc[vb] = MFMA16(sf[vb * 4 + k], B.rf[k], acc[vb]); }
            float s1 = 0.f;
#pragma unroll
            for (int vb = 0; vb < 4; ++vb) s1 += (acc[vb][0] + acc[vb][1]) + (acc[vb][2] + acc[vb][3]);
            s1 += __shfl_xor(s1, 16); s1 += __shfl_xor(s1, 32);
            const float mean = s1 * (1.f / 64.f); float s2 = 0.f;
#pragma unroll
            for (int vb = 0; vb < 4; ++vb)
#pragma unroll
                for (int j = 0; j < 4; ++j) { const float d = acc[vb][j] - mean; s2 += d * d; }
            s2 += __shfl_xor(s2, 16); s2 += __shfl_xor(s2, 32);
            const float rstd = 1.f / sqrtf(s2 * (1.f / 64.f) + GN_EPS);
            f32x4 rv[4], kv[4], vv[4], gv[4]; float dot = 0.f;
#pragma unroll
            for (int vb = 0; vb < 4; ++vb) { rv[vb] = unpack4(B.rq[vb]); kv[vb] = unpack4(B.kq[vb]); vv[vb] = unpack4(B.vq[vb]); gv[vb] = unpack4(B.gq[vb]);
                const f32x4 rk = *(const f32x4*)(a.in[I_RK] + h * 64 + 16 * vb + 4 * g);
#pragma unroll
                for (int j = 0; j < 4; ++j) dot += rv[vb][j] * kv[vb][j] * rk[j]; }
            dot += __shfl_xor(dot, 16); dot += __shfl_xor(dot, 32);
#pragma unroll
            for (int vb = 0; vb < 4; ++vb) { const int c = h * 64 + 16 * vb + 4 * g;
                const f32x4 lw = *(const f32x4*)(a.in[I_LNW] + c), lb = *(const f32x4*)(a.in[I_LNB] + c), be = *(const f32x4*)(a.in[I_BETAR] + c);
                const f32x4 o = ((acc[vb] - mean) * rstd * lw + lb + dot * vv[vb]) * gv[vb] * be;
                *(v2u*)((bf16*)(a.ws + WS_YMIX) + (mb + 16 * i) * DM + c) = __builtin_bit_cast(v2u, pack4(o)); } };
#pragma unroll 1
        for (int i = 0; i < 4; ++i) { Blk A; ldblk(i, A); doblk(i, A); }
    }
}

struct ConvItem { const float* W; bf16* WT; int N, ldd, k0, n0; size_t drow_lo, drow_hi; int win; };
__device__ __forceinline__ int win_row(int c) { return c < 3072 ? c : (c < SHIFTW ? 6144 + (c - 3072) : c - (SHIFTW - 3072)); }
constexpr int NCV_IN = 32 * 26, NCV_OUT = 32 * 8, NCV_E = 32 * 32 * 2, NCV_D = 32 * 8 * 8, NCONV = NCV_IN + NCV_OUT + 2 * NCV_E + NCV_D, CV_LDT = 528;
__device__ __forceinline__ ConvItem conv_decode(const Args& a, int r) {
    ConvItem c; unsigned char* ws = a.ws; c.win = 0;
    if (r < NCV_IN) { const int kb = r / 26, nb = r - kb * 26; c.W = a.in[I_WIN]; c.N = PROJW; c.WT = (bf16*)(ws + WS_WIN); c.ldd = DM; c.k0 = 64 * kb; c.n0 = 256 * nb; c.drow_lo = (size_t)c.n0; c.drow_hi = c.drow_lo + 128; c.win = 1; return c; } r -= NCV_IN;
    if (r < NCV_OUT) { const int kb = r >> 3, nb = r & 7; c.W = a.in[I_WOUT]; c.N = DM; c.WT = (bf16*)(ws + WS_WOUT); c.ldd = DM; c.k0 = 64 * kb; c.n0 = 256 * nb; c.drow_lo = (size_t)c.n0; c.drow_hi = c.drow_lo + 128; return c; } r -= NCV_OUT;
    if (r < 2 * NCV_E) { const int up = r >= NCV_E; if (up) r -= NCV_E; const int e = r >> 6, q = r & 63, kb = q >> 1, nb = q & 1;
        c.W = a.in[up ? I_WU : I_WG] + (size_t)e * DM * FF; c.N = FF; c.WT = (bf16*)(ws + WS_WGU); c.ldd = DM; c.k0 = 64 * kb; c.n0 = 256 * nb;
        c.drow_lo = (size_t)e * 1024 + 256 * (2 * nb) + (up ? 128 : 0); c.drow_hi = c.drow_lo + 256; return c; } r -= 2 * NCV_E;
    { const int e = r >> 6, q = r & 63, kb = q >> 3, nb = q & 7;
        c.W = a.in[I_WDN] + (size_t)e * FF * DM; c.N = DM; c.WT = (bf16*)(ws + WS_WD); c.ldd = FF; c.k0 = 64 * kb; c.n0 = 256 * nb; c.drow_lo = (size_t)e * DM + c.n0; c.drow_hi = c.drow_lo + 128; return c; }
}
__device__ __forceinline__ void conv_load(const ConvItem& c, int wave, int lane, f32x4 (&v)[8]) {
    const int col = c.n0 + 4 * lane; const float* p = c.W + (size_t)(c.k0 + 8 * wave) * c.N + col;
#pragma unroll
    for (int i = 0; i < 8; ++i) v[i] = (col < c.N) ? *(const f32x4*)(p + (size_t)i * c.N) : (f32x4){0.f, 0.f, 0.f, 0.f};
}
__device__ __forceinline__ void conv_finish(const ConvItem& c, const f32x4 (&v)[8], LAS unsigned char* tile, int wave, int lane) {
#pragma unroll
    for (int i = 0; i < 8; ++i) { v2u w; w.x = pk2(v[i][0], v[i][1]); w.y = pk2(v[i][2], v[i][3]); *(LAS v2u*)(tile + (8 * wave + i) * CV_LDT + 8 * lane) = w; }
    asm volatile("s_waitcnt lgkmcnt(0)" ::: "memory"); __builtin_amdgcn_s_barrier(); asm volatile("" ::: "memory");
    const int i16 = lane & 15, g = lane >> 4;
    s16x4 t[2][2][2];
#pragma unroll
    for (int cb = 0; cb < 2; ++cb)
#pragma unroll
        for (int h = 0; h < 2; ++h)
#pragma unroll
            for (int q = 0; q < 2; ++q) { const int r0 = 32 * h + 8 * g + 4 * q, c0 = 32 * wave + 16 * cb;
                t[cb][h][q] = __builtin_bit_cast(s16x4, __builtin_amdgcn_ds_read_tr16_b64_v4i16((LAS s16x4*)(tile + (r0 + (i16 >> 2)) * CV_LDT + (c0 + 4 * (i16 & 3)) * 2))); }
    asm volatile("s_waitcnt lgkmcnt(0)" ::: "memory");
#pragma unroll
    for (int cb = 0; cb < 2; ++cb) { const int col = 32 * wave + 16 * cb + i16;
        if (c.n0 + col < c.N) { const size_t drow = c.win ? (size_t)win_row(c.n0 + col) : (col < 128 ? c.drow_lo : c.drow_hi) + (col & 127);
            bf16* dst = c.WT + drow * (size_t)c.ldd + c.k0 + 8 * g;
#pragma unroll
            for (int h = 0; h < 2; ++h) { const v2u lo = __builtin_bit_cast(v2u, t[cb][h][0]), hi = __builtin_bit_cast(v2u, t[cb][h][1]); *(v4u*)(dst + 32 * h) = (v4u){lo.x, lo.y, hi.x, hi.y}; } } }
    __builtin_amdgcn_s_barrier(); asm volatile("" ::: "memory");
}
__device__ __forceinline__ void conv_range(const Args& a, LAS unsigned char* lds, int first, int count, int rank, int nranks) {
    const int tid = threadIdx.x, lane = tid & 63, wave = __builtin_amdgcn_readfirstlane(tid >> 6);
    LAS unsigned char* tile = lds + 32768;
    f32x4 va[8], vb[8]; ConvItem ca, cb; int k = rank;
    if (k < count) { ca = conv_decode(a, first + k); conv_load(ca, wave, lane, va); }
    while (k < count) {
        const int k2 = k + nranks;
        if (k2 < count) { cb = conv_decode(a, first + k2); conv_load(cb, wave, lane, vb); }
        conv_finish(ca, va, tile, wave, lane);
        if (k2 >= count) break;
        const int k3 = k2 + nranks;
        if (k3 < count) { ca = conv_decode(a, first + k3); conv_load(ca, wave, lane, va); }
        conv_finish(cb, vb, tile, wave, lane);
        k = k3; }
}
constexpr int CV_X2 = 192 * 7, CV_X6 = 128 * 11;
__device__ __forceinline__ void phase0(const Args& a, LAS unsigned char* lds) {
    const int tid = threadIdx.x, lane = tid & 63, wave = __builtin_amdgcn_readfirstlane(tid >> 6), G = gridDim.x, bid = blockIdx.x;
    unsigned char* ws = a.ws;
    LAS float* cact = (LAS float*)lds;
    LAS float* red = (LAS float*)(lds + 16384);
    if (bid < 192 || G < 192) {
        const float* c = a.in[I_C];
        for (int i = tid; i < 2 * DM; i += NTHR) { const float x = c[i]; cact[i] = x / (1.f + __expf(-x)); }
        __syncthreads();
        for (int item = bid; item < 192; item += G) {
            const int ro = lane >> 4, cq = lane & 15;
            const float* wp = a.in[I_WADA] + (size_t)(256 * wave + ro) * 12288 + 64 * item + 4 * cq;
            f32x4 acc0 = (f32x4){0.f, 0.f, 0.f, 0.f}, acc1 = acc0;
#pragma unroll 8
            for (int i = 0; i < 64; ++i) { const f32x4 wv = *(const f32x4*)(wp + (size_t)(4 * i) * 12288);
                const float c0 = cact[256 * wave + 4 * i + ro], c1 = cact[DM + 256 * wave + 4 * i + ro]; acc0 += c0 * wv; acc1 += c1 * wv; }
#pragma unroll
            for (int j = 0; j < 4; ++j) { float v0 = acc0[j], v1 = acc1[j]; v0 += __shfl_xor(v0, 16); v0 += __shfl_xor(v0, 32); v1 += __shfl_xor(v1, 16); v1 += __shfl_xor(v1, 32);
                if (ro == 0) { red[(wave * 2 + 0) * 64 + 4 * cq + j] = v0; red[(wave * 2 + 1) * 64 + 4 * cq + j] = v1; } }
            __syncthreads();
            if (tid < 128) { const int b = tid >> 6, cc = tid & 63; float s = a.in[I_BADA][64 * item + cc];
#pragma unroll
                for (int w2 = 0; w2 < 8; ++w2) s += red[(w2 * 2 + b) * 64 + cc];
                ((float*)(ws + WS_MOD))[b * 12288 + 64 * item + cc] = s; }
            __syncthreads();
        }
    }
    { constexpr int NPRE = 5;
      const bool pre = (G == 256), mine = pre && bid >= 192;
      const int ncv = pre ? NCONV - CV_X2 - CV_X6 : NCONV;
      const int pool0 = pre ? 64 * NPRE : 0;
      auto item_of = [&](int j) -> int { if (mine) { if (j < NPRE) return (bid - 192) + 64 * j; j -= NPRE; } return pool0 + bid + G * j; };
      LAS unsigned char* tile = lds + 32768;
      f32x4 va[8], vb[8]; ConvItem ca, cb; int j = 0; int ia = item_of(0);
      if (ia < ncv) { ca = conv_decode(a, ia); conv_load(ca, wave, lane, va); }
      while (ia < ncv) {
          const int ib = item_of(j + 1);
          if (ib < ncv) { cb = conv_decode(a, ib); conv_load(cb, wave, lane, vb); }
          conv_finish(ca, va, tile, wave, lane);
          if (ib >= ncv) break;
          const int ic = item_of(j + 2);
          if (ic < ncv) { ca = conv_decode(a, ic); conv_load(ca, wave, lane, va); }
          conv_finish(cb, vb, tile, wave, lane);
          ia = ic; j += 2; } }
    const int gt = bid * NTHR + tid, NGT = G * NTHR;
    bf16* wl = (bf16*)(ws + WS_WL);
    for (int idx = gt; idx < LORA_N * LORA_K; idx += NGT) { const int n = idx / LORA_K, k = idx - n * LORA_K; float v = 0.f;
        if (n < 1024) { if (k < 64) v = a.in[I_WDEC][k * 1024 + n]; }
        else if (n < 2048) { if (k >= 64 && k < 128) v = a.in[I_WAAA][(k - 64) * 1024 + (n - 1024)]; }
        else { if (k >= 128 && k < 288) v = a.in[I_WGATEUP][(k - 128) * 1024 + (n - 2048)]; }
        wl[idx] = (bf16)f2bf(v); }
    float* w36 = (float*)(ws + WS_W36);
    for (int idx = gt; idx < DM * 36; idx += NGT) { const int e = idx >> 11, dd = idx & (DM - 1);
        w36[idx] = (e < 4) ? a.in[I_WGRP][dd * 4 + e] : a.in[I_WEXP][((size_t)((e - 4) >> 3) * DM + dd) * 8 + ((e - 4) & 7)]; }
    v4u* wz = (v4u*)(ws + WS_WIN + (size_t)PROJW * DM * 2);
    for (int idx = gt; idx < (PROJP - PROJW) * DM / 8; idx += NGT) wz[idx] = (v4u){0u, 0u, 0u, 0u};
}

__device__ __forceinline__ void phase1(const Args& a) {
    const int tid = threadIdx.x, lane = tid & 63, wave = tid >> 6;
    const int gw = blockIdx.x * NWAVES + wave, NGW = gridDim.x * NWAVES;
    const float* mod = (const float*)(a.ws + WS_MOD);
    auto ldrow = [&](int m, f32x4 (&v)[8]) { const f32x4* xr = (const f32x4*)(a.in[I_X] + (size_t)m * DM) + lane;
#pragma unroll
        for (int j = 0; j < 8; ++j) v[j] = xr[64 * j]; };
    auto dorow = [&](int m, f32x4 (&v)[8]) { const int b = m >> 12; float s = 0.f;
#pragma unroll
        for (int j = 0; j < 8; ++j) s += (v[j].x * v[j].x + v[j].y * v[j].y) + (v[j].z * v[j].z + v[j].w * v[j].w);
        const float rstd = 1.f / sqrtf(wave_sum(s) * (1.f / DM) + RMS_EPS);
        v2u* o8 = (v2u*)((bf16*)(a.ws + WS_HB) + (size_t)m * DM) + lane;
#pragma unroll
        for (int j = 0; j < 8; ++j) { const int c = 4 * (lane + 64 * j);
            const f32x4 g = *(const f32x4*)(a.in[I_N1G] + c), sh = *(const f32x4*)(mod + b * 12288 + c), sc = *(const f32x4*)(mod + b * 12288 + DM + c);
            const f32x4 h = v[j] * rstd * g * (1.f + sc) + sh; v2u o; o.x = pk2(h.x, h.y); o.y = pk2(h.z, h.w); o8[64 * j] = o; } };
    { f32x4 va[8], vb[8]; int m = gw; if (m < MTOK) ldrow(m, va);
      while (m < MTOK) { const int m2 = m + NGW; if (m2 < MTOK) ldrow(m2, vb); dorow(m, va); if (m2 >= MTOK) break;
          const int m3 = m2 + NGW; if (m3 < MTOK) ldrow(m3, va); dorow(m2, vb); m = m3; } }
}

__device__ __forceinline__ void router_bias(const Args& a, int w0, int nw) {
    const int lane = threadIdx.x & 63; const float* mod = (const float*)(a.ws + WS_MOD); const float* w36 = (const float*)(a.ws + WS_W36);
    for (int it = w0; it < 72; it += nw) { const int b = it / 36, e = it - b * 36; float s = 0.f;
#pragma unroll 8
        for (int dd = lane; dd < DM; dd += 64) s += mod[b * 12288 + 3 * DM + dd] * w36[e * DM + dd];
        s = wave_sum(s) + ((e < 4) ? a.in[I_BGRP][e] : a.in[I_BEXP][e - 4]);
        if (lane == 0) ((float*)(a.ws + WS_B36))[it] = s; }
}

__device__ __forceinline__ void phase3(const Args& a) {
    const int gt = blockIdx.x * NTHR + threadIdx.x, NGT = gridDim.x * NTHR;
    const bf16* P = (const bf16*)(a.ws + WS_PLR); bf16* AL = (bf16*)(a.ws + WS_AL);
    for (int idx = gt; idx < MTOK * 48; idx += NGT) { const int m = idx / 48, cj = idx - m * 48;
        v4u o = (v4u){0u, 0u, 0u, 0u};
        if (cj < 36) { const int col = 3072 + 8 * cj; const v4u pc = *(const v4u*)(P + (size_t)m * 288 + 8 * cj);
            v4u pp = (v4u){0u, 0u, 0u, 0u}; if ((m & (SEQ - 1)) != 0) pp = *(const v4u*)(P + (size_t)(m - 1) * 288 + 8 * cj);
            const float* mu = a.in[I_MU] + col; float r[8];
#pragma unroll
            for (int i = 0; i < 4; ++i) { const float c0 = bflo(pc[i]), c1 = bfhi(pc[i]), p0 = bflo(pp[i]), p1 = bfhi(pp[i]);
                r[2 * i] = c0 + (p0 - c0) * mu[2 * i]; r[2 * i + 1] = c1 + (p1 - c1) * mu[2 * i + 1]; }
            if (cj < 8) {
#pragma unroll
                for (int i = 0; i < 8; ++i) r[i] = tanhf(r[i]); }
            else if (cj >= 16) {
#pragma unroll
                for (int i = 0; i < 8; ++i) r[i] = sigmoid_f(r[i]); }
            o.x = pk2(r[0], r[1]); o.y = pk2(r[2], r[3]); o.z = pk2(r[4], r[5]); o.w = pk2(r[6], r[7]); }
        *(v4u*)(AL + (size_t)m * LORA_K + 8 * cj) = o; }
}

__device__ __forceinline__ int swz_off(int key, int chunk) { return key * 128 + ((chunk ^ ((key >> 1) & 7)) << 4); }
__device__ __forceinline__ void attn_issue_tile(const bf16* kcol, int key0, LAS unsigned char* buf, int wave) {
    __builtin_amdgcn_global_load_lds((const unsigned*)(kcol + (size_t)key0 * HD), (LAS unsigned*)(buf + wave * 1024), 16, 0, 0);
    __builtin_amdgcn_global_load_lds((const unsigned*)(kcol + HM_PART + (size_t)key0 * HD), (LAS unsigned*)(buf + 8192 + wave * 1024), 16, 0, 0);
}
__device__ __forceinline__ void phase5b(const Args& a, LAS unsigned char* lds) {
    STAMP_DECL;
    const int tid = threadIdx.x, lane = tid & 63, wave = __builtin_amdgcn_readfirstlane(tid >> 6), n = lane & 15, g = lane >> 4;
    const bf16* P = (const bf16*)(a.ws + WS_P); bf16* Y = (bf16*)(a.ws + WS_YMIX);
    LAS unsigned char* QL = lds + 65536; LAS float* biasA = (LAS float*)(lds + 81920);
    for (int i = tid; i < NHEAD * 257; i += NTHR) biasA[i] = a.in[I_RELB][i] * LOG2E;
    const float SC = 0.125f * LOG2E;
    const int skey = tid >> 3, sdcx = (tid & 7) ^ ((skey >> 1) & 7);
    LAS float* betaL = (LAS float*)(lds + 81920 + NHEAD * 257 * 4 + 64);
    for (int i = tid; i < CW; i += NTHR) betaL[i] = a.in[I_BETAA][i];
#define ATTN_PROLOGUE(U) do { const int cp_ = (U) & 31, h_ = ((U) >> 5) & 15, b_ = (U) >> 9; const int js_ = (8 - 2 * cp_) > 0 ? (8 - 2 * cp_) : 0, kb_ = 64 * (2 * cp_ - 8 + js_); \
        const bf16* Qh_ = P + 3 * HM_PART + (size_t)b_ * HM_BATCH + (size_t)h_ * HM_HEAD; const bf16* kc_ = Qh_ + HM_PART + (size_t)skey * HD + 8 * sdcx; \
        const bf16* qs_ = Qh_ + (size_t)(128 * cp_ + 16 * wave + (lane >> 3)) * HD + 8 * (lane & 7); \
        __builtin_amdgcn_global_load_lds((const unsigned*)qs_, (LAS unsigned*)(QL + wave * 2048), 16, 0, 0); \
        __builtin_amdgcn_global_load_lds((const unsigned*)(qs_ + (size_t)8 * HD), (LAS unsigned*)(QL + wave * 2048 + 1024), 16, 0, 0); \
        attn_issue_tile(kc_, kb_, lds, wave); attn_issue_tile(kc_, kb_ + 64, lds + 16384, wave); \
        if (js_ < 8) attn_issue_tile(kc_, kb_ + 128, lds + 32768, wave); } while (0)
    asm volatile("s_waitcnt vmcnt(0) lgkmcnt(0)" ::: "memory"); __builtin_amdgcn_s_barrier(); asm volatile("" ::: "memory");
    if ((int)blockIdx.x < BATCH * NHEAD * 32) ATTN_PROLOGUE((int)blockIdx.x);
    for (int u = blockIdx.x; u < BATCH * NHEAD * 32; u += gridDim.x) {
        const int cp = u & 31, h = (u >> 5) & 15, b = u >> 9;
        const int t0 = 128 * cp, qrow = t0 + 16 * wave + n;
        const bf16* Qh = P + 3 * HM_PART + (size_t)b * HM_BATCH + (size_t)h * HM_HEAD;
        const LAS float* biasL = biasA + h * 257;
        const int jstart = (8 - 2 * cp) > 0 ? (8 - 2 * cp) : 0, nt = 10 - jstart;
        const bf16* kcol = Qh + HM_PART + (size_t)skey * HD + 8 * sdcx;
        const int keyb = 64 * (2 * cp - 8 + jstart);
        if (nt > 2) asm volatile("s_waitcnt vmcnt(4)" ::: "memory"); else asm volatile("s_waitcnt vmcnt(2)" ::: "memory");
        __builtin_amdgcn_s_barrier(); asm volatile("" ::: "memory");
        bf16x8 qf[2]; qf[0] = *(const LAS bf16x8*)(QL + wave * 2048 + n * 128 + 16 * g); qf[1] = *(const LAS bf16x8*)(QL + wave * 2048 + n * 128 + 64 + 16 * g);
        float mrun = -1e30f, lrun = 0.f;
        f32x4 ot[4];
#pragma unroll
        for (int i = 0; i < 4; ++i) ot[i] = (f32x4){0.f, 0.f, 0.f, 0.f};
        const float bfar = biasL[256];
        for (int r = 0; r < nt; ++r) {
            const int j = jstart + r, key0 = keyb + 64 * r;
            if (r + 3 < nt) attn_issue_tile(kcol, key0 + 192, lds + ((r + 3) & 3) * 16384, wave);
            const bool active = (wave < 4) ? (j <= 8) : (j >= 1);
            STAMP_BEGIN(13);
            if (active) {
                LAS unsigned char* Kb = lds + (r & 3) * 16384; LAS unsigned char* Vb = Kb + 8192;
                f32x4 s[4];
                { bf16x8 kfr[4][2];
#pragma unroll
                  for (int st = 0; st < 4; ++st)
#pragma unroll
                      for (int ks = 0; ks < 2; ++ks) kfr[st][ks] = *(const LAS bf16x8*)(Kb + swz_off(16 * st + n, 4 * ks + g));
                  asm volatile("s_waitcnt lgkmcnt(0)" ::: "memory"); __builtin_amdgcn_sched_barrier(0);
#pragma unroll
                  for (int st = 0; st < 4; ++st) { s[st] = (f32x4){0.f, 0.f, 0.f, 0.f};
#pragma unroll
                      for (int ks = 0; ks < 2; ++ks) s[st] = __builtin_amdgcn_mfma_f32_16x16x32_bf16(kfr[st][ks], qf[ks], s[st], 0, 0, 0); } }
                s16x4 vtr[2][4][2];
                  const int q4 = n >> 2, p4 = n & 3;
#pragma unroll
                  for (int k2 = 0; k2 < 2; ++k2)
#pragma unroll
                      for (int nd = 0; nd < 4; ++nd) { const int ka = 32 * k2 + 4 * g + q4, ch = 2 * nd + (p4 >> 1);
                          vtr[k2][nd][0] = __builtin_bit_cast(s16x4, __builtin_amdgcn_ds_read_tr16_b64_v4i16((LAS s16x4*)(Vb + swz_off(ka, ch) + 8 * (p4 & 1))));
                          vtr[k2][nd][1] = __builtin_bit_cast(s16x4, __builtin_amdgcn_ds_read_tr16_b64_v4i16((LAS s16x4*)(Vb + swz_off(ka + 16, ch) + 8 * (p4 & 1)))); }
                const bool far = (t0 + 16 * wave) - (key0 + 63) >= 128;
                float mx = -1e30f;
                if (far) {
#pragma unroll
                    for (int st = 0; st < 4; ++st)
#pragma unroll
                        for (int jj = 0; jj < 4; ++jj) { const float sv = s[st][jj] * SC + bfar; s[st][jj] = sv; mx = fmaxf(mx, sv); }
                } else {
                    float bv[4][4];
#pragma unroll
                    for (int st = 0; st < 4; ++st)
#pragma unroll
                        for (int jj = 0; jj < 4; ++jj) { const int dist = qrow - (key0 + 16 * st + 4 * g + jj); bv[st][jj] = biasL[(dist < 128 ? dist : 128) + 128]; }
#pragma unroll
                    for (int st = 0; st < 4; ++st)
#pragma unroll
                        for (int jj = 0; jj < 4; ++jj) { const float sv = s[st][jj] * SC + bv[st][jj]; s[st][jj] = sv; mx = fmaxf(mx, sv); }
                }
                mx = fmaxf(mx, __shfl_xor(mx, 16)); mx = fmaxf(mx, __shfl_xor(mx, 32));
                const float mnew = fmaxf(mrun, mx), alpha = __builtin_amdgcn_exp2f(mrun - mnew); mrun = mnew;
                float ls = 0.f;
#pragma unroll
                for (int st = 0; st < 4; ++st)
#pragma unroll
                    for (int jj = 0; jj < 4; ++jj) { const float p = __builtin_amdgcn_exp2f(s[st][jj] - mnew); s[st][jj] = p; ls += p; }
                lrun = lrun * alpha + ls;
#pragma unroll
                for (int i = 0; i < 4; ++i) ot[i] *= alpha;
                {
                  asm volatile("s_waitcnt lgkmcnt(0)" ::: "memory"); __builtin_amdgcn_sched_barrier(0);
#pragma unroll
                  for (int k2 = 0; k2 < 2; ++k2) {
                      v4u pw; pw.x = pk2(s[2 * k2][0], s[2 * k2][1]); pw.y = pk2(s[2 * k2][2], s[2 * k2][3]); pw.z = pk2(s[2 * k2 + 1][0], s[2 * k2 + 1][1]); pw.w = pk2(s[2 * k2 + 1][2], s[2 * k2 + 1][3]);
                      const bf16x8 pf = __builtin_bit_cast(bf16x8, pw);
#pragma unroll
                      for (int nd = 0; nd < 4; ++nd) { const s16x4 v0 = vtr[k2][nd][0], v1 = vtr[k2][nd][1];
                          bf16x8 vf; vf[0] = v0[0]; vf[1] = v0[1]; vf[2] = v0[2]; vf[3] = v0[3]; vf[4] = v1[0]; vf[5] = v1[1]; vf[6] = v1[2]; vf[7] = v1[3];
                          ot[nd] = __builtin_amdgcn_mfma_f32_16x16x32_bf16(vf, pf, ot[nd], 0, 0, 0); } } }
            }
            STAMP_END(13); STAMP_BEGIN(12);
            if (r + 4 <= nt) asm volatile("s_waitcnt vmcnt(4)" ::: "memory"); else if (r + 3 == nt) asm volatile("s_waitcnt vmcnt(2)" ::: "memory"); else asm volatile("s_waitcnt vmcnt(0)" ::: "memory");
            asm volatile("s_waitcnt lgkmcnt(0)" ::: "memory"); __builtin_amdgcn_s_barrier(); asm volatile("" ::: "memory");
            STAMP_END(12);
        }
        if (u + (int)gridDim.x < BATCH * NHEAD * 32) ATTN_PROLOGUE(u + (int)gridDim.x);
        float lt = lrun; lt += __shfl_xor(lt, 16); lt += __shfl_xor(lt, 32);
        const float inv = __builtin_amdgcn_rcpf(lt);
        bf16* yp = Y + ((size_t)b * SEQ + qrow) * DM + 1024 + h * 64 + 4 * g;
        const LAS float* beta = betaL + h * 64 + 4 * g;
#pragma unroll
        for (int nd = 0; nd < 4; ++nd) { const f32x4 bt = *(const LAS f32x4*)(beta + 16 * nd); const f32x4 o = ot[nd] * inv * bt;
            v2u w; w.x = pk2(o[0], o[1]); w.y = pk2(o[2], o[3]); *(v2u*)(yp + 16 * nd) = w; }
    }
}

__device__ __forceinline__ void phase8(const Args& a, LAS unsigned char* lds) {
    const int tid = threadIdx.x, lane = tid & 63, wave = __builtin_amdgcn_readfirstlane(tid >> 6), n = lane & 15, g = lane >> 4;
    const float* mod = (const float*)(a.ws + WS_MOD); const float* W36 = (const float*)(a.ws + WS_W36); const bf16* X1 = (const bf16*)(a.ws + WS_X1);
    unsigned* ctl = (unsigned*)(a.ws + WS_CTL);
    LAS float* part = (LAS float*)lds;
    LAS float* ssp = (LAS float*)(lds + 49152);
    LAS float* lg = (LAS float*)(lds + 50176);
    for (int tile = blockIdx.x; tile < MTOK / 32; tile += gridDim.x) {
        const int m0 = 32 * tile, b = m0 >> 12;
        f32x4 acc[2][3]; float ss[2] = {0.f, 0.f};
#pragma unroll
        for (int rt = 0; rt < 2; ++rt)
#pragma unroll
            for (int ct = 0; ct < 3; ++ct) acc[rt][ct] = (f32x4){0.f, 0.f, 0.f, 0.f};
        const bf16* xrow = X1 + (size_t)(m0 + n) * DM + 256 * wave + 8 * g;
        const float* w0p = W36 + (size_t)n * DM + 256 * wave + 8 * g; const float* w1p = w0p + (size_t)16 * DM; const float* w2p = w0p + (size_t)(n < 4 ? 32 : 0) * DM;
        const float* gp = a.in[I_N2G] + 256 * wave + 8 * g; const float* sp = mod + b * 12288 + 4 * DM + 256 * wave + 8 * g;
#pragma unroll 2
        for (int Q = 0; Q < 8; ++Q) {
            const v4u xb0 = *(const v4u*)(xrow + 32 * Q), xb1 = *(const v4u*)(xrow + (size_t)16 * DM + 32 * Q);
#pragma unroll
            for (int hf = 0; hf < 2; ++hf) {
                f32x4 xa = (f32x4){bflo(xb0[2 * hf]), bfhi(xb0[2 * hf]), bflo(xb0[2 * hf + 1]), bfhi(xb0[2 * hf + 1])};
                f32x4 xc = (f32x4){bflo(xb1[2 * hf]), bfhi(xb1[2 * hf]), bflo(xb1[2 * hf + 1]), bfhi(xb1[2 * hf + 1])};
                const f32x4 ab = *(const f32x4*)(gp + 32 * Q + 4 * hf) * (1.f + *(const f32x4*)(sp + 32 * Q + 4 * hf));
                const f32x4 wa = *(const f32x4*)(w0p + 32 * Q + 4 * hf), wb = *(const f32x4*)(w1p + 32 * Q + 4 * hf); f32x4 wc = *(const f32x4*)(w2p + 32 * Q + 4 * hf);
                if (n >= 4) wc = (f32x4){0.f, 0.f, 0.f, 0.f};
                ss[0] += (xa[0] * xa[0] + xa[1] * xa[1]) + (xa[2] * xa[2] + xa[3] * xa[3]); xa *= ab;
                ss[1] += (xc[0] * xc[0] + xc[1] * xc[1]) + (xc[2] * xc[2] + xc[3] * xc[3]); xc *= ab;
#pragma unroll
                for (int r = 0; r < 4; ++r) {
                    acc[0][0] = __builtin_amdgcn_mfma_f32_16x16x4f32(xa[r], wa[r], acc[0][0], 0, 0, 0); acc[1][0] = __builtin_amdgcn_mfma_f32_16x16x4f32(xc[r], wa[r], acc[1][0], 0, 0, 0);
                    acc[0][1] = __builtin_amdgcn_mfma_f32_16x16x4f32(xa[r], wb[r], acc[0][1], 0, 0, 0); acc[1][1] = __builtin_amdgcn_mfma_f32_16x16x4f32(xc[r], wb[r], acc[1][1], 0, 0, 0);
                    acc[0][2] = __builtin_amdgcn_mfma_f32_16x16x4f32(xa[r], wc[r], acc[0][2], 0, 0, 0); acc[1][2] = __builtin_amdgcn_mfma_f32_16x16x4f32(xc[r], wc[r], acc[1][2], 0, 0, 0); } }
        }
#pragma unroll
        for (int rt = 0; rt < 2; ++rt) { ss[rt] += __shfl_xor(ss[rt], 16); ss[rt] += __shfl_xor(ss[rt], 32);
#pragma unroll
            for (int ct = 0; ct < 3; ++ct) *(LAS f32x4*)(part + (wave * 64 + lane) * 24 + rt * 12 + 4 * ct) = acc[rt][ct];
            if (lane < 16) ssp[wave * 32 + rt * 16 + lane] = ss[rt]; }
        __syncthreads();
        { const int tk = tid >> 4, sl = tid & 15, rt = tk >> 4, tkl = tk & 15;
            float s2 = 0.f;
#pragma unroll
            for (int w = 0; w < 8; ++w) s2 += ssp[w * 32 + tk];
            const float rstd = 1.f / sqrtf(s2 * (1.f / DM) + RMS_EPS);
            const float* b36 = (const float*)(a.ws + WS_B36) + b * 36;
#pragma unroll
            for (int q = 0; q < 3; ++q) { const int e = 16 * q + sl; if (q < 2 || sl < 4) { float s = 0.f;
#pragma unroll
                for (int w = 0; w < 8; ++w) s += part[(w * 64 + 16 * (tkl >> 2) + sl) * 24 + rt * 12 + 4 * q + (tkl & 3)];
                lg[tk * 40 + e] = s * rstd + b36[e]; } }
            if (sl == 0) ((float*)(a.ws + WS_RSTD))[m0 + tk] = rstd; }
        __syncthreads();
        if (tid < 32) {
            float l[36];
#pragma unroll
            for (int e = 0; e < 36; ++e) l[e] = lg[tid * 40 + e];
            int gi = 0; float gm = l[0];
#pragma unroll
            for (int i = 1; i < 4; ++i) if (l[i] > gm) { gm = l[i]; gi = i; }
            float gs = 0.f;
#pragma unroll
            for (int i = 0; i < 4; ++i) gs += expf(l[i] - gm);
            const float gwt = 1.f / gs;
            float el[8];
#pragma unroll
            for (int j = 0; j < 8; ++j) el[j] = (gi == 0) ? l[4 + j] : ((gi == 1) ? l[12 + j] : ((gi == 2) ? l[20 + j] : l[28 + j]));
            int i1 = 0; float m1 = el[0];
#pragma unroll
            for (int i = 1; i < 8; ++i) if (el[i] > m1) { m1 = el[i]; i1 = i; }
            int i2 = -1; float m2 = -3.0e38f;
#pragma unroll
            for (int i = 0; i < 8; ++i) if (i != i1 && el[i] > m2) { m2 = el[i]; i2 = i; }
            const float e2 = expf(m2 - m1); const float w1 = gwt / (1.f + e2), w2 = gwt * e2 / (1.f + e2);
            int* rt = (int*)(a.ws + WS_ROUTE) + (size_t)(m0 + tid) * 8; const int ge1 = gi * 8 + i1, ge2 = gi * 8 + i2;
            rt[0] = ge1; rt[1] = ge2; rt[2] = __float_as_int(w1); rt[3] = __float_as_int(w2);
            const int sl = (((m0 + tid) >> 4) & (NSLICE - 1)) * 32;
            atomicAdd(ctl + CW_CNT + sl + ge1, 1u); atomicAdd(ctl + CW_CNT + sl + ge2, 1u);
        }
        __syncthreads();
    }
}

__device__ __forceinline__ void phase9(const Args& a) {
    const int tid = threadIdx.x, lane = tid & 63, wave = tid >> 6;
    const int gw = blockIdx.x * NWAVES + wave, NGW = gridDim.x * NWAVES;
    unsigned* ctl = (unsigned*)(a.ws + WS_CTL);
    const float* mod = (const float*)(a.ws + WS_MOD);
    unsigned cnt = 0u;
    if (lane < NEXP) for (int s = 0; s < NSLICE; ++s) cnt += __hip_atomic_load(ctl + CW_CNT + s * 32 + lane, RLX_AGENT);
    const unsigned pad = (cnt + 255u) & ~255u;
    unsigned incl = pad;
#pragma unroll
    for (int o = 1; o < 64; o <<= 1) { const unsigned t = __shfl_up(incl, o); if (lane >= o) incl += t; }
    const unsigned off = incl - pad;
    if (gw == 0) {
        if (lane < NEXP) for (unsigned t = off >> 8; t < (off + pad) >> 8; ++t) ctl[CW_TE + t] = (unsigned)lane;
        if (lane == 63) ctl[CW_NRT] = incl >> 8;
    }
    for (int task = gw; task < MTOK / 4; task += NGW) {
        const int m0 = 4 * task, b = m0 >> 12, slice = (m0 >> 4) & (NSLICE - 1);
        unsigned sbase = 0u;
        if (lane < NEXP) for (int s = 0; s < slice; ++s) sbase += __hip_atomic_load(ctl + CW_CNT + s * 32 + lane, RLX_AGENT);
        const unsigned offs = off + sbase;
        int* rt = (int*)(a.ws + WS_ROUTE) + (size_t)(m0 + (lane & 3)) * 8;
        const int e1 = rt[0], e2 = rt[1];
        unsigned p1 = 0, p2 = 0;
        if (lane < 4) { p1 = atomicAdd(ctl + CW_POS + slice * 32 + e1, 1u); p2 = atomicAdd(ctl + CW_POS + slice * 32 + e2, 1u); }
        const unsigned s1v = __shfl(offs, e1) + p1, s2v = __shfl(offs, e2) + p2;
        if (lane < 4) { rt[4] = (int)s1v; rt[5] = (int)s2v; ((float*)(a.ws + WS_SW))[s1v] = __int_as_float(rt[2]); ((float*)(a.ws + WS_SW))[s2v] = __int_as_float(rt[3]); }
        v4u xa[4], xb[4];
        auto ldx = [&](int t, v4u (&x)[4]) { const v4u* xr = (const v4u*)((const bf16*)(a.ws + WS_X1) + (size_t)(m0 + t) * DM) + lane;
#pragma unroll
            for (int j = 0; j < 4; ++j) x[j] = xr[64 * j]; };
        auto dox = [&](int t, v4u (&x)[4]) { const unsigned s1 = __shfl(s1v, t), s2 = __shfl(s2v, t);
            const float rstd = ((const float*)(a.ws + WS_RSTD))[m0 + t];
            v4u* d1 = (v4u*)((bf16*)(a.ws + WS_H2P) + (size_t)s1 * DM) + lane; v4u* d2 = (v4u*)((bf16*)(a.ws + WS_H2P) + (size_t)s2 * DM) + lane;
#pragma unroll
            for (int j = 0; j < 4; ++j) { const int c = 8 * (lane + 64 * j); v4u o;
#pragma unroll
                for (int hf = 0; hf < 2; ++hf) { const int cc = c + 4 * hf;
                    const f32x4 g = *(const f32x4*)(a.in[I_N2G] + cc), sh = *(const f32x4*)(mod + b * 12288 + 3 * DM + cc), sc = *(const f32x4*)(mod + b * 12288 + 4 * DM + cc);
                    const f32x4 xv = (f32x4){bflo(x[j][2 * hf]), bfhi(x[j][2 * hf]), bflo(x[j][2 * hf + 1]), bfhi(x[j][2 * hf + 1])};
                    const f32x4 h = xv * rstd * g * (1.f + sc) + sh; o[2 * hf] = pk2(h.x, h.y); o[2 * hf + 1] = pk2(h.z, h.w); }
                d1[64 * j] = o; d2[64 * j] = o; } };
        ldx(0, xa); ldx(1, xb); dox(0, xa); ldx(2, xa); dox(1, xb); ldx(3, xb); dox(2, xa); dox(3, xb);
    }
}

__device__ __forceinline__ void phase12(const Args& a) {
    const int tid = threadIdx.x, lane = tid & 63, wave = tid >> 6;
    const int gw = blockIdx.x * NWAVES + wave, NGW = gridDim.x * NWAVES;
    const float* mod = (const float*)(a.ws + WS_MOD);
    struct Tok { v2u x[8]; v2u f1[8], f2[8]; };
    auto ldslots = [&](int m, int& s1, int& s2) { const int* rt = (const int*)(a.ws + WS_ROUTE) + (size_t)m * 8; s1 = rt[4]; s2 = rt[5]; };
    auto ldtok = [&](int m, int s1, int s2, Tok& t) { const v2u* xr = (const v2u*)((const bf16*)(a.ws + WS_X1) + (size_t)m * DM) + lane;
        const v2u* f1 = (const v2u*)((const bf16*)(a.ws + WS_FP) + (size_t)s1 * DM) + lane; const v2u* f2 = (const v2u*)((const bf16*)(a.ws + WS_FP) + (size_t)s2 * DM) + lane;
#pragma unroll
        for (int j = 0; j < 8; ++j) { t.x[j] = xr[64 * j]; t.f1[j] = f1[64 * j]; t.f2[j] = f2[64 * j]; } };
    auto dotok = [&](int m, Tok& t) { const int b = m >> 12; float s = 0.f; f32x4 v[8];
#pragma unroll
        for (int j = 0; j < 8; ++j) { const int c = 4 * (lane + 64 * j); const f32x4 g2 = *(const f32x4*)(mod + b * 12288 + 5 * DM + c);
            const v2u a1 = t.f1[j], a2 = t.f2[j]; f32x4 f;
            f.x = bflo(a1.x) + bflo(a2.x); f.y = bfhi(a1.x) + bfhi(a2.x); f.z = bflo(a1.y) + bflo(a2.y); f.w = bfhi(a1.y) + bfhi(a2.y);
            v[j] = (f32x4){bflo(t.x[j].x), bfhi(t.x[j].x), bflo(t.x[j].y), bfhi(t.x[j].y)} + g2 * f; s += (v[j].x * v[j].x + v[j].y * v[j].y) + (v[j].z * v[j].z + v[j].w * v[j].w); }
        const float rstd = 1.f / sqrtf(wave_sum(s) * (1.f / DM) + RMS_EPS);
        f32x4* op = (f32x4*)(a.out + (size_t)m * DM) + lane;
#pragma unroll
        for (int j = 0; j < 8; ++j) { const int c = 4 * (lane + 64 * j); const f32x4 g = *(const f32x4*)(a.in[I_NFG] + c); op[64 * j] = v[j] * rstd * g; } };
    { Tok ta, tb; int m = gw, sa1 = 0, sa2 = 0, sb1 = 0, sb2 = 0;
      if (m < MTOK) { ldslots(m, sa1, sa2); if (m + NGW < MTOK) ldslots(m + NGW, sb1, sb2); ldtok(m, sa1, sa2, ta); }
      while (m < MTOK) { const int m2 = m + NGW, m3 = m2 + NGW, m4 = m3 + NGW;
          if (m3 < MTOK) ldslots(m3, sa1, sa2);
          if (m2 < MTOK) ldtok(m2, sb1, sb2, tb);
          dotok(m, ta); if (m2 >= MTOK) break;
          if (m4 < MTOK) ldslots(m4, sb1, sb2);
          if (m3 < MTOK) ldtok(m3, sa1, sa2, ta);
          dotok(m2, tb); m = m3; } }
}

#ifndef MK_ONE_LAUNCH
#define MK_ONE_LAUNCH 1
#endif
__global__ void __launch_bounds__(NTHR, 2) mega_fwd(Args args) {
    extern __shared__ __attribute__((aligned(16))) unsigned char lds_raw[];
    LAS unsigned char* lds = (LAS unsigned char*)lds_raw;
    const int tid = threadIdx.x;
    for (int u = tid; u < (LDS_BYTES - LDSCTL_OFF) / 4; u += NTHR) ((LAS unsigned*)(lds + LDSCTL_OFF))[u] = 0u;
    __syncthreads();
    volatile LAS unsigned* MISC = (volatile LAS unsigned*)(lds + MISC_OFF);
    unsigned* ctl = (unsigned*)(args.ws + WS_CTL);
    unsigned* barw = ctl + CW_BAR + args.li * XCD_BAR_WORDS;
    XcdBarrier bar; bar.bar = barw; bar.x = 0; bar.st = nullptr;
    const bool multi = (args.ph_hi - args.ph_lo) > 1;
    if (multi) bar = xcd_barrier_post(barw, MISC + 8);
    const int lo = args.ph_lo, hi = args.ph_hi, G = gridDim.x;
#define IN(k) (lo <= (k) && (k) < hi)
#define SEAM(k) do { if (IN(k) && IN((k) + 1)) xcd_barrier(bar); } while (0)
    const Args& a = args; STAMP_DECL;
#define PH_BEGIN(k) STAMP_BEGIN(100 + (k))
#define PH_END(k) STAMP_END(100 + (k))
    if (IN(0)) { PH_BEGIN(0); STAMP_BEGIN(20); phase0(args, lds); STAMP_END(20); } SEAM(0); if (IN(0)) PH_END(0);
    if (IN(1)) { PH_BEGIN(1); phase1(args); } SEAM(1); if (IN(1)) PH_END(1);
    if (IN(2)) { PH_BEGIN(2); pg8::Gemm g{(const pg8::bf16_t*)(args.ws + WS_HB), (const pg8::bf16_t*)(args.ws + WS_WIN), MTOK, PROJP, DM}; pg8::StaticOrder S; S.init(MTOK, PROJP, G, (int)blockIdx.x);
        EpiProj E{(bf16*)(args.ws + WS_P), (bf16*)(args.ws + WS_PLR)};
        pg8::gemm_phase<EpiProj, pg8::StaticOrder, true, true>(lds, g, S, E);
        if (G == 256 && (int)blockIdx.x >= 64) conv_range(args, lds, NCONV - CV_X2 - CV_X6, CV_X2, (int)blockIdx.x - 64, 192); } SEAM(2); if (IN(2)) PH_END(2);
    if (IN(3)) { PH_BEGIN(3); STAMP_BEGIN(10); phase3(args); STAMP_END(10); STAMP_BEGIN(11); phase5b(args, lds); STAMP_END(11); } SEAM(3); if (IN(3)) PH_END(3);
    if (IN(4)) { PH_BEGIN(4); pg8::Gemm g{(const pg8::bf16_t*)(args.ws + WS_AL), (const pg8::bf16_t*)(args.ws + WS_WL), MTOK, LORA_N, LORA_K}; pg8::StaticOrder S; S.init(MTOK, LORA_N, G, (int)blockIdx.x);
        EpiLora E{(float*)(args.ws + WS_LW), (bf16*)(args.ws + WS_AA), (bf16*)(args.ws + WS_GG)};
        pg8::gemm_phase<EpiLora, pg8::StaticOrder, true, true>(lds, g, S, E); } SEAM(4); if (IN(4)) PH_END(4);
    if (IN(5)) { PH_BEGIN(5); STAMP_BEGIN(30); scanA(args, lds); STAMP_END(30); } SEAM(5); if (IN(5)) PH_END(5);
    if (IN(6)) { PH_BEGIN(6); scanB(args, lds); if ((int)blockIdx.x >= (int)gridDim.x - 9) router_bias(args, ((int)gridDim.x - 1 - (int)blockIdx.x) * NWAVES + (tid >> 6), 9 * NWAVES); if (G == 256 && (int)blockIdx.x >= 128) conv_range(args, lds, NCONV - CV_X6, CV_X6, (int)blockIdx.x - 128, 128); } SEAM(6); if (IN(6)) PH_END(6);
    if (IN(7)) { PH_BEGIN(7); scanC(args); } SEAM(7); if (IN(7)) PH_END(7);
    if (IN(8)) { PH_BEGIN(8); pg8::Gemm g{(const pg8::bf16_t*)(args.ws + WS_YMIX), (const pg8::bf16_t*)(args.ws + WS_WOUT), MTOK, DM, DM}; pg8::StaticOrder S; S.init(MTOK, DM, G, (int)blockIdx.x);
        EpiResGate E{args.in[I_X], (const float*)(args.ws + WS_MOD) + 2 * DM, (bf16*)(args.ws + WS_X1)};
        pg8::gemm_phase<EpiResGate, pg8::StaticOrder, true, true>(lds, g, S, E); } SEAM(8); if (IN(8)) PH_END(8);
    if (IN(9)) { PH_BEGIN(9); phase8(args, lds); } SEAM(9); if (IN(9)) PH_END(9);
    if (IN(10)) { PH_BEGIN(10); phase9(args); } SEAM(10); if (IN(10)) PH_END(10);
    if (IN(11) || IN(12) || IN(13)) {
        const int nrt = (int)__hip_atomic_load(ctl + CW_NRT, RLX_AGENT), c = (int)blockIdx.x;
        const int Ugu = 4 * nrt, nB = Ugu > G ? Ugu - G : 0, R0 = (Ugu < G ? Ugu : G) / 4, E2 = (8 * R0 < 2 * (G - nB)) ? 8 * R0 : 2 * (G - nB);
        const pg8::Gemm gu{(const pg8::bf16_t*)(args.ws + WS_H2P), (const pg8::bf16_t*)(args.ws + WS_WGU), nrt * 256, NEXP * 1024, DM};
        const pg8::Gemm gd{(const pg8::bf16_t*)(args.ws + WS_HG), (const pg8::bf16_t*)(args.ws + WS_WD), nrt * 256, NEXP * DM, FF};
        const EpiGateUp Eu{(const float*)(args.ws + WS_SW), (bf16*)(args.ws + WS_HG)};
        const EpiStoreBf16 Ed{(bf16*)(args.ws + WS_FP), DM, 7};
        if (IN(11)) { PH_BEGIN(11); GroupOrder2 S{ctl + CW_TE, 4, 0, Ugu < G ? Ugu : G, G, c}; pg8::gemm_phase<EpiGateUp, GroupOrder2, true, true>(lds, gu, S, Eu); } SEAM(11); if (IN(11)) PH_END(11);
        if (IN(12)) { PH_BEGIN(12); if (c < nB) { GroupOrder2 S{ctl + CW_TE, 4, G, nB, nB, c}; pg8::gemm_phase<EpiGateUp, GroupOrder2, true, true>(lds, gu, S, Eu); }
                      else { GroupOrder2 S{ctl + CW_TE, 8, 0, E2, G - nB, c - nB}; pg8::gemm_phase<EpiStoreBf16, GroupOrder2, true, true>(lds, gd, S, Ed); } } SEAM(12); if (IN(12)) PH_END(12);
        if (IN(13)) { PH_BEGIN(13); GroupOrder2 S{ctl + CW_TE, 8, E2, 8 * nrt - E2, G, c}; pg8::gemm_phase<EpiStoreBf16, GroupOrder2, true, true>(lds, gd, S, Ed); } SEAM(13); if (IN(13)) PH_END(13);
    }
    if (IN(14)) { PH_BEGIN(14); phase12(args); PH_END(14); }
#ifdef STAMP_ID
    if (blockIdx.x == 0 && tid == 0 && IN(NPH - 1)) { const unsigned dly = STAMP_MULT * __hip_atomic_load(ctl + CW_STAMP, RLX_AGENT); const unsigned long long t0_ = __builtin_amdgcn_s_memrealtime();
        while (__builtin_amdgcn_s_memrealtime() - t0_ < (unsigned long long)dly) __builtin_amdgcn_s_sleep(8); }
#endif
#ifdef EXTRA_BARRIERS
    if (multi) for (int i_ = 0; i_ < EXTRA_BARRIERS; ++i_) xcd_barrier(bar);
#endif
#undef IN
#undef SEAM
}

extern "C" void kernel_launch(void* const* d_in, const int* in_sizes, int n_in, void* d_out, int out_size, void* d_ws, size_t ws_size, hipStream_t stream) {
    static int grid = 0;
    if (grid == 0) {
        if (n_in != 30 || out_size != MTOK * DM || ws_size < WS_END) { fprintf(stderr, "kernel_launch: unexpected shapes (n_in %d, out %d, ws %zu)\n", n_in, out_size, ws_size); grid = -1; return; }
        int dev = 0, cus = 0, per_cu = 0;
        if (hipGetDevice(&dev) != hipSuccess || hipDeviceGetAttribute(&cus, hipDeviceAttributeMultiprocessorCount, dev) != hipSuccess) { grid = -1; return; }
        if (hipFuncSetAttribute((const void*)mega_fwd, hipFuncAttributeMaxDynamicSharedMemorySize, LDS_BYTES) != hipSuccess) { grid = -1; return; }
        if (hipOccupancyMaxActiveBlocksPerMultiprocessor(&per_cu, (const void*)mega_fwd, NTHR, LDS_BYTES) != hipSuccess || per_cu < 1) { fprintf(stderr, "kernel_launch: occupancy query says %d\n", per_cu); grid = -1; (void)hipGetLastError(); return; }
        grid = cus;
    }
    if (grid < 0) return;
    (void)hipMemsetAsync((char*)d_ws + WS_CTL, 0, CTL_ZERO_BYTES, stream);
    Args a{};
    for (int i = 0; i < 30; ++i) a.in[i] = (const float*)d_in[i];
    a.out = (float*)d_out; a.ws = (unsigned char*)d_ws;
#if MK_ONE_LAUNCH
#ifdef PROBE_PHASE
    const int cuts[3] = {0, PROBE_PHASE, NPH};
    for (int li = 0; li < 2; ++li) { a.ph_lo = cuts[li]; a.ph_hi = cuts[li + 1] + ((li == 0) ? PROBE_REPEAT : 0); a.li = li;
        void* kargs[] = {&a};
        hipError_t e = hipLaunchCooperativeKernel((const void*)mega_fwd, dim3(grid), dim3(NTHR), kargs, LDS_BYTES, stream);
        if (e != hipSuccess) fprintf(stderr, "cooperative launch failed: %s\n", hipGetErrorString(e)); }
#else
    a.ph_lo = 0; a.ph_hi = NPH;
    void* kargs[] = {&a};
    hipError_t e = hipLaunchCooperativeKernel((const void*)mega_fwd, dim3(grid), dim3(NTHR), kargs, LDS_BYTES, stream);
    if (e != hipSuccess) fprintf(stderr, "cooperative launch failed: %s\n", hipGetErrorString(e));
#endif
#else
    for (int p = 0; p < NPH; ++p) { a.ph_lo = p; a.ph_hi = p + 1; hipLaunchKernelGGL(mega_fwd, dim3(grid), dim3(NTHR), LDS_BYTES, stream, a); }
#endif
}
```

```cpp
#include <hip/hip_runtime.h>
#include <hip/hip_bf16.h>
#include <cstdio>
#include <cstdint>

constexpr int NWAVES = 8, NTHR = 512;
constexpr int BATCH = 2, SEQ = 4096, DM = 2048, MTOK = BATCH * SEQ;
constexpr int CW = 1024, NHEAD = 16, HD = 64;
constexpr int SHIFTW = 3360, PROJW = 6432, PROJP = 6656;
constexpr int LORA_K = 384, LORA_N = 3072;
constexpr int NEXP = 32, FF = 512;
constexpr int MAXSLOT = 24576;
constexpr float RMS_EPS = 1e-6f, GN_EPS = 64e-5f;
constexpr float LOG2E = 1.4426950408889634f;

constexpr size_t MiB = 1u << 20;
constexpr size_t WS_CTL = 0, CTL_ZERO_BYTES = 1 * MiB;
constexpr size_t WS_MOD = 1 * MiB;
constexpr size_t WS_ROUTE = 1 * MiB + 128 * 1024;
constexpr size_t WS_SW = 1 * MiB + 512 * 1024;
constexpr size_t WS_B36 = 1 * MiB + 96 * 1024;
constexpr size_t WS_RSTD = 1 * MiB + 640 * 1024;
constexpr size_t WS_W36 = 1 * MiB + 704 * 1024;
constexpr size_t WS_WIN = 2 * MiB;
constexpr size_t WS_WOUT = 28 * MiB;
constexpr size_t WS_WL = 36 * MiB;
constexpr size_t WS_WGU = 39 * MiB;
constexpr size_t WS_WD = 167 * MiB;
constexpr size_t B0 = 231 * MiB;
constexpr size_t WS_P = B0;
constexpr size_t WS_PLR = B0 + 96 * MiB;
constexpr size_t HM_PART = (size_t)BATCH * NHEAD * SEQ * HD, HM_BATCH = (size_t)NHEAD * SEQ * HD, HM_HEAD = (size_t)SEQ * HD;
constexpr size_t WS_HB = B0 + 104 * MiB;
constexpr size_t WS_AL = B0 + 136 * MiB;
constexpr size_t WS_LW = B0 + 142 * MiB;
constexpr size_t WS_AA = B0 + 174 * MiB;
constexpr size_t WS_GG = B0 + 190 * MiB;
constexpr size_t WS_R = B0 + 206 * MiB, WS_K2 = B0 + 222 * MiB, WS_V = B0 + 238 * MiB, WS_KK = B0 + 254 * MiB, WS_BB = B0 + 270 * MiB;
constexpr size_t WS_YMIX = B0 + 286 * MiB;
constexpr size_t WS_X1 = B0;
constexpr size_t WS_H2P = B0 + 136 * MiB;
constexpr size_t WS_HG = B0 + 232 * MiB;
constexpr size_t WS_FP = B0 + 136 * MiB;
constexpr size_t WS_HM = B0 + 104 * MiB, WS_Y1 = B0 + 254 * MiB, WS_GT = B0 + 318 * MiB, WS_RH = B0 + 334 * MiB, WS_PLV = B0 + 136 * MiB;
constexpr size_t WS_SF = B0 + 152 * MiB;
constexpr size_t WS_END = B0 + 350 * MiB;
constexpr int CW_NRT = 1152, CW_TE = 1280, CW_BAR = 4096;
constexpr int NSLICE = 64, CW_CNT = 16384, CW_POS = 16384 + NSLICE * 32;

constexpr int CW_STAMP = 1200, CW_RDY = 1400;
#ifdef STAMP_ID
#ifndef STAMP_BLOCK
#define STAMP_BLOCK 0
#endif
#ifndef STAMP_MULT
#define STAMP_MULT 1u
#endif
#define STAMP_BEGIN(id) do { if ((id) == STAMP_ID && blockIdx.x == STAMP_BLOCK && threadIdx.x == 0) st_t0_ = __builtin_amdgcn_s_memrealtime(); } while (0)
#define STAMP_END(id) do { if ((id) == STAMP_ID && blockIdx.x == STAMP_BLOCK && threadIdx.x == 0) atomicAdd((unsigned*)(a.ws + WS_CTL) + CW_STAMP, (unsigned)(__builtin_amdgcn_s_memrealtime() - st_t0_)); } while (0)
#define STAMP_DECL unsigned long long st_t0_ = 0
#else
#define STAMP_BEGIN(id) do { } while (0)
#define STAMP_END(id) do { } while (0)
#define STAMP_DECL do { } while (0)
#endif
constexpr int RING_BYTES = 131072;
constexpr int LDSCTL_OFF = RING_BYTES, MISC_OFF = LDSCTL_OFF + 320;
constexpr int LDS_BYTES = 147456;

#define GAS __attribute__((address_space(1)))
#define LAS __attribute__((address_space(3)))
typedef unsigned short bf16;
typedef unsigned v4u __attribute__((ext_vector_type(4)));
typedef unsigned v2u __attribute__((ext_vector_type(2)));
typedef float f32x4 __attribute__((ext_vector_type(4)));
typedef short bf16x8 __attribute__((ext_vector_type(8)));
typedef short s16x4 __attribute__((ext_vector_type(4)));
typedef GAS unsigned gu32;
typedef GAS unsigned long long gu64;
#define RLX_AGENT __ATOMIC_RELAXED, __HIP_MEMORY_SCOPE_AGENT
#define LDS_WAIT() asm volatile("s_waitcnt lgkmcnt(0)" ::: "memory")
#define VM_WAIT() asm volatile("s_waitcnt vmcnt(0)" ::: "memory")
__device__ __forceinline__ unsigned f2bf(float f) { unsigned u = __builtin_bit_cast(unsigned, f); return (u + 0x7fffu + ((u >> 16) & 1u)) >> 16; }
typedef float f32x2_t __attribute__((ext_vector_type(2)));
typedef __bf16 bf16x2_t __attribute__((ext_vector_type(2)));
__device__ __forceinline__ unsigned pk2(float lo, float hi) { const f32x2_t v = {lo, hi}; return __builtin_bit_cast(unsigned, __builtin_convertvector(v, bf16x2_t)); }
__device__ __forceinline__ float bflo(unsigned u) { return __builtin_bit_cast(float, u << 16); }
__device__ __forceinline__ float bfhi(unsigned u) { return __builtin_bit_cast(float, u & 0xffff0000u); }
__device__ __forceinline__ float wave_sum(float v) {
#pragma unroll
    for (int o = 1; o < 64; o <<= 1) v += __shfl_xor(v, o);
    return v;
}
__device__ __forceinline__ float sigmoid_f(float x) { return __builtin_amdgcn_rcpf(1.f + __expf(-x)); }

struct Args { const float* in[30]; float* out; unsigned char* ws; int ph_lo, ph_hi, li, pad; };
enum { I_X = 0, I_C, I_WADA, I_BADA, I_N1G, I_WIN, I_MU, I_W0, I_WDEC, I_A0, I_WAAA, I_WGATEUP, I_KK, I_KA, I_RK, I_LNW, I_LNB, I_RELB, I_BETAR, I_BETAA,
       I_WOUT, I_N2G, I_WGRP, I_BGRP, I_WEXP, I_BEXP, I_WG, I_WU, I_WDN, I_NFG };
constexpr int NPH = 15;

namespace pg8 {
#define PG8_LAS __attribute__((address_space(3)))
typedef unsigned short bf16_t;
typedef short bf16x8 __attribute__((ext_vector_type(8)));
typedef float f32x4 __attribute__((ext_vector_type(4)));
typedef unsigned u32x4 __attribute__((ext_vector_type(4)));
constexpr int BM = 256, BK = 64, HALF = 128, HTB = HALF * BK * 2  , STAGE_BYTES = 8 * HTB, NXCD = 8, WGM = 8;

__host__ __device__ __forceinline__ int lds_byte(int r, int c) { const int st = (r >> 4) * 2 + (c >> 5), rr = r & 15, cc = c & 31, ob = rr * 64 + cc * 2; return st * 1024 + (ob ^ (((ob >> 9) & 1) << 5)); }
__host__ __device__ __forceinline__ void stage_rc(int b, int& R, int& C) { const int st = b / 1024, sb = b % 1024, swz = sb ^ (((sb >> 9) & 1) << 5); R = (st >> 1) * 16 + swz / 64; C = (st & 1) * 32 + (swz % 64) / 2; }
__host__ __device__ __forceinline__ int perm32(int rho) { const int n = rho >> 4, i = rho & 15; return 8 * (i >> 2) + 4 * n + (i & 3); }

struct Unit { int pm, pn; };
struct Gemm { const bf16_t* A; const bf16_t* Bt; int M, N, K; };

struct StaticOrder {
    int nM, nN, nwg, G, c;
    __host__ __device__ void init(int M, int N, int G_, int c_) { nM = M / BM; nN = N / BM; nwg = nM * nN; G = G_; c = c_; }
    __host__ __device__ bool next(int i, Unit& u) const {
        const long L = (long)i * G + c; if (L >= nwg) return false;
        int wgid = (int)L; { const int q = nwg / NXCD, r = nwg % NXCD, xcd = wgid % NXCD, off = wgid / NXCD; wgid = (xcd < r ? xcd * (q + 1) : r * (q + 1) + (xcd - r) * q) + off; }
        const int nig = WGM * nN, gid = wgid / nig, fm = gid * WGM, gsz = (nM - fm) < WGM ? (nM - fm) : WGM;
        u.pm = fm + ((wgid % nig) % gsz); u.pn = (wgid % nig) / gsz; return true;
    }
    __device__ __forceinline__ void a_ready(const Unit&) const {}
    __device__ __forceinline__ void done(const Unit&) const {}
};

__device__ __forceinline__ unsigned cvt_pk_bf16(float lo, float hi) { unsigned r; asm volatile("v_cvt_pk_bf16_f32 %0, %1, %2" : "=v"(r) : "v"(lo), "v"(hi)); return r; }
template <class Epi, class Sched, bool ALIGN_EPI = false, bool SP2 = false>
__device__ __forceinline__ void gemm_phase(PG8_LAS unsigned char* lds, const Gemm g, const Sched& S, const Epi& E) {
    const int tid = threadIdx.x, wid = __builtin_amdgcn_readfirstlane(tid >> 6), lane = tid & 63, wr = wid >> 2, wc = wid & 3, fr = lane & 15, fq = lane >> 4;
    const int K = g.K, nt = K / BK;
    unsigned voffA[2], voffB[2];
#pragma unroll
    for (int i = 0; i < 2; ++i) { int R, C; stage_rc(tid * 16 + i * 8192, R, C); const int Rb = Epi::PERM ? ((R & ~31) + perm32(R & 31)) : R;
        voffA[i] = (unsigned)(R * K + C) * 2u; voffB[i] = (unsigned)(Rb * K + C) * 2u; }
    const size_t kstep = (size_t)(BK * 2);
    const size_t hstep = (size_t)HALF * K * 2;
    const size_t tstep = 2 * hstep;
    const unsigned ldsw = (unsigned)wid * 1024u;
    const int aoff = lds_byte(wr * 64 + fr, fq * 8), boff = lds_byte(wc * 32 + fr, fq * 8);
#define PG8_SA(b, h) (((b) * 2 + (h)) * HTB)
#define PG8_SB(b, h) ((4 + (b) * 2 + (h)) * HTB)
#define PG8_STAGE(bufoff, gbase, voff) do { _Pragma("unroll") for (int _i = 0; _i < 2; ++_i) \
        __builtin_amdgcn_global_load_lds((const unsigned*)((const char*)(gbase) + (voff)[_i]), (PG8_LAS unsigned*)(lds + (bufoff) + ldsw + _i * 8192), 16, 0, 0); } while (0)
#define PG8_LDA(dst, b, h) do { _Pragma("unroll") for (int m = 0; m < 4; ++m) _Pragma("unroll") for (int k = 0; k < 2; ++k) dst[m][k] = *(const PG8_LAS bf16x8*)(lds + PG8_SA(b, h) + aoff + m * 2048 + k * 1024); } while (0)
#define PG8_LDB(dst, b, h) do { _Pragma("unroll") for (int n = 0; n < 2; ++n) _Pragma("unroll") for (int k = 0; k < 2; ++k) dst[n][k] = *(const PG8_LAS bf16x8*)(lds + PG8_SB(b, h) + boff + n * 2048 + k * 1024); } while (0)
#define PG8_MMA(ai, bj, At, Bt) do { __builtin_amdgcn_s_setprio(1); _Pragma("unroll") for (int m = 0; m < 4; ++m) _Pragma("unroll") for (int n = 0; n < 2; ++n) _Pragma("unroll") for (int k = 0; k < 2; ++k) \
        acc[ai][bj][m][n] = __builtin_amdgcn_mfma_f32_16x16x32_bf16(Bt[n][k], At[m][k], acc[ai][bj][m][n], 0, 0, 0); __builtin_amdgcn_s_setprio(0); } while (0)
#define PG8_WAIT_V(n) asm volatile("s_waitcnt vmcnt(" #n ")" ::: "memory")
#define PG8_WAIT_L(n) asm volatile("s_waitcnt lgkmcnt(" #n ")" ::: "memory")
#define PG8_BAR __builtin_amdgcn_s_barrier()
#define PG8_SCHED __builtin_amdgcn_sched_barrier(0)
    Unit cur, nxt; int ui = 0;
    if (!S.next(0, cur)) return;
    f32x4 acc[2][2][4][2];
#pragma unroll
    for (int a = 0; a < 2; ++a)
#pragma unroll
        for (int b = 0; b < 2; ++b)
#pragma unroll
            for (int m = 0; m < 4; ++m)
#pragma unroll
                for (int n = 0; n < 2; ++n) acc[a][b][m][n] = (f32x4){0.f, 0.f, 0.f, 0.f};
    bf16x8 At[4][2], B0[2][2], B1[2][2];
    const char* cA = (const char*)g.A + (size_t)cur.pm * tstep; const char* cB = (const char*)g.Bt + (size_t)cur.pn * tstep;
    S.a_ready(cur);
    if constexpr (SP2) {
        PG8_STAGE(PG8_SB(0, 0), cB, voffB); PG8_STAGE(PG8_SB(0, 1), cB + hstep, voffB); PG8_STAGE(PG8_SA(0, 0), cA, voffA); PG8_STAGE(PG8_SA(0, 1), cA + hstep, voffA);
        if (wr == 1) PG8_BAR;
        PG8_WAIT_V(2); PG8_BAR;
        PG8_STAGE(PG8_SB(1, 0), cB + kstep, voffB); PG8_STAGE(PG8_SA(1, 0), cA + kstep, voffA); PG8_STAGE(PG8_SB(1, 1), cB + hstep + kstep, voffB);
        PG8_WAIT_V(6); PG8_BAR;
    } else {
        PG8_STAGE(PG8_SB(0, 0), cB, voffB); PG8_STAGE(PG8_SA(0, 0), cA, voffA); PG8_STAGE(PG8_SB(0, 1), cB + hstep, voffB); PG8_STAGE(PG8_SA(0, 1), cA + hstep, voffA);
        if (wr == 1) PG8_BAR;
        PG8_WAIT_V(4); PG8_BAR;
        PG8_STAGE(PG8_SB(1, 0), cB + kstep, voffB); PG8_STAGE(PG8_SA(1, 0), cA + kstep, voffA); PG8_STAGE(PG8_SB(1, 1), cB + hstep + kstep, voffB);
        PG8_WAIT_V(6); PG8_BAR;
    }
    for (;;) {
        const bool has_next = S.next(ui + 1, nxt);
        const char* nA = has_next ? (const char*)g.A + (size_t)nxt.pm * tstep : cA; const char* nB = has_next ? (const char*)g.Bt + (size_t)nxt.pn * tstep : cB;
        for (int t = 0; t < nt; t += 2) {
            const bool last = (t == nt - 2);
            const char* a1 = cA + (size_t)(t + 1) * kstep;
            const char* a2 = last ? nA : cA + (size_t)(t + 2) * kstep; const char* b2 = last ? nB : cB + (size_t)(t + 2) * kstep;
            const char* a3 = a2 + kstep; const char* b3 = b2 + kstep;
            if (last && has_next) S.a_ready(nxt);
            if constexpr (SP2) {
            PG8_LDB(B0, 0, 0); PG8_LDB(B1, 0, 1); PG8_SCHED; PG8_LDA(At, 0, 0); PG8_STAGE(PG8_SA(1, 1), a1 + hstep, voffA);
            PG8_WAIT_V(8); PG8_WAIT_L(0); PG8_BAR; PG8_MMA(0, 0, At, B0); PG8_MMA(0, 1, At, B1); PG8_BAR; PG8_SCHED;
            PG8_LDA(At, 0, 1); PG8_STAGE(PG8_SB(0, 0), b2, voffB); PG8_STAGE(PG8_SB(0, 1), b2 + hstep, voffB); PG8_STAGE(PG8_SA(0, 0), a2, voffA);
            PG8_WAIT_V(8); PG8_WAIT_L(0); PG8_BAR; PG8_MMA(1, 0, At, B0); PG8_MMA(1, 1, At, B1); PG8_BAR; PG8_SCHED;
            PG8_LDB(B0, 1, 0); PG8_LDB(B1, 1, 1); PG8_SCHED; PG8_LDA(At, 1, 0); PG8_STAGE(PG8_SA(0, 1), a2 + hstep, voffA);
            PG8_WAIT_V(8); PG8_WAIT_L(0); PG8_BAR; PG8_MMA(0, 0, At, B0); PG8_MMA(0, 1, At, B1); PG8_BAR; PG8_SCHED;
            PG8_LDA(At, 1, 1); PG8_STAGE(PG8_SB(1, 0), b3, voffB); PG8_STAGE(PG8_SB(1, 1), b3 + hstep, voffB); PG8_STAGE(PG8_SA(1, 0), a3, voffA);
            PG8_WAIT_V(8); PG8_WAIT_L(0); PG8_BAR; PG8_MMA(1, 0, At, B0); PG8_MMA(1, 1, At, B1); PG8_BAR; PG8_SCHED;
            } else {
            PG8_LDB(B0, 0, 0); PG8_SCHED; PG8_LDA(At, 0, 0); PG8_STAGE(PG8_SA(1, 1), a1 + hstep, voffA);
            PG8_WAIT_L(8); PG8_BAR; PG8_WAIT_L(0); PG8_MMA(0, 0, At, B0); PG8_BAR; PG8_SCHED;
            PG8_LDB(B1, 0, 1); PG8_STAGE(PG8_SB(0, 0), b2, voffB);
            PG8_BAR; PG8_WAIT_L(0); PG8_MMA(0, 1, At, B1); PG8_BAR;
            PG8_LDA(At, 0, 1); PG8_STAGE(PG8_SA(0, 0), a2, voffA);
            PG8_BAR; PG8_WAIT_L(0); PG8_MMA(1, 0, At, B0); PG8_BAR; PG8_SCHED;
            PG8_STAGE(PG8_SB(0, 1), b2 + hstep, voffB);
            PG8_WAIT_V(6); PG8_BAR; PG8_MMA(1, 1, At, B1); PG8_BAR;
            PG8_LDB(B0, 1, 0); PG8_SCHED; PG8_LDA(At, 1, 0); PG8_STAGE(PG8_SA(0, 1), a2 + hstep, voffA);
            PG8_WAIT_L(8); PG8_BAR; PG8_WAIT_L(0); PG8_MMA(0, 0, At, B0); PG8_BAR; PG8_SCHED;
            PG8_LDB(B1, 1, 1); PG8_STAGE(PG8_SB(1, 0), b3, voffB);
            PG8_BAR; PG8_WAIT_L(0); PG8_MMA(0, 1, At, B1); PG8_BAR;
            PG8_LDA(At, 1, 1); PG8_STAGE(PG8_SA(1, 0), a3, voffA);
            PG8_BAR; PG8_WAIT_L(0); PG8_MMA(1, 0, At, B0); PG8_BAR; PG8_SCHED;
            PG8_STAGE(PG8_SB(1, 1), b3 + hstep, voffB);
            PG8_WAIT_V(6); PG8_BAR; PG8_MMA(1, 1, At, B1); PG8_BAR;
            }
        }
        if constexpr (ALIGN_EPI) { if (wr == 0) PG8_BAR; }
        if constexpr (!Epi::AFTER_DRAIN) { E(acc, cur, wr, wc, fr, fq); S.done(cur); }
        if (!has_next) break;
#pragma unroll
        for (int a = 0; a < 2; ++a)
#pragma unroll
            for (int b = 0; b < 2; ++b)
#pragma unroll
                for (int m = 0; m < 4; ++m)
#pragma unroll
                    for (int n = 0; n < 2; ++n) acc[a][b][m][n] = (f32x4){0.f, 0.f, 0.f, 0.f};
        cur = nxt; cA = nA; cB = nB; ++ui;
        if constexpr (ALIGN_EPI) { if (wr == 1) PG8_BAR; }
    }
    PG8_WAIT_V(0);
    if constexpr (!ALIGN_EPI) { if (wr == 0) PG8_BAR; }
    PG8_BAR;
    if constexpr (Epi::AFTER_DRAIN) { E.fused(acc, cur, wr, wc, fr, fq, lds, wid, lane); S.done(cur); }
#undef PG8_SA
#undef PG8_SB
#undef PG8_STAGE
#undef PG8_LDA
#undef PG8_LDB
#undef PG8_MMA
#undef PG8_WAIT_V
#undef PG8_WAIT_L
#undef PG8_BAR
#undef PG8_SCHED
}
}
#define XB_TMO      128
#define XB_XCNT(j)  (256  + 64 * (j))
#define XB_XSUB(j)  (1280 + 64 * (j))
#define XB_XGEN(j)  (2304 + 64 * (j))
#define XB_TOP      3328
#define XB_TOPGEN   3392
#define XCD_BAR_WORDS 3456
#define XB_SPIN_CAP (1u << 18)

__device__ __forceinline__ unsigned xb_ld(unsigned* p)              { return __hip_atomic_load(p, __ATOMIC_RELAXED, __HIP_MEMORY_SCOPE_AGENT); }
__device__ __forceinline__ unsigned xb_add(unsigned* p, unsigned v) { return __hip_atomic_fetch_add(p, v, __ATOMIC_RELAXED, __HIP_MEMORY_SCOPE_AGENT); }
__device__ __forceinline__ unsigned xb_xcc_id() { return (unsigned)__builtin_amdgcn_s_getreg((3 << 11) | 20) & 0xFu; }
#define XB_SPIN(cond, bar) do { unsigned _sp = 0; while (cond) { __builtin_amdgcn_s_sleep(1); \
    if ((++_sp & 255u) == 0u) { if (xb_ld(&(bar)[XB_TMO])) break; if (_sp > XB_SPIN_CAP) { atomicAdd(&(bar)[XB_TMO], 1u); break; } } } } while (0)

struct XcdBarrier {
    unsigned* bar; unsigned x;
    volatile LAS unsigned* st;
};

__device__ __forceinline__ XcdBarrier xcd_barrier_post(unsigned* bar, volatile LAS unsigned* st) {
    XcdBarrier b; b.bar = bar; b.x = xb_xcc_id(); b.st = st;
    if (threadIdx.x == 0) (void)xb_add(&bar[XB_XCNT(b.x)], 1u);
    return b;
}
__device__ __forceinline__ void xcd_barrier_complete(unsigned* bar, unsigned x, unsigned& nloc, unsigned& nx) {
    const unsigned G = gridDim.x * gridDim.y * gridDim.z;
    unsigned sum, cnt, mine, sp = 0u;
    for (;;) {
        sum = 0u; cnt = 0u; mine = 0u;
#pragma unroll
        for (unsigned j = 0; j < 16; ++j) { const unsigned c = xb_ld(&bar[XB_XCNT(j)]); sum += c; cnt += (c > 0u) ? 1u : 0u; mine = (j == x) ? c : mine; }
        if (sum == G) break;
        __builtin_amdgcn_s_sleep(1);
        if ((++sp & 255u) == 0u) { if (xb_ld(&bar[XB_TMO])) break; if (sp > XB_SPIN_CAP) { atomicAdd(&bar[XB_TMO], 1u); break; } }
    }
    nloc = mine > 0u ? mine : 1u; nx = cnt > 0u ? cnt : 1u;
}

__device__ __forceinline__ void xcd_barrier(const XcdBarrier& b) {
    asm volatile("s_waitcnt vmcnt(0)" ::: "memory");
    __syncthreads();
    if (threadIdx.x == 0) {
        unsigned* bar = b.bar;
        __builtin_amdgcn_s_waitcnt(0);
        unsigned nloc = b.st[0], nx = b.st[1];
        if (nloc == 0u) { xcd_barrier_complete(bar, b.x, nloc, nx); b.st[0] = nloc; b.st[1] = nx; }
        const unsigned old = xb_add(&bar[XB_XSUB(b.x)], 1u);
        const unsigned gen = old / nloc;
        if (old + 1u == (gen + 1u) * nloc) {
            __builtin_amdgcn_fence(__ATOMIC_RELEASE, "agent");
            asm volatile("s_waitcnt vmcnt(0)" ::: "memory");
            const unsigned og = xb_add(&bar[XB_TOP], 1u);
            const unsigned tg = og / nx;
            if (og + 1u == (tg + 1u) * nx) xb_add(&bar[XB_TOPGEN], 1u);
            else XB_SPIN(xb_ld(&bar[XB_TOPGEN]) == tg, bar);
            __builtin_amdgcn_fence(__ATOMIC_ACQUIRE, "agent");
            xb_add(&bar[XB_XGEN(b.x)], 1u);
            asm volatile("s_waitcnt vmcnt(0)" ::: "memory");
        } else {
            XB_SPIN(xb_ld(&bar[XB_XGEN(b.x)]) == gen, bar);
            __builtin_amdgcn_fence(__ATOMIC_ACQUIRE, "agent");
            asm volatile("s_waitcnt vmcnt(0)" ::: "memory");
        }
    }
    __syncthreads();
}

struct EpiStoreBf16 {
    static constexpr bool PERM = true, AFTER_DRAIN = false;
    bf16* O; int ldc; int pn_mask;
    __device__ __forceinline__ void operator()(const pg8::f32x4 (&acc)[2][2][4][2], const pg8::Unit& u, int wr, int wc, int fr_, int fq_) const {
        int t_ = threadIdx.x; asm volatile("" : "+v"(t_)); const int fr = t_ & 15, fq = (t_ >> 4) & 3; (void)fr_; (void)fq_;
        const int row0 = u.pm * 256 + wr * 64 + fr, col0 = (u.pn & pn_mask) * 256 + wc * 32 + 8 * fq;
#pragma unroll
        for (int ai = 0; ai < 2; ++ai)
#pragma unroll
            for (int m = 0; m < 4; ++m) { bf16* rowp = O + (size_t)(row0 + ai * 128 + m * 16) * ldc + col0;
#pragma unroll
                for (int bj = 0; bj < 2; ++bj) { const pg8::f32x4 v0 = acc[ai][bj][m][0], v1 = acc[ai][bj][m][1];
                    v4u w; w.x = pg8::cvt_pk_bf16(v0[0], v0[1]); w.y = pg8::cvt_pk_bf16(v0[2], v0[3]); w.z = pg8::cvt_pk_bf16(v1[0], v1[1]); w.w = pg8::cvt_pk_bf16(v1[2], v1[3]);
                    *(v4u*)(rowp + bj * 128) = w; } }
    }
};
struct EpiProj {
    static constexpr bool PERM = true, AFTER_DRAIN = false;
    bf16* HM; bf16* PLR;
    __device__ __forceinline__ void operator()(const pg8::f32x4 (&acc)[2][2][4][2], const pg8::Unit& u, int wr, int wc, int fr_, int fq_) const {
        int t_ = threadIdx.x; asm volatile("" : "+v"(t_)); const int fr = t_ & 15, fq = (t_ >> 4) & 3; (void)fr_; (void)fq_;
        const int row0 = u.pm * 256 + wr * 64 + fr, colb = u.pn * 256 + wc * 32 + 8 * fq;
#pragma unroll
        for (int bj = 0; bj < 2; ++bj) { const int idx = colb + bj * 128;
            if (idx >= PROJW) continue;
            const bool lora = idx >= 6144;
            const size_t hbase = (size_t)(idx >> 10) * HM_PART + (size_t)((idx >> 6) & 15) * HM_HEAD + (idx & 63);
#pragma unroll
            for (int ai = 0; ai < 2; ++ai)
#pragma unroll
                for (int m = 0; m < 4; ++m) { const int row = row0 + ai * 128 + m * 16;
                    bf16* dst = lora ? PLR + (size_t)row * 288 + (idx - 6144) : HM + hbase + (size_t)(row >> 12) * HM_BATCH + (size_t)(row & (SEQ - 1)) * HD;
                    const pg8::f32x4 v0 = acc[ai][bj][m][0], v1 = acc[ai][bj][m][1];
                    v4u w; w.x = pg8::cvt_pk_bf16(v0[0], v0[1]); w.y = pg8::cvt_pk_bf16(v0[2], v0[3]); w.z = pg8::cvt_pk_bf16(v1[0], v1[1]); w.w = pg8::cvt_pk_bf16(v1[2], v1[3]);
                    *(v4u*)dst = w; } }
    }
};
struct EpiGateUp {
    static constexpr bool PERM = true, AFTER_DRAIN = false;
    const float* sw; bf16* HG;
    __device__ __forceinline__ void operator()(const pg8::f32x4 (&acc)[2][2][4][2], const pg8::Unit& u, int wr, int wc, int fr_, int fq_) const {
        int t_ = threadIdx.x; asm volatile("" : "+v"(t_)); const int fr = t_ & 15, fq = (t_ >> 4) & 3; (void)fr_; (void)fq_;
        const int pl = u.pn & 3, row0 = u.pm * 256 + wr * 64 + fr, col0 = pl * 128 + wc * 32 + 8 * fq;
#pragma unroll
        for (int ai = 0; ai < 2; ++ai)
#pragma unroll
            for (int m = 0; m < 4; ++m) { const int row = row0 + ai * 128 + m * 16; const float w = sw[row]; float h[8];
#pragma unroll
                for (int n = 0; n < 2; ++n)
#pragma unroll
                    for (int j = 0; j < 4; ++j) { const float g = acc[ai][0][m][n][j], up = acc[ai][1][m][n][j]; h[4 * n + j] = g * sigmoid_f(g) * up * w; }
                v4u o; o.x = pg8::cvt_pk_bf16(h[0], h[1]); o.y = pg8::cvt_pk_bf16(h[2], h[3]); o.z = pg8::cvt_pk_bf16(h[4], h[5]); o.w = pg8::cvt_pk_bf16(h[6], h[7]);
                *(v4u*)(HG + (size_t)row * FF + col0) = o; }
    }
};
struct EpiResGate {
    static constexpr bool PERM = true, AFTER_DRAIN = false;
    const float* x; const float* gate; bf16* X1;
    __device__ __forceinline__ void operator()(const pg8::f32x4 (&acc)[2][2][4][2], const pg8::Unit& u, int wr, int wc, int fr_, int fq_) const {
        int t_ = threadIdx.x; asm volatile("" : "+v"(t_)); const int fr = t_ & 15, fq = (t_ >> 4) & 3; (void)fr_; (void)fq_;
        const int row0 = u.pm * 256 + wr * 64 + fr, col0 = u.pn * 256 + wc * 32 + 8 * fq;
        const float* gp = gate + (size_t)((u.pm * 256) >> 12) * 12288;
#pragma unroll
        for (int bj = 0; bj < 2; ++bj) { const int c = col0 + bj * 128; const pg8::f32x4 g0 = *(const pg8::f32x4*)(gp + c), g1 = *(const pg8::f32x4*)(gp + c + 4);
#pragma unroll
            for (int ai = 0; ai < 2; ++ai)
#pragma unroll
                for (int m = 0; m < 4; ++m) { const size_t off = (size_t)(row0 + ai * 128 + m * 16) * DM + c;
                    const pg8::f32x4 x0 = *(const pg8::f32x4*)(x + off) + g0 * acc[ai][bj][m][0], x1 = *(const pg8::f32x4*)(x + off + 4) + g1 * acc[ai][bj][m][1];
                    v4u w; w.x = pg8::cvt_pk_bf16(x0[0], x0[1]); w.y = pg8::cvt_pk_bf16(x0[2], x0[3]); w.z = pg8::cvt_pk_bf16(x1[0], x1[1]); w.w = pg8::cvt_pk_bf16(x1[2], x1[3]);
                    *(v4u*)(X1 + off) = w; } }
    }
};
struct EpiLora {
    static constexpr bool PERM = false, AFTER_DRAIN = false;
    float* LW; bf16* AA; bf16* GG;
    __device__ __forceinline__ void operator()(const pg8::f32x4 (&acc)[2][2][4][2], const pg8::Unit& u, int wr, int wc, int fr_, int fq_) const {
        int t_ = threadIdx.x; asm volatile("" : "+v"(t_)); const int fr = t_ & 15, fq = (t_ >> 4) & 3; (void)fr_; (void)fq_;
        const int type = u.pn >> 2, row0 = u.pm * 256 + wr * 64 + fr, col0 = (u.pn & 3) * 256 + wc * 32 + 4 * fq;
        bf16* hb = (type == 1) ? AA : GG;
#pragma unroll
        for (int bj = 0; bj < 2; ++bj)
#pragma unroll
            for (int n = 0; n < 2; ++n) { const int c = col0 + bj * 128 + n * 16;
#pragma unroll
                for (int ai = 0; ai < 2; ++ai)
#pragma unroll
                    for (int m = 0; m < 4; ++m) { const size_t off = (size_t)(row0 + ai * 128 + m * 16) * CW + c; const pg8::f32x4 v = acc[ai][bj][m][n];
                        if (type == 0) *(pg8::f32x4*)(LW + off) = v;
                        else { v2u o; o.x = pg8::cvt_pk_bf16(v[0], v[1]); o.y = pg8::cvt_pk_bf16(v[2], v[3]); *(v2u*)(hb + off) = o; } } }
    }
};
struct GroupOrder {
    const unsigned* te; int nrt, ncol, G, c;
    __device__ __forceinline__ bool next(int i, pg8::Unit& u) const {
        const long L = (long)i * G + c; if (L >= (long)nrt * ncol) return false;
        const int rt = (int)(L / ncol), pl = (int)(L - (long)rt * ncol);
        u.pm = rt; u.pn = (int)te[rt] * ncol + pl; return true;
    }
    __device__ __forceinline__ void a_ready(const pg8::Unit&) const {}
    __device__ __forceinline__ void done(const pg8::Unit&) const {}
};

struct GroupOrder2 {
    const unsigned* te; int ncol, base, count, Gp, cp;
    __device__ __forceinline__ bool next(int i, pg8::Unit& u) const {
        if (cp < 0) return false;
        const int q = Gp >> 3, r = Gp & 7, x = cp & 7, o = cp >> 3;
        const int cr = (x < r ? x * (q + 1) : r * (q + 1) + (x - r) * q) + o;
        const long k = (long)i * Gp + cr; if (k >= count) return false;
        const int L = base + (int)k, rt = L / ncol, pl = L - rt * ncol;
        u.pm = rt; u.pn = (int)te[rt] * ncol + pl; return true;
    }
    __device__ __forceinline__ void a_ready(const pg8::Unit&) const {}
    __device__ __forceinline__ void done(const pg8::Unit&) const {}
};

#define MFMA16(a, b, c) __builtin_amdgcn_mfma_f32_16x16x16bf16_1k(a, b, c, 0, 0, 0)
constexpr int NUNIT = BATCH * NHEAD * (SEQ / 64);
constexpr int LA_GF = 0, LA_SEG = 16384, LA_PL = 18432, LA_RT = 20480, LA_QT = 28672, LA_KT = 36864, LA_BT = 45056, LA_VT = 53248,
              LA_AQB = 61440, LA_AQK = 69632, LA_ARB = 77824, LA_ARK = 86016, LA_DG = 94208, LA_DL = 98304, LA_PRM = 100352;
__device__ __forceinline__ int swz(int row, int chunk) { return row * 128 + ((chunk ^ ((row >> 1) & 7)) << 4); }
__device__ __forceinline__ s16x4 tr_read(LAS unsigned char* base, int r0, int cb, int n) {
    return __builtin_bit_cast(s16x4, __builtin_amdgcn_ds_read_tr16_b64_v4i16((LAS s16x4*)(base + swz(r0 + (n >> 2), 2 * cb + ((n & 3) >> 1)) + 8 * (n & 1)))); }
__device__ __forceinline__ s16x4 row_read4(LAS unsigned char* base, int row, int col0) {
    return *(const LAS s16x4*)(base + swz(row, col0 >> 3) + 2 * (col0 & 7)); }
__device__ __forceinline__ s16x4 pack4(const f32x4 v) { v2u w; w.x = pk2(v[0], v[1]); w.y = pk2(v[2], v[3]); return __builtin_bit_cast(s16x4, w); }
__device__ __forceinline__ s16x4 pack4n(const f32x4 v) { v2u w; w.x = pk2(-v[0], -v[1]); w.y = pk2(-v[2], -v[3]); return __builtin_bit_cast(s16x4, w); }
__device__ __forceinline__ f32x4 unpack4(const s16x4 s) { const v2u w = __builtin_bit_cast(v2u, s); return (f32x4){bflo(w.x), bfhi(w.x), bflo(w.y), bfhi(w.y)}; }

#define LGKM0() do { asm volatile("s_waitcnt lgkmcnt(0)" ::: "memory"); __builtin_amdgcn_sched_barrier(0); } while (0)
#define LDS_BARRIER() do { asm volatile("s_waitcnt lgkmcnt(0)" ::: "memory"); __builtin_amdgcn_s_barrier(); asm volatile("" ::: "memory"); } while (0)
__device__ __forceinline__ void scanA(const Args& a, LAS unsigned char* lds) {
    const int tid = threadIdx.x, lane = tid & 63, wave = __builtin_amdgcn_readfirstlane(tid >> 6), n = lane & 15, g = lane >> 4;
    LAS float* GF = (LAS float*)(lds + LA_GF); LAS float* SEG = (LAS float*)(lds + LA_SEG); LAS float* PLs = (LAS float*)(lds + LA_PL); LAS float* DG = (LAS float*)(lds + LA_DG);
    const int tk = tid >> 3, c8 = 8 * (tid & 7);
    v4u nr4, nk4, nv4, pr4, pk4, pv4, na4; f32x4 nl0, nl1;
#define SCANA_LOAD(U) do { const int bh_ = (U) >> 6, ck_ = (U) & 63, h_ = bh_ & 15; const size_t m_ = (size_t)(bh_ >> 4) * SEQ + 64 * ck_ + tk; \
        const bf16* pc_ = (const bf16*)(a.ws + WS_P) + (size_t)(bh_ >> 4) * HM_BATCH + (size_t)h_ * HM_HEAD + (size_t)(64 * ck_ + tk) * HD + c8; const bf16* pp_ = pc_ - ((64 * ck_ + tk) != 0 ? HD : 0); \
        nr4 = *(const v4u*)pc_; nk4 = *(const v4u*)(pc_ + HM_PART); nv4 = *(const v4u*)(pc_ + 2 * HM_PART); pr4 = *(const v4u*)pp_; pk4 = *(const v4u*)(pp_ + HM_PART); pv4 = *(const v4u*)(pp_ + 2 * HM_PART); \
        const size_t off_ = m_ * CW + h_ * 64 + c8; na4 = *(const v4u*)((const bf16*)(a.ws + WS_AA) + off_); \
        nl0 = *(const f32x4*)((const float*)(a.ws + WS_LW) + off_); nl1 = *(const f32x4*)((const float*)(a.ws + WS_LW) + off_ + 4); } while (0)
#define SCANA_UNIT(IDX) (((((IDX) >> 10) * 16 + ((IDX) & 15)) << 6) + (((IDX) >> 4) & 63))
    if ((int)blockIdx.x < NUNIT) SCANA_LOAD(SCANA_UNIT((int)blockIdx.x));
    STAMP_DECL;
    LAS float* PRM = (LAS float*)(lds + LA_PRM);
    int hcur = -1;
    for (int idx = blockIdx.x; idx < NUNIT; idx += gridDim.x) {
        const int unit = SCANA_UNIT(idx);
        int tid_o = threadIdx.x; asm volatile("" : "+v"(tid_o));
        const int tid = tid_o, lane = tid & 63, n = lane & 15, g = lane >> 4, tk = tid >> 3, c8 = 8 * (tid & 7);
        STAMP_BEGIN(5); STAMP_BEGIN(1); STAMP_BEGIN(31);
        const int h = (unit >> 6) & 15, ch0 = h * 64 + c8; const bool first = ((unit & 63) == 0) && (tk == 0);
        if (h != hcur) { hcur = h;
            if (tid < 448) { const int which = tid >> 6, c = tid & 63; const float* src = (which == 0) ? a.in[I_MU] : (which == 1) ? a.in[I_MU] + 1024 : (which == 2) ? a.in[I_MU] + 2048 :
                    (which == 3) ? a.in[I_A0] : (which == 4) ? a.in[I_KK] : (which == 5) ? a.in[I_KA] : a.in[I_W0];
                PRM[tid] = src[h * 64 + c]; }
            LDS_BARRIER(); }
        float pmr[8], pmk[8], pmv[8], pa0[8], pkk[8], pka[8], pw0[8];
        { f32x4 pv[14];
#pragma unroll
          for (int q = 0; q < 7; ++q) { pv[2 * q] = *(const LAS f32x4*)(PRM + 64 * q + c8); pv[2 * q + 1] = *(const LAS f32x4*)(PRM + 64 * q + c8 + 4); }
          LGKM0();
#pragma unroll
          for (int i = 0; i < 8; ++i) { pmr[i] = pv[0 + (i >> 2)][i & 3]; pmk[i] = pv[2 + (i >> 2)][i & 3]; pmv[i] = pv[4 + (i >> 2)][i & 3]; pa0[i] = pv[6 + (i >> 2)][i & 3];
              pkk[i] = pv[8 + (i >> 2)][i & 3]; pka[i] = pv[10 + (i >> 2)][i & 3]; pw0[i] = pv[12 + (i >> 2)][i & 3]; } }
        float rf[8], kf[8], vf8[8], qf8[8], bf8[8]; f32x4 l0, l1;
        { float av[8], kkv[8]; float ssq = 0.f;
#pragma unroll
          for (int i = 0; i < 8; ++i) { const int wd = i >> 1; const bool hi = i & 1;
              const float cr = hi ? bfhi(nr4[wd]) : bflo(nr4[wd]), ckk = hi ? bfhi(nk4[wd]) : bflo(nk4[wd]), cv = hi ? bfhi(nv4[wd]) : bflo(nv4[wd]);
              const float qr = first ? 0.f : (hi ? bfhi(pr4[wd]) : bflo(pr4[wd])), qk = first ? 0.f : (hi ? bfhi(pk4[wd]) : bflo(pk4[wd])), qv = first ? 0.f : (hi ? bfhi(pv4[wd]) : bflo(pv4[wd]));
              rf[i] = cr + (qr - cr) * pmr[i]; kf[i] = ckk + (qk - ckk) * pmk[i]; vf8[i] = cv + (qv - cv) * pmv[i];
              av[i] = sigmoid_f((hi ? bfhi(na4[wd]) : bflo(na4[wd])) + pa0[i]);
              kkv[i] = kf[i] * pkk[i]; ssq += kkv[i] * kkv[i]; }
          ssq += __shfl_xor(ssq, 1); ssq += __shfl_xor(ssq, 2); ssq += __shfl_xor(ssq, 4);
          const float inv = __builtin_amdgcn_rsqf(fmaxf(ssq, 1e-24f));
#pragma unroll
          for (int i = 0; i < 8; ++i) { qf8[i] = kkv[i] * inv; bf8[i] = qf8[i] * av[i]; kf[i] = kf[i] * (1.f + (av[i] - 1.f) * pka[i]); }
#pragma unroll
          for (int i = 0; i < 4; ++i) {
              l0[i] = -0.60653066f * sigmoid_f(nl0[i] + pw0[i]); l1[i] = -0.60653066f * sigmoid_f(nl1[i] + pw0[4 + i]); }
          const size_t off = ((size_t)(unit >> 10) * SEQ + 64 * (unit & 63) + tk) * CW + ch0; v4u w;
          w.x = pk2(rf[0], rf[1]); w.y = pk2(rf[2], rf[3]); w.z = pk2(rf[4], rf[5]); w.w = pk2(rf[6], rf[7]); *(v4u*)((bf16*)(a.ws + WS_R) + off) = w;
          w.x = pk2(kf[0], kf[1]); w.y = pk2(kf[2], kf[3]); w.z = pk2(kf[4], kf[5]); w.w = pk2(kf[6], kf[7]); *(v4u*)((bf16*)(a.ws + WS_K2) + off) = w;
          w.x = pk2(vf8[0], vf8[1]); w.y = pk2(vf8[2], vf8[3]); w.z = pk2(vf8[4], vf8[5]); w.w = pk2(vf8[6], vf8[7]); *(v4u*)((bf16*)(a.ws + WS_V) + off) = w; }
        *(LAS f32x4*)(GF + tk * 64 + c8) = l0; *(LAS f32x4*)(GF + tk * 64 + c8 + 4) = l1;
        LDS_BARRIER();
        STAMP_END(31); STAMP_BEGIN(32);
        { const int c = tid & 63, sg = tid >> 6; float gv[8], run = 0.f;
#pragma unroll
          for (int i = 0; i < 8; ++i) gv[i] = GF[(8 * sg + i) * 64 + c];
          LGKM0();
#pragma unroll
          for (int i = 0; i < 8; ++i) { run += gv[i]; GF[(8 * sg + i) * 64 + c] = run; }
          SEG[sg * 64 + c] = run; }
        LDS_BARRIER();
        STAMP_END(32); STAMP_BEGIN(33);
        { const int sg = tk >> 3; float gg[8], lw[8];
          f32x4 gq[2], sq[7][2];
          gq[0] = *(const LAS f32x4*)(GF + tk * 64 + c8); gq[1] = *(const LAS f32x4*)(GF + tk * 64 + c8 + 4);
#pragma unroll
          for (int s2 = 0; s2 < 7; ++s2) { sq[s2][0] = *(const LAS f32x4*)(SEG + s2 * 64 + c8); sq[s2][1] = *(const LAS f32x4*)(SEG + s2 * 64 + c8 + 4); }
          LGKM0();
#pragma unroll
          for (int i = 0; i < 8; ++i) { float x = gq[i >> 2][i & 3];
#pragma unroll
              for (int s2 = 0; s2 < 7; ++s2) x += (s2 < sg) ? sq[s2][i >> 2][i & 3] : 0.f;
              gg[i] = x; lw[i] = (i < 4) ? l0[i] : l1[i - 4]; }
          float rr[8], qq[8], kk[8], bb[8];
#pragma unroll
          for (int i = 0; i < 4; ++i) { const int e0 = 2 * i, e1 = 2 * i + 1;
              const float eg0 = __expf(gg[e0]), eg1 = __expf(gg[e1]), en0 = __expf(-gg[e0]), en1 = __expf(-gg[e1]), em0 = __expf(gg[e0] - lw[e0]), em1 = __expf(gg[e1] - lw[e1]);
              rr[e0] = rf[e0] * eg0; rr[e1] = rf[e1] * eg1; qq[e0] = qf8[e0] * em0; qq[e1] = qf8[e1] * em1;
              kk[e0] = kf[e0] * en0; kk[e1] = kf[e1] * en1; bb[e0] = bf8[e0] * en0; bb[e1] = bf8[e1] * en1;
              if (tk == 63) { PLs[c8 + e0] = eg0; PLs[c8 + e1] = eg1; } }
          const int so = swz(tk, tid & 7); v4u w;
          w.x = pk2(rr[0], rr[1]); w.y = pk2(rr[2], rr[3]); w.z = pk2(rr[4], rr[5]); w.w = pk2(rr[6], rr[7]); *(LAS v4u*)(lds + LA_RT + so) = w;
          w.x = pk2(qq[0], qq[1]); w.y = pk2(qq[2], qq[3]); w.z = pk2(qq[4], qq[5]); w.w = pk2(qq[6], qq[7]); *(LAS v4u*)(lds + LA_QT + so) = w;
          w.x = pk2(kk[0], kk[1]); w.y = pk2(kk[2], kk[3]); w.z = pk2(kk[4], kk[5]); w.w = pk2(kk[6], kk[7]); *(LAS v4u*)(lds + LA_KT + so) = w;
          w.x = pk2(bb[0], bb[1]); w.y = pk2(bb[2], bb[3]); w.z = pk2(bb[4], bb[5]); w.w = pk2(bb[6], bb[7]); *(LAS v4u*)(lds + LA_BT + so) = w;
          w.x = pk2(vf8[0], vf8[1]); w.y = pk2(vf8[2], vf8[3]); w.z = pk2(vf8[4], vf8[5]); w.w = pk2(vf8[6], vf8[7]); *(LAS v4u*)(lds + LA_VT + so) = w; }
        LDS_BARRIER();
        STAMP_END(33); STAMP_END(1); STAMP_BEGIN(2);
        if (idx + (int)gridDim.x < NUNIT) SCANA_LOAD(SCANA_UNIT(idx + (int)gridDim.x));
        for (int id = wave; id < 40; id += NWAVES) {
            const int mat = id / 10, p = id - mat * 10, tb = p < 1 ? 0 : (p < 3 ? 1 : (p < 6 ? 2 : 3)), sb = p - tb * (tb + 1) / 2;
            LAS unsigned char* Lft = lds + ((mat & 1) ? LA_KT : LA_BT); LAS unsigned char* Rgt = lds + ((mat & 2) ? LA_RT : LA_QT);
            f32x4 acc = (f32x4){0.f, 0.f, 0.f, 0.f};
#pragma unroll
            for (int ks = 0; ks < 2; ++ks) { const bf16x8 af = *(const LAS bf16x8*)(Lft + swz(16 * sb + n, 4 * ks + g)), bfr = *(const LAS bf16x8*)(Rgt + swz(16 * tb + n, 4 * ks + g));
                acc = __builtin_amdgcn_mfma_f32_16x16x32_bf16(af, bfr, acc, 0, 0, 0); }
            const int t = 16 * tb + n, s0 = 16 * sb + 4 * g;
#pragma unroll
            for (int j = 0; j < 4; ++j) { const bool keep = (mat & 2) ? (s0 + j <= t) : (s0 + j < t); if (!keep) acc[j] = 0.f; }
            LAS unsigned char* dst = lds + (mat == 0 ? LA_AQB : (mat == 1 ? LA_AQK : (mat == 2 ? LA_ARB : LA_ARK)));
            v2u w; w.x = pk2(acc[0], acc[1]); w.y = pk2(acc[2], acc[3]);
            *(LAS v2u*)(dst + swz(t, s0 >> 3) + 2 * (s0 & 7)) = w;
            if (mat == 0 && sb == tb) *(LAS f32x4*)(DG + tb * 256 + n * 16 + 4 * g) = acc;
        }
        LDS_BARRIER();
        STAMP_END(2); STAMP_BEGIN(3);
        const bool isU = wave >= 4; const int cb = wave & 3;
        LAS unsigned char* AQB = lds + LA_AQB; LAS unsigned char* AQK = lds + LA_AQK; LAS unsigned char* ARB = lds + LA_ARB; LAS unsigned char* ARK = lds + LA_ARK;
        s16x4 vf[4], xn[4], fqb[6], frb[10], fbt[16];
        f32x4 rhs[4], y1a[4], hma[4], rti[4];
        if (isU) {
            s16x4 fqk[10], frk[10], fkt[16];
#pragma unroll
            for (int k = 0; k < 4; ++k) vf[k] = tr_read(lds + LA_VT, 16 * k + 4 * g, cb, n);
#pragma unroll
            for (int i = 0; i < 4; ++i)
#pragma unroll
                for (int k = 0; k < 4; ++k) { if (k <= i) { fqk[i * (i + 1) / 2 + k] = row_read4(AQK, 16 * i + n, 16 * k + 4 * g); frk[i * (i + 1) / 2 + k] = row_read4(ARK, 16 * i + n, 16 * k + 4 * g); }
                    fkt[4 * i + k] = tr_read(lds + LA_KT, 16 * k + 4 * g, i, n); }
            LGKM0();
#pragma unroll
            for (int i = 0; i < 4; ++i) { f32x4 acc = (f32x4){0.f, 0.f, 0.f, 0.f}, ac2 = acc, ac3 = acc;
#pragma unroll
                for (int k = 0; k < 4; ++k) { if (k <= i) { acc = MFMA16(fqk[i * (i + 1) / 2 + k], vf[k], acc); ac2 = MFMA16(frk[i * (i + 1) / 2 + k], vf[k], ac2); }
                    ac3 = MFMA16(vf[k], fkt[4 * i + k], ac3); }
                rhs[i] = acc; y1a[i] = ac2; hma[i] = ac3; rti[i] = acc; }
        } else {
            if (lane < 16) {
                const LAS float* A = DG + wave * 256; float x[16]; f32x4 ar[16][4];
                int lj = lane; asm volatile("" : "+v"(lj));
                x[0] = (lj == 0) ? 1.f : 0.f;
#pragma unroll
                for (int t = 1; t < 9; ++t)
#pragma unroll
                    for (int q = 0; q < 4; ++q) if (4 * q < t) ar[t][q] = *(const LAS f32x4*)(A + t * 16 + 4 * q);
                LGKM0();
#pragma unroll
                for (int t = 1; t < 9; ++t) { float a0 = (t == lj) ? 1.f : 0.f, a1 = 0.f;
#pragma unroll
                    for (int s2 = 0; s2 < t; ++s2) { if (s2 & 1) a1 -= ar[t][s2 >> 2][s2 & 3] * x[s2]; else a0 -= ar[t][s2 >> 2][s2 & 3] * x[s2]; }
                    x[t] = a0 + a1; }
#pragma unroll
                for (int t = 9; t < 13; ++t)
#pragma unroll
                    for (int q = 0; q < 4; ++q) if (4 * q < t) ar[t][q] = *(const LAS f32x4*)(A + t * 16 + 4 * q);
                LGKM0();
#pragma unroll
                for (int t = 9; t < 13; ++t) { float a0 = (t == lj) ? 1.f : 0.f, a1 = 0.f;
#pragma unroll
                    for (int s2 = 0; s2 < t; ++s2) { if (s2 & 1) a1 -= ar[t][s2 >> 2][s2 & 3] * x[s2]; else a0 -= ar[t][s2 >> 2][s2 & 3] * x[s2]; }
                    x[t] = a0 + a1; }
#pragma unroll
                for (int t = 13; t < 16; ++t)
#pragma unroll
                    for (int q = 0; q < 4; ++q) if (4 * q < t) ar[t][q] = *(const LAS f32x4*)(A + t * 16 + 4 * q);
                LGKM0();
#pragma unroll
                for (int t = 13; t < 16; ++t) { float a0 = (t == lj) ? 1.f : 0.f, a1 = 0.f;
#pragma unroll
                    for (int s2 = 0; s2 < t; ++s2) { if (s2 & 1) a1 -= ar[t][s2 >> 2][s2 & 3] * x[s2]; else a0 -= ar[t][s2 >> 2][s2 & 3] * x[s2]; }
                    x[t] = a0 + a1; }
                LAS bf16* D = (LAS bf16*)(lds + LA_DL) + wave * 256;
#pragma unroll
                for (int t = 0; t < 16; ++t) D[t * 16 + lane] = (bf16)f2bf(x[t]);
            }
#pragma unroll
            for (int i = 0; i < 4; ++i) { rhs[i] = unpack4(tr_read(lds + LA_QT, 16 * i + 4 * g, cb, n)); rti[i] = unpack4(tr_read(lds + LA_RT, 16 * i + 4 * g, cb, n)); vf[i] = (s16x4){0, 0, 0, 0}; y1a[i] = (f32x4){0.f, 0.f, 0.f, 0.f}; hma[i] = y1a[i]; }
        }
#pragma unroll
        for (int i = 0; i < 4; ++i)
#pragma unroll
            for (int k = 0; k < 4; ++k) { if (k < i) fqb[i * (i - 1) / 2 + k] = row_read4(AQB, 16 * i + n, 16 * k + 4 * g); if (k <= i) frb[i * (i + 1) / 2 + k] = row_read4(ARB, 16 * i + n, 16 * k + 4 * g);
                fbt[4 * i + k] = tr_read(lds + LA_BT, 16 * k + 4 * g, i, n); }
        LDS_BARRIER();
        STAMP_END(3); STAMP_BEGIN(4);
        {
            s16x4 df[4];
#pragma unroll
            for (int i = 0; i < 4; ++i) df[i] = *(const LAS s16x4*)(lds + LA_DL + i * 512 + n * 32 + 8 * g);
            const float plv[4] = {PLs[n], PLs[16 + n], PLs[32 + n], PLs[48 + n]};
            LGKM0();
#pragma unroll
            for (int i = 0; i < 4; ++i) { f32x4 acc = rhs[i];
#pragma unroll
                for (int k = 0; k < 4; ++k) if (k < i) acc = MFMA16(fqb[i * (i - 1) / 2 + k], xn[k], acc);
                const f32x4 xi = MFMA16(df[i], pack4(acc), ((f32x4){0.f, 0.f, 0.f, 0.f}));
                xn[i] = pack4n(xi); }
            if (!isU) {
                bf16* RH = (bf16*)(a.ws + WS_RH) + (size_t)unit * 4096;
#pragma unroll
                for (int i = 0; i < 4; ++i) { f32x4 acc = rti[i];
#pragma unroll
                    for (int k = 0; k < 4; ++k) if (k <= i) acc = MFMA16(frb[i * (i + 1) / 2 + k], xn[k], acc);
#pragma unroll
                    for (int j = 0; j < 4; ++j) RH[(16 * i + 4 * g + j) * 64 + 16 * cb + n] = (bf16)f2bf(acc[j]); }
                bf16* GT = (bf16*)(a.ws + WS_GT) + (size_t)unit * 4096;
#pragma unroll
                for (int c2b = 0; c2b < 4; ++c2b) { f32x4 acc = (f32x4){0.f, 0.f, 0.f, 0.f};
#pragma unroll
                    for (int k = 0; k < 4; ++k) acc = MFMA16(xn[k], fbt[4 * c2b + k], acc);
                    acc *= plv[c2b]; *(v2u*)(GT + (16 * c2b + n) * 64 + 16 * cb + 4 * g) = __builtin_bit_cast(v2u, pack4(acc)); }
            } else {
                float* Y1 = (float*)(a.ws + WS_Y1) + (size_t)unit * 4096;
#pragma unroll
                for (int i = 0; i < 4; ++i) { f32x4 acc = y1a[i];
#pragma unroll
                    for (int k = 0; k < 4; ++k) if (k <= i) acc = MFMA16(frb[i * (i + 1) / 2 + k], xn[k], acc);
#pragma unroll
                    for (int j = 0; j < 4; ++j) Y1[(16 * i + 4 * g + j) * 64 + 16 * cb + n] = acc[j]; }
                float* HM = (float*)(a.ws + WS_HM) + (size_t)unit * 4096;
#pragma unroll
                for (int c2b = 0; c2b < 4; ++c2b) { f32x4 acc = hma[c2b];
#pragma unroll
                    for (int k = 0; k < 4; ++k) acc = MFMA16(xn[k], fbt[4 * c2b + k], acc);
#pragma unroll
                    for (int j = 0; j < 4; ++j) HM[(16 * cb + 4 * g + j) * 64 + 16 * c2b + n] = acc[j] * plv[c2b]; }
            }
            if (wave == 0) ((float*)(a.ws + WS_PLV))[(size_t)unit * 64 + lane] = PLs[lane];
        }
        LDS_BARRIER();
        STAMP_END(4); STAMP_END(5);
    }
}

constexpr int LB_SLOT = 13312, LB_NPIECE = 13, LB_PER_WAVE = 4, LB_NSLOT = 8, LB_DIST = 7;
__device__ __forceinline__ void chainB_issue(const Args& a, LAS unsigned char* lds, size_t unit, int vb, int step, int lw, int lane) {
    const unsigned char* gt = a.ws + WS_GT + unit * 8192; const unsigned char* hm = a.ws + WS_HM + unit * 16384 + vb * 4096; const unsigned char* pv = a.ws + WS_PLV + unit * 256;
#pragma unroll
    for (int i = 0; i < LB_PER_WAVE; ++i) { int p = lw + 4 * i; p = p < LB_NPIECE - 1 ? p : LB_NPIECE - 1;
        const unsigned char* src = (p < 8) ? gt + p * 1024 : ((p < 12) ? hm + (p - 8) * 1024 : pv);
        __builtin_amdgcn_global_load_lds((const unsigned*)(src + lane * 16), (LAS unsigned*)(lds + (step & (LB_NSLOT - 1)) * LB_SLOT + p * 1024), 16, 0, 0); }
}
struct ChainOps { s16x4 gf[4][4]; f32x4 hm[4], pl[4]; };
__device__ __forceinline__ void chainB_read(ChainOps& o, LAS unsigned char* sl, int n, int g) {
#pragma unroll
    for (int i = 0; i < 4; ++i) { o.hm[i] = *(const LAS f32x4*)(sl + 8192 + (n * 64 + 16 * i + 4 * g) * 4); o.pl[i] = *(const LAS f32x4*)(sl + 12288 + (16 * i + 4 * g) * 4);
#pragma unroll
        for (int k = 0; k < 4; ++k) o.gf[i][k] = *(const LAS s16x4*)(sl + (16 * i + n) * 128 + (16 * k + 4 * g) * 2); }
}
__device__ __forceinline__ void chainB_step(const ChainOps& o, f32x4 (&acc)[4], v2u* SF) {
    s16x4 sb[4]; f32x4 nx[4];
#pragma unroll
    for (int k = 0; k < 4; ++k) { sb[k] = pack4(acc[k]); SF[k * 64] = __builtin_bit_cast(v2u, sb[k]); }
#pragma unroll
    for (int i = 0; i < 4; ++i) nx[i] = o.pl[i] * acc[i] + o.hm[i];
#pragma unroll
    for (int k = 0; k < 4; ++k)
#pragma unroll
        for (int i = 0; i < 4; ++i) nx[i] = MFMA16(o.gf[i][k], sb[k], nx[i]);
#pragma unroll
    for (int i = 0; i < 4; ++i) acc[i] = nx[i];
}
__device__ __forceinline__ void scanB(const Args& a, LAS unsigned char* lds) {
    const int tid = threadIdx.x, lane = tid & 63, wave = __builtin_amdgcn_readfirstlane(tid >> 6), n = lane & 15, g = lane >> 4;
    constexpr int NCK = SEQ / 64;
    const int nit = BATCH * NHEAD * 4, ib0 = ((int)gridDim.x >= nit && (nit % 8) == 0 && (int)blockIdx.x < nit) ? ((int)blockIdx.x % 8) * (nit / 8) + (int)blockIdx.x / 8 : (int)blockIdx.x;
    for (int item = ib0; item < nit; item += gridDim.x) {
        const int bh = item >> 2, vb = item & 3;
        const size_t u0 = (size_t)bh * 64;
        f32x4 acc[4];
#pragma unroll
        for (int i = 0; i < 4; ++i) acc[i] = (f32x4){0.f, 0.f, 0.f, 0.f};
        if (wave >= 4) {
#pragma unroll
            for (int s = 0; s < LB_DIST; ++s) chainB_issue(a, lds, u0 + s, vb, s, wave - 4, lane);
            asm volatile("s_waitcnt vmcnt(20)" ::: "memory"); }
        __builtin_amdgcn_s_barrier(); asm volatile("" ::: "memory");
        if (wave >= 4) {
            for (int ck = 0; ck < NCK; ++ck) {
                if (ck + LB_DIST < NCK) { chainB_issue(a, lds, u0 + ck + LB_DIST, vb, ck + LB_DIST, wave - 4, lane); asm volatile("s_waitcnt vmcnt(20)" ::: "memory"); }
                else asm volatile("s_waitcnt vmcnt(0)" ::: "memory");
                __builtin_amdgcn_s_barrier(); asm volatile("" ::: "memory");
            }
        } else if (wave == 0) {
            v2u* SF = (v2u*)(a.ws + WS_SF) + (u0 * 16 + vb * 4) * 64 + lane;
            ChainOps A, B;
            chainB_read(A, lds, n, g);
            for (int ck = 0; ck < NCK; ck += 2) {
                chainB_read(B, lds + ((ck + 1) & (LB_NSLOT - 1)) * LB_SLOT, n, g);
                chainB_step(A, acc, SF + (size_t)ck * 16 * 64);
                __builtin_amdgcn_s_barrier(); asm volatile("" ::: "memory");
                if (ck + 2 < NCK) chainB_read(A, lds + ((ck + 2) & (LB_NSLOT - 1)) * LB_SLOT, n, g);
                chainB_step(B, acc, SF + (size_t)(ck + 1) * 16 * 64);
                __builtin_amdgcn_s_barrier(); asm volatile("" ::: "memory");
            }
        } else {
            for (int ck = 0; ck < NCK; ++ck) { __builtin_amdgcn_s_barrier(); asm volatile("" ::: "memory"); }
        }
    }
}

__device__ __forceinline__ void scanC(const Args& a) {
    const int tid = threadIdx.x, lane = tid & 63, wave = tid >> 6, n = lane & 15, g = lane >> 4;
    const int gw = blockIdx.x * NWAVES + wave, NGW = gridDim.x * NWAVES;
    struct Blk { s16x4 rf[4], rq[4], kq[4], vq[4], gq[4]; f32x4 y1[4]; };
    for (int unit = gw; unit < NUNIT; unit += NGW) {
        const int bh = unit >> 6, ck = unit & 63, b = bh >> 4, h = bh & 15;
        const v2u* SF = (const v2u*)(a.ws + WS_SF) + (size_t)unit * 16 * 64 + lane;
        const bf16* RH = (const bf16*)(a.ws + WS_RH) + (size_t)unit * 4096; const float* Y1 = (const float*)(a.ws + WS_Y1) + (size_t)unit * 4096;
        const size_t mb = (size_t)b * SEQ + 64 * ck + n;
        s16x4 sf[16];
#pragma unroll
        for (int q = 0; q < 16; ++q) sf[q] = __builtin_bit_cast(s16x4, SF[q * 64]);
        auto ldblk = [&](int i, Blk& B) {
#pragma unroll
            for (int vb = 0; vb < 4; ++vb) { const size_t o = (mb + 16 * i) * CW + h * 64 + 16 * vb + 4 * g;
                B.rq[vb] = *(const s16x4*)((const bf16*)(a.ws + WS_R) + o); B.kq[vb] = *(const s16x4*)((const bf16*)(a.ws + WS_K2) + o);
                B.vq[vb] = *(const s16x4*)((const bf16*)(a.ws + WS_V) + o); B.gq[vb] = *(const s16x4*)((const bf16*)(a.ws + WS_GG) + o);
                B.y1[vb] = *(const f32x4*)(Y1 + (16 * i + n) * 64 + 16 * vb + 4 * g); B.rf[vb] = *(const s16x4*)(RH + (16 * i + n) * 64 + 16 * vb + 4 * g); } };
        auto doblk = [&](int i, Blk& B) {
            f32x4 acc[4];
#pragma unroll
            for (int vb = 0; vb < 4; ++vb) { acc[vb] = B.y1[vb];
#pragma unroll
                for (int k = 0; k < 4; ++k) acc[vb] = MFMA16(sf[vb * 4 + k], B.rf[k], acc[vb]); }
            float s1 = 0.f;
#pragma unroll
            for (int vb = 0; vb < 4; ++vb) s1 += (acc[vb][0] + acc[vb][1]) + (acc[vb][2] + acc[vb][3]);
            s1 += __shfl_xor(s1, 16); s1 += __shfl_xor(s1, 32);
            const float mean = s1 * (1.f / 64.f); float s2 = 0.f;
#pragma unroll
            for (int vb = 0; vb < 4; ++vb)
#pragma unroll
                for (int j = 0; j < 4; ++j) { const float d = acc[vb][j] - mean; s2 += d * d; }
            s2 += __shfl_xor(s2, 16); s2 += __shfl_xor(s2, 32);
            const float rstd = 1.f / sqrtf(s2 * (1.f / 64.f) + GN_EPS);
            f32x4 rv[4], kv[4], vv[4], gv[4]; float dot = 0.f;
#pragma unroll
            for (int vb = 0; vb < 4; ++vb) { rv[vb] = unpack4(B.rq[vb]); kv[vb] = unpack4(B.kq[vb]); vv[vb] = unpack4(B.vq[vb]); gv[vb] = unpack4(B.gq[vb]);
                const f32x4 rk = *(const f32x4*)(a.in[I_RK] + h * 64 + 16 * vb + 4 * g);
#pragma unroll
                for (int j = 0; j < 4; ++j) dot += rv[vb][j] * kv[vb][j] * rk[j]; }
            dot += __shfl_xor(dot, 16); dot += __shfl_xor(dot, 32);
#pragma unroll
            for (int vb = 0; vb < 4; ++vb) { const int c = h * 64 + 16 * vb + 4 * g;
                const f32x4 lw = *(const f32x4*)(a.in[I_LNW] + c), lb = *(const f32x4*)(a.in[I_LNB] + c), be = *(const f32x4*)(a.in[I_BETAR] + c);
                const f32x4 o = ((acc[vb] - mean) * rstd * lw + lb + dot * vv[vb]) * gv[vb] * be;
                *(v2u*)((bf16*)(a.ws + WS_YMIX) + (mb + 16 * i) * DM + c) = __builtin_bit_cast(v2u, pack4(o)); } };
#pragma unroll 1
        for (int i = 0; i < 4; ++i) { Blk A; ldblk(i, A); doblk(i, A); }
    }
}

struct ConvItem { const float* W; bf16* WT; int N, ldd, k0, n0; size_t drow_lo, drow_hi; int win; };
__device__ __forceinline__ int win_row(int c) { return c < 3072 ? c : (c < SHIFTW ? 6144 + (c - 3072) : c - (SHIFTW - 3072)); }
constexpr int NCV_IN = 32 * 26, NCV_OUT = 32 * 8, NCV_E = 32 * 32 * 2, NCV_D = 32 * 8 * 8, NCONV = NCV_IN + NCV_OUT + 2 * NCV_E + NCV_D, CV_LDT = 528;
__device__ __forceinline__ ConvItem conv_decode(const Args& a, int r) {
    ConvItem c; unsigned char* ws = a.ws; c.win = 0;
    if (r < NCV_IN) { const int kb = r / 26, nb = r - kb * 26; c.W = a.in[I_WIN]; c.N = PROJW; c.WT = (bf16*)(ws + WS_WIN); c.ldd = DM; c.k0 = 64 * kb; c.n0 = 256 * nb; c.drow_lo = (size_t)c.n0; c.drow_hi = c.drow_lo + 128; c.win = 1; return c; } r -= NCV_IN;
    if (r < NCV_OUT) { const int kb = r >> 3, nb = r & 7; c.W = a.in[I_WOUT]; c.N = DM; c.WT = (bf16*)(ws + WS_WOUT); c.ldd = DM; c.k0 = 64 * kb; c.n0 = 256 * nb; c.drow_lo = (size_t)c.n0; c.drow_hi = c.drow_lo + 128; return c; } r -= NCV_OUT;
    if (r < 2 * NCV_E) { const int up = r >= NCV_E; if (up) r -= NCV_E; const int e = r >> 6, q = r & 63, kb = q >> 1, nb = q & 1;
        c.W = a.in[up ? I_WU : I_WG] + (size_t)e * DM * FF; c.N = FF; c.WT = (bf16*)(ws + WS_WGU); c.ldd = DM; c.k0 = 64 * kb; c.n0 = 256 * nb;
        c.drow_lo = (size_t)e * 1024 + 256 * (2 * nb) + (up ? 128 : 0); c.drow_hi = c.drow_lo + 256; return c; } r -= 2 * NCV_E;
    { const int e = r >> 6, q = r & 63, kb = q >> 3, nb = q & 7;
        c.W = a.in[I_WDN] + (size_t)e * FF * DM; c.N = DM; c.WT = (bf16*)(ws + WS_WD); c.ldd = FF; c.k0 = 64 * kb; c.n0 = 256 * nb; c.drow_lo = (size_t)e * DM + c.n0; c.drow_hi = c.drow_lo + 128; return c; }
}
__device__ __forceinline__ void conv_load(const ConvItem& c, int wave, int lane, f32x4 (&v)[8]) {
    const int col = c.n0 + 4 * lane; const float* p = c.W + (size_t)(c.k0 + 8 * wave) * c.N + col;
#pragma unroll
    for (int i = 0; i < 8; ++i) v[i] = (col < c.N) ? *(const f32x4*)(p + (size_t)i * c.N) : (f32x4){0.f, 0.f, 0.f, 0.f};
}
__device__ __forceinline__ void conv_finish(const ConvItem& c, const f32x4 (&v)[8], LAS unsigned char* tile, int wave, int lane) {
#pragma unroll
    for (int i = 0; i < 8; ++i) { v2u w; w.x = pk2(v[i][0], v[i][1]); w.y = pk2(v[i][2], v[i][3]); *(LAS v2u*)(tile + (8 * wave + i) * CV_LDT + 8 * lane) = w; }
    asm volatile("s_waitcnt lgkmcnt(0)" ::: "memory"); __builtin_amdgcn_s_barrier(); asm volatile("" ::: "memory");
    const int i16 = lane & 15, g = lane >> 4;
    s16x4 t[2][2][2];
#pragma unroll
    for (int cb = 0; cb < 2; ++cb)
#pragma unroll
        for (int h = 0; h < 2; ++h)
#pragma unroll
            for (int q = 0; q < 2; ++q) { const int r0 = 32 * h + 8 * g + 4 * q, c0 = 32 * wave + 16 * cb;
                t[cb][h][q] = __builtin_bit_cast(s16x4, __builtin_amdgcn_ds_read_tr16_b64_v4i16((LAS s16x4*)(tile + (r0 + (i16 >> 2)) * CV_LDT + (c0 + 4 * (i16 & 3)) * 2))); }
    asm volatile("s_waitcnt lgkmcnt(0)" ::: "memory");
#pragma unroll
    for (int cb = 0; cb < 2; ++cb) { const int col = 32 * wave + 16 * cb + i16;
        if (c.n0 + col < c.N) { const size_t drow = c.win ? (size_t)win_row(c.n0 + col) : (col < 128 ? c.drow_lo : c.drow_hi) + (col & 127);
            bf16* dst = c.WT + drow * (size_t)c.ldd + c.k0 + 8 * g;
#pragma unroll
            for (int h = 0; h < 2; ++h) { const v2u lo = __builtin_bit_cast(v2u, t[cb][h][0]), hi = __builtin_bit_cast(v2u, t[cb][h][1]); *(v4u*)(dst + 32 * h) = (v4u){lo.x, lo.y, hi.x, hi.y}; } } }
    __builtin_amdgcn_s_barrier(); asm volatile("" ::: "memory");
}
__device__ __forceinline__ void conv_range(const Args& a, LAS unsigned char* lds, int first, int count, int rank, int nranks) {
    const int tid = threadIdx.x, lane = tid & 63, wave = __builtin_amdgcn_readfirstlane(tid >> 6);
    LAS unsigned char* tile = lds + 32768;
    f32x4 va[8], vb[8]; ConvItem ca, cb; int k = rank;
    if (k < count) { ca = conv_decode(a, first + k); conv_load(ca, wave, lane, va); }
    while (k < count) {
        const int k2 = k + nranks;
        if (k2 < count) { cb = conv_decode(a, first + k2); conv_load(cb, wave, lane, vb); }
        conv_finish(ca, va, tile, wave, lane);
        if (k2 >= count) break;
        const int k3 = k2 + nranks;
        if (k3 < count) { ca = conv_decode(a, first + k3); conv_load(ca, wave, lane, va); }
        conv_finish(cb, vb, tile, wave, lane);
        k = k3; }
}
constexpr int CV_X2 = 192 * 7, CV_X6 = 128 * 11;
__device__ __forceinline__ void phase0(const Args& a, LAS unsigned char* lds) {
    const int tid = threadIdx.x, lane = tid & 63, wave = __builtin_amdgcn_readfirstlane(tid >> 6), G = gridDim.x, bid = blockIdx.x;
    unsigned char* ws = a.ws;
    LAS float* cact = (LAS float*)lds;
    LAS float* red = (LAS float*)(lds + 16384);
    if (bid < 192 || G < 192) {
        const float* c = a.in[I_C];
        for (int i = tid; i < 2 * DM; i += NTHR) { const float x = c[i]; cact[i] = x / (1.f + __expf(-x)); }
        __syncthreads();
        for (int item = bid; item < 192; item += G) {
            const int ro = lane >> 4, cq = lane & 15;
            const float* wp = a.in[I_WADA] + (size_t)(256 * wave + ro) * 12288 + 64 * item + 4 * cq;
            f32x4 acc0 = (f32x4){0.f, 0.f, 0.f, 0.f}, acc1 = acc0;
#pragma unroll 8
            for (int i = 0; i < 64; ++i) { const f32x4 wv = *(const f32x4*)(wp + (size_t)(4 * i) * 12288);
                const float c0 = cact[256 * wave + 4 * i + ro], c1 = cact[DM + 256 * wave + 4 * i + ro]; acc0 += c0 * wv; acc1 += c1 * wv; }
#pragma unroll
            for (int j = 0; j < 4; ++j) { float v0 = acc0[j], v1 = acc1[j]; v0 += __shfl_xor(v0, 16); v0 += __shfl_xor(v0, 32); v1 += __shfl_xor(v1, 16); v1 += __shfl_xor(v1, 32);
                if (ro == 0) { red[(wave * 2 + 0) * 64 + 4 * cq + j] = v0; red[(wave * 2 + 1) * 64 + 4 * cq + j] = v1; } }
            __syncthreads();
            if (tid < 128) { const int b = tid >> 6, cc = tid & 63; float s = a.in[I_BADA][64 * item + cc];
#pragma unroll
                for (int w2 = 0; w2 < 8; ++w2) s += red[(w2 * 2 + b) * 64 + cc];
                ((float*)(ws + WS_MOD))[b * 12288 + 64 * item + cc] = s; }
            __syncthreads();
        }
    }
    { constexpr int NPRE = 5;
      const bool pre = (G == 256), mine = pre && bid >= 192;
      const int ncv = pre ? NCONV - CV_X2 - CV_X6 : NCONV;
      const int pool0 = pre ? 64 * NPRE : 0;
      auto item_of = [&](int j) -> int { if (mine) { if (j < NPRE) return (bid - 192) + 64 * j; j -= NPRE; } return pool0 + bid + G * j; };
      LAS unsigned char* tile = lds + 32768;
      f32x4 va[8], vb[8]; ConvItem ca, cb; int j = 0; int ia = item_of(0);
      if (ia < ncv) { ca = conv_decode(a, ia); conv_load(ca, wave, lane, va); }
      while (ia < ncv) {
          const int ib = item_of(j + 1);
          if (ib < ncv) { cb = conv_decode(a, ib); conv_load(cb, wave, lane, vb); }
          conv_finish(ca, va, tile, wave, lane);
          if (ib >= ncv) break;
          const int ic = item_of(j + 2);
          if (ic < ncv) { ca = conv_decode(a, ic); conv_load(ca, wave, lane, va); }
          conv_finish(cb, vb, tile, wave, lane);
          ia = ic; j += 2; } }
    const int gt = bid * NTHR + tid, NGT = G * NTHR;
    bf16* wl = (bf16*)(ws + WS_WL);
    for (int idx = gt; idx < LORA_N * LORA_K; idx += NGT) { const int n = idx / LORA_K, k = idx - n * LORA_K; float v = 0.f;
        if (n < 1024) { if (k < 64) v = a.in[I_WDEC][k * 1024 + n]; }
        else if (n < 2048) { if (k >= 64 && k < 128) v = a.in[I_WAAA][(k - 64) * 1024 + (n - 1024)]; }
        else { if (k >= 128 && k < 288) v = a.in[I_WGATEUP][(k - 128) * 1024 + (n - 2048)]; }
        wl[idx] = (bf16)f2bf(v); }
    float* w36 = (float*)(ws + WS_W36);
    for (int idx = gt; idx < DM * 36; idx += NGT) { const int e = idx >> 11, dd = idx & (DM - 1);
        w36[idx] = (e < 4) ? a.in[I_WGRP][dd * 4 + e] : a.in[I_WEXP][((size_t)((e - 4) >> 3) * DM + dd) * 8 + ((e - 4) & 7)]; }
    v4u* wz = (v4u*)(ws + WS_WIN + (size_t)PROJW * DM * 2);
    for (int idx = gt; idx < (PROJP - PROJW) * DM / 8; idx += NGT) wz[idx] = (v4u){0u, 0u, 0u, 0u};
}

__device__ __forceinline__ void phase1(const Args& a) {
    const int tid = threadIdx.x, lane = tid & 63, wave = tid >> 6;
    const int gw = blockIdx.x * NWAVES + wave, NGW = gridDim.x * NWAVES;
    const float* mod = (const float*)(a.ws + WS_MOD);
    auto ldrow = [&](int m, f32x4 (&v)[8]) { const f32x4* xr = (const f32x4*)(a.in[I_X] + (size_t)m * DM) + lane;
#pragma unroll
        for (int j = 0; j < 8; ++j) v[j] = xr[64 * j]; };
    auto dorow = [&](int m, f32x4 (&v)[8]) { const int b = m >> 12; float s = 0.f;
#pragma unroll
        for (int j = 0; j < 8; ++j) s += (v[j].x * v[j].x + v[j].y * v[j].y) + (v[j].z * v[j].z + v[j].w * v[j].w);
        const float rstd = 1.f / sqrtf(wave_sum(s) * (1.f / DM) + RMS_EPS);
        v2u* o8 = (v2u*)((bf16*)(a.ws + WS_HB) + (size_t)m * DM) + lane;
#pragma unroll
        for (int j = 0; j < 8; ++j) { const int c = 4 * (lane + 64 * j);
            const f32x4 g = *(const f32x4*)(a.in[I_N1G] + c), sh = *(const f32x4*)(mod + b * 12288 + c), sc = *(const f32x4*)(mod + b * 12288 + DM + c);
            const f32x4 h = v[j] * rstd * g * (1.f + sc) + sh; v2u o; o.x = pk2(h.x, h.y); o.y = pk2(h.z, h.w); o8[64 * j] = o; } };
    { f32x4 va[8], vb[8]; int m = gw; if (m < MTOK) ldrow(m, va);
      while (m < MTOK) { const int m2 = m + NGW; if (m2 < MTOK) ldrow(m2, vb); dorow(m, va); if (m2 >= MTOK) break;
          const int m3 = m2 + NGW; if (m3 < MTOK) ldrow(m3, va); dorow(m2, vb); m = m3; } }
}

__device__ __forceinline__ void router_bias(const Args& a, int w0, int nw) {
    const int lane = threadIdx.x & 63; const float* mod = (const float*)(a.ws + WS_MOD); const float* w36 = (const float*)(a.ws + WS_W36);
    for (int it = w0; it < 72; it += nw) { const int b = it / 36, e = it - b * 36; float s = 0.f;
#pragma unroll 8
        for (int dd = lane; dd < DM; dd += 64) s += mod[b * 12288 + 3 * DM + dd] * w36[e * DM + dd];
        s = wave_sum(s) + ((e < 4) ? a.in[I_BGRP][e] : a.in[I_BEXP][e - 4]);
        if (lane == 0) ((float*)(a.ws + WS_B36))[it] = s; }
}

__device__ __forceinline__ void phase3(const Args& a) {
    const int gt = blockIdx.x * NTHR + threadIdx.x, NGT = gridDim.x * NTHR;
    const bf16* P = (const bf16*)(a.ws + WS_PLR); bf16* AL = (bf16*)(a.ws + WS_AL);
    for (int idx = gt; idx < MTOK * 48; idx += NGT) { const int m = idx / 48, cj = idx - m * 48;
        v4u o = (v4u){0u, 0u, 0u, 0u};
        if (cj < 36) { const int col = 3072 + 8 * cj; const v4u pc = *(const v4u*)(P + (size_t)m * 288 + 8 * cj);
            v4u pp = (v4u){0u, 0u, 0u, 0u}; if ((m & (SEQ - 1)) != 0) pp = *(const v4u*)(P + (size_t)(m - 1) * 288 + 8 * cj);
            const float* mu = a.in[I_MU] + col; float r[8];
#pragma unroll
            for (int i = 0; i < 4; ++i) { const float c0 = bflo(pc[i]), c1 = bfhi(pc[i]), p0 = bflo(pp[i]), p1 = bfhi(pp[i]);
                r[2 * i] = c0 + (p0 - c0) * mu[2 * i]; r[2 * i + 1] = c1 + (p1 - c1) * mu[2 * i + 1]; }
            if (cj < 8) {
#pragma unroll
                for (int i = 0; i < 8; ++i) r[i] = tanhf(r[i]); }
            else if (cj >= 16) {
#pragma unroll
                for (int i = 0; i < 8; ++i) r[i] = sigmoid_f(r[i]); }
            o.x = pk2(r[0], r[1]); o.y = pk2(r[2], r[3]); o.z = pk2(r[4], r[5]); o.w = pk2(r[6], r[7]); }
        *(v4u*)(AL + (size_t)m * LORA_K + 8 * cj) = o; }
}

__device__ __forceinline__ int swz_off(int key, int chunk) { return key * 128 + ((chunk ^ ((key >> 1) & 7)) << 4); }
__device__ __forceinline__ void attn_issue_tile(const bf16* kcol, int key0, LAS unsigned char* buf, int wave) {
    __builtin_amdgcn_global_load_lds((const unsigned*)(kcol + (size_t)key0 * HD), (LAS unsigned*)(buf + wave * 1024), 16, 0, 0);
    __builtin_amdgcn_global_load_lds((const unsigned*)(kcol + HM_PART + (size_t)key0 * HD), (LAS unsigned*)(buf + 8192 + wave * 1024), 16, 0, 0);
}
__device__ __forceinline__ void phase5b(const Args& a, LAS unsigned char* lds) {
    STAMP_DECL;
    const int tid = threadIdx.x, lane = tid & 63, wave = __builtin_amdgcn_readfirstlane(tid >> 6), n = lane & 15, g = lane >> 4;
    const bf16* P = (const bf16*)(a.ws + WS_P); bf16* Y = (bf16*)(a.ws + WS_YMIX);
    LAS unsigned char* QL = lds + 65536; LAS float* biasA = (LAS float*)(lds + 81920);
    for (int i = tid; i < NHEAD * 257; i += NTHR) biasA[i] = a.in[I_RELB][i] * LOG2E;
    const float SC = 0.125f * LOG2E;
    const int skey = tid >> 3, sdcx = (tid & 7) ^ ((skey >> 1) & 7);
    LAS float* betaL = (LAS float*)(lds + 81920 + NHEAD * 257 * 4 + 64);
    for (int i = tid; i < CW; i += NTHR) betaL[i] = a.in[I_BETAA][i];
#define ATTN_PROLOGUE(U) do { const int cp_ = (U) & 31, h_ = ((U) >> 5) & 15, b_ = (U) >> 9; const int js_ = (8 - 2 * cp_) > 0 ? (8 - 2 * cp_) : 0, kb_ = 64 * (2 * cp_ - 8 + js_); \
        const bf16* Qh_ = P + 3 * HM_PART + (size_t)b_ * HM_BATCH + (size_t)h_ * HM_HEAD; const bf16* kc_ = Qh_ + HM_PART + (size_t)skey * HD + 8 * sdcx; \
        const bf16* qs_ = Qh_ + (size_t)(128 * cp_ + 16 * wave + (lane >> 3)) * HD + 8 * (lane & 7); \
        __builtin_amdgcn_global_load_lds((const unsigned*)qs_, (LAS unsigned*)(QL + wave * 2048), 16, 0, 0); \
        __builtin_amdgcn_global_load_lds((const unsigned*)(qs_ + (size_t)8 * HD), (LAS unsigned*)(QL + wave * 2048 + 1024), 16, 0, 0); \
        attn_issue_tile(kc_, kb_, lds, wave); attn_issue_tile(kc_, kb_ + 64, lds + 16384, wave); \
        if (js_ < 8) attn_issue_tile(kc_, kb_ + 128, lds + 32768, wave); } while (0)
    asm volatile("s_waitcnt vmcnt(0) lgkmcnt(0)" ::: "memory"); __builtin_amdgcn_s_barrier(); asm volatile("" ::: "memory");
    const int ubase = ((int)gridDim.x % 8 == 0) ? ((int)blockIdx.x % 8) * ((int)gridDim.x / 8) + (int)blockIdx.x / 8 : (int)blockIdx.x;
    if (ubase < BATCH * NHEAD * 32) ATTN_PROLOGUE(ubase);
    for (int u = ubase; u < BATCH * NHEAD * 32; u += gridDim.x) {
        const int cp = u & 31, h = (u >> 5) & 15, b = u >> 9;
        const int t0 = 128 * cp, qrow = t0 + 16 * wave + n;
        const bf16* Qh = P + 3 * HM_PART + (size_t)b * HM_BATCH + (size_t)h * HM_HEAD;
        const LAS float* biasL = biasA + h * 257;
        const int jstart = (8 - 2 * cp) > 0 ? (8 - 2 * cp) : 0, nt = 10 - jstart;
        const bf16* kcol = Qh + HM_PART + (size_t)skey * HD + 8 * sdcx;
        const int keyb = 64 * (2 * cp - 8 + jstart);
        if (nt > 2) asm volatile("s_waitcnt vmcnt(4)" ::: "memory"); else asm volatile("s_waitcnt vmcnt(2)" ::: "memory");
        __builtin_amdgcn_s_barrier(); asm volatile("" ::: "memory");
        bf16x8 qf[2]; qf[0] = *(const LAS bf16x8*)(QL + wave * 2048 + n * 128 + 16 * g); qf[1] = *(const LAS bf16x8*)(QL + wave * 2048 + n * 128 + 64 + 16 * g);
        float mrun = -1e30f, lrun = 0.f;
        f32x4 ot[4];
#pragma unroll
        for (int i = 0; i < 4; ++i) ot[i] = (f32x4){0.f, 0.f, 0.f, 0.f};
        const float bfar = biasL[256];
        for (int r = 0; r < nt; ++r) {
            const int j = jstart + r, key0 = keyb + 64 * r;
            if (r + 3 < nt) attn_issue_tile(kcol, key0 + 192, lds + ((r + 3) & 3) * 16384, wave);
            const bool active = (wave < 4) ? (j <= 8) : (j >= 1);
            STAMP_BEGIN(13);
            if (active) {
                LAS unsigned char* Kb = lds + (r & 3) * 16384; LAS unsigned char* Vb = Kb + 8192;
                f32x4 s[4];
                { bf16x8 kfr[4][2];
#pragma unroll
                  for (int st = 0; st < 4; ++st)
#pragma unroll
                      for (int ks = 0; ks < 2; ++ks) kfr[st][ks] = *(const LAS bf16x8*)(Kb + swz_off(16 * st + n, 4 * ks + g));
                  asm volatile("s_waitcnt lgkmcnt(0)" ::: "memory"); __builtin_amdgcn_sched_barrier(0);
#pragma unroll
                  for (int st = 0; st < 4; ++st) { s[st] = (f32x4){0.f, 0.f, 0.f, 0.f};
#pragma unroll
                      for (int ks = 0; ks < 2; ++ks) s[st] = __builtin_amdgcn_mfma_f32_16x16x32_bf16(kfr[st][ks], qf[ks], s[st], 0, 0, 0); } }
                s16x4 vtr[2][4][2];
                  const int q4 = n >> 2, p4 = n & 3;
#pragma unroll
                  for (int k2 = 0; k2 < 2; ++k2)
#pragma unroll
                      for (int nd = 0; nd < 4; ++nd) { const int ka = 32 * k2 + 4 * g + q4, ch = 2 * nd + (p4 >> 1);
                          vtr[k2][nd][0] = __builtin_bit_cast(s16x4, __builtin_amdgcn_ds_read_tr16_b64_v4i16((LAS s16x4*)(Vb + swz_off(ka, ch) + 8 * (p4 & 1))));
                          vtr[k2][nd][1] = __builtin_bit_cast(s16x4, __builtin_amdgcn_ds_read_tr16_b64_v4i16((LAS s16x4*)(Vb + swz_off(ka + 16, ch) + 8 * (p4 & 1)))); }
                const bool far = (t0 + 16 * wave) - (key0 + 63) >= 128;
                float mx = -1e30f;
                if (far) {
#pragma unroll
                    for (int st = 0; st < 4; ++st)
#pragma unroll
                        for (int jj = 0; jj < 4; ++jj) { const float sv = s[st][jj] * SC + bfar; s[st][jj] = sv; mx = fmaxf(mx, sv); }
                } else {
                    float bv[4][4];
#pragma unroll
                    for (int st = 0; st < 4; ++st)
#pragma unroll
                        for (int jj = 0; jj < 4; ++jj) { const int dist = qrow - (key0 + 16 * st + 4 * g + jj); bv[st][jj] = biasL[(dist < 128 ? dist : 128) + 128]; }
#pragma unroll
                    for (int st = 0; st < 4; ++st)
#pragma unroll
                        for (int jj = 0; jj < 4; ++jj) { const float sv = s[st][jj] * SC + bv[st][jj]; s[st][jj] = sv; mx = fmaxf(mx, sv); }
                }
                mx = fmaxf(mx, __shfl_xor(mx, 16)); mx = fmaxf(mx, __shfl_xor(mx, 32));
                const float mnew = fmaxf(mrun, mx), alpha = __builtin_amdgcn_exp2f(mrun - mnew); mrun = mnew;
                float ls = 0.f;
#pragma unroll
                for (int st = 0; st < 4; ++st)
#pragma unroll
                    for (int jj = 0; jj < 4; ++jj) { const float p = __builtin_amdgcn_exp2f(s[st][jj] - mnew); s[st][jj] = p; ls += p; }
                lrun = lrun * alpha + ls;
#pragma unroll
                for (int i = 0; i < 4; ++i) ot[i] *= alpha;
                {
                  asm volatile("s_waitcnt lgkmcnt(0)" ::: "memory"); __builtin_amdgcn_sched_barrier(0);
#pragma unroll
                  for (int k2 = 0; k2 < 2; ++k2) {
                      v4u pw; pw.x = pk2(s[2 * k2][0], s[2 * k2][1]); pw.y = pk2(s[2 * k2][2], s[2 * k2][3]); pw.z = pk2(s[2 * k2 + 1][0], s[2 * k2 + 1][1]); pw.w = pk2(s[2 * k2 + 1][2], s[2 * k2 + 1][3]);
                      const bf16x8 pf = __builtin_bit_cast(bf16x8, pw);
#pragma unroll
                      for (int nd = 0; nd < 4; ++nd) { const s16x4 v0 = vtr[k2][nd][0], v1 = vtr[k2][nd][1];
                          bf16x8 vf; vf[0] = v0[0]; vf[1] = v0[1]; vf[2] = v0[2]; vf[3] = v0[3]; vf[4] = v1[0]; vf[5] = v1[1]; vf[6] = v1[2]; vf[7] = v1[3];
                          ot[nd] = __builtin_amdgcn_mfma_f32_16x16x32_bf16(vf, pf, ot[nd], 0, 0, 0); } } }
            }
            STAMP_END(13); STAMP_BEGIN(12);
            if (r + 4 <= nt) asm volatile("s_waitcnt vmcnt(4)" ::: "memory"); else if (r + 3 == nt) asm volatile("s_waitcnt vmcnt(2)" ::: "memory"); else asm volatile("s_waitcnt vmcnt(0)" ::: "memory");
            asm volatile("s_waitcnt lgkmcnt(0)" ::: "memory"); __builtin_amdgcn_s_barrier(); asm volatile("" ::: "memory");
            STAMP_END(12);
        }
        if (u + (int)gridDim.x < BATCH * NHEAD * 32) ATTN_PROLOGUE(u + (int)gridDim.x);
        float lt = lrun; lt += __shfl_xor(lt, 16); lt += __shfl_xor(lt, 32);
        const float inv = __builtin_amdgcn_rcpf(lt);
        bf16* yp = Y + ((size_t)b * SEQ + qrow) * DM + 1024 + h * 64 + 4 * g;
        const LAS float* beta = betaL + h * 64 + 4 * g;
#pragma unroll
        for (int nd = 0; nd < 4; ++nd) { const f32x4 bt = *(const LAS f32x4*)(beta + 16 * nd); const f32x4 o = ot[nd] * inv * bt;
            v2u w; w.x = pk2(o[0], o[1]); w.y = pk2(o[2], o[3]); *(v2u*)(yp + 16 * nd) = w; }
    }
}

__device__ __forceinline__ void phase8(const Args& a, LAS unsigned char* lds) {
    const int tid = threadIdx.x, lane = tid & 63, wave = __builtin_amdgcn_readfirstlane(tid >> 6), n = lane & 15, g = lane >> 4;
    const float* mod = (const float*)(a.ws + WS_MOD); const float* W36 = (const float*)(a.ws + WS_W36); const bf16* X1 = (const bf16*)(a.ws + WS_X1);
    unsigned* ctl = (unsigned*)(a.ws + WS_CTL);
    LAS float* part = (LAS float*)lds;
    LAS float* ssp = (LAS float*)(lds + 49152);
    LAS float* lg = (LAS float*)(lds + 50176);
    for (int tile = blockIdx.x; tile < MTOK / 32; tile += gridDim.x) {
        const int m0 = 32 * tile, b = m0 >> 12;
        f32x4 acc[2][3]; float ss[2] = {0.f, 0.f};
#pragma unroll
        for (int rt = 0; rt < 2; ++rt)
#pragma unroll
            for (int ct = 0; ct < 3; ++ct) acc[rt][ct] = (f32x4){0.f, 0.f, 0.f, 0.f};
        const bf16* xrow = X1 + (size_t)(m0 + n) * DM + 256 * wave + 8 * g;
        const float* w0p = W36 + (size_t)n * DM + 256 * wave + 8 * g; const float* w1p = w0p + (size_t)16 * DM; const float* w2p = w0p + (size_t)(n < 4 ? 32 : 0) * DM;
        const float* gp = a.in[I_N2G] + 256 * wave + 8 * g; const float* sp = mod + b * 12288 + 4 * DM + 256 * wave + 8 * g;
#pragma unroll 2
        for (int Q = 0; Q < 8; ++Q) {
            const v4u xb0 = *(const v4u*)(xrow + 32 * Q), xb1 = *(const v4u*)(xrow + (size_t)16 * DM + 32 * Q);
#pragma unroll
            for (int hf = 0; hf < 2; ++hf) {
                f32x4 xa = (f32x4){bflo(xb0[2 * hf]), bfhi(xb0[2 * hf]), bflo(xb0[2 * hf + 1]), bfhi(xb0[2 * hf + 1])};
                f32x4 xc = (f32x4){bflo(xb1[2 * hf]), bfhi(xb1[2 * hf]), bflo(xb1[2 * hf + 1]), bfhi(xb1[2 * hf + 1])};
                const f32x4 ab = *(const f32x4*)(gp + 32 * Q + 4 * hf) * (1.f + *(const f32x4*)(sp + 32 * Q + 4 * hf));
                const f32x4 wa = *(const f32x4*)(w0p + 32 * Q + 4 * hf), wb = *(const f32x4*)(w1p + 32 * Q + 4 * hf); f32x4 wc = *(const f32x4*)(w2p + 32 * Q + 4 * hf);
                if (n >= 4) wc = (f32x4){0.f, 0.f, 0.f, 0.f};
                ss[0] += (xa[0] * xa[0] + xa[1] * xa[1]) + (xa[2] * xa[2] + xa[3] * xa[3]); xa *= ab;
                ss[1] += (xc[0] * xc[0] + xc[1] * xc[1]) + (xc[2] * xc[2] + xc[3] * xc[3]); xc *= ab;
#pragma unroll
                for (int r = 0; r < 4; ++r) {
                    acc[0][0] = __builtin_amdgcn_mfma_f32_16x16x4f32(xa[r], wa[r], acc[0][0], 0, 0, 0); acc[1][0] = __builtin_amdgcn_mfma_f32_16x16x4f32(xc[r], wa[r], acc[1][0], 0, 0, 0);
                    acc[0][1] = __builtin_amdgcn_mfma_f32_16x16x4f32(xa[r], wb[r], acc[0][1], 0, 0, 0); acc[1][1] = __builtin_amdgcn_mfma_f32_16x16x4f32(xc[r], wb[r], acc[1][1], 0, 0, 0);
                    acc[0][2] = __builtin_amdgcn_mfma_f32_16x16x4f32(xa[r], wc[r], acc[0][2], 0, 0, 0); acc[1][2] = __builtin_amdgcn_mfma_f32_16x16x4f32(xc[r], wc[r], acc[1][2], 0, 0, 0); } }
        }
#pragma unroll
        for (int rt = 0; rt < 2; ++rt) { ss[rt] += __shfl_xor(ss[rt], 16); ss[rt] += __shfl_xor(ss[rt], 32);
#pragma unroll
            for (int ct = 0; ct < 3; ++ct) *(LAS f32x4*)(part + (wave * 64 + lane) * 24 + rt * 12 + 4 * ct) = acc[rt][ct];
            if (lane < 16) ssp[wave * 32 + rt * 16 + lane] = ss[rt]; }
        __syncthreads();
        { const int tk = tid >> 4, sl = tid & 15, rt = tk >> 4, tkl = tk & 15;
            float s2 = 0.f;
#pragma unroll
            for (int w = 0; w < 8; ++w) s2 += ssp[w * 32 + tk];
            const float rstd = 1.f / sqrtf(s2 * (1.f / DM) + RMS_EPS);
            const float* b36 = (const float*)(a.ws + WS_B36) + b * 36;
#pragma unroll
            for (int q = 0; q < 3; ++q) { const int e = 16 * q + sl; if (q < 2 || sl < 4) { float s = 0.f;
#pragma unroll
                for (int w = 0; w < 8; ++w) s += part[(w * 64 + 16 * (tkl >> 2) + sl) * 24 + rt * 12 + 4 * q + (tkl & 3)];
                lg[tk * 40 + e] = s * rstd + b36[e]; } }
            if (sl == 0) ((float*)(a.ws + WS_RSTD))[m0 + tk] = rstd; }
        __syncthreads();
        if (tid < 32) {
            float l[36];
#pragma unroll
            for (int e = 0; e < 36; ++e) l[e] = lg[tid * 40 + e];
            int gi = 0; float gm = l[0];
#pragma unroll
            for (int i = 1; i < 4; ++i) if (l[i] > gm) { gm = l[i]; gi = i; }
            float gs = 0.f;
#pragma unroll
            for (int i = 0; i < 4; ++i) gs += expf(l[i] - gm);
            const float gwt = 1.f / gs;
            float el[8];
#pragma unroll
            for (int j = 0; j < 8; ++j) el[j] = (gi == 0) ? l[4 + j] : ((gi == 1) ? l[12 + j] : ((gi == 2) ? l[20 + j] : l[28 + j]));
            int i1 = 0; float m1 = el[0];
#pragma unroll
            for (int i = 1; i < 8; ++i) if (el[i] > m1) { m1 = el[i]; i1 = i; }
            int i2 = -1; float m2 = -3.0e38f;
#pragma unroll
            for (int i = 0; i < 8; ++i) if (i != i1 && el[i] > m2) { m2 = el[i]; i2 = i; }
            const float e2 = expf(m2 - m1); const float w1 = gwt / (1.f + e2), w2 = gwt * e2 / (1.f + e2);
            int* rt = (int*)(a.ws + WS_ROUTE) + (size_t)(m0 + tid) * 8; const int ge1 = gi * 8 + i1, ge2 = gi * 8 + i2;
            rt[0] = ge1; rt[1] = ge2; rt[2] = __float_as_int(w1); rt[3] = __float_as_int(w2);
            const int sl = (((m0 + tid) >> 4) & (NSLICE - 1)) * 32;
            atomicAdd(ctl + CW_CNT + sl + ge1, 1u); atomicAdd(ctl + CW_CNT + sl + ge2, 1u);
        }
        __syncthreads();
    }
}

__device__ __forceinline__ void phase9(const Args& a) {
    const int tid = threadIdx.x, lane = tid & 63, wave = tid >> 6;
    const int gw = blockIdx.x * NWAVES + wave, NGW = gridDim.x * NWAVES;
    unsigned* ctl = (unsigned*)(a.ws + WS_CTL);
    const float* mod = (const float*)(a.ws + WS_MOD);
    unsigned cnt = 0u;
    if (lane < NEXP) for (int s = 0; s < NSLICE; ++s) cnt += __hip_atomic_load(ctl + CW_CNT + s * 32 + lane, RLX_AGENT);
    const unsigned pad = (cnt + 255u) & ~255u;
    unsigned incl = pad;
#pragma unroll
    for (int o = 1; o < 64; o <<= 1) { const unsigned t = __shfl_up(incl, o); if (lane >= o) incl += t; }
    const unsigned off = incl - pad;
    if (gw == 0) {
        if (lane < NEXP) for (unsigned t = off >> 8; t < (off + pad) >> 8; ++t) ctl[CW_TE + t] = (unsigned)lane;
        if (lane == 63) ctl[CW_NRT] = incl >> 8;
    }
    for (int task = gw; task < MTOK / 4; task += NGW) {
        const int m0 = 4 * task, b = m0 >> 12, slice = (m0 >> 4) & (NSLICE - 1);
        unsigned sbase = 0u;
        if (lane < NEXP) for (int s = 0; s < slice; ++s) sbase += __hip_atomic_load(ctl + CW_CNT + s * 32 + lane, RLX_AGENT);
        const unsigned offs = off + sbase;
        int* rt = (int*)(a.ws + WS_ROUTE) + (size_t)(m0 + (lane & 3)) * 8;
        const int e1 = rt[0], e2 = rt[1];
        unsigned p1 = 0, p2 = 0;
        if (lane < 4) { p1 = atomicAdd(ctl + CW_POS + slice * 32 + e1, 1u); p2 = atomicAdd(ctl + CW_POS + slice * 32 + e2, 1u); }
        const unsigned s1v = __shfl(offs, e1) + p1, s2v = __shfl(offs, e2) + p2;
        if (lane < 4) { rt[4] = (int)s1v; rt[5] = (int)s2v; ((float*)(a.ws + WS_SW))[s1v] = __int_as_float(rt[2]); ((float*)(a.ws + WS_SW))[s2v] = __int_as_float(rt[3]); }
        v4u xa[4], xb[4];
        auto ldx = [&](int t, v4u (&x)[4]) { const v4u* xr = (const v4u*)((const bf16*)(a.ws + WS_X1) + (size_t)(m0 + t) * DM) + lane;
#pragma unroll
            for (int j = 0; j < 4; ++j) x[j] = xr[64 * j]; };
        auto dox = [&](int t, v4u (&x)[4]) { const unsigned s1 = __shfl(s1v, t), s2 = __shfl(s2v, t);
            const float rstd = ((const float*)(a.ws + WS_RSTD))[m0 + t];
            v4u* d1 = (v4u*)((bf16*)(a.ws + WS_H2P) + (size_t)s1 * DM) + lane; v4u* d2 = (v4u*)((bf16*)(a.ws + WS_H2P) + (size_t)s2 * DM) + lane;
#pragma unroll
            for (int j = 0; j < 4; ++j) { const int c = 8 * (lane + 64 * j); v4u o;
#pragma unroll
                for (int hf = 0; hf < 2; ++hf) { const int cc = c + 4 * hf;
                    const f32x4 g = *(const f32x4*)(a.in[I_N2G] + cc), sh = *(const f32x4*)(mod + b * 12288 + 3 * DM + cc), sc = *(const f32x4*)(mod + b * 12288 + 4 * DM + cc);
                    const f32x4 xv = (f32x4){bflo(x[j][2 * hf]), bfhi(x[j][2 * hf]), bflo(x[j][2 * hf + 1]), bfhi(x[j][2 * hf + 1])};
                    const f32x4 h = xv * rstd * g * (1.f + sc) + sh; o[2 * hf] = pk2(h.x, h.y); o[2 * hf + 1] = pk2(h.z, h.w); }
                d1[64 * j] = o; d2[64 * j] = o; } };
        ldx(0, xa); ldx(1, xb); dox(0, xa); ldx(2, xa); dox(1, xb); ldx(3, xb); dox(2, xa); dox(3, xb);
    }
}

__device__ __forceinline__ void phase12(const Args& a) {
    const int tid = threadIdx.x, lane = tid & 63, wave = tid >> 6;
    const int gw = blockIdx.x * NWAVES + wave, NGW = gridDim.x * NWAVES;
    const float* mod = (const float*)(a.ws + WS_MOD);
    struct Tok { v2u x[8]; v2u f1[8], f2[8]; };
    auto ldslots = [&](int m, int& s1, int& s2) { const int* rt = (const int*)(a.ws + WS_ROUTE) + (size_t)m * 8; s1 = rt[4]; s2 = rt[5]; };
    auto ldtok = [&](int m, int s1, int s2, Tok& t) { const v2u* xr = (const v2u*)((const bf16*)(a.ws + WS_X1) + (size_t)m * DM) + lane;
        const v2u* f1 = (const v2u*)((const bf16*)(a.ws + WS_FP) + (size_t)s1 * DM) + lane; const v2u* f2 = (const v2u*)((const bf16*)(a.ws + WS_FP) + (size_t)s2 * DM) + lane;
#pragma unroll
        for (int j = 0; j < 8; ++j) { t.x[j] = xr[64 * j]; t.f1[j] = f1[64 * j]; t.f2[j] = f2[64 * j]; } };
    auto dotok = [&](int m, Tok& t) { const int b = m >> 12; float s = 0.f; f32x4 v[8];
#pragma unroll
        for (int j = 0; j < 8; ++j) { const int c = 4 * (lane + 64 * j); const f32x4 g2 = *(const f32x4*)(mod + b * 12288 + 5 * DM + c);
            const v2u a1 = t.f1[j], a2 = t.f2[j]; f32x4 f;
            f.x = bflo(a1.x) + bflo(a2.x); f.y = bfhi(a1.x) + bfhi(a2.x); f.z = bflo(a1.y) + bflo(a2.y); f.w = bfhi(a1.y) + bfhi(a2.y);
            v[j] = (f32x4){bflo(t.x[j].x), bfhi(t.x[j].x), bflo(t.x[j].y), bfhi(t.x[j].y)} + g2 * f; s += (v[j].x * v[j].x + v[j].y * v[j].y) + (v[j].z * v[j].z + v[j].w * v[j].w); }
        const float rstd = 1.f / sqrtf(wave_sum(s) * (1.f / DM) + RMS_EPS);
        f32x4* op = (f32x4*)(a.out + (size_t)m * DM) + lane;
#pragma unroll
        for (int j = 0; j < 8; ++j) { const int c = 4 * (lane + 64 * j); const f32x4 g = *(const f32x4*)(a.in[I_NFG] + c); op[64 * j] = v[j] * rstd * g; } };
    { Tok ta, tb; int m = gw, sa1 = 0, sa2 = 0, sb1 = 0, sb2 = 0;
      if (m < MTOK) { ldslots(m, sa1, sa2); if (m + NGW < MTOK) ldslots(m + NGW, sb1, sb2); ldtok(m, sa1, sa2, ta); }
      while (m < MTOK) { const int m2 = m + NGW, m3 = m2 + NGW, m4 = m3 + NGW;
          if (m3 < MTOK) ldslots(m3, sa1, sa2);
          if (m2 < MTOK) ldtok(m2, sb1, sb2, tb);
          dotok(m, ta); if (m2 >= MTOK) break;
          if (m4 < MTOK) ldslots(m4, sb1, sb2);
          if (m3 < MTOK) ldtok(m3, sa1, sa2, ta);
          dotok(m2, tb); m = m3; } }
}

#ifndef MK_ONE_LAUNCH
#define MK_ONE_LAUNCH 1
#endif
__global__ void __launch_bounds__(NTHR, 2) mega_fwd(Args args) {
    extern __shared__ __attribute__((aligned(16))) unsigned char lds_raw[];
    LAS unsigned char* lds = (LAS unsigned char*)lds_raw;
    const int tid = threadIdx.x;
    for (int u = tid; u < (LDS_BYTES - LDSCTL_OFF) / 4; u += NTHR) ((LAS unsigned*)(lds + LDSCTL_OFF))[u] = 0u;
    __syncthreads();
    volatile LAS unsigned* MISC = (volatile LAS unsigned*)(lds + MISC_OFF);
    unsigned* ctl = (unsigned*)(args.ws + WS_CTL);
    unsigned* barw = ctl + CW_BAR + args.li * XCD_BAR_WORDS;
    XcdBarrier bar; bar.bar = barw; bar.x = 0; bar.st = nullptr;
    const bool multi = (args.ph_hi - args.ph_lo) > 1;
    if (multi) bar = xcd_barrier_post(barw, MISC + 8);
    const int lo = args.ph_lo, hi = args.ph_hi, G = gridDim.x;
#define IN(k) (lo <= (k) && (k) < hi)
#define SEAM(k) do { if (IN(k) && IN((k) + 1)) xcd_barrier(bar); } while (0)
    const Args& a = args; STAMP_DECL;
#define PH_BEGIN(k) STAMP_BEGIN(100 + (k))
#define PH_END(k) STAMP_END(100 + (k))
    if (IN(0)) { PH_BEGIN(0); STAMP_BEGIN(20); phase0(args, lds); STAMP_END(20); } SEAM(0); if (IN(0)) PH_END(0);
    if (IN(1)) { PH_BEGIN(1); phase1(args); } SEAM(1); if (IN(1)) PH_END(1);
    if (IN(2)) { PH_BEGIN(2); pg8::Gemm g{(const pg8::bf16_t*)(args.ws + WS_HB), (const pg8::bf16_t*)(args.ws + WS_WIN), MTOK, PROJP, DM}; pg8::StaticOrder S; S.init(MTOK, PROJP, G, (int)blockIdx.x);
        EpiProj E{(bf16*)(args.ws + WS_P), (bf16*)(args.ws + WS_PLR)};
        pg8::gemm_phase<EpiProj, pg8::StaticOrder, true, true>(lds, g, S, E);
        if (G == 256 && (int)blockIdx.x >= 64) conv_range(args, lds, NCONV - CV_X2 - CV_X6, CV_X2, (int)blockIdx.x - 64, 192); } SEAM(2); if (IN(2)) PH_END(2);
    if (IN(3)) { PH_BEGIN(3); STAMP_BEGIN(10); phase3(args); STAMP_END(10); STAMP_BEGIN(11); phase5b(args, lds); STAMP_END(11); } SEAM(3); if (IN(3)) PH_END(3);
    if (IN(4)) { PH_BEGIN(4); pg8::Gemm g{(const pg8::bf16_t*)(args.ws + WS_AL), (const pg8::bf16_t*)(args.ws + WS_WL), MTOK, LORA_N, LORA_K}; pg8::StaticOrder S; S.init(MTOK, LORA_N, G, (int)blockIdx.x);
        EpiLora E{(float*)(args.ws + WS_LW), (bf16*)(args.ws + WS_AA), (bf16*)(args.ws + WS_GG)};
        pg8::gemm_phase<EpiLora, pg8::StaticOrder, true, true>(lds, g, S, E); } SEAM(4); if (IN(4)) PH_END(4);
    if (IN(5)) { PH_BEGIN(5); STAMP_BEGIN(30); scanA(args, lds); STAMP_END(30); } SEAM(5); if (IN(5)) PH_END(5);
    if (IN(6)) { PH_BEGIN(6); scanB(args, lds); if ((int)blockIdx.x >= (int)gridDim.x - 9) router_bias(args, ((int)gridDim.x - 1 - (int)blockIdx.x) * NWAVES + (tid >> 6), 9 * NWAVES); if (G == 256 && (int)blockIdx.x >= 128) conv_range(args, lds, NCONV - CV_X6, CV_X6, (int)blockIdx.x - 128, 128); } SEAM(6); if (IN(6)) PH_END(6);
    if (IN(7)) { PH_BEGIN(7); scanC(args); } SEAM(7); if (IN(7)) PH_END(7);
    if (IN(8)) { PH_BEGIN(8); pg8::Gemm g{(const pg8::bf16_t*)(args.ws + WS_YMIX), (const pg8::bf16_t*)(args.ws + WS_WOUT), MTOK, DM, DM}; pg8::StaticOrder S; S.init(MTOK, DM, G, (int)blockIdx.x);
        EpiResGate E{args.in[I_X], (const float*)(args.ws + WS_MOD) + 2 * DM, (bf16*)(args.ws + WS_X1)};
        pg8::gemm_phase<EpiResGate, pg8::StaticOrder, true, true>(lds, g, S, E); } SEAM(8); if (IN(8)) PH_END(8);
    if (IN(9)) { PH_BEGIN(9); phase8(args, lds); } SEAM(9); if (IN(9)) PH_END(9);
    if (IN(10)) { PH_BEGIN(10); phase9(args); } SEAM(10); if (IN(10)) PH_END(10);
    if (IN(11) || IN(12) || IN(13)) {
        const int nrt = (int)__hip_atomic_load(ctl + CW_NRT, RLX_AGENT), c = (int)blockIdx.x;
        const int Ugu = 4 * nrt, nB = Ugu > G ? Ugu - G : 0, R0 = (Ugu < G ? Ugu : G) / 4, E2 = (8 * R0 < 2 * (G - nB)) ? 8 * R0 : 2 * (G - nB);
        const pg8::Gemm gu{(const pg8::bf16_t*)(args.ws + WS_H2P), (const pg8::bf16_t*)(args.ws + WS_WGU), nrt * 256, NEXP * 1024, DM};
        const pg8::Gemm gd{(const pg8::bf16_t*)(args.ws + WS_HG), (const pg8::bf16_t*)(args.ws + WS_WD), nrt * 256, NEXP * DM, FF};
        const EpiGateUp Eu{(const float*)(args.ws + WS_SW), (bf16*)(args.ws + WS_HG)};
        const EpiStoreBf16 Ed{(bf16*)(args.ws + WS_FP), DM, 7};
        if (IN(11)) { PH_BEGIN(11); GroupOrder2 S{ctl + CW_TE, 4, 0, Ugu < G ? Ugu : G, G, c}; pg8::gemm_phase<EpiGateUp, GroupOrder2, true, true>(lds, gu, S, Eu); } SEAM(11); if (IN(11)) PH_END(11);
        if (IN(12)) { PH_BEGIN(12); if (c < nB) { GroupOrder2 S{ctl + CW_TE, 4, G, nB, nB, c}; pg8::gemm_phase<EpiGateUp, GroupOrder2, true, true>(lds, gu, S, Eu); }
                      else { GroupOrder2 S{ctl + CW_TE, 8, 0, E2, G - nB, c - nB}; pg8::gemm_phase<EpiStoreBf16, GroupOrder2, true, true>(lds, gd, S, Ed); } } SEAM(12); if (IN(12)) PH_END(12);
        if (IN(13)) { PH_BEGIN(13); GroupOrder2 S{ctl + CW_TE, 8, E2, 8 * nrt - E2, G, c}; pg8::gemm_phase<EpiStoreBf16, GroupOrder2, true, true>(lds, gd, S, Ed); } SEAM(13); if (IN(13)) PH_END(13);
    }
    if (IN(14)) { PH_BEGIN(14); phase12(args); PH_END(14); }
#ifdef STAMP_ID
    if (blockIdx.x == 0 && tid == 0 && IN(NPH - 1)) { const unsigned dly = STAMP_MULT * __hip_atomic_load(ctl + CW_STAMP, RLX_AGENT); const unsigned long long t0_ = __builtin_amdgcn_s_memrealtime();
        while (__builtin_amdgcn_s_memrealtime() - t0_ < (unsigned long long)dly) __builtin_amdgcn_s_sleep(8); }
#endif
#ifdef EXTRA_BARRIERS
    if (multi) for (int i_ = 0; i_ < EXTRA_BARRIERS; ++i_) xcd_barrier(bar);
#endif
#undef IN
#undef SEAM
}

extern "C" void kernel_launch(void* const* d_in, const int* in_sizes, int n_in, void* d_out, int out_size, void* d_ws, size_t ws_size, hipStream_t stream) {
    static int grid = 0;
    if (grid == 0) {
        if (n_in != 30 || out_size != MTOK * DM || ws_size < WS_END) { fprintf(stderr, "kernel_launch: unexpected shapes (n_in %d, out %d, ws %zu)\n", n_in, out_size, ws_size); grid = -1; return; }
        int dev = 0, cus = 0, per_cu = 0;
        if (hipGetDevice(&dev) != hipSuccess || hipDeviceGetAttribute(&cus, hipDeviceAttributeMultiprocessorCount, dev) != hipSuccess) { grid = -1; return; }
        if (hipFuncSetAttribute((const void*)mega_fwd, hipFuncAttributeMaxDynamicSharedMemorySize, LDS_BYTES) != hipSuccess) { grid = -1; return; }
        if (hipOccupancyMaxActiveBlocksPerMultiprocessor(&per_cu, (const void*)mega_fwd, NTHR, LDS_BYTES) != hipSuccess || per_cu < 1) { fprintf(stderr, "kernel_launch: occupancy query says %d\n", per_cu); grid = -1; (void)hipGetLastError(); return; }
        grid = cus;
    }
    if (grid < 0) return;
    (void)hipMemsetAsync((char*)d_ws + WS_CTL, 0, CTL_ZERO_BYTES, stream);
    Args a{};
    for (int i = 0; i < 30; ++i) a.in[i] = (const float*)d_in[i];
    a.out = (float*)d_out; a.ws = (unsigned char*)d_ws;
#if MK_ONE_LAUNCH
#ifdef PROBE_PHASE
    const int cuts[3] = {0, PROBE_PHASE, NPH};
    for (int li = 0; li < 2; ++li) { a.ph_lo = cuts[li]; a.ph_hi = cuts[li + 1] + ((li == 0) ? PROBE_REPEAT : 0); a.li = li;
        void* kargs[] = {&a};
        hipError_t e = hipLaunchCooperativeKernel((const void*)mega_fwd, dim3(grid), dim3(NTHR), kargs, LDS_BYTES, stream);
        if (e != hipSuccess) fprintf(stderr, "cooperative launch failed: %s\n", hipGetErrorString(e)); }
#else
    a.ph_lo = 0; a.ph_hi = NPH;
    void* kargs[] = {&a};
    hipError_t e = hipLaunchCooperativeKernel((const void*)mega_fwd, dim3(grid), dim3(NTHR), kargs, LDS_BYTES, stream);
    if (e != hipSuccess) fprintf(stderr, "cooperative launch failed: %s\n", hipGetErrorString(e));
#endif
#else
    for (int p = 0; p < NPH; ++p) { a.ph_lo = p; a.ph_hi = p + 1; hipLaunchKernelGGL(mega_fwd, dim3(grid), dim3(NTHR), LDS_BYTES, stream, a); }
#endif
}
```
